# Optimizing an MI355X kernel written in HIP

```python
import jax, jax.numpy as jnp
from jax import lax
import numpy as np

D_MODEL = 1024
BATCH = 16
SEQ = 4096
DEPTH = 4

GRID_W = 64
CTX_LEN = 256
N_MOD = 6
EPS = 1e-6
ROPE_BASE = 10000.0
QBLK = 128
NEG_INF = -1e30
A_HEADS = 12
A_NOPE = 64
A_ROPE = 32
A_QK = A_NOPE + A_ROPE
A_V = 64
A_Q_LORA = 256
A_KV_LORA = 128
A_IN = A_Q_LORA + A_KV_LORA + A_ROPE
B_GROUPS = 4
B_GDIM = 64
B_WIDTH = B_GROUPS * B_GDIM
EVEN_IN = A_IN + B_WIDTH
EVEN_MIX = A_HEADS * A_V + B_WIDTH
C_HEADS = 12
C_KV_HEADS = 4
C_GROUP = C_HEADS // C_KV_HEADS
C_HDIM = 64
C_WINDOW = 128
C_QW = C_HEADS * C_HDIM
C_KW = C_KV_HEADS * C_HDIM
D_GROUPS = 4
D_GDIM = 64
D_WIDTH = D_GROUPS * D_GDIM
D_WINDOWS = (2, 4, 8, 16)
ODD_IN = C_QW + 2 * C_KW + D_WIDTH
ODD_MIX = C_QW + D_WIDTH
D_FF = 2816
CONV_W = 3
N_EVEN = (DEPTH + 1) // 2
N_ODD = DEPTH // 2

kernel_name = 'hybrid_mla_fnet_swa_pool_dit'


def rmsnorm(x, g):
    xf = x.astype(jnp.float32)
    y = xf * lax.rsqrt(jnp.mean(xf * xf, axis=-1, keepdims=True) + EPS)
    return (y * g.astype(jnp.float32)).astype(x.dtype)


def modulate(u, shift, scale):
    return u * (1 + scale) + shift


def axial_rope_tables(rows, rot_dim, dtype):
    n_freq = rot_dim // 4
    inv = ROPE_BASE ** (-jnp.arange(n_freq, dtype=jnp.float32) / n_freq)
    row = jnp.broadcast_to(jnp.arange(rows, dtype=jnp.float32)[:, None], (rows, GRID_W)).reshape(-1)
    col = jnp.broadcast_to(jnp.arange(GRID_W, dtype=jnp.float32)[None, :], (rows, GRID_W)).reshape(-1)
    ang = jnp.concatenate([row[:, None] * inv, col[:, None] * inv], axis=-1)
    return jnp.cos(ang).astype(dtype), jnp.sin(ang).astype(dtype)


def apply_rope(x, cos, sin):
    h = x.shape[-1] // 2
    x1, x2 = x[..., :h], x[..., h:]
    cs, sn = cos[None, :, None, :], sin[None, :, None, :]
    return jnp.concatenate([x1 * cs - x2 * sn, x1 * sn + x2 * cs], axis=-1)


def attend_grouped(q, k, v, scale, sink=None):
    s = jnp.einsum('bqkgd,bskd->bkgqs', q, k).astype(jnp.float32) * scale
    if sink is not None:
        sk = jnp.broadcast_to(sink.astype(jnp.float32)[None, :, :, None, None], s.shape[:-1] + (1,))
        s = jnp.concatenate([s, sk], axis=-1)
    p = jax.nn.softmax(s, axis=-1)[..., :k.shape[1]].astype(v.dtype)
    return jnp.einsum('bkgqs,bskd->bqkgd', p, v)


def latent_dense_attention(q, k, v, k_ctx, v_ctx, scale):
    B, L, H, dq = q.shape
    nb = L // QBLK
    n_ctx = k_ctx.shape[1]
    qb = jnp.moveaxis(q.reshape(B, nb, QBLK, H, dq), 1, 0)

    def block(qi):
        s = jnp.concatenate([jnp.einsum('bqhd,bchd->bhqc', qi, k_ctx),
                             jnp.einsum('bqhd,bkhd->bhqk', qi, k)], axis=-1).astype(jnp.float32) * scale
        p = jax.nn.softmax(s, axis=-1).astype(v.dtype)
        return (jnp.einsum('bhqc,bchd->bqhd', p[..., :n_ctx], v_ctx)
                + jnp.einsum('bhqk,bkhd->bqhd', p[..., n_ctx:], v))

    o = lax.map(block, qb)
    return jnp.moveaxis(o, 0, 1).reshape(B, L, -1)


def window_attention(q, k, v, k_ctx, v_ctx, sink, scale):
    B, L = q.shape[:2]
    nb = L // QBLK
    n_ctx = k_ctx.shape[1]
    span = 3 * QBLK
    pad = ((0, 0), (QBLK, QBLK), (0, 0), (0, 0))
    k_pad, v_pad = jnp.pad(k, pad), jnp.pad(v, pad)
    qb = jnp.moveaxis(q.reshape((B, nb, QBLK) + q.shape[2:]), 1, 0)
    rel = jnp.arange(span)[None, :] - QBLK - jnp.arange(QBLK)[:, None]
    band = jnp.abs(rel) <= C_WINDOW
    sink_col = jnp.broadcast_to(sink.astype(jnp.float32)[None, :, :, None, None], (B, C_KV_HEADS, C_GROUP, QBLK, 1))

    def block(args):
        i, qi = args
        start = i * QBLK
        ki = lax.dynamic_slice_in_dim(k_pad, start, span, axis=1)
        vi = lax.dynamic_slice_in_dim(v_pad, start, span, axis=1)
        key_pos = start - QBLK + jnp.arange(span)
        valid = band & ((key_pos >= 0) & (key_pos < L))[None, :]
        s_ctx = jnp.einsum('bqkgd,bckd->bkgqc', qi, k_ctx).astype(jnp.float32) * scale
        s_win = jnp.einsum('bqkgd,bskd->bkgqs', qi, ki).astype(jnp.float32) * scale
        s_win = jnp.where(valid, s_win, NEG_INF)
        p = jax.nn.softmax(jnp.concatenate([s_ctx, s_win, sink_col], axis=-1), axis=-1).astype(v.dtype)
        return (jnp.einsum('bkgqc,bckd->bqkgd', p[..., :n_ctx], v_ctx)
                + jnp.einsum('bkgqs,bskd->bqkgd', p[..., n_ctx:n_ctx + span], vi))

    o = lax.map(block, (jnp.arange(nb), qb))
    return jnp.moveaxis(o, 0, 1).reshape(B, L, C_QW)


def fourier_mix(u, w_f):
    B, L, _ = u.shape
    z = u.reshape(B, L, B_GROUPS, B_GDIM).astype(jnp.float32)
    z = jnp.fft.fft2(z, axes=(1, 3), norm='ortho').real.astype(u.dtype)
    return jnp.einsum('blgc,gcd->blgd', z, w_f).reshape(B, L, B_WIDTH)


def multiscale_pool(u, w_p, p_scale):
    B, L, _ = u.shape
    z = u.reshape(B, L, D_GROUPS, D_GDIM).astype(jnp.float32)
    cs = jnp.concatenate([jnp.zeros((B, 1, D_GROUPS, D_GDIM), jnp.float32), jnp.cumsum(z, axis=1)], axis=1)
    t = jnp.arange(L)[:, None]
    half = jnp.asarray(D_WINDOWS, jnp.int32)[None, :] // 2
    lo = jnp.clip(t - half, 0, L)
    hi = jnp.clip(t + half, 0, L)
    grp = jnp.arange(D_GROUPS)[None, :]
    win_sum = cs[:, hi, grp, :] - cs[:, lo, grp, :]
    mean = win_sum / (hi - lo).astype(jnp.float32)[None, :, :, None]
    pooled = (mean - z).astype(u.dtype)
    y = jnp.einsum('blgc,gcd->blgd', pooled, w_p).reshape(B, L, D_WIDTH)
    return y * p_scale


def mla_keys_values(h, ckv_g, w_ukv, k_g):
    B, L, _ = h.shape
    ckv = h[..., A_Q_LORA:A_Q_LORA + A_KV_LORA]
    k_rope = h[..., A_Q_LORA + A_KV_LORA:A_IN]
    kv = (rmsnorm(ckv, ckv_g) @ w_ukv).reshape(B, L, A_HEADS, A_NOPE + A_V)
    k = jnp.concatenate([kv[..., :A_NOPE], jnp.broadcast_to(k_rope[:, :, None, :], (B, L, A_HEADS, A_ROPE))], axis=-1)
    return rmsnorm(k, k_g), kv[..., A_NOPE:]


def mla_queries(h, cq_g, w_uq, q_g):
    B, L, _ = h.shape
    q = (rmsnorm(h[..., :A_Q_LORA], cq_g) @ w_uq).reshape(B, L, A_HEADS, A_QK)
    return rmsnorm(q, q_g)


def rope_tail(x, cos, sin):
    return jnp.concatenate([x[..., :A_NOPE], apply_rope(x[..., A_NOPE:], cos, sin)], axis=-1)


def even_mixer(u_ctx, u_lat, w_in, cq_g, ckv_g, w_uq, w_ukv, q_g, k_g, w_f, w_out, cos, sin, ctx_out):
    scale = A_QK ** -0.5
    B, L, _ = u_lat.shape
    h_ctx = u_ctx @ w_in
    h_lat = u_lat @ w_in
    k_ctx, v_ctx = mla_keys_values(h_ctx, ckv_g, w_ukv, k_g)
    k_lat, v_lat = mla_keys_values(h_lat, ckv_g, w_ukv, k_g)
    q_lat = rope_tail(mla_queries(h_lat, cq_g, w_uq, q_g), cos, sin)
    k_lat = rope_tail(k_lat, cos, sin)
    o_lat = latent_dense_attention(q_lat, k_lat, v_lat, k_ctx, v_ctx, scale)
    y_lat = jnp.concatenate([o_lat, fourier_mix(h_lat[..., A_IN:], w_f)], axis=-1) @ w_out
    y_ctx = None
    if ctx_out:
        Bc, C, _ = u_ctx.shape
        q_ctx = mla_queries(h_ctx, cq_g, w_uq, q_g)[:, :, :, None, :]
        o_ctx = attend_grouped(q_ctx, k_ctx, v_ctx, scale).reshape(Bc, C, -1)
        y_ctx = jnp.concatenate([o_ctx, fourier_mix(h_ctx[..., A_IN:], w_f)], axis=-1) @ w_out
    return y_ctx, y_lat


def gqa_keys_values(h, k_g):
    B, L, _ = h.shape
    k = rmsnorm(h[..., C_QW:C_QW + C_KW].reshape(B, L, C_KV_HEADS, C_HDIM), k_g)
    v = h[..., C_QW + C_KW:C_QW + 2 * C_KW].reshape(B, L, C_KV_HEADS, C_HDIM)
    return k, v


def gqa_queries(h, q_g):
    B, L, _ = h.shape
    return rmsnorm(h[..., :C_QW].reshape(B, L, C_HEADS, C_HDIM), q_g)


def odd_mixer(u_ctx, u_lat, w_in, q_g, k_g, sink, w_p, p_scale, w_out, cos, sin, ctx_out):
    scale = C_HDIM ** -0.5
    B, L, _ = u_lat.shape
    h_ctx = u_ctx @ w_in
    h_lat = u_lat @ w_in
    k_ctx, v_ctx = gqa_keys_values(h_ctx, k_g)
    k_lat, v_lat = gqa_keys_values(h_lat, k_g)
    q_lat = apply_rope(gqa_queries(h_lat, q_g), cos, sin).reshape(B, L, C_KV_HEADS, C_GROUP, C_HDIM)
    k_lat = apply_rope(k_lat, cos, sin)
    o_lat = window_attention(q_lat, k_lat, v_lat, k_ctx, v_ctx, sink, scale)
    y_lat = jnp.concatenate([o_lat, multiscale_pool(h_lat[..., C_QW + 2 * C_KW:], w_p, p_scale)], axis=-1) @ w_out
    y_ctx = None
    if ctx_out:
        Bc, C, _ = u_ctx.shape
        q_ctx = gqa_queries(h_ctx, q_g).reshape(Bc, C, C_KV_HEADS, C_GROUP, C_HDIM)
        o_ctx = attend_grouped(q_ctx, k_ctx, v_ctx, scale, sink).reshape(Bc, C, C_QW)
        y_ctx = jnp.concatenate([o_ctx, multiscale_pool(h_ctx[..., C_QW + 2 * C_KW:], w_p, p_scale)], axis=-1) @ w_out
    return y_ctx, y_lat


def conv_ffn(u, w_up, conv_w, conv_b, w_down):
    h = u @ w_up
    hp = jnp.pad(h, ((0, 0), (1, 1), (0, 0)))
    h = hp[:, :-2] * conv_w[0] + hp[:, 1:-1] * conv_w[1] + hp[:, 2:] * conv_w[2] + conv_b
    return (jax.nn.silu(h[..., :D_FF]) * h[..., D_FF:]) @ w_down


def setup_inputs(seed: int = 0) -> dict:
    key = jax.random.key(seed)
    ks = iter(jax.random.split(key, 32))
    D = D_MODEL

    def nrm(shape, scale):
        return jax.random.normal(next(ks), shape, jnp.float32) * scale

    def gain(shape):
        return 1.0 + nrm(shape, 0.02)

    return {
        'x': nrm((BATCH, SEQ, D), 1.0),
        'c': nrm((BATCH, D), 1.0),
        'ctx': nrm((BATCH, CTX_LEN, D), 1.0),
        'c_ctx': nrm((D,), 1.0),
        'mod_w': nrm((DEPTH, D, N_MOD * D), 0.5 * D ** -0.5),
        'mod_b': nrm((DEPTH, N_MOD * D), 0.01),
        'norm1_g': gain((DEPTH, D)),
        'norm2_g': gain((DEPTH, D)),
        'mla_w_in': nrm((N_EVEN, D, EVEN_IN), D ** -0.5),
        'mla_cq_g': gain((N_EVEN, A_Q_LORA)),
        'mla_ckv_g': gain((N_EVEN, A_KV_LORA)),
        'mla_w_uq': nrm((N_EVEN, A_Q_LORA, A_HEADS * A_QK), A_Q_LORA ** -0.5),
        'mla_w_ukv': nrm((N_EVEN, A_KV_LORA, A_HEADS * (A_NOPE + A_V)), A_KV_LORA ** -0.5),
        'mla_q_g': gain((N_EVEN, A_QK)),
        'mla_k_g': gain((N_EVEN, A_QK)),
        'fnet_w': nrm((N_EVEN, B_GROUPS, B_GDIM, B_GDIM), B_GDIM ** -0.5),
        'even_w_out': nrm((N_EVEN, EVEN_MIX, D), EVEN_MIX ** -0.5),
        'win_w_in': nrm((N_ODD, D, ODD_IN), D ** -0.5),
        'win_q_g': gain((N_ODD, C_HDIM)),
        'win_k_g': gain((N_ODD, C_HDIM)),
        'win_sink': nrm((N_ODD, C_KV_HEADS, C_GROUP), 0.5),
        'pool_w': nrm((N_ODD, D_GROUPS, D_GDIM, D_GDIM), D_GDIM ** -0.5),
        'pool_scale': 0.5 + nrm((N_ODD, D_WIDTH), 0.1),
        'odd_w_out': nrm((N_ODD, ODD_MIX, D), ODD_MIX ** -0.5),
        'ffn_up': nrm((DEPTH, D, 2 * D_FF), D ** -0.5),
        'ffn_conv_w': nrm((DEPTH, CONV_W, 2 * D_FF), CONV_W ** -0.5),
        'ffn_conv_b': nrm((DEPTH, 2 * D_FF), 0.01),
        'ffn_down': nrm((DEPTH, D_FF, D), D_FF ** -0.5),
    }


def reference(x, c, ctx, c_ctx, mod_w, mod_b, norm1_g, norm2_g,
              mla_w_in, mla_cq_g, mla_ckv_g, mla_w_uq, mla_w_ukv, mla_q_g, mla_k_g, fnet_w, even_w_out,
              win_w_in, win_q_g, win_k_g, win_sink, pool_w, pool_scale, odd_w_out,
              ffn_up, ffn_conv_w, ffn_conv_b, ffn_down):
    rows = x.shape[1] // GRID_W
    cos_a, sin_a = axial_rope_tables(rows, A_ROPE, x.dtype)
    cos_w, sin_w = axial_rope_tables(rows, C_HDIM, x.dtype)
    h_ctx = ctx
    for i in range(DEPTH):
        ctx_out = i < DEPTH - 1
        j = i // 2
        m_lat = jnp.split((jax.nn.silu(c) @ mod_w[i] + mod_b[i])[:, None, :], N_MOD, axis=-1)
        m_ctx = jnp.split(jax.nn.silu(c_ctx) @ mod_w[i] + mod_b[i], N_MOD, axis=-1)
        u_lat = modulate(rmsnorm(x, norm1_g[i]), m_lat[0], m_lat[1])
        u_ctx = modulate(rmsnorm(h_ctx, norm1_g[i]), m_ctx[0], m_ctx[1])
        if i % 2 == 0:
            y_ctx, y_lat = even_mixer(u_ctx, u_lat, mla_w_in[j], mla_cq_g[j], mla_ckv_g[j], mla_w_uq[j], mla_w_ukv[j],
                                      mla_q_g[j], mla_k_g[j], fnet_w[j], even_w_out[j], cos_a, sin_a, ctx_out)
        else:
            y_ctx, y_lat = odd_mixer(u_ctx, u_lat, win_w_in[j], win_q_g[j], win_k_g[j], win_sink[j],
                                     pool_w[j], pool_scale[j], odd_w_out[j], cos_w, sin_w, ctx_out)
        x = x + m_lat[2] * y_lat
        x = x + m_lat[5] * conv_ffn(modulate(rmsnorm(x, norm2_g[i]), m_lat[3], m_lat[4]),
                                    ffn_up[i], ffn_conv_w[i], ffn_conv_b[i], ffn_down[i])
        if ctx_out:
            h_ctx = h_ctx + m_ctx[2] * y_ctx
            h_ctx = h_ctx + m_ctx[5] * conv_ffn(modulate(rmsnorm(h_ctx, norm2_g[i]), m_ctx[3], m_ctx[4]),
                                                ffn_up[i], ffn_conv_w[i], ffn_conv_b[i], ffn_down[i])
    return x
```

```cpp
#include <hip/hip_runtime.h>
#include <hip/hip_cooperative_groups.h>
#include <cstdio>
#include <cstdint>
namespace cg = cooperative_groups;

#define REP_NORM 1
#define REP_GIN 1
#define REP_G3 1
#define REP_ATTE 1
#define REP_FNET 1
#define REP_ATTO 1
#define REP_WOUT 1
#define REP_UP 1
#define REP_DN 1
#define REP_P0 1
#define REP_EW 1
#define REP_SYNC 1
#define PROBE_MODE 0
#define REPLOOP(N) int nrep_ = (N); asm volatile("" : "+s"(nrep_)); for (int rep_ = 0; rep_ < nrep_; ++rep_)

constexpr int NB = 16, SEQ = 4096, NCTX = 256, DM = 1024, TB = SEQ + NCTX, T = NB * TB;
constexpr int DFF = 2816, U2B = 4608;
constexpr float EPS = 1e-6f;
constexpr float LOG2E = 1.4426950408889634f;

constexpr size_t MiB = 1u << 20;
constexpr size_t WS_MODS = 1 * MiB;
constexpr size_t WS_WINE = 3 * MiB;
constexpr size_t WS_WUQ = 6 * MiB;
constexpr size_t WS_WUKV = WS_WUQ + 3 * MiB / 2;
constexpr size_t WS_WF = WS_WUKV + 3 * MiB / 4;
constexpr size_t WS_WP = WS_WF + MiB / 2;
constexpr size_t WS_WOUTE = 9 * MiB;
constexpr size_t WS_WOUTO = 13 * MiB;
constexpr size_t WS_WINO = 17 * MiB;
constexpr size_t WS_WUP = 23 * MiB;
constexpr size_t WS_WDN = 34 * MiB;
constexpr size_t WS_DFTC = 40 * MiB;
constexpr size_t WS_DFTL = 41 * MiB;
constexpr size_t WS_HCTX = 105 * MiB;
constexpr size_t WS_U = 121 * MiB;
constexpr size_t WS_MIX = 275 * MiB;
constexpr size_t WS_ARENA = 411 * MiB;
constexpr size_t WS_H = WS_ARENA;
constexpr size_t WS_Q = WS_ARENA + 102 * MiB;
constexpr size_t WS_KV = WS_Q + 204 * MiB;
constexpr size_t WS_ZL = WS_KV + 204 * MiB;
constexpr size_t WS_ZC = WS_ZL + 64 * MiB;
constexpr size_t WS_POOL = WS_ARENA + 204 * MiB;
constexpr size_t WS_HID = WS_ARENA;
constexpr size_t WS_ROPE_E = WS_ZC + 4 * MiB;
constexpr size_t WS_ROPE_O = WS_ROPE_E + 1 * MiB;
constexpr size_t WS_WDN2 = WS_ROPE_O + 1 * MiB;
constexpr size_t WS_END = WS_WDN2 + 6 * MiB;
static_assert(WS_END <= 1024 * MiB, "ws map");

#define LAS __attribute__((address_space(3)))
#define GAS __attribute__((address_space(1)))
typedef unsigned short bf16_t;
typedef short bf16x8 __attribute__((ext_vector_type(8)));
typedef float f32x4 __attribute__((ext_vector_type(4)));
typedef float f32x16 __attribute__((ext_vector_type(16)));
typedef unsigned u32x4 __attribute__((ext_vector_type(4)));
typedef unsigned u32x2 __attribute__((ext_vector_type(2)));
typedef float f32x2v __attribute__((ext_vector_type(2)));

__device__ __forceinline__ unsigned cvt_pk_bf16(float lo, float hi) { unsigned r; asm volatile("v_cvt_pk_bf16_f32 %0, %1, %2" : "=v"(r) : "v"(lo), "v"(hi)); return r; }
__device__ __forceinline__ float bflo(unsigned u) { return __uint_as_float(u << 16); }
__device__ __forceinline__ float bfhi(unsigned u) { return __uint_as_float(u & 0xffff0000u); }
__device__ __forceinline__ float bf2f(bf16_t b) { return __uint_as_float((unsigned)b << 16); }
__device__ __forceinline__ float wave_sum(float v) {
#pragma unroll
    for (int o = 1; o < 64; o <<= 1) v += __shfl_xor(v, o);
    return v;
}
__device__ __forceinline__ float half_sum(float v) {
#pragma unroll
    for (int o = 1; o < 32; o <<= 1) v += __shfl_xor(v, o);
    return v;
}

namespace pg8 {
constexpr int BM = 256, BK = 64, HALF = 128, HTB = HALF * BK * 2, STAGE_BYTES = 8 * HTB, NXCD = 8, WGM = 8;
__device__ __forceinline__ int lds_byte(int r, int c) { const int st = (r >> 4) * 2 + (c >> 5), rr = r & 15, cc = c & 31, ob = rr * 64 + cc * 2; return st * 1024 + (ob ^ (((ob >> 9) & 1) << 5)); }
__device__ __forceinline__ void stage_rc(int b, int& R, int& C) { const int st = b / 1024, sb = b % 1024, swz = sb ^ (((sb >> 9) & 1) << 5); R = (st >> 1) * 16 + swz / 64; C = (st & 1) * 32 + (swz % 64) / 2; }
__device__ __forceinline__ int perm32(int rho) { const int n = rho >> 4, i = rho & 15; return 8 * (i >> 2) + 4 * n + (i & 3); }

struct Unit { int pm, pn, arow, brow, orow, ocol, aux, bt; };
struct Gemm { const bf16_t* A; const bf16_t* Bt; int lda, ldb, K; };

template <class Map> struct Order {
    int nM, nN, nwg, G, c; Map map;
    __device__ __forceinline__ void init(int nM_, int nN_, int G_, int c_, const Map& m) { nM = nM_; nN = nN_; nwg = nM * nN; G = G_; c = c_; map = m; }
    __device__ __forceinline__ bool next(int i, Unit& u) const {
        const long L = (long)i * G + c; if (L >= nwg) return false;
        int wgid = (int)L; { const int q = nwg / NXCD, r = nwg % NXCD, xcd = wgid % NXCD, off = wgid / NXCD; wgid = (xcd < r ? xcd * (q + 1) : r * (q + 1) + (xcd - r) * q) + off; }
        const int nig = WGM * nN, gid = wgid / nig, fm = gid * WGM, gsz = (nM - fm) < WGM ? (nM - fm) : WGM;
        u.pm = fm + ((wgid % nig) % gsz); u.pn = (wgid % nig) / gsz; map(u); return true;
    }
};

struct EpiBf16 {
    static constexpr bool PERM = true;
    bf16_t* O0; int ld0; bf16_t* O1; int ld1;
    __device__ __forceinline__ void operator()(const f32x4 (&acc)[2][2][4][2], const Unit& u, int wr, int wc, int fr, int fq, LAS unsigned char*) const {
        bf16_t* base = u.aux ? O1 : O0; const int ldc = u.aux ? ld1 : ld0;
        const int row0 = u.orow + wr * 64 + fr, col0 = u.ocol + wc * 32 + 8 * fq;
#pragma unroll
        for (int ai = 0; ai < 2; ++ai)
#pragma unroll
            for (int m = 0; m < 4; ++m) { bf16_t* rowp = base + (size_t)(row0 + ai * HALF + m * 16) * ldc + col0;
#pragma unroll
                for (int bj = 0; bj < 2; ++bj) { const f32x4 v0 = acc[ai][bj][m][0], v1 = acc[ai][bj][m][1];
                    u32x4 w; w.x = cvt_pk_bf16(v0[0], v0[1]); w.y = cvt_pk_bf16(v0[2], v0[3]); w.z = cvt_pk_bf16(v1[0], v1[1]); w.w = cvt_pk_bf16(v1[2], v1[3]);
                    *(u32x4*)(rowp + bj * HALF) = w; } }
    }
};

struct EpiRes {
    static constexpr bool PERM = false;
    const float* xin; float* xout; const float* cin; float* cout; const float* mods_l; int gidx; float gs;
    __device__ __forceinline__ void operator()(const f32x4 (&acc)[2][2][4][2], const Unit& u, int wr, int wc, int fr, int fq, LAS unsigned char*) const {
        const float* src = u.aux ? cin : xin; float* dst = u.aux ? cout : xout;
        const float* gate = mods_l + (size_t)(u.aux ? 16 : u.bt) * 6144 + gidx * 1024;
        const int row0 = u.orow + wr * 64 + fr, col0 = u.ocol + wc * 32 + 4 * fq;
#pragma unroll
        for (int bj = 0; bj < 2; ++bj)
#pragma unroll
            for (int n = 0; n < 2; ++n) { const int col = col0 + bj * HALF + n * 16; const f32x4 g4 = *(const f32x4*)(gate + col) * gs;
#pragma unroll
                for (int ai = 0; ai < 2; ++ai)
#pragma unroll
                    for (int m = 0; m < 4; ++m) { const size_t off = (size_t)(row0 + ai * HALF + m * 16) * DM + col;
                        const f32x4 x4 = *(const f32x4*)(src + off); *(f32x4*)(dst + off) = x4 + g4 * acc[ai][bj][m][n]; } }
    }
};

__device__ __forceinline__ float dpp_ror1(float v) { return __int_as_float(__builtin_amdgcn_update_dpp(__float_as_int(v), __float_as_int(v), 0x121, 0xf, 0xf, false)); }
__device__ __forceinline__ float dpp_ror15(float v) { return __int_as_float(__builtin_amdgcn_update_dpp(__float_as_int(v), __float_as_int(v), 0x12F, 0xf, 0xf, false)); }
__device__ __forceinline__ float silu_f(float x) { return x * __builtin_amdgcn_rcpf(1.0f + __expf(-x)); }

struct EpiUp {
    static constexpr bool PERM = false;
    bf16_t* Hd; const float* cw; const float* cb;
    __device__ __forceinline__ void operator()(const f32x4 (&acc)[2][2][4][2], const Unit& u, int wr, int wc, int fr, int fq, LAS unsigned char* lds) const {
        LAS float* hal = (LAS float*)(lds + STAGE_BYTES);
        if (fr == 0) {
#pragma unroll
            for (int ai = 0; ai < 2; ++ai)
#pragma unroll
                for (int bj = 0; bj < 2; ++bj)
#pragma unroll
                    for (int n = 0; n < 2; ++n) *(LAS f32x4*)(hal + ((2 * ai + wr) * 2 + 0) * 256 + bj * 128 + wc * 32 + n * 16 + 4 * fq) = acc[ai][bj][0][n];
        }
        if (fr == 15) {
#pragma unroll
            for (int ai = 0; ai < 2; ++ai)
#pragma unroll
                for (int bj = 0; bj < 2; ++bj)
#pragma unroll
                    for (int n = 0; n < 2; ++n) *(LAS f32x4*)(hal + ((2 * ai + wr) * 2 + 1) * 256 + bj * 128 + wc * 32 + n * 16 + 4 * fq) = acc[ai][bj][3][n];
        }
        asm volatile("s_waitcnt lgkmcnt(0)" ::: "memory"); __builtin_amdgcn_s_barrier(); asm volatile("" ::: "memory");
        const int rmin = u.aux ? 0 : 1, rmax = u.bt;
        const f32x4 zero4 = {0.f, 0.f, 0.f, 0.f};
#pragma unroll
        for (int ai = 0; ai < 2; ++ai) {
            const int g = 2 * ai + wr;
#pragma unroll
            for (int n = 0; n < 2; ++n) {
                const int chb = u.ocol + wc * 32 + n * 16 + 4 * fq;
                const int colh = wc * 32 + n * 16 + 4 * fq;
                f32x4 w0[2], w1[2], w2[2], bb[2], uh[2], dh[2];
#pragma unroll
                for (int bj = 0; bj < 2; ++bj) { const int ch = bj * DFF + chb;
                    w0[bj] = *(const f32x4*)(cw + ch); w1[bj] = *(const f32x4*)(cw + 2 * DFF + ch); w2[bj] = *(const f32x4*)(cw + 4 * DFF + ch); bb[bj] = *(const f32x4*)(cb + ch);
                    uh[bj] = zero4; dh[bj] = zero4;
                    if (g > 0) uh[bj] = *(LAS f32x4*)(hal + ((g - 1) * 2 + 1) * 256 + bj * 128 + colh);
                    if (g < 3) dh[bj] = *(LAS f32x4*)(hal + ((g + 1) * 2 + 0) * 256 + bj * 128 + colh); }
#pragma unroll
                for (int m = 0; m < 4; ++m) {
                    f32x4 res[2];
#pragma unroll
                    for (int bj = 0; bj < 2; ++bj) {
                        const f32x4 cur = acc[ai][bj][m][n];
                        const f32x4 prv = m > 0 ? acc[ai][bj][m > 0 ? m - 1 : 0][n] : uh[bj];
                        const f32x4 nxt = m < 3 ? acc[ai][bj][m < 3 ? m + 1 : 3][n] : dh[bj];
                        f32x4 up, dn;
#pragma unroll
                        for (int j = 0; j < 4; ++j) { up[j] = dpp_ror1(fr == 15 ? prv[j] : cur[j]); dn[j] = dpp_ror15(fr == 0 ? nxt[j] : cur[j]); }
                        if (m == 0) { if (fr == 0) up = uh[bj]; }
                        if (m == 3) { if (fr == 15) dn = dh[bj]; }
                        res[bj] = w0[bj] * up + w1[bj] * cur + w2[bj] * dn + bb[bj];
                    }
                    const int r = ai * HALF + wr * 64 + m * 16 + fr;
                    if (r >= rmin && r <= rmax) {
                        const f32x4 gq = res[0], vq = res[1];
                        u32x2 w; w.x = cvt_pk_bf16(silu_f(gq[0]) * vq[0], silu_f(gq[1]) * vq[1]); w.y = cvt_pk_bf16(silu_f(gq[2]) * vq[2], silu_f(gq[3]) * vq[3]);
                        *(u32x2*)(Hd + (size_t)(u.orow + r) * DFF + chb) = w;
                    }
                }
            }
        }
    }
};

template <class Epi, class Sched>
__device__ __forceinline__ void gemm_phase(LAS unsigned char* lds, const Gemm g, const Sched& S, const Epi& E) {
    int tid = threadIdx.x; asm volatile("" : "+v"(tid));
    const int wid = __builtin_amdgcn_readfirstlane(tid >> 6), lane = tid & 63, wr = wid >> 2, wc = wid & 3, fr = lane & 15, fq = lane >> 4;
    int K = g.K, lda_ = g.lda, ldb_ = g.ldb; asm volatile("" : "+s"(K), "+s"(lda_), "+s"(ldb_));
    const int nt = K / BK;
    unsigned voffA[2], voffB[2];
#pragma unroll
    for (int i = 0; i < 2; ++i) { int R, C; stage_rc(tid * 16 + i * 8192, R, C); const int Rb = Epi::PERM ? ((R & ~31) + perm32(R & 31)) : R;
        voffA[i] = (unsigned)(R * lda_ + C) * 2u; voffB[i] = (unsigned)(Rb * ldb_ + C) * 2u; }
    const size_t kstep = (size_t)(BK * 2);
    const size_t hstepA = (size_t)HALF * lda_ * 2, hstepB = (size_t)HALF * ldb_ * 2;
    const unsigned ldsw = (unsigned)wid * 1024u;
    const int aoff = lds_byte(wr * 64 + fr, fq * 8), boff = lds_byte(wc * 32 + fr, fq * 8);
#define PG8_SA(b, h) (((b) * 2 + (h)) * HTB)
#define PG8_SB(b, h) ((4 + (b) * 2 + (h)) * HTB)
#define PG8_STAGE(bufoff, gbase, voff) do { _Pragma("unroll") for (int _i = 0; _i < 2; ++_i) \
        __builtin_amdgcn_global_load_lds((const unsigned*)((const char*)(gbase) + (voff)[_i]), (LAS unsigned*)(lds + (bufoff) + ldsw + _i * 8192), 16, 0, 0); } while (0)
#define PG8_LDA(dst, b, h) do { _Pragma("unroll") for (int m = 0; m < 4; ++m) _Pragma("unroll") for (int k = 0; k < 2; ++k) dst[m][k] = *(const LAS bf16x8*)(lds + PG8_SA(b, h) + aoff + m * 2048 + k * 1024); } while (0)
#define PG8_LDB(dst, b, h) do { _Pragma("unroll") for (int n = 0; n < 2; ++n) _Pragma("unroll") for (int k = 0; k < 2; ++k) dst[n][k] = *(const LAS bf16x8*)(lds + PG8_SB(b, h) + boff + n * 2048 + k * 1024); } while (0)
#define PG8_MMA(ai, bj, At, Bt) do { __builtin_amdgcn_s_setprio(1); _Pragma("unroll") for (int m = 0; m < 4; ++m) _Pragma("unroll") for (int n = 0; n < 2; ++n) _Pragma("unroll") for (int k = 0; k < 2; ++k) \
        acc[ai][bj][m][n] = __builtin_amdgcn_mfma_f32_16x16x32_bf16(Bt[n][k], At[m][k], acc[ai][bj][m][n], 0, 0, 0); __builtin_amdgcn_s_setprio(0); } while (0)
#define PG8_WAIT_V(n) asm volatile("s_waitcnt vmcnt(" #n ")" ::: "memory")
#define PG8_WAIT_L(n) asm volatile("s_waitcnt lgkmcnt(" #n ")" ::: "memory")
#define PG8_BAR __builtin_amdgcn_s_barrier()
#define PG8_SCHED __builtin_amdgcn_sched_barrier(0)
    Unit cur, nxt; int ui = 0;
    if (!S.next(0, cur)) return;
    f32x4 acc[2][2][4][2];
#pragma unroll
    for (int a = 0; a < 2; ++a)
#pragma unroll
        for (int b = 0; b < 2; ++b)
#pragma unroll
            for (int m = 0; m < 4; ++m)
#pragma unroll
                for (int n = 0; n < 2; ++n) acc[a][b][m][n] = (f32x4){0.f, 0.f, 0.f, 0.f};
    bf16x8 At[4][2], B0[2][2], B1[2][2];
    const char* cA = (const char*)g.A + (size_t)cur.arow * lda_ * 2; const char* cB = (const char*)g.Bt + (size_t)cur.brow * ldb_ * 2;
    PG8_STAGE(PG8_SB(0, 0), cB, voffB); PG8_STAGE(PG8_SB(0, 1), cB + hstepB, voffB); PG8_STAGE(PG8_SA(0, 0), cA, voffA); PG8_STAGE(PG8_SA(0, 1), cA + hstepA, voffA);
    if (wr == 1) PG8_BAR;
    PG8_WAIT_V(2); PG8_BAR;
    PG8_STAGE(PG8_SB(1, 0), cB + kstep, voffB); PG8_STAGE(PG8_SA(1, 0), cA + kstep, voffA); PG8_STAGE(PG8_SB(1, 1), cB + hstepB + kstep, voffB);
    PG8_WAIT_V(6); PG8_BAR;
    for (;;) {
        const bool has_next = S.next(ui + 1, nxt);
        const char* nA = has_next ? (const char*)g.A + (size_t)nxt.arow * lda_ * 2 : cA; const char* nB = has_next ? (const char*)g.Bt + (size_t)nxt.brow * ldb_ * 2 : cB;
        for (int t = 0; t < nt; t += 2) {
            const bool last = (t == nt - 2);
            const char* a1 = cA + (size_t)(t + 1) * kstep;
            const char* a2 = last ? nA : cA + (size_t)(t + 2) * kstep; const char* b2 = last ? nB : cB + (size_t)(t + 2) * kstep;
            const char* a3 = a2 + kstep; const char* b3 = b2 + kstep;
            PG8_LDB(B0, 0, 0); PG8_LDB(B1, 0, 1); PG8_SCHED; PG8_LDA(At, 0, 0); PG8_STAGE(PG8_SA(1, 1), a1 + hstepA, voffA);
            PG8_WAIT_V(8); PG8_WAIT_L(0); PG8_BAR; PG8_MMA(0, 0, At, B0); PG8_MMA(0, 1, At, B1); PG8_BAR; PG8_SCHED;
            PG8_LDA(At, 0, 1); PG8_STAGE(PG8_SB(0, 0), b2, voffB); PG8_STAGE(PG8_SB(0, 1), b2 + hstepB, voffB); PG8_STAGE(PG8_SA(0, 0), a2, voffA);
            PG8_WAIT_V(8); PG8_WAIT_L(0); PG8_BAR; PG8_MMA(1, 0, At, B0); PG8_MMA(1, 1, At, B1); PG8_BAR; PG8_SCHED;
            PG8_LDB(B0, 1, 0); PG8_LDB(B1, 1, 1); PG8_SCHED; PG8_LDA(At, 1, 0); PG8_STAGE(PG8_SA(0, 1), a2 + hstepA, voffA);
            PG8_WAIT_V(8); PG8_WAIT_L(0); PG8_BAR; PG8_MMA(0, 0, At, B0); PG8_MMA(0, 1, At, B1); PG8_BAR; PG8_SCHED;
            PG8_LDA(At, 1, 1); PG8_STAGE(PG8_SB(1, 0), b3, voffB); PG8_STAGE(PG8_SB(1, 1), b3 + hstepB, voffB); PG8_STAGE(PG8_SA(1, 0), a3, voffA);
            PG8_WAIT_V(8); PG8_WAIT_L(0); PG8_BAR; PG8_MMA(1, 0, At, B0); PG8_MMA(1, 1, At, B1); PG8_BAR; PG8_SCHED;
        }
        if (wr == 0) PG8_BAR;
        E(acc, cur, wr, wc, fr, fq, lds);
        if (!has_next) break;
#pragma unroll
        for (int a = 0; a < 2; ++a)
#pragma unroll
            for (int b = 0; b < 2; ++b)
#pragma unroll
                for (int m = 0; m < 4; ++m)
#pragma unroll
                    for (int n = 0; n < 2; ++n) acc[a][b][m][n] = (f32x4){0.f, 0.f, 0.f, 0.f};
        cur = nxt; cA = nA; cB = nB; ++ui;
        if (wr == 1) PG8_BAR;
    }
    PG8_WAIT_V(0);
    PG8_BAR;
#undef PG8_SA
#undef PG8_SB
#undef PG8_STAGE
#undef PG8_LDA
#undef PG8_LDB
#undef PG8_MMA
#undef PG8_WAIT_V
#undef PG8_WAIT_L
#undef PG8_BAR
#undef PG8_SCHED
}

struct MapStd { int coff; __device__ __forceinline__ void operator()(Unit& u) const { u.arow = u.pm * 256; u.brow = u.pn * 256; u.orow = u.pm * 256; u.ocol = coff + u.pn * 256; u.aux = 0; u.bt = 0; } };
struct MapRes { int all;
    __device__ __forceinline__ void operator()(Unit& u) const {
        int b, j; if (all) { b = u.pm / 17; j = u.pm % 17; } else { b = u.pm / 16; j = u.pm % 16 + 1; }
        u.arow = (b * 17 + j) * 256; u.brow = u.pn * 256; u.ocol = u.pn * 256; u.bt = b;
        if (j == 0) { u.aux = 1; u.orow = b * 256; } else { u.aux = 0; u.orow = b * SEQ + (j - 1) * 256; } asm volatile("" : "+s"(u.aux)); } };
struct MapUp { int all;
    __device__ __forceinline__ void operator()(Unit& u) const {
        int b, j; if (all) { b = u.pm / 18; j = u.pm % 18; } else { b = u.pm / 17; j = u.pm % 17 + 1; }
        u.brow = u.pn * 256; u.ocol = u.pn * 128;
        if (j == 0) { u.aux = 1; u.arow = b * U2B; u.orow = b * TB; u.bt = 255; }
        else { const int i = j - 1; u.aux = 0; u.arow = b * U2B + 263 + 254 * i; u.orow = b * TB + NCTX + 254 * i - 1; const int lim = SEQ - 254 * i; u.bt = lim < 254 ? lim : 254; } } };
struct MapZ {
    __device__ __forceinline__ void operator()(Unit& u) const {
        const int b = u.pn / 17, j = u.pn % 17; u.arow = u.pm * 256; u.brow = u.pn * 256; u.orow = b * 256; u.bt = b;
        if (j == 0) { u.aux = 1; u.ocol = u.pm * NCTX; } else { u.aux = 0; u.ocol = u.pm * SEQ + (j - 1) * 256; } } };
struct MapFnetL { __device__ __forceinline__ void operator()(Unit& u) const { const int b = u.pm / 16, mt = u.pm % 16; u.arow = mt * 256; u.brow = b * 256; u.orow = b * TB + NCTX + mt * 256; u.ocol = 768; u.aux = 0; u.bt = b; } };
struct MapFnetC { __device__ __forceinline__ void operator()(Unit& u) const { const int b = u.pm; u.arow = 0; u.brow = b * 256; u.orow = b * TB; u.ocol = 768; u.aux = 0; u.bt = b; } };
}

typedef short v4i16_t __attribute__((ext_vector_type(4)));
__device__ __forceinline__ v4i16_t vtr(const LAS unsigned char* p) { return __builtin_amdgcn_ds_read_tr16_b64_v4i16((LAS v4i16_t*)p); }
#define MX3(a_, b_, c_) __builtin_fmaxf(__builtin_fmaxf((a_), (b_)), (c_))
__device__ __forceinline__ float tile_max(const f32x16& s0, const f32x16& s1) {
    float ma = MX3(s0[0], s0[1], s1[0]), mb = MX3(s0[2], s0[3], s1[1]); ma = MX3(ma, s1[2], s1[3]);
#pragma unroll
    for (int r = 4; r < 16; r += 4) { ma = MX3(ma, s0[r], s0[r + 1]); mb = MX3(mb, s0[r + 2], s0[r + 3]); ma = MX3(ma, s1[r], s1[r + 1]); mb = MX3(mb, s1[r + 2], s1[r + 3]); }
    return __builtin_fmaxf(ma, mb);
}
#undef MX3
__device__ __forceinline__ void band_mask(f32x16& s0, f32x16& s1, int k0pos, int qp, int hi) {
#pragma unroll
    for (int r = 0; r < 16; ++r) { const int kp = k0pos + (r & 3) + 8 * (r >> 2) + 4 * hi; const int d0 = kp - qp, d1 = d0 + 32;
        if (d0 > 128 || d0 < -128) s0[r] = -1e30f; if (d1 > 128 || d1 < -128) s1[r] = -1e30f; }
}
__device__ __forceinline__ void exp4(f32x16& s, int r0, float& acc0, float& acc1) {
    s[r0] = __builtin_amdgcn_exp2f(s[r0]); s[r0 + 1] = __builtin_amdgcn_exp2f(s[r0 + 1]); s[r0 + 2] = __builtin_amdgcn_exp2f(s[r0 + 2]); s[r0 + 3] = __builtin_amdgcn_exp2f(s[r0 + 3]);
    acc0 += s[r0] + s[r0 + 2]; acc1 += s[r0 + 1] + s[r0 + 3];
}
__device__ __forceinline__ bf16x8 pack8(const f32x16& s, int r0) {
    u32x4 w; w.x = cvt_pk_bf16(s[r0], s[r0 + 1]); w.y = cvt_pk_bf16(s[r0 + 2], s[r0 + 3]); w.z = cvt_pk_bf16(s[r0 + 4], s[r0 + 5]); w.w = cvt_pk_bf16(s[r0 + 6], s[r0 + 7]);
    return __builtin_bit_cast(bf16x8, w);
}
__device__ __forceinline__ void pv_slab(const LAS unsigned char* vb, int koff, const bf16x8 pj, f32x16& o0, f32x16& o1) {
    const v4i16_t a0 = vtr(vb + koff), a1 = vtr(vb + koff + 512), b0 = vtr(vb + 8192 + koff), b1 = vtr(vb + 8192 + koff + 512);
    const bf16x8 v0 = {a0[0], a0[1], a0[2], a0[3], a1[0], a1[1], a1[2], a1[3]}, v1 = {b0[0], b0[1], b0[2], b0[3], b1[0], b1[1], b1[2], b1[3]};
    o0 = __builtin_amdgcn_mfma_f32_32x32x16_bf16(v0, pj, o0, 0, 0, 0);
    o1 = __builtin_amdgcn_mfma_f32_32x32x16_bf16(v1, pj, o1, 0, 0, 0);
}

#define ATT_SCHED() __builtin_amdgcn_sched_barrier(0)
template <int DQ, bool WIN>
__device__ __forceinline__ void attn_qk(LAS unsigned char* lds, int kbufoff, int t, const bf16x8 (&qf)[DQ / 16], f32x16& o0, f32x16& o1, float& mrun, float& lsum,
                                        f32x16& sa0, f32x16& sa1, f32x16& sb0, f32x16& sb1, int l31, int hi, int qw) {
    constexpr int NDK = DQ / 16, KST = DQ * 2 + 16;
    const LAS unsigned char* kb = lds + kbufoff + l31 * KST + hi * 16;
    bf16x8 kf[2][4];
#define KLOAD(dst, dk) do { dst[0] = *(const LAS bf16x8*)(kb + (dk) * 32); dst[1] = *(const LAS bf16x8*)(kb + 32 * KST + (dk) * 32); \
                            dst[2] = *(const LAS bf16x8*)(kb + 64 * KST + (dk) * 32); dst[3] = *(const LAS bf16x8*)(kb + 96 * KST + (dk) * 32); } while (0)
    KLOAD(kf[0], 0);
#pragma unroll
    for (int dk = 0; dk < NDK; ++dk) {
        if (dk + 1 < NDK) KLOAD(kf[(dk + 1) & 1], dk + 1);
        ATT_SCHED();
        const bf16x8 (&f)[4] = kf[dk & 1];
        if (dk == 0) { f32x16 z16;
#pragma unroll
                       for (int r = 0; r < 16; ++r) z16[r] = 0.f;
                       sa0 = __builtin_amdgcn_mfma_f32_32x32x16_bf16(f[0], qf[0], z16, 0, 0, 0); sa1 = __builtin_amdgcn_mfma_f32_32x32x16_bf16(f[1], qf[0], z16, 0, 0, 0);
                       sb0 = __builtin_amdgcn_mfma_f32_32x32x16_bf16(f[2], qf[0], z16, 0, 0, 0); sb1 = __builtin_amdgcn_mfma_f32_32x32x16_bf16(f[3], qf[0], z16, 0, 0, 0); }
        else { sa0 = __builtin_amdgcn_mfma_f32_32x32x16_bf16(f[0], qf[dk], sa0, 0, 0, 0); sa1 = __builtin_amdgcn_mfma_f32_32x32x16_bf16(f[1], qf[dk], sa1, 0, 0, 0);
               sb0 = __builtin_amdgcn_mfma_f32_32x32x16_bf16(f[2], qf[dk], sb0, 0, 0, 0); sb1 = __builtin_amdgcn_mfma_f32_32x32x16_bf16(f[3], qf[dk], sb1, 0, 0, 0); }
        ATT_SCHED();
    }
#undef KLOAD
    if (__builtin_expect(__any(mrun != 0.f), 0)) {
#pragma unroll
        for (int r = 0; r < 16; ++r) { sa0[r] -= mrun; sa1[r] -= mrun; sb0[r] -= mrun; sb1[r] -= mrun; }
    }
    if (WIN && t >= 4) { const int qp = qw + l31, k0pos = (t - 4) * 64; band_mask(sa0, sa1, k0pos, qp, hi); band_mask(sb0, sb1, k0pos + 64, qp, hi); }
    float mx = __builtin_fmaxf(tile_max(sa0, sa1), tile_max(sb0, sb1));
    { auto rr = __builtin_amdgcn_permlane32_swap(__float_as_uint(mx), __float_as_uint(mx), false, false); mx = __builtin_fmaxf(__uint_as_float(rr[0]), __uint_as_float(rr[1])); }
    if (__builtin_expect(__any(mx > 8.0f), 0)) {
        const float dl = mx > 8.0f ? mx : 0.f; mrun += dl;
        const float alpha = __builtin_amdgcn_exp2f(-dl); lsum *= alpha;
#pragma unroll
        for (int r = 0; r < 16; ++r) { sa0[r] -= dl; sa1[r] -= dl; sb0[r] -= dl; sb1[r] -= dl; o0[r] *= alpha; o1[r] *= alpha; }
    }
}
#define VLOAD(dst, j) do { dst[0] = vtr(vb + (j) * 1024); dst[1] = vtr(vb + (j) * 1024 + 512); dst[2] = vtr(vb + 8192 + (j) * 1024); dst[3] = vtr(vb + 8192 + (j) * 1024 + 512); } while (0)
#define PVMMA(src, P_) do { const bf16x8 v0_ = {src[0][0], src[0][1], src[0][2], src[0][3], src[1][0], src[1][1], src[1][2], src[1][3]}, v1_ = {src[2][0], src[2][1], src[2][2], src[2][3], src[3][0], src[3][1], src[3][2], src[3][3]}; \
        const bf16x8 p_ = (P_); o0 = __builtin_amdgcn_mfma_f32_32x32x16_bf16(v0_, p_, o0, 0, 0, 0); o1 = __builtin_amdgcn_mfma_f32_32x32x16_bf16(v1_, p_, o1, 0, 0, 0); } while (0)
__device__ __forceinline__ void attn_softmax_pv(const LAS unsigned char* vb, f32x16& sa0, f32x16& sa1, f32x16& sb0, f32x16& sb1, f32x16& o0, f32x16& o1, float& lsum) {
    v4i16_t vf[2][4];
    VLOAD(vf[0], 0);
    float p0 = 0.f, p1 = 0.f, p2 = 0.f, p3 = 0.f;
    exp4(sa0, 0, p0, p1); exp4(sa0, 4, p2, p3); exp4(sa0, 8, p0, p1); exp4(sa0, 12, p2, p3);
    exp4(sa1, 0, p0, p1); exp4(sa1, 4, p2, p3); exp4(sa1, 8, p0, p1); exp4(sa1, 12, p2, p3);
    VLOAD(vf[1], 1); ATT_SCHED(); PVMMA(vf[0], pack8(sa0, 0)); exp4(sb0, 0, p0, p1); exp4(sb0, 4, p2, p3); ATT_SCHED();
    VLOAD(vf[0], 2); ATT_SCHED(); PVMMA(vf[1], pack8(sa0, 8)); exp4(sb0, 8, p0, p1); exp4(sb0, 12, p2, p3); ATT_SCHED();
    VLOAD(vf[1], 3); ATT_SCHED(); PVMMA(vf[0], pack8(sa1, 0)); exp4(sb1, 0, p0, p1); exp4(sb1, 4, p2, p3); ATT_SCHED();
    VLOAD(vf[0], 4); ATT_SCHED(); PVMMA(vf[1], pack8(sa1, 8)); exp4(sb1, 8, p0, p1); exp4(sb1, 12, p2, p3); ATT_SCHED();
    lsum += (p0 + p1) + (p2 + p3);
    VLOAD(vf[1], 5); ATT_SCHED(); PVMMA(vf[0], pack8(sb0, 0)); ATT_SCHED();
    VLOAD(vf[0], 6); ATT_SCHED(); PVMMA(vf[1], pack8(sb0, 8)); ATT_SCHED();
    VLOAD(vf[1], 7); ATT_SCHED(); PVMMA(vf[0], pack8(sb1, 0)); ATT_SCHED();
    PVMMA(vf[1], pack8(sb1, 8));
}
__device__ __forceinline__ void attn_softmax_keep(f32x16& sa0, f32x16& sa1, f32x16& sb0, f32x16& sb1, bf16x8 (&pw)[8], float& lsum) {
    float p0 = 0.f, p1 = 0.f, p2 = 0.f, p3 = 0.f;
    exp4(sa0, 0, p0, p1); exp4(sa0, 4, p2, p3); exp4(sa0, 8, p0, p1); exp4(sa0, 12, p2, p3); pw[0] = pack8(sa0, 0); pw[1] = pack8(sa0, 8);
    exp4(sa1, 0, p0, p1); exp4(sa1, 4, p2, p3); exp4(sa1, 8, p0, p1); exp4(sa1, 12, p2, p3); pw[2] = pack8(sa1, 0); pw[3] = pack8(sa1, 8);
    exp4(sb0, 0, p0, p1); exp4(sb0, 4, p2, p3); exp4(sb0, 8, p0, p1); exp4(sb0, 12, p2, p3); pw[4] = pack8(sb0, 0); pw[5] = pack8(sb0, 8);
    exp4(sb1, 0, p0, p1); exp4(sb1, 4, p2, p3); exp4(sb1, 8, p0, p1); exp4(sb1, 12, p2, p3); pw[6] = pack8(sb1, 0); pw[7] = pack8(sb1, 8);
    lsum += (p0 + p1) + (p2 + p3);
}
__device__ __forceinline__ void attn_pv_all(const LAS unsigned char* vb, const bf16x8 (&pw)[8], f32x16& o0, f32x16& o1) {
    v4i16_t vf[2][4];
    VLOAD(vf[0], 0);
    VLOAD(vf[1], 1); ATT_SCHED(); PVMMA(vf[0], pw[0]); ATT_SCHED();
    VLOAD(vf[0], 2); ATT_SCHED(); PVMMA(vf[1], pw[1]); ATT_SCHED();
    VLOAD(vf[1], 3); ATT_SCHED(); PVMMA(vf[0], pw[2]); ATT_SCHED();
    VLOAD(vf[0], 4); ATT_SCHED(); PVMMA(vf[1], pw[3]); ATT_SCHED();
    VLOAD(vf[1], 5); ATT_SCHED(); PVMMA(vf[0], pw[4]); ATT_SCHED();
    VLOAD(vf[0], 6); ATT_SCHED(); PVMMA(vf[1], pw[5]); ATT_SCHED();
    VLOAD(vf[1], 7); ATT_SCHED(); PVMMA(vf[0], pw[6]); ATT_SCHED();
    PVMMA(vf[1], pw[7]);
}
#undef VLOAD
#undef PVMMA
#undef ATT_SCHED

template <int DQ, bool WIN, int MODE = 0>
__device__ __forceinline__ void attn_unit(LAS unsigned char* lds, const bf16_t* Qp, int ldq, const bf16_t* Kp, int ldk, const bf16_t* Vp, int ldv, bf16_t* Op,
                                          int n1, int s2, int e2, int q0pos, float m_init, bool has_sink) {
    constexpr int NDK = DQ / 16, CH = DQ / 8, NKC = DQ / 32, KST = DQ * 2 + 16, KBUF = 128 * KST, VBUF = 16384, VOFF = 2 * KBUF;
    int tid = threadIdx.x; asm volatile("" : "+v"(tid));
    const int lane = tid & 63, wid = __builtin_amdgcn_readfirstlane(tid >> 6), l31 = lane & 31, hi = lane >> 5;
    const bool late = wid >= 4;
    bf16x8 qf[NDK];
    { const bf16_t* qrow = Qp + (size_t)(32 * wid + l31) * ldq + 8 * hi;
#pragma unroll
      for (int dk = 0; dk < NDK; ++dk) qf[dk] = *(const bf16x8*)(qrow + 16 * dk); }
    f32x16 o0, o1;
#pragma unroll
    for (int r = 0; r < 16; ++r) { o0[r] = 0.f; o1[r] = 0.f; }
    float mrun = 0.f, lsum = (has_sink && hi == 0) ? __builtin_amdgcn_exp2f(m_init) : 0.f;
    const int qw = q0pos + 32 * wid;
    const int vlane = (4 * hi + ((lane & 15) >> 2)) * 64 + ((lane >> 4) & 1) * 32 + (lane & 3) * 8;
    u32x4 kr[NKC], vr[2];
#define ATT_TILE(i_) ((i_) < n1 ? (i_) : s2 + ((i_) - n1))
#define ATT_LOAD(t) do { const bf16_t* kp_ = Kp + (size_t)(t) * 64 * ldk; const bf16_t* vp_ = Vp + (size_t)(t) * 64 * ldv; \
        _Pragma("unroll") for (int m_ = 0; m_ < NKC; ++m_) { const int c_ = tid + 512 * m_; kr[m_] = *(const GAS u32x4*)(kp_ + (size_t)(c_ / CH) * ldk + (c_ % CH) * 8); } \
        _Pragma("unroll") for (int m_ = 0; m_ < 2; ++m_) { const int c_ = tid + 512 * m_; vr[m_] = *(const GAS u32x4*)(vp_ + (size_t)(c_ >> 3) * ldv + (c_ & 7) * 8); } } while (0)
#define ATT_STORE(kb_, vb_) do { \
        _Pragma("unroll") for (int m_ = 0; m_ < NKC; ++m_) { const int c_ = tid + 512 * m_; *(LAS u32x4*)(lds + (kb_) * KBUF + (c_ / CH) * KST + (c_ % CH) * 16) = kr[m_]; } \
        _Pragma("unroll") for (int m_ = 0; m_ < 2; ++m_) { const int c_ = tid + 512 * m_; *(LAS u32x4*)(lds + VOFF + (vb_) * VBUF + ((c_ & 7) >> 2) * 8192 + (c_ >> 3) * 64 + (c_ & 3) * 16) = vr[m_]; } } while (0)
#define ATT_BAR() asm volatile("s_waitcnt lgkmcnt(0)\n\ts_barrier" ::: "memory")
    const int nst = (n1 + (e2 - s2)) >> 1;
    ATT_LOAD(0); ATT_STORE(0, 0);
    ATT_BAR();
    if (!late) {
        int vcur = 0;
        for (int I = 0; I < nst; ++I) {
            const int t = ATT_TILE(2 * I);
            if (I + 1 < nst) { const int tn = ATT_TILE(2 * I + 2); ATT_LOAD(tn); }
            bool active = true; if (WIN && t >= 4) { const int k0 = (t - 4) * 64; active = (k0 + 127 >= qw - 128) && (k0 <= qw + 31 + 128); }
            const int vnext = vcur == 2 ? 0 : vcur + 1;
            if (active) { f32x16 sa0, sa1, sb0, sb1;
                attn_qk<DQ, WIN>(lds, (I & 1) * KBUF, t, qf, o0, o1, mrun, lsum, sa0, sa1, sb0, sb1, l31, hi, qw);
                attn_softmax_pv(lds + VOFF + vcur * VBUF + vlane, sa0, sa1, sb0, sb1, o0, o1, lsum); }
            if (I + 1 < nst) ATT_STORE((I + 1) & 1, vnext);
            vcur = vnext;
            ATT_BAR();
        }
    } else {
        bf16x8 pw[8]; bool havep = false; int pvoff = 0;
        int vcur = 0;
        for (int I = 0; I < nst; ++I) {
            const int t = ATT_TILE(2 * I);
            if (I + 1 < nst) { const int tn = ATT_TILE(2 * I + 2); ATT_LOAD(tn); }
            bool active = true; if (WIN && t >= 4) { const int k0 = (t - 4) * 64; active = (k0 + 127 >= qw - 128) && (k0 <= qw + 31 + 128); }
            const int vnext = vcur == 2 ? 0 : vcur + 1;
            if (havep) attn_pv_all(lds + VOFF + pvoff + vlane, pw, o0, o1);
            havep = false;
            if (active) { f32x16 sa0, sa1, sb0, sb1;
                attn_qk<DQ, WIN>(lds, (I & 1) * KBUF, t, qf, o0, o1, mrun, lsum, sa0, sa1, sb0, sb1, l31, hi, qw);
                attn_softmax_keep(sa0, sa1, sb0, sb1, pw, lsum); havep = true; pvoff = vcur * VBUF; }
            if (I + 1 < nst) ATT_STORE((I + 1) & 1, vnext);
            vcur = vnext;
            ATT_BAR();
        }
        if (havep) attn_pv_all(lds + VOFF + pvoff + vlane, pw, o0, o1);
    }
    ATT_BAR();
#undef ATT_TILE
#undef ATT_LOAD
#undef ATT_STORE
#undef ATT_BAR
    const float lt = lsum + __shfl_xor(lsum, 32), inv = 1.0f / lt;
    bf16_t* orow = Op + (size_t)(32 * wid + l31) * DM + 4 * hi;
#pragma unroll
    for (int g = 0; g < 4; ++g) {
        u32x2 w0, w1;
        w0.x = cvt_pk_bf16(o0[4 * g] * inv, o0[4 * g + 1] * inv); w0.y = cvt_pk_bf16(o0[4 * g + 2] * inv, o0[4 * g + 3] * inv);
        w1.x = cvt_pk_bf16(o1[4 * g] * inv, o1[4 * g + 1] * inv); w1.y = cvt_pk_bf16(o1[4 * g + 2] * inv, o1[4 * g + 3] * inv);
        *(u32x2*)(orow + 8 * g) = w0; *(u32x2*)(orow + 32 + 8 * g) = w1;
    }
}

struct Args { const float* in[28]; float* out; unsigned char* ws; int lo, hi; };
typedef const GAS float* cfp_t;
struct Ctx { const __attribute__((address_space(4))) cfp_t* in; float* out; unsigned char* ws;
    __device__ __forceinline__ const float* inp(int i) const { return (const float*)in[i]; } };
enum { I_X = 0, I_C, I_CTX, I_CCTX, I_MODW, I_MODB, I_N1G, I_N2G, I_MLAWIN, I_CQG, I_CKVG, I_WUQ, I_WUKV, I_QG, I_KG, I_FNETW, I_EWOUT,
       I_WINWIN, I_WQG, I_WKG, I_SINK, I_POOLW, I_POOLS, I_OWOUT, I_FFNUP, I_CONVW, I_CONVB, I_FFNDN };

__device__ __forceinline__ void tr_item(const float* W, int K, int Nsrc, bf16_t* WT, int nblk, int item, LAS float* scr, int lane, int mode, const float* ksc) {
    const int kb = item / nblk, nb = item % nblk, k0 = 64 * kb, n0 = 32 * nb;
    int s0 = n0;
    if (mode == 1) s0 = n0 < 672 ? n0 : -1;
    else if (mode == 2) { const int hd = n0 >> 7, d0 = n0 & 127; s0 = d0 < 96 ? hd * 96 + d0 : -1; }
    else if (mode == 3) { const int pn = n0 >> 8, bj = (n0 >> 7) & 1, c = n0 & 127; s0 = bj * DFF + pn * 128 + c; }
#pragma unroll 16
    for (int i = 0; i < 32; ++i) { const int kk = 2 * i + (lane >> 5); float v = 0.f;
        if (s0 >= 0) { v = W[(size_t)(k0 + kk) * Nsrc + s0 + (lane & 31)]; if (ksc) v *= ksc[k0 + kk]; }
        scr[kk * 33 + (lane & 31)] = v; }
    asm volatile("s_waitcnt lgkmcnt(0)" ::: "memory");
    const int c = lane & 7;
#pragma unroll
    for (int j = 0; j < 4; ++j) { const int n = (lane >> 3) + 8 * j; const LAS float* s = scr + (8 * c) * 33 + n;
        u32x4 o; o.x = cvt_pk_bf16(s[0 * 33], s[1 * 33]); o.y = cvt_pk_bf16(s[2 * 33], s[3 * 33]); o.z = cvt_pk_bf16(s[4 * 33], s[5 * 33]); o.w = cvt_pk_bf16(s[6 * 33], s[7 * 33]);
        *(u32x4*)(WT + (size_t)(n0 + n) * K + k0 + 8 * c) = o; }
    asm volatile("s_waitcnt lgkmcnt(0)" ::: "memory");
}
__device__ __forceinline__ void tr_job(const float* W, int K, int Nsrc, bf16_t* WT, int Nout, int mode, const float* ksc, LAS float* scr, int gw, int ngw, int lane) {
    const int nblk = Nout / 32, nitems = (K / 64) * nblk;
    for (int it = gw; it < nitems; it += ngw) tr_item(W, K, Nsrc, WT, nblk, it, scr, lane, mode, ksc);
}
__device__ __forceinline__ void ffn_weights(const Ctx& a, int layer, LAS float* scr, int gw, int ngw, int lane) {
    tr_job(a.inp(I_FFNUP) + (size_t)layer * DM * 2 * DFF, DM, 2 * DFF, (bf16_t*)(a.ws + WS_WUP), 2 * DFF, 3, nullptr, scr, gw, ngw, lane);
    tr_job(a.inp(I_FFNDN) + (size_t)layer * DFF * DM, DFF, DM, (bf16_t*)(a.ws + ((layer & 1) ? WS_WDN2 : WS_WDN)), DM, 0, nullptr, scr, gw, ngw, lane);
}

__device__ __forceinline__ void mods_item(const Ctx& a, int item, LAS float* sl) {
    int tid = threadIdx.x; asm volatile("" : "+v"(tid)); const int l = item / 48, nb = item % 48;
    LAS float* red = sl + 17 * 1024;
    for (int idx = tid; idx < 17 * 1024; idx += 512) { const int r = idx >> 10, k = idx & 1023; const float v = r < 16 ? a.inp(I_C)[r * 1024 + k] : a.inp(I_CCTX)[k]; sl[idx] = v / (1.0f + __expf(-v)); }
    __syncthreads();
    const int cn = tid & 127, ks = tid >> 7, n = 128 * nb + cn;
    float acc[17];
#pragma unroll
    for (int r = 0; r < 17; ++r) acc[r] = 0.f;
    const float* wp = a.inp(I_MODW) + ((size_t)l * 1024 + 256 * ks) * 6144 + n;
#pragma unroll 4
    for (int k = 0; k < 256; k += 4) {
        const float w0 = wp[(size_t)(k + 0) * 6144], w1 = wp[(size_t)(k + 1) * 6144], w2 = wp[(size_t)(k + 2) * 6144], w3 = wp[(size_t)(k + 3) * 6144];
#pragma unroll
        for (int r = 0; r < 17; ++r) { const f32x4 s4 = *(const LAS f32x4*)(sl + r * 1024 + 256 * ks + k); acc[r] += s4[0] * w0 + s4[1] * w1 + s4[2] * w2 + s4[3] * w3; }
    }
#pragma unroll
    for (int r = 0; r < 17; ++r) red[(ks * 17 + r) * 128 + cn] = acc[r];
    __syncthreads();
    float* mods = (float*)(a.ws + WS_MODS);
    for (int idx = tid; idx < 17 * 128; idx += 512) { const int r = idx >> 7, c2 = idx & 127;
        const float s = red[(0 * 17 + r) * 128 + c2] + red[(1 * 17 + r) * 128 + c2] + red[(2 * 17 + r) * 128 + c2] + red[(3 * 17 + r) * 128 + c2];
        mods[((size_t)l * 17 + r) * 6144 + 128 * nb + c2] = s + a.inp(I_MODB)[l * 6144 + 128 * nb + c2]; }
    __syncthreads();
}

__device__ __forceinline__ void norm_pass(const float* xsrc, const float* csrc, const float* g, const float* mods_l, int shift_idx, int scale_idx,
                                          bf16_t* U, bool ffn_layout, bool skip_ctx, int gw, int ngw, int lane) {
    for (int R0 = gw; R0 < T; R0 += 2 * ngw) {
        f32x4 v[2][4]; bool ok[2]; int bb[2], pp[2];
#pragma unroll
        for (int s = 0; s < 2; ++s) { const int R = R0 + s * ngw; const int b = R / TB, p = R % TB; const bool isctx = p < NCTX; bb[s] = b; pp[s] = p;
            ok[s] = (R < T) && !(isctx && skip_ctx);
            const float* src = isctx ? csrc + (size_t)(b * NCTX + p) * DM : xsrc + (size_t)(b * SEQ + p - NCTX) * DM;
            if (ok[s]) {
#pragma unroll
                for (int j = 0; j < 4; ++j) v[s][j] = *(const f32x4*)(src + (lane + 64 * j) * 4); } }
#pragma unroll
        for (int s = 0; s < 2; ++s) if (ok[s]) {
            const int R = R0 + s * ngw, b = bb[s], p = pp[s]; const bool isctx = p < NCTX;
            const float* mrow = mods_l + (size_t)(isctx ? 16 : b) * 6144;
            float ss = 0.f;
#pragma unroll
            for (int j = 0; j < 4; ++j) ss += (v[s][j][0] * v[s][j][0] + v[s][j][1] * v[s][j][1]) + (v[s][j][2] * v[s][j][2] + v[s][j][3] * v[s][j][3]);
            const float rs = rsqrtf(wave_sum(ss) * (1.0f / DM) + EPS);
            const size_t orow = ffn_layout ? (size_t)b * U2B + (isctx ? p : 264 + p - NCTX) : (size_t)R;
#pragma unroll
            for (int j = 0; j < 4; ++j) { const int c4 = (lane + 64 * j) * 4;
                const f32x4 gg = *(const f32x4*)(g + c4), sh = *(const f32x4*)(mrow + shift_idx * 1024 + c4), sc = *(const f32x4*)(mrow + scale_idx * 1024 + c4);
                const f32x4 y = v[s][j] * rs * gg * (sc + 1.0f) + sh;
                u32x2 w; w.x = cvt_pk_bf16(y[0], y[1]); w.y = cvt_pk_bf16(y[2], y[3]);
                *(u32x2*)(U + orow * DM + c4) = w; }
        }
    }
    if (ffn_layout && gw < 32) {
        const int b = gw >> 1; const size_t orow = (size_t)b * U2B + ((gw & 1) ? 264 + SEQ : 263);
#pragma unroll
        for (int j = 0; j < 4; ++j) *(u32x2*)(U + orow * DM + (lane + 64 * j) * 4) = (u32x2){0u, 0u};
    }
}

template <int NF> __device__ __forceinline__ void rope_cs(int pos, int i, float& cs, float& sn) {
    const int row = pos >> 6, col = pos & 63; const int f = i < NF ? i : i - NF;
    const float inv = exp2f(-(float)f * (13.287712379549449f / NF));
    const float ang = (float)(i < NF ? row : col) * inv;
    sincosf(ang, &sn, &cs);
}

__device__ __forceinline__ void unpack8(const u32x4 v, float (&x)[8]) {
#pragma unroll
    for (int i = 0; i < 4; ++i) { x[2 * i] = bflo(v[i]); x[2 * i + 1] = bfhi(v[i]); }
}
__device__ __forceinline__ u32x4 pack8f(const float (&x)[8]) { u32x4 o; o.x = cvt_pk_bf16(x[0], x[1]); o.y = cvt_pk_bf16(x[2], x[3]); o.z = cvt_pk_bf16(x[4], x[5]); o.w = cvt_pk_bf16(x[6], x[7]); return o; }

__device__ __forceinline__ void ew_even(const Ctx& a, int j, int gw, int ngw, int lane) {
    const bf16_t* H = (const bf16_t*)(a.ws + WS_H); bf16_t* Qb = (bf16_t*)(a.ws + WS_Q); bf16_t* KVb = (bf16_t*)(a.ws + WS_KV); bf16_t* Kout = (bf16_t*)(a.ws + WS_U);
    const float QS = 0.10206207261596577f * LOG2E;
    const f32x2v* ropeT = (const f32x2v*)(a.ws + WS_ROPE_E);
    const int g16 = lane >> 4, c16 = lane & 15; const bool act = c16 < 12; const int cc = act ? c16 : 0;
    float qg[8], kg[8];
#pragma unroll
    for (int e = 0; e < 8; ++e) { qg[e] = a.inp(I_QG)[j * 96 + 8 * cc + e]; kg[e] = a.inp(I_KG)[j * 96 + 8 * cc + e]; }
    for (int R = gw; R < T; R += ngw) {
        const int p = R % TB; const int pos = p - NCTX; const bool lat = pos >= 0;
        const bf16_t* hrow = H + (size_t)R * 768; bf16_t* qrow = Qb + (size_t)R * 1536; bf16_t* kvrow = KVb + (size_t)R * 1536;
        const u32x4 z4 = {0u, 0u, 0u, 0u};
        u32x4 hv = z4; if (lane < 48) hv = *(const u32x4*)(hrow + 8 * lane);
        u32x4 qv[3], kv[3], vv[2];
#pragma unroll
        for (int rd = 0; rd < 3; ++rd) { const int hd = 4 * rd + g16; qv[rd] = z4; kv[rd] = z4;
            if (act) { qv[rd] = *(const u32x4*)(qrow + hd * 128 + 8 * c16); kv[rd] = c16 < 8 ? *(const u32x4*)(kvrow + hd * 128 + 8 * c16) : *(const u32x4*)(hrow + 384 + 8 * (c16 - 8)); } }
        vv[0] = *(const u32x4*)(kvrow + (lane >> 3) * 128 + 64 + 8 * (lane & 7)); vv[1] = z4;
        if (lane < 32) vv[1] = *(const u32x4*)(kvrow + ((lane + 64) >> 3) * 128 + 64 + 8 * (lane & 7));
        float cs[8], sn[8];
#pragma unroll
        for (int e = 0; e < 8; ++e) { cs[e] = 1.f; sn[e] = 0.f; }
        if (lat && c16 >= 8 && act) {
#pragma unroll
            for (int e = 0; e < 8; ++e) { const f32x2v t = ropeT[pos * 16 + 8 * (c16 & 1) + e]; cs[e] = t.x; sn[e] = t.y; } }
        float x[8]; unpack8(hv, x); float ss = 0.f;
#pragma unroll
        for (int e = 0; e < 8; ++e) ss += x[e] * x[e];
        ss = half_sum(ss);
        const float r_q = rsqrtf(__shfl(ss, 0) * (1.0f / 256.0f) + EPS), r_kv = rsqrtf(__shfl(ss, 32) * (1.0f / 128.0f) + EPS);
#pragma unroll
        for (int rd = 0; rd < 3; ++rd) {
            const int hd = 4 * rd + g16;
            { float y[8], o[8]; unpack8(qv[rd], y); float s2 = 0.f;
#pragma unroll
              for (int e = 0; e < 8; ++e) { y[e] *= r_q; s2 += y[e] * y[e]; }
              s2 += __shfl_xor(s2, 8); s2 += __shfl_xor(s2, 4); s2 += __shfl_xor(s2, 2); s2 += __shfl_xor(s2, 1);
              const float sc = rsqrtf(s2 * (1.0f / 96.0f) + EPS);
#pragma unroll
              for (int e = 0; e < 8; ++e) { y[e] *= sc * qg[e]; o[e] = __shfl_xor(y[e], 2); }
              if (c16 >= 8) {
#pragma unroll
                  for (int e = 0; e < 8; ++e) y[e] = c16 < 10 ? y[e] * cs[e] - o[e] * sn[e] : o[e] * sn[e] + y[e] * cs[e]; }
#pragma unroll
              for (int e = 0; e < 8; ++e) y[e] *= QS;
              if (act) *(u32x4*)(qrow + hd * 128 + 8 * c16) = pack8f(y); }
            { float y[8], o[8]; unpack8(kv[rd], y); float s2 = 0.f; const float pre = c16 < 8 ? r_kv : 1.0f;
#pragma unroll
              for (int e = 0; e < 8; ++e) { y[e] *= pre; s2 += y[e] * y[e]; }
              s2 += __shfl_xor(s2, 8); s2 += __shfl_xor(s2, 4); s2 += __shfl_xor(s2, 2); s2 += __shfl_xor(s2, 1);
              const float sc = rsqrtf(s2 * (1.0f / 96.0f) + EPS);
#pragma unroll
              for (int e = 0; e < 8; ++e) { y[e] *= sc * kg[e]; o[e] = __shfl_xor(y[e], 2); }
              if (c16 >= 8) {
#pragma unroll
                  for (int e = 0; e < 8; ++e) y[e] = c16 < 10 ? y[e] * cs[e] - o[e] * sn[e] : o[e] * sn[e] + y[e] * cs[e]; }
              if (act) *(u32x4*)(Kout + (size_t)R * 1152 + hd * 96 + 8 * c16) = pack8f(y); }
        }
        { float y[8]; unpack8(vv[0], y);
#pragma unroll
          for (int e = 0; e < 8; ++e) y[e] *= r_kv;
          *(u32x4*)(kvrow + (lane >> 3) * 128 + 64 + 8 * (lane & 7)) = pack8f(y);
          if (lane < 32) { unpack8(vv[1], y);
#pragma unroll
              for (int e = 0; e < 8; ++e) y[e] *= r_kv;
              *(u32x4*)(kvrow + ((lane + 64) >> 3) * 128 + 64 + 8 * (lane & 7)) = pack8f(y); } }
    }
}

__device__ __forceinline__ void ew_odd(const Ctx& a, int j, int gw, int ngw, int lane) {
    bf16_t* H = (bf16_t*)(a.ws + WS_H); bf16_t* PO = (bf16_t*)(a.ws + WS_POOL);
    const float QS = 0.125f * LOG2E;
    const f32x2v* ropeT = (const f32x2v*)(a.ws + WS_ROPE_O);
    const int c8 = lane & 7, hl = lane >> 3;
    float qg[8], kg[8];
#pragma unroll
    for (int e = 0; e < 8; ++e) { qg[e] = a.inp(I_WQG)[j * 64 + 8 * c8 + e]; kg[e] = a.inp(I_WKG)[j * 64 + 8 * c8 + e]; }
    for (int R = gw; R < T; R += ngw) {
        const int p = R % TB; const int pos = p - NCTX; const bool lat = pos >= 0;
        bf16_t* hrow = H + (size_t)R * 1536;
        u32x4 qk[2]; qk[0] = *(const u32x4*)(hrow + 8 * lane); qk[1] = *(const u32x4*)(hrow + 512 + 8 * lane);
        float cs[8], sn[8];
#pragma unroll
        for (int e = 0; e < 8; ++e) { cs[e] = 1.f; sn[e] = 0.f; }
        if (lat) {
#pragma unroll
            for (int e = 0; e < 8; ++e) { const f32x2v t = ropeT[pos * 32 + 8 * (c8 & 3) + e]; cs[e] = t.x; sn[e] = t.y; } }
        const int tpos = lat ? pos : p, Ls = lat ? SEQ : NCTX;
        { const int pc = lane & 31, g = pc >> 3, half = 1 << g;
          const int lo = tpos - half < 0 ? 0 : tpos - half, hi = tpos + half > Ls ? Ls : tpos + half;
          float sum[8];
#pragma unroll
          for (int e = 0; e < 8; ++e) sum[e] = 0.f;
          if (lane < 32) {
              for (int tt = lo; tt < hi; ++tt) { float z[8]; unpack8(*(const u32x4*)(hrow + (ptrdiff_t)(tt - tpos) * 1536 + 1280 + 8 * pc), z);
#pragma unroll
                  for (int e = 0; e < 8; ++e) sum[e] += z[e]; }
              const float rc = 1.0f / (float)(hi - lo); float z[8]; unpack8(*(const u32x4*)(hrow + 1280 + 8 * pc), z);
#pragma unroll
              for (int e = 0; e < 8; ++e) sum[e] = sum[e] * rc - z[e];
              *(u32x4*)(PO + (size_t)R * 256 + 8 * pc) = pack8f(sum); } }
#pragma unroll
        for (int rd = 0; rd < 2; ++rd) {
            const int hd = 8 * rd + hl; const bool isq = hd < 12;
            float y[8], o[8]; unpack8(qk[rd], y); float s2 = 0.f;
#pragma unroll
            for (int e = 0; e < 8; ++e) s2 += y[e] * y[e];
            s2 += __shfl_xor(s2, 4); s2 += __shfl_xor(s2, 2); s2 += __shfl_xor(s2, 1);
            const float sc = rsqrtf(s2 * (1.0f / 64.0f) + EPS);
#pragma unroll
            for (int e = 0; e < 8; ++e) { y[e] *= sc * (isq ? qg[e] : kg[e]); o[e] = __shfl_xor(y[e], 4); }
#pragma unroll
            for (int e = 0; e < 8; ++e) y[e] = c8 < 4 ? y[e] * cs[e] - o[e] * sn[e] : o[e] * sn[e] + y[e] * cs[e];
            const float osc = isq ? QS : 1.0f;
#pragma unroll
            for (int e = 0; e < 8; ++e) y[e] *= osc;
            *(u32x4*)(hrow + 512 * rd + 8 * lane) = pack8f(y);
        }
    }
}

#define XB_TMO      128
#define XB_XCNT(j)  (256  + 64 * (j))
#define XB_XSUB(j)  (1280 + 64 * (j))
#define XB_XGEN(j)  (2304 + 64 * (j))
#define XB_TOP      3328
#define XB_TOPGEN   3392
#define XCD_BAR_WORDS 3456
#define XB_SPIN_CAP (1u << 18)
__device__ __forceinline__ unsigned xb_ld(unsigned* p)              { return __hip_atomic_load(p, __ATOMIC_RELAXED, __HIP_MEMORY_SCOPE_AGENT); }
__device__ __forceinline__ unsigned xb_add(unsigned* p, unsigned v) { return __hip_atomic_fetch_add(p, v, __ATOMIC_RELAXED, __HIP_MEMORY_SCOPE_AGENT); }
__device__ __forceinline__ unsigned xb_xcc_id() { return (unsigned)__builtin_amdgcn_s_getreg((3 << 11) | 20) & 0xFu; }
#define XB_SPIN(cond, bar) do { unsigned _sp = 0; while (cond) { __builtin_amdgcn_s_sleep(1); \
    if ((++_sp & 255u) == 0u) { if (xb_ld(&(bar)[XB_TMO])) break; if (_sp > XB_SPIN_CAP) { atomicAdd(&(bar)[XB_TMO], 1u); break; } } } } while (0)
struct XcdBarrier { unsigned* bar; unsigned x; volatile LAS unsigned* st; };
__device__ __forceinline__ XcdBarrier xcd_barrier_post(unsigned* bar, volatile LAS unsigned* st) {
    XcdBarrier b; b.bar = bar; b.x = xb_xcc_id(); b.st = st;
    int tid_ = threadIdx.x; asm volatile("" : "+v"(tid_));
    if (tid_ == 0) (void)xb_add(&bar[XB_XCNT(b.x)], 1u);
    return b;
}
__device__ __forceinline__ void xcd_barrier_complete(unsigned* bar, unsigned x, unsigned& nloc, unsigned& nx) {
    const unsigned G = gridDim.x * gridDim.y * gridDim.z;
    unsigned sum, cnt, mine, sp = 0u;
    for (;;) {
        sum = 0u; cnt = 0u; mine = 0u;
#pragma unroll
        for (unsigned j = 0; j < 16; ++j) { const unsigned c = xb_ld(&bar[XB_XCNT(j)]); sum += c; cnt += (c > 0u) ? 1u : 0u; mine = (j == x) ? c : mine; }
        if (sum == G) break;
        __builtin_amdgcn_s_sleep(1);
        if ((++sp & 255u) == 0u) { if (xb_ld(&bar[XB_TMO])) break; if (sp > XB_SPIN_CAP) { atomicAdd(&bar[XB_TMO], 1u); break; } }
    }
    nloc = mine > 0u ? mine : 1u; nx = cnt > 0u ? cnt : 1u;
}
__device__ __forceinline__ void xcd_barrier(const XcdBarrier& b) {
    asm volatile("s_waitcnt vmcnt(0)" ::: "memory");
    __syncthreads();
    int tid_ = threadIdx.x; asm volatile("" : "+v"(tid_));
    if (tid_ == 0) {
        unsigned* bar = b.bar;
        __builtin_amdgcn_s_waitcnt(0);
        unsigned nloc = b.st[0], nx = b.st[1];
        if (nloc == 0u) { xcd_barrier_complete(bar, b.x, nloc, nx); b.st[0] = nloc; b.st[1] = nx; }
        const unsigned old = xb_add(&bar[XB_XSUB(b.x)], 1u);
        const unsigned gen = old / nloc;
        if (old + 1u == (gen + 1u) * nloc) {
            __builtin_amdgcn_fence(__ATOMIC_RELEASE, "agent");
            asm volatile("s_waitcnt vmcnt(0)" ::: "memory");
            const unsigned og = xb_add(&bar[XB_TOP], 1u);
            const unsigned tg = og / nx;
            if (og + 1u == (tg + 1u) * nx) xb_add(&bar[XB_TOPGEN], 1u);
            else XB_SPIN(xb_ld(&bar[XB_TOPGEN]) == tg, bar);
            __builtin_amdgcn_fence(__ATOMIC_ACQUIRE, "agent");
            xb_add(&bar[XB_XGEN(b.x)], 1u);
            asm volatile("s_waitcnt vmcnt(0)" ::: "memory");
        } else {
            XB_SPIN(xb_ld(&bar[XB_XGEN(b.x)]) == gen, bar);
            __builtin_amdgcn_fence(__ATOMIC_ACQUIRE, "agent");
            asm volatile("s_waitcnt vmcnt(0)" ::: "memory");
        }
    }
    __syncthreads();
}

constexpr int LDS_BYTES = 147456;
constexpr int NPHASES = 1 + 2 * 9 + 2 * 8;

__global__ void __launch_bounds__(512, 2) mega_fwd(Args ka) {
    extern __shared__ __attribute__((aligned(16))) unsigned char lds_raw[];
    LAS unsigned char* lds = (LAS unsigned char*)lds_raw;
    cg::grid_group grid = cg::this_grid();
    volatile LAS unsigned* xbst = (volatile LAS unsigned*)(lds + 139264);
    { int tid_ = threadIdx.x; asm volatile("" : "+v"(tid_)); if (tid_ < 2) xbst[tid_] = 0u; }
    __syncthreads();
    XcdBarrier xbar; xbar.bar = (unsigned*)ka.ws; xbar.x = 0; xbar.st = xbst;
    if (ka.hi - ka.lo > 1) xbar = xcd_barrier_post((unsigned*)ka.ws, xbst);
#define U ((bf16_t*)(wsl + WS_U))
#define MIX ((bf16_t*)(wsl + WS_MIX))
#define Hb ((bf16_t*)(wsl + WS_H))
#define Qb ((bf16_t*)(wsl + WS_Q))
#define KVb ((bf16_t*)(wsl + WS_KV))
#define ZL ((bf16_t*)(wsl + WS_ZL))
#define ZC ((bf16_t*)(wsl + WS_ZC))
#define HID ((bf16_t*)(wsl + WS_HID))
#define POOL ((bf16_t*)(wsl + WS_POOL))
#define DFTL ((bf16_t*)(wsl + WS_DFTL))
#define DFTC ((bf16_t*)(wsl + WS_DFTC))
#define hctx ((float*)(wsl + WS_HCTX))
    int ph = 0, layer_ = 0;
#define PHASE_BEGIN if (ph >= ka.lo && ph < ka.hi) { GAS unsigned char* wsg_ = (GAS unsigned char*)ka.ws; asm volatile("" : "+s"(wsg_)); unsigned char* wsl = (unsigned char*)wsg_; \
        const __attribute__((address_space(4))) cfp_t* ain_ = (const __attribute__((address_space(4))) cfp_t*)__builtin_amdgcn_kernarg_segment_ptr(); asm volatile("" : "+s"(ain_)); \
        const Ctx a{ain_, ka.out, wsl}; \
        int lyr_ = layer_; asm volatile("" : "+s"(lyr_)); const float* mods_l = (const float*)(wsl + WS_MODS) + (size_t)lyr_ * 17 * 6144; const float* xin = lyr_ == 0 ? a.inp(I_X) : a.out; const float* cin = lyr_ == 0 ? a.inp(I_CTX) : (const float*)(wsl + WS_HCTX); (void)mods_l; (void)xin; (void)cin; int tid = threadIdx.x; asm volatile("" : "+v"(tid)); int G = gridDim.x, bx = blockIdx.x; asm volatile("" : "+s"(G), "+s"(bx)); \
        const int vcu = (G % 8 == 0) ? (bx % 8) * (G / 8) + bx / 8 : bx, ngw = G * 8, ngt = G * 512; (void)vcu; (void)ngw; (void)ngt; \
        const int lane = tid & 63, wave = __builtin_amdgcn_readfirstlane(tid >> 6), gw = bx * 8 + wave, gtid = bx * 512 + tid; LAS float* scr = (LAS float*)(lds + wave * 8448); \
        (void)lane; (void)gw; (void)gtid; (void)scr;
#define PHASE_END } if (ph >= ka.lo && ph + 1 < ka.hi) { for (int sr_ = 0; sr_ < REP_SYNC; ++sr_) { if (ph == 0) grid.sync(); else xcd_barrier(xbar); } } ++ph;

    PHASE_BEGIN
#ifndef SKIP_P0
        { REPLOOP(REP_P0) {
        for (int it = bx; it < 192; it += G) mods_item(a, it, (LAS float*)lds);
        for (int j = 0; j < 2; ++j) {
            tr_job(a.inp(I_MLAWIN) + (size_t)j * DM * 672, DM, 672, (bf16_t*)(wsl + WS_WINE) + (size_t)j * 768 * DM, 768, 1, nullptr, scr, gw, ngw, lane);
            tr_job(a.inp(I_WUQ) + (size_t)j * 256 * 1152, 256, 1152, (bf16_t*)(wsl + WS_WUQ) + (size_t)j * 1536 * 256, 1536, 2, a.inp(I_CQG) + j * 256, scr, gw, ngw, lane);
            tr_job(a.inp(I_WUKV) + (size_t)j * 128 * 1536, 128, 1536, (bf16_t*)(wsl + WS_WUKV) + (size_t)j * 1536 * 128, 1536, 0, a.inp(I_CKVG) + j * 128, scr, gw, ngw, lane);
            tr_job(a.inp(I_EWOUT) + (size_t)j * DM * DM, DM, DM, (bf16_t*)(wsl + WS_WOUTE) + (size_t)j * DM * DM, DM, 0, nullptr, scr, gw, ngw, lane);
            tr_job(a.inp(I_WINWIN) + (size_t)j * DM * 1536, DM, 1536, (bf16_t*)(wsl + WS_WINO) + (size_t)j * 1536 * DM, 1536, 0, nullptr, scr, gw, ngw, lane);
            tr_job(a.inp(I_OWOUT) + (size_t)j * DM * DM, DM, DM, (bf16_t*)(wsl + WS_WOUTO) + (size_t)j * DM * DM, DM, 0, nullptr, scr, gw, ngw, lane);
        }
        ffn_weights(a, 0, scr, gw, ngw, lane);
        __syncthreads();
        LAS float* ctab = (LAS float*)lds;
        for (int m = tid; m < 4096; m += 512) ctab[m] = cospif((float)m * (1.0f / 2048.0f)) * (1.0f / 64.0f);
        __syncthreads();
        for (int idx = gtid; idx < 4096 * 1024; idx += ngt) { const int k = idx >> 10, col0 = (idx & 1023) * 8, cs = col0 >> 12, l0 = col0 & 4095; float v[8];
#pragma unroll
            for (int e = 0; e < 8; ++e) { const int m = (k * (l0 + e) + cs * 1024) & 4095; v[e] = ctab[m]; }
            u32x4 o; o.x = cvt_pk_bf16(v[0], v[1]); o.y = cvt_pk_bf16(v[2], v[3]); o.z = cvt_pk_bf16(v[4], v[5]); o.w = cvt_pk_bf16(v[6], v[7]);
            *(u32x4*)(DFTL + (size_t)k * 8192 + col0) = o; }
        for (int idx = gtid; idx < 256 * 64; idx += ngt) { const int k = idx >> 6, col0 = (idx & 63) * 8, cs = col0 >> 8, l0 = col0 & 255; float v[8];
#pragma unroll
            for (int e = 0; e < 8; ++e) { const int m = (k * (l0 + e)) & 255; const float x = (float)m * (1.0f / 128.0f); v[e] = (cs ? -sinpif(x) : cospif(x)) * (1.0f / 16.0f); }
            u32x4 o; o.x = cvt_pk_bf16(v[0], v[1]); o.y = cvt_pk_bf16(v[2], v[3]); o.z = cvt_pk_bf16(v[4], v[5]); o.w = cvt_pk_bf16(v[6], v[7]);
            *(u32x4*)(DFTC + (size_t)k * 512 + col0) = o; }
        for (int idx = gtid; idx < 2 * 512 * 256; idx += ngt) { const int j = idx >> 17, n = (idx >> 8) & 511, k = idx & 255; const int cs = n >> 8, g = (n >> 6) & 3, d = n & 63, g2 = k >> 6, c = k & 63;
            float s = 0.f;
            if (g2 == g) { const float* wf = a.inp(I_FNETW) + ((size_t)(j * 4 + g) * 64) * 64 + d;
                for (int c2 = 0; c2 < 64; ++c2) { const int m = (c * c2) & 63; s += (cs ? -ctab[(m * 64 + 1024) & 4095] : ctab[m * 64]) * wf[c2 * 64]; }
                s *= 8.0f; }
            ((bf16_t*)(wsl + WS_WF))[idx] = (bf16_t)(cvt_pk_bf16(s, 0.f) & 0xffffu); }
        for (int idx = gtid; idx < 4096 * 16; idx += ngt) { float cs, sn; rope_cs<8>(idx >> 4, idx & 15, cs, sn); ((f32x2v*)(wsl + WS_ROPE_E))[idx] = (f32x2v){cs, sn}; }
        for (int idx = gtid; idx < 4096 * 32; idx += ngt) { float cs, sn; rope_cs<16>(idx >> 5, idx & 31, cs, sn); ((f32x2v*)(wsl + WS_ROPE_O))[idx] = (f32x2v){cs, sn}; }
        for (int idx = gtid; idx < 2 * 256 * 256; idx += ngt) { const int j = idx >> 16, n = (idx >> 8) & 255, k = idx & 255; const int g = n >> 6, d = n & 63, g2 = k >> 6, c = k & 63;
            float s = 0.f; if (g2 == g) s = a.inp(I_POOLW)[((size_t)(j * 4 + g) * 64 + c) * 64 + d] * a.inp(I_POOLS)[j * 256 + n];
            ((bf16_t*)(wsl + WS_WP))[idx] = (bf16_t)(cvt_pk_bf16(s, 0.f) & 0xffffu); }
        __syncthreads(); } }
#endif
    PHASE_END

    for (int layer = 0; layer < 4; ++layer) {
        const int j = layer >> 1; const bool even = !(layer & 1); const bool ctx_out = layer < 3;
        layer_ = layer;

        PHASE_BEGIN
#ifndef SKIP_NORM
            { REPLOOP(REP_NORM)
            norm_pass(xin, cin, a.inp(I_N1G) + layer * DM, mods_l, 0, 1, U, false, false, gw, ngw, lane); }
#endif
        PHASE_END

        PHASE_BEGIN
#ifndef SKIP_GIN
            { REPLOOP(REP_GIN) {
            if (even) { pg8::Gemm g{U, (const bf16_t*)(wsl + WS_WINE) + (size_t)j * 768 * DM, DM, DM, DM};
                pg8::Order<pg8::MapStd> S; S.init(T / 256, 3, G, bx, pg8::MapStd{0}); pg8::EpiBf16 E{Hb, 768, Hb, 768}; pg8::gemm_phase(lds, g, S, E); }
            else { pg8::Gemm g{U, (const bf16_t*)(wsl + WS_WINO) + (size_t)j * 1536 * DM, DM, DM, DM};
                pg8::Order<pg8::MapStd> S; S.init(T / 256, 6, G, bx, pg8::MapStd{0}); pg8::EpiBf16 E{Hb, 1536, Hb, 1536}; pg8::gemm_phase(lds, g, S, E); }
            } }
#endif
        PHASE_END

        if (even) {
            PHASE_BEGIN
#ifndef SKIP_G3
                { REPLOOP(REP_G3) {
                { pg8::Gemm g{Hb, (const bf16_t*)(wsl + WS_WUQ) + (size_t)j * 1536 * 256, 768, 256, 256};
                  pg8::Order<pg8::MapStd> S; S.init(T / 256, 6, G, bx, pg8::MapStd{0}); pg8::EpiBf16 E{Qb, 1536, Qb, 1536}; pg8::gemm_phase(lds, g, S, E); }
                { pg8::Gemm g{Hb + 256, (const bf16_t*)(wsl + WS_WUKV) + (size_t)j * 1536 * 128, 768, 128, 128};
                  pg8::Order<pg8::MapStd> S; S.init(T / 256, 6, G, bx, pg8::MapStd{0}); pg8::EpiBf16 E{KVb, 1536, KVb, 1536}; pg8::gemm_phase(lds, g, S, E); }
                { pg8::Gemm g{(const bf16_t*)(wsl + WS_WF) + (size_t)j * 512 * 256, Hb + 416, 256, 768, 256};
                  pg8::Order<pg8::MapZ> S; S.init(2, T / 256, G, bx, pg8::MapZ{}); pg8::EpiBf16 E{ZL, 8192, ZC, 512}; pg8::gemm_phase(lds, g, S, E); }
                } }
#endif
            PHASE_END
            PHASE_BEGIN
#ifndef SKIP_EWE
                ew_even(a, j, gw, ngw, lane);
#endif
            PHASE_END
            PHASE_BEGIN
#ifndef SKIP_ATTE
                const bf16_t* Kb = (const bf16_t*)(wsl + WS_U);
                const int nu = 3072 + (ctx_out ? 192 : 0);
                { REPLOOP(REP_ATTE)
                for (int uid = vcu; uid < nu; uid += G) {
                    if (uid < 3072) { const int bh = uid >> 4, qb = uid & 15, b = bh / 12, h = bh % 12; const size_t base = (size_t)b * TB, qrow = base + NCTX + qb * 256;
                        attn_unit<96, false>(lds, Qb + qrow * 1536 + h * 128, 1536, Kb + base * 1152 + h * 96, 1152, KVb + base * 1536 + h * 128 + 64, 1536, MIX + qrow * DM + h * 64, 68, 0, 0, 0, -1e30f, false); }
                    else { const int bh = uid - 3072, b = bh / 12, h = bh % 12; const size_t base = (size_t)b * TB;
                        attn_unit<96, false>(lds, Qb + base * 1536 + h * 128, 1536, Kb + base * 1152 + h * 96, 1152, KVb + base * 1536 + h * 128 + 64, 1536, MIX + base * DM + h * 64, 4, 0, 0, 0, -1e30f, false); }
                } }
#ifndef SKIP_ATTE_G
                { REPLOOP(REP_FNET) {
                { pg8::Gemm g{DFTL, ZL, 8192, 8192, 8192};
                  pg8::Order<pg8::MapFnetL> S; S.init(256, 1, G, bx, pg8::MapFnetL{}); pg8::EpiBf16 E{MIX, DM, MIX, DM}; pg8::gemm_phase(lds, g, S, E); }
                if (ctx_out) { pg8::Gemm g{DFTC, ZC, 512, 512, 512};
                  pg8::Order<pg8::MapFnetC> S; S.init(16, 1, G, bx, pg8::MapFnetC{}); pg8::EpiBf16 E{MIX, DM, MIX, DM}; pg8::gemm_phase(lds, g, S, E); }
                } }
#endif
#endif
            PHASE_END
        } else {
            PHASE_BEGIN
#ifndef SKIP_EWO
                ew_odd(a, j, gw, ngw, lane);
#endif
            PHASE_END
            PHASE_BEGIN
#ifndef SKIP_ATTO
                const float* sink = a.inp(I_SINK) + j * 12;
                const int nu = 3072 + (ctx_out ? 192 : 0);
                { REPLOOP(REP_ATTO)
                for (int uid = vcu; uid < nu; uid += G) {
                    if (uid < 3072) { const int bh = uid >> 4, qb = uid & 15, b = bh / 12, h = bh % 12, kvh = h / 3; const size_t base = (size_t)b * TB, qrow = base + NCTX + qb * 256;
                        int lt0 = qb * 4 - 2, lt1 = qb * 4 + 6; if (lt0 < 0) lt0 = 0; if (lt1 > 64) lt1 = 64;
                        attn_unit<64, true>(lds, Hb + qrow * 1536 + h * 64, 1536, Hb + base * 1536 + 768 + kvh * 64, 1536, Hb + base * 1536 + 1024 + kvh * 64, 1536, MIX + qrow * DM + h * 64,
                                            4, 4 + lt0, 4 + lt1, qb * 256, sink[h] * LOG2E, true); }
                    else { const int bh = uid - 3072, b = bh / 12, h = bh % 12, kvh = h / 3; const size_t base = (size_t)b * TB;
                        attn_unit<64, true>(lds, Hb + base * 1536 + h * 64, 1536, Hb + base * 1536 + 768 + kvh * 64, 1536, Hb + base * 1536 + 1024 + kvh * 64, 1536, MIX + base * DM + h * 64,
                                            4, 0, 0, 0, sink[h] * LOG2E, true); }
                } }
                { pg8::Gemm g{POOL, (const bf16_t*)(wsl + WS_WP) + (size_t)j * 256 * 256, 256, 256, 256};
                  pg8::Order<pg8::MapStd> S; S.init(T / 256, 1, G, bx, pg8::MapStd{768}); pg8::EpiBf16 E{MIX, DM, MIX, DM}; pg8::gemm_phase(lds, g, S, E); }
#endif
            PHASE_END
        }

        PHASE_BEGIN
#ifndef SKIP_WOUT
            pg8::Gemm g{MIX, (const bf16_t*)(wsl + (even ? WS_WOUTE : WS_WOUTO)) + (size_t)j * DM * DM, DM, DM, DM};
            pg8::Order<pg8::MapRes> S; S.init(ctx_out ? 272 : 256, 4, G, bx, pg8::MapRes{ctx_out ? 1 : 0});
            { REPLOOP(REP_WOUT) { pg8::EpiRes E{rep_ ? (const float*)a.out : xin, a.out, rep_ ? (const float*)hctx : cin, hctx, mods_l, 2, rep_ ? 0.f : 1.f}; pg8::gemm_phase(lds, g, S, E); } }
#endif
        PHASE_END

        PHASE_BEGIN
#ifndef SKIP_NORM2
            { REPLOOP(REP_NORM)
            norm_pass(a.out, hctx, a.inp(I_N2G) + layer * DM, mods_l, 3, 4, U, true, !ctx_out, gw, ngw, lane); }
#endif
        PHASE_END

        PHASE_BEGIN
#ifndef SKIP_UP
            pg8::Gemm g{U, (const bf16_t*)(wsl + WS_WUP), DM, DM, DM};
            pg8::Order<pg8::MapUp> S; S.init(ctx_out ? 288 : 272, 22, G, bx, pg8::MapUp{ctx_out ? 1 : 0});
            pg8::EpiUp E{HID, a.inp(I_CONVW) + (size_t)layer * 3 * 2 * DFF, a.inp(I_CONVB) + (size_t)layer * 2 * DFF}; { REPLOOP(REP_UP) pg8::gemm_phase(lds, g, S, E); }
#endif
        PHASE_END

        PHASE_BEGIN
#ifndef SKIP_DN
            pg8::Gemm g{HID, (const bf16_t*)(wsl + ((layer & 1) ? WS_WDN2 : WS_WDN)), DFF, DFF, DFF};
            pg8::Order<pg8::MapRes> S; S.init(ctx_out ? 272 : 256, 4, G, bx, pg8::MapRes{ctx_out ? 1 : 0});
            { REPLOOP(REP_DN) { pg8::EpiRes E{a.out, a.out, hctx, hctx, mods_l, 5, rep_ ? 0.f : 1.f}; pg8::gemm_phase(lds, g, S, E); } }
            if (layer < 3) {
                const int nfree = (ctx_out && G == 256) ? 192 : G, first = (ctx_out && G == 256) ? 64 : 0;
                if (bx >= first) ffn_weights(a, layer + 1, scr, (bx - first) * 8 + wave, nfree * 8, lane);
            }
#endif
        PHASE_END
    }
#undef PHASE_BEGIN
#undef PHASE_END
#undef U
#undef MIX
#undef Hb
#undef Qb
#undef KVb
#undef ZL
#undef ZC
#undef HID
#undef POOL
#undef DFTL
#undef DFTC
#undef hctx
}

extern "C" void kernel_launch(void* const* d_in, const int* in_sizes, int n_in, void* d_out, int out_size, void* d_ws, size_t ws_size, hipStream_t stream) {
    static int grid = 0;
    if (grid == 0) {
        if (n_in != 28 || out_size != NB * SEQ * DM || ws_size < WS_END) { fprintf(stderr, "kernel_launch: unexpected shapes (n_in %d, out %d, ws %zu); nothing launched\n", n_in, out_size, ws_size); grid = -1; return; }
        int dev = 0, cus = 0, per_cu = 0;
        if (hipGetDevice(&dev) != hipSuccess || hipDeviceGetAttribute(&cus, hipDeviceAttributeMultiprocessorCount, dev) != hipSuccess) { grid = -1; return; }
        if (hipFuncSetAttribute((const void*)mega_fwd, hipFuncAttributeMaxDynamicSharedMemorySize, LDS_BYTES) != hipSuccess) { fprintf(stderr, "kernel_launch: hipFuncSetAttribute failed\n"); grid = -1; return; }
        if (hipOccupancyMaxActiveBlocksPerMultiprocessor(&per_cu, (const void*)mega_fwd, 512, LDS_BYTES) != hipSuccess || per_cu < 1) { fprintf(stderr, "kernel_launch: occupancy query says %d\n", per_cu); per_cu = 1; }
        (void)hipGetLastError();
        grid = cus * 1;
    }
    if (grid < 0) return;
    Args a{};
    for (int i = 0; i < 28; ++i) a.in[i] = (const float*)d_in[i];
    a.out = (float*)d_out; a.ws = (unsigned char*)d_ws; a.lo = 0; a.hi = NPHASES;
    (void)hipMemsetAsync(d_ws, 0, 16384, stream);
    void* args[] = {&a};
    hipError_t e = hipLaunchCooperativeKernel((const void*)mega_fwd, dim3(grid), dim3(512), args, LDS_BYTES, stream);
    if (e != hipSuccess) {
        fprintf(stderr, "kernel_launch: cooperative launch failed: %s (grid %d); falling back to one launch per phase\n", hipGetErrorString(e), grid);
        (void)hipGetLastError();
        for (int p = 0; p < NPHASES; ++p) { a.lo = p; a.hi = p + 1; hipLaunchKernelGGL(mega_fwd, dim3(grid), dim3(512), LDS_BYTES, stream, a); }
    }
}
```

```cpp
#include <hip/hip_runtime.h>
#include <hip/hip_cooperative_groups.h>
#include <cstdio>
#include <cstdint>
namespace cg = cooperative_groups;

#define REP_NORM 1
#define REP_GIN 1
#define REP_G3 1
#define REP_ATTE 1
#define REP_FNET 1
#define REP_ATTO 1
#define REP_WOUT 1
#define REP_UP 1
#define REP_DN 1
#define REP_P0 1
#define REP_EW 1
#define REP_SYNC 1
#define PROBE_MODE 0
#define REPLOOP(N) int nrep_ = (N); asm volatile("" : "+s"(nrep_)); for (int rep_ = 0; rep_ < nrep_; ++rep_)

constexpr int NB = 16, SEQ = 4096, NCTX = 256, DM = 1024, TB = SEQ + NCTX, T = NB * TB;
constexpr int DFF = 2816, U2B = 4608;
constexpr float EPS = 1e-6f;
constexpr float LOG2E = 1.4426950408889634f;

constexpr size_t MiB = 1u << 20;
constexpr size_t WS_MODS = 1 * MiB;
constexpr size_t WS_WINE = 3 * MiB;
constexpr size_t WS_WUQ = 6 * MiB;
constexpr size_t WS_WUKV = WS_WUQ + 3 * MiB / 2;
constexpr size_t WS_WF = WS_WUKV + 3 * MiB / 4;
constexpr size_t WS_WP = WS_WF + MiB / 2;
constexpr size_t WS_WOUTE = 9 * MiB;
constexpr size_t WS_WOUTO = 13 * MiB;
constexpr size_t WS_WINO = 17 * MiB;
constexpr size_t WS_WUP = 23 * MiB;
constexpr size_t WS_WDN = 34 * MiB;
constexpr size_t WS_DFTC = 40 * MiB;
constexpr size_t WS_DFTL = 41 * MiB;
constexpr size_t WS_HCTX = 105 * MiB;
constexpr size_t WS_U = 121 * MiB;
constexpr size_t WS_MIX = 275 * MiB;
constexpr size_t WS_ARENA = 411 * MiB;
constexpr size_t WS_H = WS_ARENA;
constexpr size_t WS_Q = WS_ARENA + 102 * MiB;
constexpr size_t WS_KV = WS_Q + 204 * MiB;
constexpr size_t WS_ZL = WS_KV + 204 * MiB;
constexpr size_t WS_ZC = WS_ZL + 64 * MiB;
constexpr size_t WS_POOL = WS_ARENA + 204 * MiB;
constexpr size_t WS_HID = WS_ARENA;
constexpr size_t WS_ROPE_E = WS_ZC + 4 * MiB;
constexpr size_t WS_ROPE_O = WS_ROPE_E + 1 * MiB;
constexpr size_t WS_WDN2 = WS_ROPE_O + 1 * MiB;
constexpr size_t WS_END = WS_WDN2 + 6 * MiB;
static_assert(WS_END <= 1024 * MiB, "ws map");

#define LAS __attribute__((address_space(3)))
#define GAS __attribute__((address_space(1)))
typedef unsigned short bf16_t;
typedef short bf16x8 __attribute__((ext_vector_type(8)));
typedef float f32x4 __attribute__((ext_vector_type(4)));
typedef float f32x16 __attribute__((ext_vector_type(16)));
typedef unsigned u32x4 __attribute__((ext_vector_type(4)));
typedef unsigned u32x2 __attribute__((ext_vector_type(2)));
typedef float f32x2v __attribute__((ext_vector_type(2)));

__device__ __forceinline__ unsigned cvt_pk_bf16(float lo, float hi) { unsigned r; asm volatile("v_cvt_pk_bf16_f32 %0, %1, %2" : "=v"(r) : "v"(lo), "v"(hi)); return r; }
__device__ __forceinline__ float bflo(unsigned u) { return __uint_as_float(u << 16); }
__device__ __forceinline__ float bfhi(unsigned u) { return __uint_as_float(u & 0xffff0000u); }
__device__ __forceinline__ float bf2f(bf16_t b) { return __uint_as_float((unsigned)b << 16); }
__device__ __forceinline__ float wave_sum(float v) {
#pragma unroll
    for (int o = 1; o < 64; o <<= 1) v += __shfl_xor(v, o);
    return v;
}
__device__ __forceinline__ float half_sum(float v) {
#pragma unroll
    for (int o = 1; o < 32; o <<= 1) v += __shfl_xor(v, o);
    return v;
}

namespace pg8 {
constexpr int BM = 256, BK = 64, HALF = 128, HTB = HALF * BK * 2, STAGE_BYTES = 8 * HTB, NXCD = 8, WGM = 8;
__device__ __forceinline__ int lds_byte(int r, int c) { const int st = (r >> 4) * 2 + (c >> 5), rr = r & 15, cc = c & 31, ob = rr * 64 + cc * 2; return st * 1024 + (ob ^ (((ob >> 9) & 1) << 5)); }
__device__ __forceinline__ void stage_rc(int b, int& R, int& C) { const int st = b / 1024, sb = b % 1024, swz = sb ^ (((sb >> 9) & 1) << 5); R = (st >> 1) * 16 + swz / 64; C = (st & 1) * 32 + (swz % 64) / 2; }
__device__ __forceinline__ int perm32(int rho) { const int n = rho >> 4, i = rho & 15; return 8 * (i >> 2) + 4 * n + (i & 3); }

struct Unit { int pm, pn, arow, brow, orow, ocol, aux, bt; };
struct Gemm { const bf16_t* A; const bf16_t* Bt; int lda, ldb, K; };

template <class Map> struct Order {
    int nM, nN, nwg, G, c; Map map;
    __device__ __forceinline__ void init(int nM_, int nN_, int G_, int c_, const Map& m) { nM = nM_; nN = nN_; nwg = nM * nN; G = G_; c = c_; map = m; }
    __device__ __forceinline__ bool next(int i, Unit& u) const {
        const long L = (long)i * G + c; if (L >= nwg) return false;
        int wgid = (int)L; { const int q = nwg / NXCD, r = nwg % NXCD, xcd = wgid % NXCD, off = wgid / NXCD; wgid = (xcd < r ? xcd * (q + 1) : r * (q + 1) + (xcd - r) * q) + off; }
        const int nig = WGM * nN, gid = wgid / nig, fm = gid * WGM, gsz = (nM - fm) < WGM ? (nM - fm) : WGM;
        u.pm = fm + ((wgid % nig) % gsz); u.pn = (wgid % nig) / gsz; map(u); return true;
    }
};

struct EpiBf16 {
    static constexpr bool PERM = true;
    bf16_t* O0; int ld0; bf16_t* O1; int ld1;
    __device__ __forceinline__ void operator()(const f32x4 (&acc)[2][2][4][2], const Unit& u, int wr, int wc, int fr, int fq, LAS unsigned char*) const {
        bf16_t* base = u.aux ? O1 : O0; const int ldc = u.aux ? ld1 : ld0;
        const int row0 = u.orow + wr * 64 + fr, col0 = u.ocol + wc * 32 + 8 * fq;
#pragma unroll
        for (int ai = 0; ai < 2; ++ai)
#pragma unroll
            for (int m = 0; m < 4; ++m) { bf16_t* rowp = base + (size_t)(row0 + ai * HALF + m * 16) * ldc + col0;
#pragma unroll
                for (int bj = 0; bj < 2; ++bj) { const f32x4 v0 = acc[ai][bj][m][0], v1 = acc[ai][bj][m][1];
                    u32x4 w; w.x = cvt_pk_bf16(v0[0], v0[1]); w.y = cvt_pk_bf16(v0[2], v0[3]); w.z = cvt_pk_bf16(v1[0], v1[1]); w.w = cvt_pk_bf16(v1[2], v1[3]);
                    *(u32x4*)(rowp + bj * HALF) = w; } }
    }
};

struct EpiRes {
    static constexpr bool PERM = false;
    const float* xin; float* xout; const float* cin; float* cout; const float* mods_l; int gidx; float gs;
    __device__ __forceinline__ void operator()(const f32x4 (&acc)[2][2][4][2], const Unit& u, int wr, int wc, int fr, int fq, LAS unsigned char*) const {
        const float* src = u.aux ? cin : xin; float* dst = u.aux ? cout : xout;
        const float* gate = mods_l + (size_t)(u.aux ? 16 : u.bt) * 6144 + gidx * 1024;
        const int row0 = u.orow + wr * 64 + fr, col0 = u.ocol + wc * 32 + 4 * fq;
        const __amdgpu_buffer_rsrc_t rs = __builtin_amdgcn_make_buffer_rsrc((void*)dst, 0, 0x40000000, 0x00020000);
#pragma unroll
        for (int bj = 0; bj < 2; ++bj)
#pragma unroll
            for (int n = 0; n < 2; ++n) { const int col = col0 + bj * HALF + n * 16; const f32x4 g4 = *(const f32x4*)(gate + col) * gs;
#pragma unroll
                for (int ai = 0; ai < 2; ++ai)
#pragma unroll
                    for (int m = 0; m < 4; ++m) { const size_t off = (size_t)(row0 + ai * HALF + m * 16) * DM + col;
                        const f32x4 x4 = *(const f32x4*)(src + off); __builtin_amdgcn_raw_buffer_store_b128(__builtin_bit_cast(u32x4, x4 + g4 * acc[ai][bj][m][n]), rs, (unsigned)(off * 4), 0, 16); } }
    }
};

__device__ __forceinline__ float dpp_ror1(float v) { return __int_as_float(__builtin_amdgcn_update_dpp(__float_as_int(v), __float_as_int(v), 0x121, 0xf, 0xf, false)); }
__device__ __forceinline__ float dpp_ror15(float v) { return __int_as_float(__builtin_amdgcn_update_dpp(__float_as_int(v), __float_as_int(v), 0x12F, 0xf, 0xf, false)); }
__device__ __forceinline__ float silu_f(float x) { return x * __builtin_amdgcn_rcpf(1.0f + __expf(-x)); }

struct EpiUp {
    static constexpr bool PERM = false;
    bf16_t* Hd; const float* cw; const float* cb;
    __device__ __forceinline__ void operator()(const f32x4 (&acc)[2][2][4][2], const Unit& u, int wr, int wc, int fr, int fq, LAS unsigned char* lds) const {
        LAS float* hal = (LAS float*)(lds + STAGE_BYTES);
        LAS float* cwl = (LAS float*)(lds + 140288);
        const int tid_ = (wr * 4 + wc) * 64 + fq * 16 + fr;
        float cwv[2];
#pragma unroll
        for (int q = 0; q < 2; ++q) { const int e = tid_ + 512 * q, t = e >> 8, bj = (e >> 7) & 1, c = e & 127; cwv[q] = t < 3 ? cw[t * (2 * DFF) + bj * DFF + u.ocol + c] : cb[bj * DFF + u.ocol + c]; }
        if (fr == 0) {
#pragma unroll
            for (int ai = 0; ai < 2; ++ai)
#pragma unroll
                for (int bj = 0; bj < 2; ++bj)
#pragma unroll
                    for (int n = 0; n < 2; ++n) *(LAS f32x4*)(hal + ((2 * ai + wr) * 2 + 0) * 256 + bj * 128 + wc * 32 + n * 16 + 4 * fq) = acc[ai][bj][0][n];
        }
        if (fr == 15) {
#pragma unroll
            for (int ai = 0; ai < 2; ++ai)
#pragma unroll
                for (int bj = 0; bj < 2; ++bj)
#pragma unroll
                    for (int n = 0; n < 2; ++n) *(LAS f32x4*)(hal + ((2 * ai + wr) * 2 + 1) * 256 + bj * 128 + wc * 32 + n * 16 + 4 * fq) = acc[ai][bj][3][n];
        }
        cwl[tid_] = cwv[0]; cwl[tid_ + 512] = cwv[1];
        asm volatile("s_waitcnt lgkmcnt(0)" ::: "memory"); __builtin_amdgcn_s_barrier(); asm volatile("" ::: "memory");
        int fr_ = fr, fq_ = fq; asm volatile("" : "+v"(fr_), "+v"(fq_));
        const int rmin = u.aux ? 0 : 1, rmax = u.bt;
        const f32x4 zero4 = {0.f, 0.f, 0.f, 0.f};
#pragma unroll
        for (int ai = 0; ai < 2; ++ai) {
            const int g = 2 * ai + wr;
#pragma unroll
            for (int n = 0; n < 2; ++n) {
                const int chb = u.ocol + wc * 32 + n * 16 + 4 * fq_;
                const int colh = wc * 32 + n * 16 + 4 * fq_;
                f32x4 w0[2], w1[2], w2[2], bb[2], uh[2], dh[2];
#pragma unroll
                for (int bj = 0; bj < 2; ++bj) { const int cl = bj * 128 + colh;
                    w0[bj] = *(const LAS f32x4*)(cwl + 0 * 256 + cl); w1[bj] = *(const LAS f32x4*)(cwl + 1 * 256 + cl); w2[bj] = *(const LAS f32x4*)(cwl + 2 * 256 + cl); bb[bj] = *(const LAS f32x4*)(cwl + 3 * 256 + cl);
                    uh[bj] = zero4; dh[bj] = zero4;
                    if (g > 0) uh[bj] = *(LAS f32x4*)(hal + ((g - 1) * 2 + 1) * 256 + bj * 128 + colh);
                    if (g < 3) dh[bj] = *(LAS f32x4*)(hal + ((g + 1) * 2 + 0) * 256 + bj * 128 + colh); }
#pragma unroll
                for (int m = 0; m < 4; ++m) {
                    f32x4 res[2];
#pragma unroll
                    for (int bj = 0; bj < 2; ++bj) {
                        const f32x4 cur = acc[ai][bj][m][n];
                        const f32x4 prv = m > 0 ? acc[ai][bj][m > 0 ? m - 1 : 0][n] : uh[bj];
                        const f32x4 nxt = m < 3 ? acc[ai][bj][m < 3 ? m + 1 : 3][n] : dh[bj];
                        f32x4 up, dn;
#pragma unroll
                        for (int j = 0; j < 4; ++j) { up[j] = dpp_ror1(fr_ == 15 ? prv[j] : cur[j]); dn[j] = dpp_ror15(fr_ == 0 ? nxt[j] : cur[j]); }
                        if (m == 0) { if (fr_ == 0) up = uh[bj]; }
                        if (m == 3) { if (fr_ == 15) dn = dh[bj]; }
                        res[bj] = w0[bj] * up + w1[bj] * cur + w2[bj] * dn + bb[bj];
                    }
                    const int r = ai * HALF + wr * 64 + m * 16 + fr_;
                    if (r >= rmin && r <= rmax) {
                        const f32x4 gq = res[0], vq = res[1];
                        u32x2 w; w.x = cvt_pk_bf16(silu_f(gq[0]) * vq[0], silu_f(gq[1]) * vq[1]); w.y = cvt_pk_bf16(silu_f(gq[2]) * vq[2], silu_f(gq[3]) * vq[3]);
                        *(u32x2*)(Hd + (size_t)(u.orow + r) * DFF + chb) = w;
                    }
                }
            }
        }
    }
};

template <class Epi, class Sched>
__device__ __forceinline__ void gemm_phase(LAS unsigned char* lds, const Gemm g, const Sched& S, const Epi& E) {
    int tid = threadIdx.x; asm volatile("" : "+v"(tid));
    const int wid = __builtin_amdgcn_readfirstlane(tid >> 6), lane = tid & 63, wr = wid >> 2, wc = wid & 3, fr = lane & 15, fq = lane >> 4;
    int K = g.K, lda_ = g.lda, ldb_ = g.ldb; asm volatile("" : "+s"(K), "+s"(lda_), "+s"(ldb_));
    const int nt = K / BK;
    unsigned voffA[2], voffB[2];
#pragma unroll
    for (int i = 0; i < 2; ++i) { int R, C; stage_rc(tid * 16 + i * 8192, R, C); const int Rb = Epi::PERM ? ((R & ~31) + perm32(R & 31)) : R;
        voffA[i] = (unsigned)(R * lda_ + C) * 2u; voffB[i] = (unsigned)(Rb * ldb_ + C) * 2u; }
    const size_t kstep = (size_t)(BK * 2);
    const size_t hstepA = (size_t)HALF * lda_ * 2, hstepB = (size_t)HALF * ldb_ * 2;
    const unsigned ldsw = (unsigned)wid * 1024u;
    const int aoff = lds_byte(wr * 64 + fr, fq * 8), boff = lds_byte(wc * 32 + fr, fq * 8);
#define PG8_SA(b, h) (((b) * 2 + (h)) * HTB)
#define PG8_SB(b, h) ((4 + (b) * 2 + (h)) * HTB)
#define PG8_STAGE(bufoff, gbase, voff) do { _Pragma("unroll") for (int _i = 0; _i < 2; ++_i) \
        __builtin_amdgcn_global_load_lds((const unsigned*)((const char*)(gbase) + (voff)[_i]), (LAS unsigned*)(lds + (bufoff) + ldsw + _i * 8192), 16, 0, 0); } while (0)
#define PG8_LDA(dst, b, h) do { _Pragma("unroll") for (int m = 0; m < 4; ++m) _Pragma("unroll") for (int k = 0; k < 2; ++k) dst[m][k] = *(const LAS bf16x8*)(lds + PG8_SA(b, h) + aoff + m * 2048 + k * 1024); } while (0)
#define PG8_LDB(dst, b, h) do { _Pragma("unroll") for (int n = 0; n < 2; ++n) _Pragma("unroll") for (int k = 0; k < 2; ++k) dst[n][k] = *(const LAS bf16x8*)(lds + PG8_SB(b, h) + boff + n * 2048 + k * 1024); } while (0)
#define PG8_MMA(ai, bj, At, Bt) do { __builtin_amdgcn_s_setprio(1); _Pragma("unroll") for (int m = 0; m < 4; ++m) _Pragma("unroll") for (int n = 0; n < 2; ++n) _Pragma("unroll") for (int k = 0; k < 2; ++k) \
        acc[ai][bj][m][n] = __builtin_amdgcn_mfma_f32_16x16x32_bf16(Bt[n][k], At[m][k], acc[ai][bj][m][n], 0, 0, 0); __builtin_amdgcn_s_setprio(0); } while (0)
#define PG8_WAIT_V(n) asm volatile("s_waitcnt vmcnt(" #n ")" ::: "memory")
#define PG8_WAIT_L(n) asm volatile("s_waitcnt lgkmcnt(" #n ")" ::: "memory")
#define PG8_BAR __builtin_amdgcn_s_barrier()
#define PG8_SCHED __builtin_amdgcn_sched_barrier(0)
    Unit cur, nxt; int ui = 0;
    if (!S.next(0, cur)) return;
    f32x4 acc[2][2][4][2];
#pragma unroll
    for (int a = 0; a < 2; ++a)
#pragma unroll
        for (int b = 0; b < 2; ++b)
#pragma unroll
            for (int m = 0; m < 4; ++m)
#pragma unroll
                for (int n = 0; n < 2; ++n) acc[a][b][m][n] = (f32x4){0.f, 0.f, 0.f, 0.f};
    bf16x8 At[4][2], B0[2][2], B1[2][2];
    const char* cA = (const char*)g.A + (size_t)cur.arow * lda_ * 2; const char* cB = (const char*)g.Bt + (size_t)cur.brow * ldb_ * 2;
    PG8_STAGE(PG8_SB(0, 0), cB, voffB); PG8_STAGE(PG8_SB(0, 1), cB + hstepB, voffB); PG8_STAGE(PG8_SA(0, 0), cA, voffA); PG8_STAGE(PG8_SA(0, 1), cA + hstepA, voffA);
    if (wr == 1) PG8_BAR;
    PG8_WAIT_V(2); PG8_BAR;
    PG8_STAGE(PG8_SB(1, 0), cB + kstep, voffB); PG8_STAGE(PG8_SA(1, 0), cA + kstep, voffA); PG8_STAGE(PG8_SB(1, 1), cB + hstepB + kstep, voffB);
    PG8_WAIT_V(6); PG8_BAR;
    for (;;) {
        const bool has_next = S.next(ui + 1, nxt);
        const char* nA = has_next ? (const char*)g.A + (size_t)nxt.arow * lda_ * 2 : cA; const char* nB = has_next ? (const char*)g.Bt + (size_t)nxt.brow * ldb_ * 2 : cB;
        for (int t = 0; t < nt; t += 2) {
            const bool last = (t == nt - 2);
            const char* a1 = cA + (size_t)(t + 1) * kstep;
            const char* a2 = last ? nA : cA + (size_t)(t + 2) * kstep; const char* b2 = last ? nB : cB + (size_t)(t + 2) * kstep;
            const char* a3 = a2 + kstep; const char* b3 = b2 + kstep;
            PG8_LDB(B0, 0, 0); PG8_LDB(B1, 0, 1); PG8_SCHED; PG8_LDA(At, 0, 0); PG8_STAGE(PG8_SA(1, 1), a1 + hstepA, voffA);
            PG8_WAIT_V(8); PG8_WAIT_L(0); PG8_BAR; PG8_MMA(0, 0, At, B0); PG8_MMA(0, 1, At, B1); PG8_BAR; PG8_SCHED;
            PG8_LDA(At, 0, 1); PG8_STAGE(PG8_SB(0, 0), b2, voffB); PG8_STAGE(PG8_SB(0, 1), b2 + hstepB, voffB); PG8_STAGE(PG8_SA(0, 0), a2, voffA);
            PG8_WAIT_V(8); PG8_WAIT_L(0); PG8_BAR; PG8_MMA(1, 0, At, B0); PG8_MMA(1, 1, At, B1); PG8_BAR; PG8_SCHED;
            PG8_LDB(B0, 1, 0); PG8_LDB(B1, 1, 1); PG8_SCHED; PG8_LDA(At, 1, 0); PG8_STAGE(PG8_SA(0, 1), a2 + hstepA, voffA);
            PG8_WAIT_V(8); PG8_WAIT_L(0); PG8_BAR; PG8_MMA(0, 0, At, B0); PG8_MMA(0, 1, At, B1); PG8_BAR; PG8_SCHED;
            PG8_LDA(At, 1, 1); PG8_STAGE(PG8_SB(1, 0), b3, voffB); PG8_STAGE(PG8_SB(1, 1), b3 + hstepB, voffB); PG8_STAGE(PG8_SA(1, 0), a3, voffA);
            PG8_WAIT_V(8); PG8_WAIT_L(0); PG8_BAR; PG8_MMA(1, 0, At, B0); PG8_MMA(1, 1, At, B1); PG8_BAR; PG8_SCHED;
        }
        if (wr == 0) PG8_BAR;
        E(acc, cur, wr, wc, fr, fq, lds);
        if (!has_next) break;
#pragma unroll
        for (int a = 0; a < 2; ++a)
#pragma unroll
            for (int b = 0; b < 2; ++b)
#pragma unroll
                for (int m = 0; m < 4; ++m)
#pragma unroll
                    for (int n = 0; n < 2; ++n) acc[a][b][m][n] = (f32x4){0.f, 0.f, 0.f, 0.f};
        cur = nxt; cA = nA; cB = nB; ++ui;
        if (wr == 1) PG8_BAR;
    }
    PG8_WAIT_V(0);
    PG8_BAR;
#undef PG8_SA
#undef PG8_SB
#undef PG8_STAGE
#undef PG8_LDA
#undef PG8_LDB
#undef PG8_MMA
#undef PG8_WAIT_V
#undef PG8_WAIT_L
#undef PG8_BAR
#undef PG8_SCHED
}

struct MapStd { int coff; __device__ __forceinline__ void operator()(Unit& u) const { u.arow = u.pm * 256; u.brow = u.pn * 256; u.orow = u.pm * 256; u.ocol = coff + u.pn * 256; u.aux = 0; u.bt = 0; } };
struct MapRes { int all;
    __device__ __forceinline__ void operator()(Unit& u) const {
        int b, j; if (all) { b = u.pm / 17; j = u.pm % 17; } else { b = u.pm / 16; j = u.pm % 16 + 1; }
        u.arow = (b * 17 + j) * 256; u.brow = u.pn * 256; u.ocol = u.pn * 256; u.bt = b;
        if (j == 0) { u.aux = 1; u.orow = b * 256; } else { u.aux = 0; u.orow = b * SEQ + (j - 1) * 256; } asm volatile("" : "+s"(u.aux)); } };
struct MapUp { int all;
    __device__ __forceinline__ void operator()(Unit& u) const {
        int b, j; if (all) { b = u.pm / 18; j = u.pm % 18; } else { b = u.pm / 17; j = u.pm % 17 + 1; }
        u.brow = u.pn * 256; u.ocol = u.pn * 128;
        if (j == 0) { u.aux = 1; u.arow = b * U2B; u.orow = b * TB; u.bt = 255; }
        else { const int i = j - 1; u.aux = 0; u.arow = b * U2B + 263 + 254 * i; u.orow = b * TB + NCTX + 254 * i - 1; const int lim = SEQ - 254 * i; u.bt = lim < 254 ? lim : 254; } } };
struct MapZ {
    __device__ __forceinline__ void operator()(Unit& u) const {
        const int b = u.pn / 17, j = u.pn % 17; u.arow = u.pm * 256; u.brow = u.pn * 256; u.orow = b * 256; u.bt = b;
        if (j == 0) { u.aux = 1; u.ocol = u.pm * NCTX; } else { u.aux = 0; u.ocol = u.pm * SEQ + (j - 1) * 256; } } };
struct MapFnetL { __device__ __forceinline__ void operator()(Unit& u) const { const int b = u.pm / 16, mt = u.pm % 16; u.arow = mt * 256; u.brow = b * 256; u.orow = b * TB + NCTX + mt * 256; u.ocol = 768; u.aux = 0; u.bt = b; } };
struct MapFnetC { __device__ __forceinline__ void operator()(Unit& u) const { const int b = u.pm; u.arow = 0; u.brow = b * 256; u.orow = b * TB; u.ocol = 768; u.aux = 0; u.bt = b; } };
}

typedef short v4i16_t __attribute__((ext_vector_type(4)));
__device__ __forceinline__ v4i16_t vtr(const LAS unsigned char* p) { return __builtin_amdgcn_ds_read_tr16_b64_v4i16((LAS v4i16_t*)p); }
#define MX3(a_, b_, c_) __builtin_fmaxf(__builtin_fmaxf((a_), (b_)), (c_))
__device__ __forceinline__ float tile_max(const f32x16& s0, const f32x16& s1) {
    float ma = MX3(s0[0], s0[1], s1[0]), mb = MX3(s0[2], s0[3], s1[1]); ma = MX3(ma, s1[2], s1[3]);
#pragma unroll
    for (int r = 4; r < 16; r += 4) { ma = MX3(ma, s0[r], s0[r + 1]); mb = MX3(mb, s0[r + 2], s0[r + 3]); ma = MX3(ma, s1[r], s1[r + 1]); mb = MX3(mb, s1[r + 2], s1[r + 3]); }
    return __builtin_fmaxf(ma, mb);
}
#undef MX3
__device__ __forceinline__ void band_mask(f32x16& s0, f32x16& s1, int k0pos, int qp, int hi) {
#pragma unroll
    for (int r = 0; r < 16; ++r) { const int kp = k0pos + (r & 3) + 8 * (r >> 2) + 4 * hi; const int d0 = kp - qp, d1 = d0 + 32;
        if (d0 > 128 || d0 < -128) s0[r] = -1e30f; if (d1 > 128 || d1 < -128) s1[r] = -1e30f; }
}
__device__ __forceinline__ void exp4(f32x16& s, int r0, float& acc0, float& acc1) {
    s[r0] = __builtin_amdgcn_exp2f(s[r0]); s[r0 + 1] = __builtin_amdgcn_exp2f(s[r0 + 1]); s[r0 + 2] = __builtin_amdgcn_exp2f(s[r0 + 2]); s[r0 + 3] = __builtin_amdgcn_exp2f(s[r0 + 3]);
    acc0 += s[r0] + s[r0 + 2]; acc1 += s[r0 + 1] + s[r0 + 3];
}
__device__ __forceinline__ bf16x8 pack8(const f32x16& s, int r0) {
    u32x4 w; w.x = cvt_pk_bf16(s[r0], s[r0 + 1]); w.y = cvt_pk_bf16(s[r0 + 2], s[r0 + 3]); w.z = cvt_pk_bf16(s[r0 + 4], s[r0 + 5]); w.w = cvt_pk_bf16(s[r0 + 6], s[r0 + 7]);
    return __builtin_bit_cast(bf16x8, w);
}
__device__ __forceinline__ void pv_slab(const LAS unsigned char* vb, int koff, const bf16x8 pj, f32x16& o0, f32x16& o1) {
    const v4i16_t a0 = vtr(vb + koff), a1 = vtr(vb + koff + 512), b0 = vtr(vb + 8192 + koff), b1 = vtr(vb + 8192 + koff + 512);
    const bf16x8 v0 = {a0[0], a0[1], a0[2], a0[3], a1[0], a1[1], a1[2], a1[3]}, v1 = {b0[0], b0[1], b0[2], b0[3], b1[0], b1[1], b1[2], b1[3]};
    o0 = __builtin_amdgcn_mfma_f32_32x32x16_bf16(v0, pj, o0, 0, 0, 0);
    o1 = __builtin_amdgcn_mfma_f32_32x32x16_bf16(v1, pj, o1, 0, 0, 0);
}

#define ATT_SCHED() __builtin_amdgcn_sched_barrier(0)
template <int DQ, bool WIN>
__device__ __forceinline__ void attn_qk(LAS unsigned char* lds, int kbufoff, int t, const bf16x8 (&qf)[DQ / 16], f32x16& o0, f32x16& o1, float& mrun, float& lsum,
                                        f32x16& sa0, f32x16& sa1, f32x16& sb0, f32x16& sb1, int l31, int hi, int qw) {
    constexpr int NDK = DQ / 16, KST = DQ * 2 + 16;
    const LAS unsigned char* kb = lds + kbufoff + l31 * KST + hi * 16;
    bf16x8 kf[2][4];
#define KLOAD(dst, dk) do { dst[0] = *(const LAS bf16x8*)(kb + (dk) * 32); dst[1] = *(const LAS bf16x8*)(kb + 32 * KST + (dk) * 32); \
                            dst[2] = *(const LAS bf16x8*)(kb + 64 * KST + (dk) * 32); dst[3] = *(const LAS bf16x8*)(kb + 96 * KST + (dk) * 32); } while (0)
    KLOAD(kf[0], 0);
#pragma unroll
    for (int dk = 0; dk < NDK; ++dk) {
        if (dk + 1 < NDK) KLOAD(kf[(dk + 1) & 1], dk + 1);
        ATT_SCHED();
        const bf16x8 (&f)[4] = kf[dk & 1];
        if (dk == 0) { f32x16 z16;
#pragma unroll
                       for (int r = 0; r < 16; ++r) z16[r] = 0.f;
                       sa0 = __builtin_amdgcn_mfma_f32_32x32x16_bf16(f[0], qf[0], z16, 0, 0, 0); sa1 = __builtin_amdgcn_mfma_f32_32x32x16_bf16(f[1], qf[0], z16, 0, 0, 0);
                       sb0 = __builtin_amdgcn_mfma_f32_32x32x16_bf16(f[2], qf[0], z16, 0, 0, 0); sb1 = __builtin_amdgcn_mfma_f32_32x32x16_bf16(f[3], qf[0], z16, 0, 0, 0); }
        else { sa0 = __builtin_amdgcn_mfma_f32_32x32x16_bf16(f[0], qf[dk], sa0, 0, 0, 0); sa1 = __builtin_amdgcn_mfma_f32_32x32x16_bf16(f[1], qf[dk], sa1, 0, 0, 0);
               sb0 = __builtin_amdgcn_mfma_f32_32x32x16_bf16(f[2], qf[dk], sb0, 0, 0, 0); sb1 = __builtin_amdgcn_mfma_f32_32x32x16_bf16(f[3], qf[dk], sb1, 0, 0, 0); }
        ATT_SCHED();
    }
#undef KLOAD
    if (__builtin_expect(__any(mrun != 0.f), 0)) {
#pragma unroll
        for (int r = 0; r < 16; ++r) { sa0[r] -= mrun; sa1[r] -= mrun; sb0[r] -= mrun; sb1[r] -= mrun; }
    }
    if (WIN && t >= 4) { const int qp = qw + l31, k0pos = (t - 4) * 64; band_mask(sa0, sa1, k0pos, qp, hi); band_mask(sb0, sb1, k0pos + 64, qp, hi); }
    float mx = __builtin_fmaxf(tile_max(sa0, sa1), tile_max(sb0, sb1));
    { auto rr = __builtin_amdgcn_permlane32_swap(__float_as_uint(mx), __float_as_uint(mx), false, false); mx = __builtin_fmaxf(__uint_as_float(rr[0]), __uint_as_float(rr[1])); }
    if (__builtin_expect(__any(mx > 8.0f), 0)) {
        const float dl = mx > 8.0f ? mx : 0.f; mrun += dl;
        const float alpha = __builtin_amdgcn_exp2f(-dl); lsum *= alpha;
#pragma unroll
        for (int r = 0; r < 16; ++r) { sa0[r] -= dl; sa1[r] -= dl; sb0[r] -= dl; sb1[r] -= dl; o0[r] *= alpha; o1[r] *= alpha; }
    }
}
#define VLOAD(dst, j) do { dst[0] = vtr(vb + (j) * 1024); dst[1] = vtr(vb + (j) * 1024 + 512); dst[2] = vtr(vb + 8192 + (j) * 1024); dst[3] = vtr(vb + 8192 + (j) * 1024 + 512); } while (0)
#define PVMMA(src, P_) do { const bf16x8 v0_ = {src[0][0], src[0][1], src[0][2], src[0][3], src[1][0], src[1][1], src[1][2], src[1][3]}, v1_ = {src[2][0], src[2][1], src[2][2], src[2][3], src[3][0], src[3][1], src[3][2], src[3][3]}; \
        const bf16x8 p_ = (P_); o0 = __builtin_amdgcn_mfma_f32_32x32x16_bf16(v0_, p_, o0, 0, 0, 0); o1 = __builtin_amdgcn_mfma_f32_32x32x16_bf16(v1_, p_, o1, 0, 0, 0); } while (0)
__device__ __forceinline__ void attn_softmax_pv(const LAS unsigned char* vb, f32x16& sa0, f32x16& sa1, f32x16& sb0, f32x16& sb1, f32x16& o0, f32x16& o1, float& lsum) {
    v4i16_t vf[2][4];
    VLOAD(vf[0], 0);
    float p0 = 0.f, p1 = 0.f, p2 = 0.f, p3 = 0.f;
    exp4(sa0, 0, p0, p1); exp4(sa0, 4, p2, p3); exp4(sa0, 8, p0, p1); exp4(sa0, 12, p2, p3);
    exp4(sa1, 0, p0, p1); exp4(sa1, 4, p2, p3); exp4(sa1, 8, p0, p1); exp4(sa1, 12, p2, p3);
    VLOAD(vf[1], 1); ATT_SCHED(); PVMMA(vf[0], pack8(sa0, 0)); exp4(sb0, 0, p0, p1); exp4(sb0, 4, p2, p3); ATT_SCHED();
    VLOAD(vf[0], 2); ATT_SCHED(); PVMMA(vf[1], pack8(sa0, 8)); exp4(sb0, 8, p0, p1); exp4(sb0, 12, p2, p3); ATT_SCHED();
    VLOAD(vf[1], 3); ATT_SCHED(); PVMMA(vf[0], pack8(sa1, 0)); exp4(sb1, 0, p0, p1); exp4(sb1, 4, p2, p3); ATT_SCHED();
    VLOAD(vf[0], 4); ATT_SCHED(); PVMMA(vf[1], pack8(sa1, 8)); exp4(sb1, 8, p0, p1); exp4(sb1, 12, p2, p3); ATT_SCHED();
    lsum += (p0 + p1) + (p2 + p3);
    VLOAD(vf[1], 5); ATT_SCHED(); PVMMA(vf[0], pack8(sb0, 0)); ATT_SCHED();
    VLOAD(vf[0], 6); ATT_SCHED(); PVMMA(vf[1], pack8(sb0, 8)); ATT_SCHED();
    VLOAD(vf[1], 7); ATT_SCHED(); PVMMA(vf[0], pack8(sb1, 0)); ATT_SCHED();
    PVMMA(vf[1], pack8(sb1, 8));
}
__device__ __forceinline__ void attn_softmax_keep(f32x16& sa0, f32x16& sa1, f32x16& sb0, f32x16& sb1, bf16x8 (&pw)[8], float& lsum) {
    float p0 = 0.f, p1 = 0.f, p2 = 0.f, p3 = 0.f;
    exp4(sa0, 0, p0, p1); exp4(sa0, 4, p2, p3); exp4(sa0, 8, p0, p1); exp4(sa0, 12, p2, p3); pw[0] = pack8(sa0, 0); pw[1] = pack8(sa0, 8);
    exp4(sa1, 0, p0, p1); exp4(sa1, 4, p2, p3); exp4(sa1, 8, p0, p1); exp4(sa1, 12, p2, p3); pw[2] = pack8(sa1, 0); pw[3] = pack8(sa1, 8);
    exp4(sb0, 0, p0, p1); exp4(sb0, 4, p2, p3); exp4(sb0, 8, p0, p1); exp4(sb0, 12, p2, p3); pw[4] = pack8(sb0, 0); pw[5] = pack8(sb0, 8);
    exp4(sb1, 0, p0, p1); exp4(sb1, 4, p2, p3); exp4(sb1, 8, p0, p1); exp4(sb1, 12, p2, p3); pw[6] = pack8(sb1, 0); pw[7] = pack8(sb1, 8);
    lsum += (p0 + p1) + (p2 + p3);
}
__device__ __forceinline__ void attn_pv_all(const LAS unsigned char* vb, const bf16x8 (&pw)[8], f32x16& o0, f32x16& o1) {
    v4i16_t vf[2][4];
    VLOAD(vf[0], 0);
    VLOAD(vf[1], 1); ATT_SCHED(); PVMMA(vf[0], pw[0]); ATT_SCHED();
    VLOAD(vf[0], 2); ATT_SCHED(); PVMMA(vf[1], pw[1]); ATT_SCHED();
    VLOAD(vf[1], 3); ATT_SCHED(); PVMMA(vf[0], pw[2]); ATT_SCHED();
    VLOAD(vf[0], 4); ATT_SCHED(); PVMMA(vf[1], pw[3]); ATT_SCHED();
    VLOAD(vf[1], 5); ATT_SCHED(); PVMMA(vf[0], pw[4]); ATT_SCHED();
    VLOAD(vf[0], 6); ATT_SCHED(); PVMMA(vf[1], pw[5]); ATT_SCHED();
    VLOAD(vf[1], 7); ATT_SCHED(); PVMMA(vf[0], pw[6]); ATT_SCHED();
    PVMMA(vf[1], pw[7]);
}
#undef VLOAD
#undef PVMMA
#undef ATT_SCHED

template <int DQ, bool WIN, int MODE = 0>
__device__ __forceinline__ void attn_unit(LAS unsigned char* lds, const bf16_t* Qp, int ldq, const bf16_t* Kp, int ldk, const bf16_t* Vp, int ldv, bf16_t* Op,
                                          int n1, int s2, int e2, int q0pos, float m_init, bool has_sink, const float* qgain = nullptr, const f32x2v* ropeT = nullptr, bool qrope = false) {
    constexpr int NDK = DQ / 16, CH = DQ / 8, NKC = DQ / 32, KST = DQ * 2 + 16, KBUF = 128 * KST, VBUF = 16384, VOFF = 2 * KBUF;
    int tid = threadIdx.x; asm volatile("" : "+v"(tid));
    const int lane = tid & 63, wid = __builtin_amdgcn_readfirstlane(tid >> 6), l31 = lane & 31, hi = lane >> 5;
    const bool late = wid >= 4;
    bf16x8 qf[NDK];
    { const bf16_t* qrow = Qp + (size_t)(32 * wid + l31) * ldq + 8 * hi;
#pragma unroll
      for (int dk = 0; dk < NDK; ++dk) qf[dk] = *(const bf16x8*)(qrow + 16 * dk); }
    if (DQ == 64 && qgain != nullptr) {
        float y[4][8]; float ss = 0.f;
#pragma unroll
        for (int dk = 0; dk < 4; ++dk) { const u32x4 w = __builtin_bit_cast(u32x4, qf[dk < NDK ? dk : 0]);
#pragma unroll
            for (int i = 0; i < 4; ++i) { y[dk][2 * i] = bflo(w[i]); y[dk][2 * i + 1] = bfhi(w[i]); ss += y[dk][2 * i] * y[dk][2 * i] + y[dk][2 * i + 1] * y[dk][2 * i + 1]; } }
        ss += __shfl_xor(ss, 32);
        const float rn = rsqrtf(ss * (1.0f / 64.0f) + EPS);
#pragma unroll
        for (int dk = 0; dk < 4; ++dk)
#pragma unroll
            for (int e = 0; e < 8; ++e) y[dk][e] *= rn * qgain[16 * dk + 8 * hi + e];
        if (qrope) { const int pos = q0pos + 32 * wid + l31;
#pragma unroll
            for (int dk = 0; dk < 2; ++dk)
#pragma unroll
                for (int e = 0; e < 8; ++e) { const f32x2v t = ropeT[pos * 32 + 16 * dk + 8 * hi + e]; const float x1 = y[dk][e], x2 = y[dk + 2][e]; y[dk][e] = x1 * t.x - x2 * t.y; y[dk + 2][e] = x1 * t.y + x2 * t.x; } }
        const float QS_ = 0.125f * LOG2E;
#pragma unroll
        for (int dk = 0; dk < 4; ++dk) { u32x4 w;
#pragma unroll
            for (int i = 0; i < 4; ++i) w[i] = cvt_pk_bf16(y[dk][2 * i] * QS_, y[dk][2 * i + 1] * QS_);
            if (dk < NDK) qf[dk] = __builtin_bit_cast(bf16x8, w); }
    }
    f32x16 o0, o1;
#pragma unroll
    for (int r = 0; r < 16; ++r) { o0[r] = 0.f; o1[r] = 0.f; }
    float mrun = 0.f, lsum = (has_sink && hi == 0) ? __builtin_amdgcn_exp2f(m_init) : 0.f;
    const int qw = q0pos + 32 * wid;
    const int vlane = (4 * hi + ((lane & 15) >> 2)) * 64 + ((lane >> 4) & 1) * 32 + (lane & 3) * 8;
    u32x4 kr[NKC], vr[2];
#define ATT_TILE(i_) ((i_) < n1 ? (i_) : s2 + ((i_) - n1))
#define ATT_LOAD(t) do { const bf16_t* kp_ = Kp + (size_t)(t) * 64 * ldk; const bf16_t* vp_ = Vp + (size_t)(t) * 64 * ldv; \
        _Pragma("unroll") for (int m_ = 0; m_ < NKC; ++m_) { const int c_ = tid + 512 * m_; kr[m_] = *(const GAS u32x4*)(kp_ + (size_t)(c_ / CH) * ldk + (c_ % CH) * 8); } \
        _Pragma("unroll") for (int m_ = 0; m_ < 2; ++m_) { const int c_ = tid + 512 * m_; vr[m_] = *(const GAS u32x4*)(vp_ + (size_t)(c_ >> 3) * ldv + (c_ & 7) * 8); } } while (0)
#define ATT_STORE(kb_, vb_) do { \
        _Pragma("unroll") for (int m_ = 0; m_ < NKC; ++m_) { const int c_ = tid + 512 * m_; *(LAS u32x4*)(lds + (kb_) * KBUF + (c_ / CH) * KST + (c_ % CH) * 16) = kr[m_]; } \
        _Pragma("unroll") for (int m_ = 0; m_ < 2; ++m_) { const int c_ = tid + 512 * m_; *(LAS u32x4*)(lds + VOFF + (vb_) * VBUF + ((c_ & 7) >> 2) * 8192 + (c_ >> 3) * 64 + (c_ & 3) * 16) = vr[m_]; } } while (0)
#define ATT_BAR() asm volatile("s_waitcnt lgkmcnt(0)\n\ts_barrier" ::: "memory")
    const int nst = (n1 + (e2 - s2)) >> 1;
    ATT_LOAD(0); ATT_STORE(0, 0);
    ATT_BAR();
    if (!late) {
        int vcur = 0;
        for (int I = 0; I < nst; ++I) {
            const int t = ATT_TILE(2 * I);
            if (I + 1 < nst) { const int tn = ATT_TILE(2 * I + 2); ATT_LOAD(tn); }
            bool active = true; if (WIN && t >= 4) { const int k0 = (t - 4) * 64; active = (k0 + 127 >= qw - 128) && (k0 <= qw + 31 + 128); }
            const int vnext = vcur == 2 ? 0 : vcur + 1;
            if (active) { f32x16 sa0, sa1, sb0, sb1;
                attn_qk<DQ, WIN>(lds, (I & 1) * KBUF, t, qf, o0, o1, mrun, lsum, sa0, sa1, sb0, sb1, l31, hi, qw);
                attn_softmax_pv(lds + VOFF + vcur * VBUF + vlane, sa0, sa1, sb0, sb1, o0, o1, lsum); }
            if (I + 1 < nst) ATT_STORE((I + 1) & 1, vnext);
            vcur = vnext;
            ATT_BAR();
        }
    } else {
        bf16x8 pw[8]; bool havep = false; int pvoff = 0;
        int vcur = 0;
        for (int I = 0; I < nst; ++I) {
            const int t = ATT_TILE(2 * I);
            if (I + 1 < nst) { const int tn = ATT_TILE(2 * I + 2); ATT_LOAD(tn); }
            bool active = true; if (WIN && t >= 4) { const int k0 = (t - 4) * 64; active = (k0 + 127 >= qw - 128) && (k0 <= qw + 31 + 128); }
            const int vnext = vcur == 2 ? 0 : vcur + 1;
            if (havep) attn_pv_all(lds + VOFF + pvoff + vlane, pw, o0, o1);
            havep = false;
            if (active) { f32x16 sa0, sa1, sb0, sb1;
                attn_qk<DQ, WIN>(lds, (I & 1) * KBUF, t, qf, o0, o1, mrun, lsum, sa0, sa1, sb0, sb1, l31, hi, qw);
                attn_softmax_keep(sa0, sa1, sb0, sb1, pw, lsum); havep = true; pvoff = vcur * VBUF; }
            if (I + 1 < nst) ATT_STORE((I + 1) & 1, vnext);
            vcur = vnext;
            ATT_BAR();
        }
        if (havep) attn_pv_all(lds + VOFF + pvoff + vlane, pw, o0, o1);
    }
    ATT_BAR();
#undef ATT_TILE
#undef ATT_LOAD
#undef ATT_STORE
#undef ATT_BAR
    const float lt = lsum + __shfl_xor(lsum, 32), inv = 1.0f / lt;
    bf16_t* orow = Op + (size_t)(32 * wid + l31) * DM + 4 * hi;
#pragma unroll
    for (int g = 0; g < 4; ++g) {
        u32x2 w0, w1;
        w0.x = cvt_pk_bf16(o0[4 * g] * inv, o0[4 * g + 1] * inv); w0.y = cvt_pk_bf16(o0[4 * g + 2] * inv, o0[4 * g + 3] * inv);
        w1.x = cvt_pk_bf16(o1[4 * g] * inv, o1[4 * g + 1] * inv); w1.y = cvt_pk_bf16(o1[4 * g + 2] * inv, o1[4 * g + 3] * inv);
        *(u32x2*)(orow + 8 * g) = w0; *(u32x2*)(orow + 32 + 8 * g) = w1;
    }
}

struct Args { const float* in[28]; float* out; unsigned char* ws; int lo, hi; };
typedef const GAS float* cfp_t;
struct Ctx { const __attribute__((address_space(4))) cfp_t* in; float* out; unsigned char* ws;
    __device__ __forceinline__ const float* inp(int i) const { return (const float*)in[i]; } };
enum { I_X = 0, I_C, I_CTX, I_CCTX, I_MODW, I_MODB, I_N1G, I_N2G, I_MLAWIN, I_CQG, I_CKVG, I_WUQ, I_WUKV, I_QG, I_KG, I_FNETW, I_EWOUT,
       I_WINWIN, I_WQG, I_WKG, I_SINK, I_POOLW, I_POOLS, I_OWOUT, I_FFNUP, I_CONVW, I_CONVB, I_FFNDN };

__device__ __forceinline__ void tr_item(const float* W, int K, int Nsrc, bf16_t* WT, int nblk, int item, LAS float* scr, int lane, int mode, const float* ksc) {
    const int kb = item / nblk, nb = item % nblk, k0 = 64 * kb, n0 = 32 * nb;
    int s0 = n0;
    if (mode == 1) s0 = n0 < 672 ? n0 : -1;
    else if (mode == 2) { const int hd = n0 >> 7, d0 = n0 & 127; s0 = d0 < 96 ? hd * 96 + d0 : -1; }
    else if (mode == 3) { const int pn = n0 >> 8, bj = (n0 >> 7) & 1, c = n0 & 127; s0 = bj * DFF + pn * 128 + c; }
#pragma unroll 16
    for (int i = 0; i < 32; ++i) { const int kk = 2 * i + (lane >> 5); float v = 0.f;
        if (s0 >= 0) { v = W[(size_t)(k0 + kk) * Nsrc + s0 + (lane & 31)]; if (ksc) v *= ksc[k0 + kk]; }
        scr[kk * 33 + (lane & 31)] = v; }
    asm volatile("s_waitcnt lgkmcnt(0)" ::: "memory");
    const int c = lane & 7;
#pragma unroll
    for (int j = 0; j < 4; ++j) { const int n = (lane >> 3) + 8 * j; const LAS float* s = scr + (8 * c) * 33 + n;
        u32x4 o; o.x = cvt_pk_bf16(s[0 * 33], s[1 * 33]); o.y = cvt_pk_bf16(s[2 * 33], s[3 * 33]); o.z = cvt_pk_bf16(s[4 * 33], s[5 * 33]); o.w = cvt_pk_bf16(s[6 * 33], s[7 * 33]);
        *(u32x4*)(WT + (size_t)(n0 + n) * K + k0 + 8 * c) = o; }
    asm volatile("s_waitcnt lgkmcnt(0)" ::: "memory");
}
__device__ __forceinline__ void tr_job(const float* W, int K, int Nsrc, bf16_t* WT, int Nout, int mode, const float* ksc, LAS float* scr, int gw, int ngw, int lane) {
    const int nblk = Nout / 32, nitems = (K / 64) * nblk;
    for (int it = gw; it < nitems; it += ngw) tr_item(W, K, Nsrc, WT, nblk, it, scr, lane, mode, ksc);
}
__device__ __forceinline__ void ffn_weights(const Ctx& a, int layer, LAS float* scr, int gw, int ngw, int lane) {
    tr_job(a.inp(I_FFNUP) + (size_t)layer * DM * 2 * DFF, DM, 2 * DFF, (bf16_t*)(a.ws + WS_WUP), 2 * DFF, 3, nullptr, scr, gw, ngw, lane);
    tr_job(a.inp(I_FFNDN) + (size_t)layer * DFF * DM, DFF, DM, (bf16_t*)(a.ws + ((layer & 1) ? WS_WDN2 : WS_WDN)), DM, 0, nullptr, scr, gw, ngw, lane);
}

__device__ __forceinline__ void mods_item(const Ctx& a, int item, LAS float* sl) {
    int tid = threadIdx.x; asm volatile("" : "+v"(tid)); const int l = item / 48, nb = item % 48;
    LAS float* red = sl + 17 * 1024;
    for (int idx = tid; idx < 17 * 1024; idx += 512) { const int r = idx >> 10, k = idx & 1023; const float v = r < 16 ? a.inp(I_C)[r * 1024 + k] : a.inp(I_CCTX)[k]; sl[idx] = v / (1.0f + __expf(-v)); }
    __syncthreads();
    const int cn = tid & 127, ks = tid >> 7, n = 128 * nb + cn;
    float acc[17];
#pragma unroll
    for (int r = 0; r < 17; ++r) acc[r] = 0.f;
    const float* wp = a.inp(I_MODW) + ((size_t)l * 1024 + 256 * ks) * 6144 + n;
#pragma unroll 4
    for (int k = 0; k < 256; k += 4) {
        const float w0 = wp[(size_t)(k + 0) * 6144], w1 = wp[(size_t)(k + 1) * 6144], w2 = wp[(size_t)(k + 2) * 6144], w3 = wp[(size_t)(k + 3) * 6144];
#pragma unroll
        for (int r = 0; r < 17; ++r) { const f32x4 s4 = *(const LAS f32x4*)(sl + r * 1024 + 256 * ks + k); acc[r] += s4[0] * w0 + s4[1] * w1 + s4[2] * w2 + s4[3] * w3; }
    }
#pragma unroll
    for (int r = 0; r < 17; ++r) red[(ks * 17 + r) * 128 + cn] = acc[r];
    __syncthreads();
    float* mods = (float*)(a.ws + WS_MODS);
    for (int idx = tid; idx < 17 * 128; idx += 512) { const int r = idx >> 7, c2 = idx & 127;
        const float s = red[(0 * 17 + r) * 128 + c2] + red[(1 * 17 + r) * 128 + c2] + red[(2 * 17 + r) * 128 + c2] + red[(3 * 17 + r) * 128 + c2];
        mods[((size_t)l * 17 + r) * 6144 + 128 * nb + c2] = s + a.inp(I_MODB)[l * 6144 + 128 * nb + c2]; }
    __syncthreads();
}

__device__ __forceinline__ void norm_pass(const float* xsrc, const float* csrc, const float* g, const float* mods_l, int shift_idx, int scale_idx,
                                          bf16_t* U, bool ffn_layout, bool skip_ctx, int gw, int ngw, int lane) {
    for (int R0 = gw; R0 < T; R0 += 2 * ngw) {
        f32x4 v[2][4]; bool ok[2]; int bb[2], pp[2];
#pragma unroll
        for (int s = 0; s < 2; ++s) { const int R = R0 + s * ngw; const int b = R / TB, p = R % TB; const bool isctx = p < NCTX; bb[s] = b; pp[s] = p;
            ok[s] = (R < T) && !(isctx && skip_ctx);
            const float* src = isctx ? csrc + (size_t)(b * NCTX + p) * DM : xsrc + (size_t)(b * SEQ + p - NCTX) * DM;
            if (ok[s]) {
#pragma unroll
                for (int j = 0; j < 4; ++j) v[s][j] = *(const f32x4*)(src + (lane + 64 * j) * 4); } }
#pragma unroll
        for (int s = 0; s < 2; ++s) if (ok[s]) {
            const int R = R0 + s * ngw, b = bb[s], p = pp[s]; const bool isctx = p < NCTX;
            const float* mrow = mods_l + (size_t)(isctx ? 16 : b) * 6144;
            float ss = 0.f;
#pragma unroll
            for (int j = 0; j < 4; ++j) ss += (v[s][j][0] * v[s][j][0] + v[s][j][1] * v[s][j][1]) + (v[s][j][2] * v[s][j][2] + v[s][j][3] * v[s][j][3]);
            const float rs = rsqrtf(wave_sum(ss) * (1.0f / DM) + EPS);
            const size_t orow = ffn_layout ? (size_t)b * U2B + (isctx ? p : 264 + p - NCTX) : (size_t)R;
#pragma unroll
            for (int j = 0; j < 4; ++j) { const int c4 = (lane + 64 * j) * 4;
                const f32x4 gg = *(const f32x4*)(g + c4), sh = *(const f32x4*)(mrow + shift_idx * 1024 + c4), sc = *(const f32x4*)(mrow + scale_idx * 1024 + c4);
                const f32x4 y = v[s][j] * rs * gg * (sc + 1.0f) + sh;
                u32x2 w; w.x = cvt_pk_bf16(y[0], y[1]); w.y = cvt_pk_bf16(y[2], y[3]);
                *(u32x2*)(U + orow * DM + c4) = w; }
        }
    }
    if (ffn_layout && gw < 32) {
        const int b = gw >> 1; const size_t orow = (size_t)b * U2B + ((gw & 1) ? 264 + SEQ : 263);
#pragma unroll
        for (int j = 0; j < 4; ++j) *(u32x2*)(U + orow * DM + (lane + 64 * j) * 4) = (u32x2){0u, 0u};
    }
}

template <int NF> __device__ __forceinline__ void rope_cs(int pos, int i, float& cs, float& sn) {
    const int row = pos >> 6, col = pos & 63; const int f = i < NF ? i : i - NF;
    const float inv = exp2f(-(float)f * (13.287712379549449f / NF));
    const float ang = (float)(i < NF ? row : col) * inv;
    sincosf(ang, &sn, &cs);
}

__device__ __forceinline__ void unpack8(const u32x4 v, float (&x)[8]) {
#pragma unroll
    for (int i = 0; i < 4; ++i) { x[2 * i] = bflo(v[i]); x[2 * i + 1] = bfhi(v[i]); }
}
__device__ __forceinline__ u32x4 pack8f(const float (&x)[8]) { u32x4 o; o.x = cvt_pk_bf16(x[0], x[1]); o.y = cvt_pk_bf16(x[2], x[3]); o.z = cvt_pk_bf16(x[4], x[5]); o.w = cvt_pk_bf16(x[6], x[7]); return o; }

__device__ __forceinline__ void ew_even(const Ctx& a, int j, int gw, int ngw, int lane) {
    const bf16_t* H = (const bf16_t*)(a.ws + WS_H); bf16_t* Qb = (bf16_t*)(a.ws + WS_Q); bf16_t* KVb = (bf16_t*)(a.ws + WS_KV); bf16_t* Kout = (bf16_t*)(a.ws + WS_U);
    const float QS = 0.10206207261596577f * LOG2E;
    const f32x2v* ropeT = (const f32x2v*)(a.ws + WS_ROPE_E);
    const int g16 = lane >> 4, c16 = lane & 15; const bool act = c16 < 12; const int cc = act ? c16 : 0;
    float qg[8], kg[8];
#pragma unroll
    for (int e = 0; e < 8; ++e) { qg[e] = a.inp(I_QG)[j * 96 + 8 * cc + e]; kg[e] = a.inp(I_KG)[j * 96 + 8 * cc + e]; }
    for (int R = gw; R < T; R += ngw) {
        const int p = R % TB; const int pos = p - NCTX; const bool lat = pos >= 0;
        const bf16_t* hrow = H + (size_t)R * 768; bf16_t* qrow = Qb + (size_t)R * 1536; bf16_t* kvrow = KVb + (size_t)R * 1536;
        const u32x4 z4 = {0u, 0u, 0u, 0u};
        u32x4 hv = z4; if (lane < 48) hv = *(const u32x4*)(hrow + 8 * lane);
        u32x4 qv[3], kv[3], vv[2];
#pragma unroll
        for (int rd = 0; rd < 3; ++rd) { const int hd = 4 * rd + g16; qv[rd] = z4; kv[rd] = z4;
            if (act) { qv[rd] = *(const u32x4*)(qrow + hd * 128 + 8 * c16); kv[rd] = c16 < 8 ? *(const u32x4*)(kvrow + hd * 128 + 8 * c16) : *(const u32x4*)(hrow + 384 + 8 * (c16 - 8)); } }
        vv[0] = *(const u32x4*)(kvrow + (lane >> 3) * 128 + 64 + 8 * (lane & 7)); vv[1] = z4;
        if (lane < 32) vv[1] = *(const u32x4*)(kvrow + ((lane + 64) >> 3) * 128 + 64 + 8 * (lane & 7));
        float cs[8], sn[8];
#pragma unroll
        for (int e = 0; e < 8; ++e) { cs[e] = 1.f; sn[e] = 0.f; }
        if (lat && c16 >= 8 && act) {
#pragma unroll
            for (int e = 0; e < 8; ++e) { const f32x2v t = ropeT[pos * 16 + 8 * (c16 & 1) + e]; cs[e] = t.x; sn[e] = t.y; } }
        float x[8]; unpack8(hv, x); float ss = 0.f;
#pragma unroll
        for (int e = 0; e < 8; ++e) ss += x[e] * x[e];
        ss = half_sum(ss);
        const float r_q = rsqrtf(__shfl(ss, 0) * (1.0f / 256.0f) + EPS), r_kv = rsqrtf(__shfl(ss, 32) * (1.0f / 128.0f) + EPS);
#pragma unroll
        for (int rd = 0; rd < 3; ++rd) {
            const int hd = 4 * rd + g16;
            { float y[8], o[8]; unpack8(qv[rd], y); float s2 = 0.f;
#pragma unroll
              for (int e = 0; e < 8; ++e) { y[e] *= r_q; s2 += y[e] * y[e]; }
              s2 += __shfl_xor(s2, 8); s2 += __shfl_xor(s2, 4); s2 += __shfl_xor(s2, 2); s2 += __shfl_xor(s2, 1);
              const float sc = rsqrtf(s2 * (1.0f / 96.0f) + EPS);
#pragma unroll
              for (int e = 0; e < 8; ++e) { y[e] *= sc * qg[e]; o[e] = __shfl_xor(y[e], 2); }
              if (c16 >= 8) {
#pragma unroll
                  for (int e = 0; e < 8; ++e) y[e] = c16 < 10 ? y[e] * cs[e] - o[e] * sn[e] : o[e] * sn[e] + y[e] * cs[e]; }
#pragma unroll
              for (int e = 0; e < 8; ++e) y[e] *= QS;
              if (act) *(u32x4*)(qrow + hd * 128 + 8 * c16) = pack8f(y); }
            { float y[8], o[8]; unpack8(kv[rd], y); float s2 = 0.f; const float pre = c16 < 8 ? r_kv : 1.0f;
#pragma unroll
              for (int e = 0; e < 8; ++e) { y[e] *= pre; s2 += y[e] * y[e]; }
              s2 += __shfl_xor(s2, 8); s2 += __shfl_xor(s2, 4); s2 += __shfl_xor(s2, 2); s2 += __shfl_xor(s2, 1);
              const float sc = rsqrtf(s2 * (1.0f / 96.0f) + EPS);
#pragma unroll
              for (int e = 0; e < 8; ++e) { y[e] *= sc * kg[e]; o[e] = __shfl_xor(y[e], 2); }
              if (c16 >= 8) {
#pragma unroll
                  for (int e = 0; e < 8; ++e) y[e] = c16 < 10 ? y[e] * cs[e] - o[e] * sn[e] : o[e] * sn[e] + y[e] * cs[e]; }
              if (act) *(u32x4*)(Kout + (size_t)R * 1152 + hd * 96 + 8 * c16) = pack8f(y); }
        }
        { float y[8]; unpack8(vv[0], y);
#pragma unroll
          for (int e = 0; e < 8; ++e) y[e] *= r_kv;
          *(u32x4*)(kvrow + (lane >> 3) * 128 + 64 + 8 * (lane & 7)) = pack8f(y);
          if (lane < 32) { unpack8(vv[1], y);
#pragma unroll
              for (int e = 0; e < 8; ++e) y[e] *= r_kv;
              *(u32x4*)(kvrow + ((lane + 64) >> 3) * 128 + 64 + 8 * (lane & 7)) = pack8f(y); } }
    }
}

__device__ __forceinline__ void ew_odd(const Ctx& a, int j, int gw, int ngw, int lane) {
    bf16_t* H = (bf16_t*)(a.ws + WS_H); bf16_t* PO = (bf16_t*)(a.ws + WS_POOL);
    const float QS = 0.125f * LOG2E;
    const f32x2v* ropeT = (const f32x2v*)(a.ws + WS_ROPE_O);
    const int c8 = lane & 7, hl = lane >> 3;
    float qg[8], kg[8];
#pragma unroll
    for (int e = 0; e < 8; ++e) { qg[e] = a.inp(I_WQG)[j * 64 + 8 * c8 + e]; kg[e] = a.inp(I_WKG)[j * 64 + 8 * c8 + e]; }
    for (int R = gw; R < T; R += ngw) {
        const int p = R % TB; const int pos = p - NCTX; const bool lat = pos >= 0;
        bf16_t* hrow = H + (size_t)R * 1536;
        u32x4 qk[2]; qk[1] = (u32x4){0u, 0u, 0u, 0u}; if (lane >= 32) qk[1] = *(const u32x4*)(hrow + 512 + 8 * lane);
        float cs[8], sn[8];
#pragma unroll
        for (int e = 0; e < 8; ++e) { cs[e] = 1.f; sn[e] = 0.f; }
        if (lat) {
#pragma unroll
            for (int e = 0; e < 8; ++e) { const f32x2v t = ropeT[pos * 32 + 8 * (c8 & 3) + e]; cs[e] = t.x; sn[e] = t.y; } }
        const int tpos = lat ? pos : p, Ls = lat ? SEQ : NCTX;
        { const int pc = lane & 31, g = pc >> 3, half = 1 << g;
          const int lo = tpos - half < 0 ? 0 : tpos - half, hi = tpos + half > Ls ? Ls : tpos + half;
          float sum[8];
#pragma unroll
          for (int e = 0; e < 8; ++e) sum[e] = 0.f;
          if (lane < 32) {
              for (int tt = lo; tt < hi; ++tt) { float z[8]; unpack8(*(const u32x4*)(hrow + (ptrdiff_t)(tt - tpos) * 1536 + 1280 + 8 * pc), z);
#pragma unroll
                  for (int e = 0; e < 8; ++e) sum[e] += z[e]; }
              const float rc = 1.0f / (float)(hi - lo); float z[8]; unpack8(*(const u32x4*)(hrow + 1280 + 8 * pc), z);
#pragma unroll
              for (int e = 0; e < 8; ++e) sum[e] = sum[e] * rc - z[e];
              *(u32x4*)(PO + (size_t)R * 256 + 8 * pc) = pack8f(sum); } }
        if (lane >= 32) {
            float y[8], o[8]; unpack8(qk[1], y); float s2 = 0.f;
#pragma unroll
            for (int e = 0; e < 8; ++e) s2 += y[e] * y[e];
            s2 += __shfl_xor(s2, 4); s2 += __shfl_xor(s2, 2); s2 += __shfl_xor(s2, 1);
            const float sc = rsqrtf(s2 * (1.0f / 64.0f) + EPS);
#pragma unroll
            for (int e = 0; e < 8; ++e) { y[e] *= sc * kg[e]; o[e] = __shfl_xor(y[e], 4); }
#pragma unroll
            for (int e = 0; e < 8; ++e) y[e] = c8 < 4 ? y[e] * cs[e] - o[e] * sn[e] : o[e] * sn[e] + y[e] * cs[e];
            *(u32x4*)(hrow + 512 + 8 * lane) = pack8f(y);
        }
    }
}

#define XB_TMO      128
#define XB_XCNT(j)  (256  + 64 * (j))
#define XB_XSUB(j)  (1280 + 64 * (j))
#define XB_XGEN(j)  (2304 + 64 * (j))
#define XB_TOP      3328
#define XB_TOPGEN   3392
#define XCD_BAR_WORDS 3456
#define XB_SPIN_CAP (1u << 18)
__device__ __forceinline__ unsigned xb_ld(unsigned* p)              { return __hip_atomic_load(p, __ATOMIC_RELAXED, __HIP_MEMORY_SCOPE_AGENT); }
__device__ __forceinline__ unsigned xb_add(unsigned* p, unsigned v) { return __hip_atomic_fetch_add(p, v, __ATOMIC_RELAXED, __HIP_MEMORY_SCOPE_AGENT); }
__device__ __forceinline__ unsigned xb_xcc_id() { return (unsigned)__builtin_amdgcn_s_getreg((3 << 11) | 20) & 0xFu; }
#define XB_SPIN(cond, bar) do { unsigned _sp = 0; while (cond) { __builtin_amdgcn_s_sleep(1); \
    if ((++_sp & 255u) == 0u) { if (xb_ld(&(bar)[XB_TMO])) break; if (_sp > XB_SPIN_CAP) { atomicAdd(&(bar)[XB_TMO], 1u); break; } } } } while (0)
struct XcdBarrier { unsigned* bar; unsigned x; volatile LAS unsigned* st; };
__device__ __forceinline__ XcdBarrier xcd_barrier_post(unsigned* bar, volatile LAS unsigned* st) {
    XcdBarrier b; b.bar = bar; b.x = xb_xcc_id(); b.st = st;
    int tid_ = threadIdx.x; asm volatile("" : "+v"(tid_));
    if (tid_ == 0) (void)xb_add(&bar[XB_XCNT(b.x)], 1u);
    return b;
}
__device__ __forceinline__ void xcd_barrier_complete(unsigned* bar, unsigned x, unsigned& nloc, unsigned& nx) {
    const unsigned G = gridDim.x * gridDim.y * gridDim.z;
    unsigned sum, cnt, mine, sp = 0u;
    for (;;) {
        sum = 0u; cnt = 0u; mine = 0u;
#pragma unroll
        for (unsigned j = 0; j < 16; ++j) { const unsigned c = xb_ld(&bar[XB_XCNT(j)]); sum += c; cnt += (c > 0u) ? 1u : 0u; mine = (j == x) ? c : mine; }
        if (sum == G) break;
        __builtin_amdgcn_s_sleep(1);
        if ((++sp & 255u) == 0u) { if (xb_ld(&bar[XB_TMO])) break; if (sp > XB_SPIN_CAP) { atomicAdd(&bar[XB_TMO], 1u); break; } }
    }
    nloc = mine > 0u ? mine : 1u; nx = cnt > 0u ? cnt : 1u;
}
__device__ __forceinline__ void xcd_barrier(const XcdBarrier& b) {
    asm volatile("s_waitcnt vmcnt(0)" ::: "memory");
    __syncthreads();
    int tid_ = threadIdx.x; asm volatile("" : "+v"(tid_));
    if (tid_ == 0) {
        unsigned* bar = b.bar;
        __builtin_amdgcn_s_waitcnt(0);
        unsigned nloc = b.st[0], nx = b.st[1];
        if (nloc == 0u) { xcd_barrier_complete(bar, b.x, nloc, nx); b.st[0] = nloc; b.st[1] = nx; }
        const unsigned old = xb_add(&bar[XB_XSUB(b.x)], 1u);
        const unsigned gen = old / nloc;
        if (old + 1u == (gen + 1u) * nloc) {
            __builtin_amdgcn_fence(__ATOMIC_RELEASE, "agent");
            asm volatile("s_waitcnt vmcnt(0)" ::: "memory");
            const unsigned og = xb_add(&bar[XB_TOP], 1u);
            const unsigned tg = og / nx;
            if (og + 1u == (tg + 1u) * nx) xb_add(&bar[XB_TOPGEN], 1u);
            else XB_SPIN(xb_ld(&bar[XB_TOPGEN]) == tg, bar);
            __builtin_amdgcn_fence(__ATOMIC_ACQUIRE, "agent");
            xb_add(&bar[XB_XGEN(b.x)], 1u);
            asm volatile("s_waitcnt vmcnt(0)" ::: "memory");
        } else {
            XB_SPIN(xb_ld(&bar[XB_XGEN(b.x)]) == gen, bar);
            __builtin_amdgcn_fence(__ATOMIC_ACQUIRE, "agent");
            asm volatile("s_waitcnt vmcnt(0)" ::: "memory");
        }
    }
    __syncthreads();
}

constexpr int LDS_BYTES = 147456;
constexpr int NPHASES = 1 + 2 * 9 + 2 * 8;

__global__ void __launch_bounds__(512, 2) mega_fwd(Args ka) {
    extern __shared__ __attribute__((aligned(16))) unsigned char lds_raw[];
    LAS unsigned char* lds = (LAS unsigned char*)lds_raw;
    cg::grid_group grid = cg::this_grid();
    volatile LAS unsigned* xbst = (volatile LAS unsigned*)(lds + 139264);
    { int tid_ = threadIdx.x; asm volatile("" : "+v"(tid_)); if (tid_ < 2) xbst[tid_] = 0u; }
    __syncthreads();
    XcdBarrier xbar; xbar.bar = (unsigned*)ka.ws; xbar.x = 0; xbar.st = xbst;
    if (ka.hi - ka.lo > 1) xbar = xcd_barrier_post((unsigned*)ka.ws, xbst);
#define U ((bf16_t*)(wsl + WS_U))
#define MIX ((bf16_t*)(wsl + WS_MIX))
#define Hb ((bf16_t*)(wsl + WS_H))
#define Qb ((bf16_t*)(wsl + WS_Q))
#define KVb ((bf16_t*)(wsl + WS_KV))
#define ZL ((bf16_t*)(wsl + WS_ZL))
#define ZC ((bf16_t*)(wsl + WS_ZC))
#define HID ((bf16_t*)(wsl + WS_HID))
#define POOL ((bf16_t*)(wsl + WS_POOL))
#define DFTL ((bf16_t*)(wsl + WS_DFTL))
#define DFTC ((bf16_t*)(wsl + WS_DFTC))
#define hctx ((float*)(wsl + WS_HCTX))
    int ph = 0, layer_ = 0;
#define PHASE_BEGIN if (ph >= ka.lo && ph < ka.hi) { GAS unsigned char* wsg_ = (GAS unsigned char*)ka.ws; asm volatile("" : "+s"(wsg_)); unsigned char* wsl = (unsigned char*)wsg_; \
        const __attribute__((address_space(4))) cfp_t* ain_ = (const __attribute__((address_space(4))) cfp_t*)__builtin_amdgcn_kernarg_segment_ptr(); asm volatile("" : "+s"(ain_)); \
        const Ctx a{ain_, ka.out, wsl}; \
        int lyr_ = layer_; asm volatile("" : "+s"(lyr_)); const float* mods_l = (const float*)(wsl + WS_MODS) + (size_t)lyr_ * 17 * 6144; const float* xin = lyr_ == 0 ? a.inp(I_X) : a.out; const float* cin = lyr_ == 0 ? a.inp(I_CTX) : (const float*)(wsl + WS_HCTX); (void)mods_l; (void)xin; (void)cin; int tid = threadIdx.x; asm volatile("" : "+v"(tid)); int G = gridDim.x, bx = blockIdx.x; asm volatile("" : "+s"(G), "+s"(bx)); \
        const int vcu = (G % 8 == 0) ? (bx % 8) * (G / 8) + bx / 8 : bx, ngw = G * 8, ngt = G * 512; (void)vcu; (void)ngw; (void)ngt; \
        const int lane = tid & 63, wave = __builtin_amdgcn_readfirstlane(tid >> 6), gw = bx * 8 + wave, gtid = bx * 512 + tid; LAS float* scr = (LAS float*)(lds + wave * 8448); \
        (void)lane; (void)gw; (void)gtid; (void)scr;
#define PHASE_END } if (ph >= ka.lo && ph + 1 < ka.hi) { for (int sr_ = 0; sr_ < REP_SYNC; ++sr_) { if (ph == 0) grid.sync(); else xcd_barrier(xbar); } } ++ph;

    PHASE_BEGIN
#ifndef SKIP_P0
        { REPLOOP(REP_P0) {
        for (int it = bx; it < 192; it += G) mods_item(a, it, (LAS float*)lds);
        for (int j = 0; j < 2; ++j) {
            tr_job(a.inp(I_MLAWIN) + (size_t)j * DM * 672, DM, 672, (bf16_t*)(wsl + WS_WINE) + (size_t)j * 768 * DM, 768, 1, nullptr, scr, gw, ngw, lane);
            tr_job(a.inp(I_WUQ) + (size_t)j * 256 * 1152, 256, 1152, (bf16_t*)(wsl + WS_WUQ) + (size_t)j * 1536 * 256, 1536, 2, a.inp(I_CQG) + j * 256, scr, gw, ngw, lane);
            tr_job(a.inp(I_WUKV) + (size_t)j * 128 * 1536, 128, 1536, (bf16_t*)(wsl + WS_WUKV) + (size_t)j * 1536 * 128, 1536, 0, a.inp(I_CKVG) + j * 128, scr, gw, ngw, lane);
            tr_job(a.inp(I_EWOUT) + (size_t)j * DM * DM, DM, DM, (bf16_t*)(wsl + WS_WOUTE) + (size_t)j * DM * DM, DM, 0, nullptr, scr, gw, ngw, lane);
            tr_job(a.inp(I_WINWIN) + (size_t)j * DM * 1536, DM, 1536, (bf16_t*)(wsl + WS_WINO) + (size_t)j * 1536 * DM, 1536, 0, nullptr, scr, gw, ngw, lane);
            tr_job(a.inp(I_OWOUT) + (size_t)j * DM * DM, DM, DM, (bf16_t*)(wsl + WS_WOUTO) + (size_t)j * DM * DM, DM, 0, nullptr, scr, gw, ngw, lane);
        }
        ffn_weights(a, 0, scr, gw, ngw, lane);
        __syncthreads();
        LAS float* ctab = (LAS float*)lds;
        for (int m = tid; m < 4096; m += 512) ctab[m] = cospif((float)m * (1.0f / 2048.0f)) * (1.0f / 64.0f);
        __syncthreads();
        for (int idx = gtid; idx < 4096 * 1024; idx += ngt) { const int k = idx >> 10, col0 = (idx & 1023) * 8, cs = col0 >> 12, l0 = col0 & 4095; float v[8];
#pragma unroll
            for (int e = 0; e < 8; ++e) { const int m = (k * (l0 + e) + cs * 1024) & 4095; v[e] = ctab[m]; }
            u32x4 o; o.x = cvt_pk_bf16(v[0], v[1]); o.y = cvt_pk_bf16(v[2], v[3]); o.z = cvt_pk_bf16(v[4], v[5]); o.w = cvt_pk_bf16(v[6], v[7]);
            *(u32x4*)(DFTL + (size_t)k * 8192 + col0) = o; }
        for (int idx = gtid; idx < 256 * 64; idx += ngt) { const int k = idx >> 6, col0 = (idx & 63) * 8, cs = col0 >> 8, l0 = col0 & 255; float v[8];
#pragma unroll
            for (int e = 0; e < 8; ++e) { const int m = (k * (l0 + e)) & 255; const float x = (float)m * (1.0f / 128.0f); v[e] = (cs ? -sinpif(x) : cospif(x)) * (1.0f / 16.0f); }
            u32x4 o; o.x = cvt_pk_bf16(v[0], v[1]); o.y = cvt_pk_bf16(v[2], v[3]); o.z = cvt_pk_bf16(v[4], v[5]); o.w = cvt_pk_bf16(v[6], v[7]);
            *(u32x4*)(DFTC + (size_t)k * 512 + col0) = o; }
        for (int idx = gtid; idx < 2 * 512 * 256; idx += ngt) { const int j = idx >> 17, n = (idx >> 8) & 511, k = idx & 255; const int cs = n >> 8, g = (n >> 6) & 3, d = n & 63, g2 = k >> 6, c = k & 63;
            float s = 0.f;
            if (g2 == g) { const float* wf = a.inp(I_FNETW) + ((size_t)(j * 4 + g) * 64) * 64 + d;
                for (int c2 = 0; c2 < 64; ++c2) { const int m = (c * c2) & 63; s += (cs ? -ctab[(m * 64 + 1024) & 4095] : ctab[m * 64]) * wf[c2 * 64]; }
                s *= 8.0f; }
            ((bf16_t*)(wsl + WS_WF))[idx] = (bf16_t)(cvt_pk_bf16(s, 0.f) & 0xffffu); }
        for (int idx = gtid; idx < 4096 * 16; idx += ngt) { float cs, sn; rope_cs<8>(idx >> 4, idx & 15, cs, sn); ((f32x2v*)(wsl + WS_ROPE_E))[idx] = (f32x2v){cs, sn}; }
        for (int idx = gtid; idx < 4096 * 32; idx += ngt) { float cs, sn; rope_cs<16>(idx >> 5, idx & 31, cs, sn); ((f32x2v*)(wsl + WS_ROPE_O))[idx] = (f32x2v){cs, sn}; }
        for (int idx = gtid; idx < 2 * 256 * 256; idx += ngt) { const int j = idx >> 16, n = (idx >> 8) & 255, k = idx & 255; const int g = n >> 6, d = n & 63, g2 = k >> 6, c = k & 63;
            float s = 0.f; if (g2 == g) s = a.inp(I_POOLW)[((size_t)(j * 4 + g) * 64 + c) * 64 + d] * a.inp(I_POOLS)[j * 256 + n];
            ((bf16_t*)(wsl + WS_WP))[idx] = (bf16_t)(cvt_pk_bf16(s, 0.f) & 0xffffu); }
        __syncthreads(); } }
#endif
    PHASE_END

    for (int layer = 0; layer < 4; ++layer) {
        const int j = layer >> 1; const bool even = !(layer & 1); const bool ctx_out = layer < 3;
        layer_ = layer;

        PHASE_BEGIN
#ifndef SKIP_NORM
            { REPLOOP(REP_NORM)
            norm_pass(xin, cin, a.inp(I_N1G) + layer * DM, mods_l, 0, 1, U, false, false, gw, ngw, lane); }
#endif
        PHASE_END

        PHASE_BEGIN
#ifndef SKIP_GIN
            { REPLOOP(REP_GIN) {
            if (even) { pg8::Gemm g{U, (const bf16_t*)(wsl + WS_WINE) + (size_t)j * 768 * DM, DM, DM, DM};
                pg8::Order<pg8::MapStd> S; S.init(T / 256, 3, G, bx, pg8::MapStd{0}); pg8::EpiBf16 E{Hb, 768, Hb, 768}; pg8::gemm_phase(lds, g, S, E); }
            else { pg8::Gemm g{U, (const bf16_t*)(wsl + WS_WINO) + (size_t)j * 1536 * DM, DM, DM, DM};
                pg8::Order<pg8::MapStd> S; S.init(T / 256, 6, G, bx, pg8::MapStd{0}); pg8::EpiBf16 E{Hb, 1536, Hb, 1536}; pg8::gemm_phase(lds, g, S, E); }
            } }
#endif
        PHASE_END

        if (even) {
            PHASE_BEGIN
#ifndef SKIP_G3
                { REPLOOP(REP_G3) {
                { pg8::Gemm g{Hb, (const bf16_t*)(wsl + WS_WUQ) + (size_t)j * 1536 * 256, 768, 256, 256};
                  pg8::Order<pg8::MapStd> S; S.init(T / 256, 6, G, bx, pg8::MapStd{0}); pg8::EpiBf16 E{Qb, 1536, Qb, 1536}; pg8::gemm_phase(lds, g, S, E); }
                { pg8::Gemm g{Hb + 256, (const bf16_t*)(wsl + WS_WUKV) + (size_t)j * 1536 * 128, 768, 128, 128};
                  pg8::Order<pg8::MapStd> S; S.init(T / 256, 6, G, bx, pg8::MapStd{0}); pg8::EpiBf16 E{KVb, 1536, KVb, 1536}; pg8::gemm_phase(lds, g, S, E); }
                { pg8::Gemm g{(const bf16_t*)(wsl + WS_WF) + (size_t)j * 512 * 256, Hb + 416, 256, 768, 256};
                  pg8::Order<pg8::MapZ> S; S.init(2, T / 256, G, bx, pg8::MapZ{}); pg8::EpiBf16 E{ZL, 8192, ZC, 512}; pg8::gemm_phase(lds, g, S, E); }
                } }
#endif
            PHASE_END
            PHASE_BEGIN
#ifndef SKIP_EWE
                ew_even(a, j, gw, ngw, lane);
#endif
            PHASE_END
            PHASE_BEGIN
#ifndef SKIP_ATTE
                const bf16_t* Kb = (const bf16_t*)(wsl + WS_U);
                const int nu = 3072 + (ctx_out ? 192 : 0);
                { REPLOOP(REP_ATTE)
                for (int uid = vcu; uid < nu; uid += G) {
                    if (uid < 3072) { const int bh = uid >> 4, qb = uid & 15, b = bh / 12, h = bh % 12; const size_t base = (size_t)b * TB, qrow = base + NCTX + qb * 256;
                        attn_unit<96, false>(lds, Qb + qrow * 1536 + h * 128, 1536, Kb + base * 1152 + h * 96, 1152, KVb + base * 1536 + h * 128 + 64, 1536, MIX + qrow * DM + h * 64, 68, 0, 0, 0, -1e30f, false); }
                    else { const int bh = uid - 3072, b = bh / 12, h = bh % 12; const size_t base = (size_t)b * TB;
                        attn_unit<96, false>(lds, Qb + base * 1536 + h * 128, 1536, Kb + base * 1152 + h * 96, 1152, KVb + base * 1536 + h * 128 + 64, 1536, MIX + base * DM + h * 64, 4, 0, 0, 0, -1e30f, false); }
                } }
#ifndef SKIP_ATTE_G
                { REPLOOP(REP_FNET) {
                { pg8::Gemm g{DFTL, ZL, 8192, 8192, 8192};
                  pg8::Order<pg8::MapFnetL> S; S.init(256, 1, G, bx, pg8::MapFnetL{}); pg8::EpiBf16 E{MIX, DM, MIX, DM}; pg8::gemm_phase(lds, g, S, E); }
                if (ctx_out) { pg8::Gemm g{DFTC, ZC, 512, 512, 512};
                  pg8::Order<pg8::MapFnetC> S; S.init(16, 1, G, bx, pg8::MapFnetC{}); pg8::EpiBf16 E{MIX, DM, MIX, DM}; pg8::gemm_phase(lds, g, S, E); }
                } }
#endif
#endif
            PHASE_END
        } else {
            PHASE_BEGIN
#ifndef SKIP_EWO
                ew_odd(a, j, gw, ngw, lane);
#endif
            PHASE_END
            PHASE_BEGIN
#ifndef SKIP_ATTO
                const float* sink = a.inp(I_SINK) + j * 12;
                const int nu = 3072 + (ctx_out ? 192 : 0);
                { REPLOOP(REP_ATTO)
                for (int uid = vcu; uid < nu; uid += G) {
                    if (uid < 3072) { const int bh = uid >> 4, qb = uid & 15, b = bh / 12, h = bh % 12, kvh = h / 3; const size_t base = (size_t)b * TB, qrow = base + NCTX + qb * 256;
                        int lt0 = qb * 4 - 2, lt1 = qb * 4 + 6; if (lt0 < 0) lt0 = 0; if (lt1 > 64) lt1 = 64;
                        attn_unit<64, true>(lds, Hb + qrow * 1536 + h * 64, 1536, Hb + base * 1536 + 768 + kvh * 64, 1536, Hb + base * 1536 + 1024 + kvh * 64, 1536, MIX + qrow * DM + h * 64,
                                            4, 4 + lt0, 4 + lt1, qb * 256, sink[h] * LOG2E, true, a.inp(I_WQG) + j * 64, (const f32x2v*)(wsl + WS_ROPE_O), true); }
                    else { const int bh = uid - 3072, b = bh / 12, h = bh % 12, kvh = h / 3; const size_t base = (size_t)b * TB;
                        attn_unit<64, true>(lds, Hb + base * 1536 + h * 64, 1536, Hb + base * 1536 + 768 + kvh * 64, 1536, Hb + base * 1536 + 1024 + kvh * 64, 1536, MIX + base * DM + h * 64,
                                            4, 0, 0, 0, sink[h] * LOG2E, true, a.inp(I_WQG) + j * 64, (const f32x2v*)(wsl + WS_ROPE_O), false); }
                } }
                { pg8::Gemm g{POOL, (const bf16_t*)(wsl + WS_WP) + (size_t)j * 256 * 256, 256, 256, 256};
                  pg8::Order<pg8::MapStd> S; S.init(T / 256, 1, G, bx, pg8::MapStd{768}); pg8::EpiBf16 E{MIX, DM, MIX, DM}; pg8::gemm_phase(lds, g, S, E); }
#endif
            PHASE_END
        }

        PHASE_BEGIN
#ifndef SKIP_WOUT
            pg8::Gemm g{MIX, (const bf16_t*)(wsl + (even ? WS_WOUTE : WS_WOUTO)) + (size_t)j * DM * DM, DM, DM, DM};
            pg8::Order<pg8::MapRes> S; S.init(ctx_out ? 272 : 256, 4, G, bx, pg8::MapRes{ctx_out ? 1 : 0});
            { REPLOOP(REP_WOUT) { pg8::EpiRes E{rep_ ? (const float*)a.out : xin, a.out, rep_ ? (const float*)hctx : cin, hctx, mods_l, 2, rep_ ? 0.f : 1.f}; pg8::gemm_phase(lds, g, S, E); } }
#endif
        PHASE_END

        PHASE_BEGIN
#ifndef SKIP_NORM2
            { REPLOOP(REP_NORM)
            norm_pass(a.out, hctx, a.inp(I_N2G) + layer * DM, mods_l, 3, 4, U, true, !ctx_out, gw, ngw, lane); }
#endif
        PHASE_END

        PHASE_BEGIN
#ifndef SKIP_UP
            pg8::Gemm g{U, (const bf16_t*)(wsl + WS_WUP), DM, DM, DM};
            pg8::Order<pg8::MapUp> S; S.init(ctx_out ? 288 : 272, 22, G, bx, pg8::MapUp{ctx_out ? 1 : 0});
            pg8::EpiUp E{HID, a.inp(I_CONVW) + (size_t)layer * 3 * 2 * DFF, a.inp(I_CONVB) + (size_t)layer * 2 * DFF}; { REPLOOP(REP_UP) pg8::gemm_phase(lds, g, S, E); }
#endif
        PHASE_END

        PHASE_BEGIN
#ifndef SKIP_DN
            pg8::Gemm g{HID, (const bf16_t*)(wsl + ((layer & 1) ? WS_WDN2 : WS_WDN)), DFF, DFF, DFF};
            pg8::Order<pg8::MapRes> S; S.init(ctx_out ? 272 : 256, 4, G, bx, pg8::MapRes{ctx_out ? 1 : 0});
            { REPLOOP(REP_DN) { pg8::EpiRes E{a.out, a.out, hctx, hctx, mods_l, 5, rep_ ? 0.f : 1.f}; pg8::gemm_phase(lds, g, S, E); } }
            if (layer < 3) {
                const int nfree = (ctx_out && G == 256) ? 192 : G, first = (ctx_out && G == 256) ? 64 : 0;
                if (bx >= first) ffn_weights(a, layer + 1, scr, (bx - first) * 8 + wave, nfree * 8, lane);
            }
#endif
        PHASE_END
    }
#undef PHASE_BEGIN
#undef PHASE_END
#undef U
#undef MIX
#undef Hb
#undef Qb
#undef KVb
#undef ZL
#undef ZC
#undef HID
#undef POOL
#undef DFTL
#undef DFTC
#undef hctx
}

extern "C" void kernel_launch(void* const* d_in, const int* in_sizes, int n_in, void* d_out, int out_size, void* d_ws, size_t ws_size, hipStream_t stream) {
    static int grid = 0;
    if (grid == 0) {
        if (n_in != 28 || out_size != NB * SEQ * DM || ws_size < WS_END) { fprintf(stderr, "kernel_launch: unexpected shapes (n_in %d, out %d, ws %zu); nothing launched\n", n_in, out_size, ws_size); grid = -1; return; }
        int dev = 0, cus = 0, per_cu = 0;
        if (hipGetDevice(&dev) != hipSuccess || hipDeviceGetAttribute(&cus, hipDeviceAttributeMultiprocessorCount, dev) != hipSuccess) { grid = -1; return; }
        if (hipFuncSetAttribute((const void*)mega_fwd, hipFuncAttributeMaxDynamicSharedMemorySize, LDS_BYTES) != hipSuccess) { fprintf(stderr, "kernel_launch: hipFuncSetAttribute failed\n"); grid = -1; return; }
        if (hipOccupancyMaxActiveBlocksPerMultiprocessor(&per_cu, (const void*)mega_fwd, 512, LDS_BYTES) != hipSuccess || per_cu < 1) { fprintf(stderr, "kernel_launch: occupancy query says %d\n", per_cu); per_cu = 1; }
        (void)hipGetLastError();
        grid = cus * 1;
    }
    if (grid < 0) return;
    Args a{};
    for (int i = 0; i < 28; ++i) a.in[i] = (const float*)d_in[i];
    a.out = (float*)d_out; a.ws = (unsigned char*)d_ws; a.lo = 0; a.hi = NPHASES;
    (void)hipMemsetAsync(d_ws, 0, 16384, stream);
    void* args[] = {&a};
    hipError_t e = hipLaunchCooperativeKernel((const void*)mega_fwd, dim3(grid), dim3(512), args, LDS_BYTES, stream);
    if (e != hipSuccess) {
        fprintf(stderr, "kernel_launch: cooperative launch failed: %s (grid %d); falling back to one launch per phase\n", hipGetErrorString(e), grid);
        (void)hipGetLastError();
        for (int p = 0; p < NPHASES; ++p) { a.lo = p; a.hi = p + 1; hipLaunchKernelGGL(mega_fwd, dim3(grid), dim3(512), LDS_BYTES, stream, a); }
    }
}
```

```cpp
#include <hip/hip_runtime.h>
#include <hip/hip_cooperative_groups.h>
#include <cstdio>
#include <cstdint>
namespace cg = cooperative_groups;

#define REP_NORM 1
#define REP_GIN 1
#define REP_G3 1
#define REP_ATTE 1
#define REP_FNET 1
#define REP_ATTO 1
#define REP_WOUT 1
#define REP_UP 1
#define REP_DN 1
#define REP_P0 1
#define REP_EW 1
#define REP_SYNC 1
#define PROBE_MODE 0
#define REPLOOP(N) int nrep_ = (N); asm volatile("" : "+s"(nrep_)); for (int rep_ = 0; rep_ < nrep_; ++rep_)

constexpr int NB = 16, SEQ = 4096, NCTX = 256, DM = 1024, TB = SEQ + NCTX, T = NB * TB;
constexpr int DFF = 2816, U2B = 4608, TAILROW0 = 16 * 4608, TAILSEG = 34;
constexpr float EPS = 1e-6f;
constexpr float LOG2E = 1.4426950408889634f;

constexpr size_t MiB = 1u << 20;
constexpr size_t WS_MODS = 1 * MiB;
constexpr size_t WS_WINE = 3 * MiB;
constexpr size_t WS_WUQ = 6 * MiB;
constexpr size_t WS_WUKV = WS_WUQ + 3 * MiB / 2;
constexpr size_t WS_WF = WS_WUKV + 3 * MiB / 4;
constexpr size_t WS_WP = WS_WF + MiB / 2;
constexpr size_t WS_WOUTE = 9 * MiB;
constexpr size_t WS_WOUTO = 13 * MiB;
constexpr size_t WS_WINO = 17 * MiB;
constexpr size_t WS_WUP = 23 * MiB;
constexpr size_t WS_WDN = 34 * MiB;
constexpr size_t WS_DFTC = 40 * MiB;
constexpr size_t WS_DFTL = 41 * MiB;
constexpr size_t WS_HCTX = 105 * MiB;
constexpr size_t WS_U = 121 * MiB;
constexpr size_t WS_MIX = 275 * MiB;
constexpr size_t WS_ARENA = 411 * MiB;
constexpr size_t WS_H = WS_ARENA;
constexpr size_t WS_Q = WS_ARENA + 102 * MiB;
constexpr size_t WS_KV = WS_Q + 204 * MiB;
constexpr size_t WS_ZL = WS_KV + 204 * MiB;
constexpr size_t WS_ZC = WS_ZL + 64 * MiB;
constexpr size_t WS_POOL = WS_ARENA + 204 * MiB;
constexpr size_t WS_HID = WS_ARENA;
constexpr size_t WS_ROPE_E = WS_ZC + 4 * MiB;
constexpr size_t WS_ROPE_O = WS_ROPE_E + 1 * MiB;
constexpr size_t WS_WDN2 = WS_ROPE_O + 1 * MiB;
constexpr size_t WS_END = WS_WDN2 + 6 * MiB;
static_assert(WS_END <= 1024 * MiB, "ws map");

#define LAS __attribute__((address_space(3)))
#define GAS __attribute__((address_space(1)))
typedef unsigned short bf16_t;
typedef short bf16x8 __attribute__((ext_vector_type(8)));
typedef float f32x4 __attribute__((ext_vector_type(4)));
typedef float f32x16 __attribute__((ext_vector_type(16)));
typedef unsigned u32x4 __attribute__((ext_vector_type(4)));
typedef unsigned u32x2 __attribute__((ext_vector_type(2)));
typedef float f32x2v __attribute__((ext_vector_type(2)));

__device__ __forceinline__ unsigned cvt_pk_bf16(float lo, float hi) { unsigned r; asm volatile("v_cvt_pk_bf16_f32 %0, %1, %2" : "=v"(r) : "v"(lo), "v"(hi)); return r; }
__device__ __forceinline__ float bflo(unsigned u) { return __uint_as_float(u << 16); }
__device__ __forceinline__ float bfhi(unsigned u) { return __uint_as_float(u & 0xffff0000u); }
__device__ __forceinline__ float bf2f(bf16_t b) { return __uint_as_float((unsigned)b << 16); }
__device__ __forceinline__ float wave_sum(float v) {
#pragma unroll
    for (int o = 1; o < 64; o <<= 1) v += __shfl_xor(v, o);
    return v;
}
__device__ __forceinline__ float half_sum(float v) {
#pragma unroll
    for (int o = 1; o < 32; o <<= 1) v += __shfl_xor(v, o);
    return v;
}

namespace pg8 {
constexpr int BM = 256, BK = 64, HALF = 128, HTB = HALF * BK * 2, STAGE_BYTES = 8 * HTB, NXCD = 8, WGM = 8;
__device__ __forceinline__ int lds_byte(int r, int c) { const int st = (r >> 4) * 2 + (c >> 5), rr = r & 15, cc = c & 31, ob = rr * 64 + cc * 2; return st * 1024 + (ob ^ (((ob >> 9) & 1) << 5)); }
__device__ __forceinline__ void stage_rc(int b, int& R, int& C) { const int st = b / 1024, sb = b % 1024, swz = sb ^ (((sb >> 9) & 1) << 5); R = (st >> 1) * 16 + swz / 64; C = (st & 1) * 32 + (swz % 64) / 2; }
__device__ __forceinline__ int perm32(int rho) { const int n = rho >> 4, i = rho & 15; return 8 * (i >> 2) + 4 * n + (i & 3); }

struct Unit { int pm, pn, arow, brow, orow, ocol, aux, bt; };
struct Gemm { const bf16_t* A; const bf16_t* Bt; int lda, ldb, K; };

template <class Map> struct Order {
    int nM, nN, nwg, G, c; Map map;
    __device__ __forceinline__ void init(int nM_, int nN_, int G_, int c_, const Map& m) { nM = nM_; nN = nN_; nwg = nM * nN; G = G_; c = c_; map = m; }
    __device__ __forceinline__ bool next(int i, Unit& u) const {
        const long L = (long)i * G + c; if (L >= nwg) return false;
        int wgid = (int)L; { const int q = nwg / NXCD, r = nwg % NXCD, xcd = wgid % NXCD, off = wgid / NXCD; wgid = (xcd < r ? xcd * (q + 1) : r * (q + 1) + (xcd - r) * q) + off; }
        const int nig = WGM * nN, gid = wgid / nig, fm = gid * WGM, gsz = (nM - fm) < WGM ? (nM - fm) : WGM;
        u.pm = fm + ((wgid % nig) % gsz); u.pn = (wgid % nig) / gsz; map(u); return true;
    }
};

struct EpiBf16 {
    static constexpr bool PERM = true;
    bf16_t* O0; int ld0; bf16_t* O1; int ld1;
    __device__ __forceinline__ void operator()(const f32x4 (&acc)[2][2][4][2], const Unit& u, int wr, int wc, int fr, int fq, LAS unsigned char*) const {
        bf16_t* base = u.aux ? O1 : O0; const int ldc = u.aux ? ld1 : ld0;
        const int row0 = u.orow + wr * 64 + fr, col0 = u.ocol + wc * 32 + 8 * fq;
#pragma unroll
        for (int ai = 0; ai < 2; ++ai)
#pragma unroll
            for (int m = 0; m < 4; ++m) { bf16_t* rowp = base + (size_t)(row0 + ai * HALF + m * 16) * ldc + col0;
#pragma unroll
                for (int bj = 0; bj < 2; ++bj) { const f32x4 v0 = acc[ai][bj][m][0], v1 = acc[ai][bj][m][1];
                    u32x4 w; w.x = cvt_pk_bf16(v0[0], v0[1]); w.y = cvt_pk_bf16(v0[2], v0[3]); w.z = cvt_pk_bf16(v1[0], v1[1]); w.w = cvt_pk_bf16(v1[2], v1[3]);
                    *(u32x4*)(rowp + bj * HALF) = w; } }
    }
};

struct EpiRes {
    static constexpr bool PERM = false;
    const float* xin; float* xout; const float* cin; float* cout; const float* mods_l; int gidx; float gs;
    __device__ __forceinline__ void operator()(const f32x4 (&acc)[2][2][4][2], const Unit& u, int wr, int wc, int fr, int fq, LAS unsigned char*) const {
        const float* src = u.aux ? cin : xin; float* dst = u.aux ? cout : xout;
        const float* gate = mods_l + (size_t)(u.aux ? 16 : u.bt) * 6144 + gidx * 1024;
        const int row0 = u.orow + wr * 64 + fr, col0 = u.ocol + wc * 32 + 4 * fq;
        const __amdgpu_buffer_rsrc_t rs = __builtin_amdgcn_make_buffer_rsrc((void*)dst, 0, 0x40000000, 0x00020000);
#pragma unroll
        for (int bj = 0; bj < 2; ++bj)
#pragma unroll
            for (int n = 0; n < 2; ++n) { const int col = col0 + bj * HALF + n * 16; const f32x4 g4 = *(const f32x4*)(gate + col) * gs;
#pragma unroll
                for (int ai = 0; ai < 2; ++ai)
#pragma unroll
                    for (int m = 0; m < 4; ++m) { const size_t off = (size_t)(row0 + ai * HALF + m * 16) * DM + col;
                        const f32x4 x4 = *(const f32x4*)(src + off); __builtin_amdgcn_raw_buffer_store_b128(__builtin_bit_cast(u32x4, x4 + g4 * acc[ai][bj][m][n]), rs, (unsigned)(off * 4), 0, 16); } }
    }
};

__device__ __forceinline__ float dpp_ror1(float v) { return __int_as_float(__builtin_amdgcn_update_dpp(__float_as_int(v), __float_as_int(v), 0x121, 0xf, 0xf, false)); }
__device__ __forceinline__ float dpp_ror15(float v) { return __int_as_float(__builtin_amdgcn_update_dpp(__float_as_int(v), __float_as_int(v), 0x12F, 0xf, 0xf, false)); }
__device__ __forceinline__ float silu_f(float x) { return x * __builtin_amdgcn_rcpf(1.0f + __expf(-x)); }

struct EpiUp {
    static constexpr bool PERM = false;
    bf16_t* Hd; const float* cw; const float* cb;
    __device__ __forceinline__ void operator()(const f32x4 (&acc)[2][2][4][2], const Unit& u, int wr, int wc, int fr, int fq, LAS unsigned char* lds) const {
        LAS float* hal = (LAS float*)(lds + STAGE_BYTES);
        LAS float* cwl = (LAS float*)(lds + 140288);
        const int tid_ = (wr * 4 + wc) * 64 + fq * 16 + fr;
        float cwv[2];
#pragma unroll
        for (int q = 0; q < 2; ++q) { const int e = tid_ + 512 * q, t = e >> 8, bj = (e >> 7) & 1, c = e & 127; cwv[q] = t < 3 ? cw[t * (2 * DFF) + bj * DFF + u.ocol + c] : cb[bj * DFF + u.ocol + c]; }
        if (fr == 0) {
#pragma unroll
            for (int ai = 0; ai < 2; ++ai)
#pragma unroll
                for (int bj = 0; bj < 2; ++bj)
#pragma unroll
                    for (int n = 0; n < 2; ++n) *(LAS f32x4*)(hal + ((2 * ai + wr) * 2 + 0) * 256 + bj * 128 + wc * 32 + n * 16 + 4 * fq) = acc[ai][bj][0][n];
        }
        if (fr == 15) {
#pragma unroll
            for (int ai = 0; ai < 2; ++ai)
#pragma unroll
                for (int bj = 0; bj < 2; ++bj)
#pragma unroll
                    for (int n = 0; n < 2; ++n) *(LAS f32x4*)(hal + ((2 * ai + wr) * 2 + 1) * 256 + bj * 128 + wc * 32 + n * 16 + 4 * fq) = acc[ai][bj][3][n];
        }
        cwl[tid_] = cwv[0]; cwl[tid_ + 512] = cwv[1];
        asm volatile("s_waitcnt lgkmcnt(0)" ::: "memory"); __builtin_amdgcn_s_barrier(); asm volatile("" ::: "memory");
        int fr_ = fr, fq_ = fq; asm volatile("" : "+v"(fr_), "+v"(fq_));
        const int rmin = u.aux == 1 ? 0 : 1, rmax = u.bt;
        const f32x4 zero4 = {0.f, 0.f, 0.f, 0.f};
#pragma unroll
        for (int ai = 0; ai < 2; ++ai) {
            const int g = 2 * ai + wr;
#pragma unroll
            for (int n = 0; n < 2; ++n) {
                const int chb = u.ocol + wc * 32 + n * 16 + 4 * fq_;
                const int colh = wc * 32 + n * 16 + 4 * fq_;
                f32x4 w0[2], w1[2], w2[2], bb[2], uh[2], dh[2];
#pragma unroll
                for (int bj = 0; bj < 2; ++bj) { const int cl = bj * 128 + colh;
                    w0[bj] = *(const LAS f32x4*)(cwl + 0 * 256 + cl); w1[bj] = *(const LAS f32x4*)(cwl + 1 * 256 + cl); w2[bj] = *(const LAS f32x4*)(cwl + 2 * 256 + cl); bb[bj] = *(const LAS f32x4*)(cwl + 3 * 256 + cl);
                    uh[bj] = zero4; dh[bj] = zero4;
                    if (g > 0) uh[bj] = *(LAS f32x4*)(hal + ((g - 1) * 2 + 1) * 256 + bj * 128 + colh);
                    if (g < 3) dh[bj] = *(LAS f32x4*)(hal + ((g + 1) * 2 + 0) * 256 + bj * 128 + colh); }
#pragma unroll
                for (int m = 0; m < 4; ++m) {
                    f32x4 res[2];
#pragma unroll
                    for (int bj = 0; bj < 2; ++bj) {
                        const f32x4 cur = acc[ai][bj][m][n];
                        const f32x4 prv = m > 0 ? acc[ai][bj][m > 0 ? m - 1 : 0][n] : uh[bj];
                        const f32x4 nxt = m < 3 ? acc[ai][bj][m < 3 ? m + 1 : 3][n] : dh[bj];
                        f32x4 up, dn;
#pragma unroll
                        for (int j = 0; j < 4; ++j) { up[j] = dpp_ror1(fr_ == 15 ? prv[j] : cur[j]); dn[j] = dpp_ror15(fr_ == 0 ? nxt[j] : cur[j]); }
                        if (m == 0) { if (fr_ == 0) up = uh[bj]; }
                        if (m == 3) { if (fr_ == 15) dn = dh[bj]; }
                        res[bj] = w0[bj] * up + w1[bj] * cur + w2[bj] * dn + bb[bj];
                    }
                    const int r = ai * HALF + wr * 64 + m * 16 + fr_;
                    bool okr = r >= rmin && r <= rmax; int trow = u.orow + r;
                    if (u.aux == 2) { const int seg = r / TAILSEG, sq = r - seg * TAILSEG, sb = 7 * (u.orow >> 8) + seg;
                        okr = seg < 7 && sb < NB && sq >= 1 && sq <= 32; trow = sb * TB + NCTX + (SEQ - 33) + sq; }
                    if (okr) {
                        const f32x4 gq = res[0], vq = res[1];
                        u32x2 w; w.x = cvt_pk_bf16(silu_f(gq[0]) * vq[0], silu_f(gq[1]) * vq[1]); w.y = cvt_pk_bf16(silu_f(gq[2]) * vq[2], silu_f(gq[3]) * vq[3]);
                        *(u32x2*)(Hd + (size_t)trow * DFF + chb) = w;
                    }
                }
            }
        }
    }
};

template <class Epi, class Sched>
__device__ __forceinline__ void gemm_phase(LAS unsigned char* lds, const Gemm g, const Sched& S, const Epi& E) {
    int tid = threadIdx.x; asm volatile("" : "+v"(tid));
    const int wid = __builtin_amdgcn_readfirstlane(tid >> 6), lane = tid & 63, wr = wid >> 2, wc = wid & 3, fr = lane & 15, fq = lane >> 4;
    int K = g.K, lda_ = g.lda, ldb_ = g.ldb; asm volatile("" : "+s"(K), "+s"(lda_), "+s"(ldb_));
    const int nt = K / BK;
    unsigned voffA[2], voffB[2];
#pragma unroll
    for (int i = 0; i < 2; ++i) { int R, C; stage_rc(tid * 16 + i * 8192, R, C); const int Rb = Epi::PERM ? ((R & ~31) + perm32(R & 31)) : R;
        voffA[i] = (unsigned)(R * lda_ + C) * 2u; voffB[i] = (unsigned)(Rb * ldb_ + C) * 2u; }
    const size_t kstep = (size_t)(BK * 2);
    const size_t hstepA = (size_t)HALF * lda_ * 2, hstepB = (size_t)HALF * ldb_ * 2;
    const unsigned ldsw = (unsigned)wid * 1024u;
    const int aoff = lds_byte(wr * 64 + fr, fq * 8), boff = lds_byte(wc * 32 + fr, fq * 8);
#define PG8_SA(b, h) (((b) * 2 + (h)) * HTB)
#define PG8_SB(b, h) ((4 + (b) * 2 + (h)) * HTB)
#define PG8_STAGE(bufoff, gbase, voff) do { _Pragma("unroll") for (int _i = 0; _i < 2; ++_i) \
        __builtin_amdgcn_global_load_lds((const unsigned*)((const char*)(gbase) + (voff)[_i]), (LAS unsigned*)(lds + (bufoff) + ldsw + _i * 8192), 16, 0, 0); } while (0)
#define PG8_LDA(dst, b, h) do { _Pragma("unroll") for (int m = 0; m < 4; ++m) _Pragma("unroll") for (int k = 0; k < 2; ++k) dst[m][k] = *(const LAS bf16x8*)(lds + PG8_SA(b, h) + aoff + m * 2048 + k * 1024); } while (0)
#define PG8_LDB(dst, b, h) do { _Pragma("unroll") for (int n = 0; n < 2; ++n) _Pragma("unroll") for (int k = 0; k < 2; ++k) dst[n][k] = *(const LAS bf16x8*)(lds + PG8_SB(b, h) + boff + n * 2048 + k * 1024); } while (0)
#define PG8_MMA(ai, bj, At, Bt) do { __builtin_amdgcn_s_setprio(1); _Pragma("unroll") for (int m = 0; m < 4; ++m) _Pragma("unroll") for (int n = 0; n < 2; ++n) _Pragma("unroll") for (int k = 0; k < 2; ++k) \
        acc[ai][bj][m][n] = __builtin_amdgcn_mfma_f32_16x16x32_bf16(Bt[n][k], At[m][k], acc[ai][bj][m][n], 0, 0, 0); __builtin_amdgcn_s_setprio(0); } while (0)
#define PG8_WAIT_V(n) asm volatile("s_waitcnt vmcnt(" #n ")" ::: "memory")
#define PG8_WAIT_L(n) asm volatile("s_waitcnt lgkmcnt(" #n ")" ::: "memory")
#define PG8_BAR __builtin_amdgcn_s_barrier()
#define PG8_SCHED __builtin_amdgcn_sched_barrier(0)
    Unit cur, nxt; int ui = 0;
    if (!S.next(0, cur)) return;
    f32x4 acc[2][2][4][2];
#pragma unroll
    for (int a = 0; a < 2; ++a)
#pragma unroll
        for (int b = 0; b < 2; ++b)
#pragma unroll
            for (int m = 0; m < 4; ++m)
#pragma unroll
                for (int n = 0; n < 2; ++n) acc[a][b][m][n] = (f32x4){0.f, 0.f, 0.f, 0.f};
    bf16x8 At[4][2], B0[2][2], B1[2][2];
    const char* cA = (const char*)g.A + (size_t)cur.arow * lda_ * 2; const char* cB = (const char*)g.Bt + (size_t)cur.brow * ldb_ * 2;
    PG8_STAGE(PG8_SB(0, 0), cB, voffB); PG8_STAGE(PG8_SB(0, 1), cB + hstepB, voffB); PG8_STAGE(PG8_SA(0, 0), cA, voffA); PG8_STAGE(PG8_SA(0, 1), cA + hstepA, voffA);
    if (wr == 1) PG8_BAR;
    PG8_WAIT_V(2); PG8_BAR;
    PG8_STAGE(PG8_SB(1, 0), cB + kstep, voffB); PG8_STAGE(PG8_SA(1, 0), cA + kstep, voffA); PG8_STAGE(PG8_SB(1, 1), cB + hstepB + kstep, voffB);
    PG8_WAIT_V(6); PG8_BAR;
    for (;;) {
        const bool has_next = S.next(ui + 1, nxt);
        const char* nA = has_next ? (const char*)g.A + (size_t)nxt.arow * lda_ * 2 : cA; const char* nB = has_next ? (const char*)g.Bt + (size_t)nxt.brow * ldb_ * 2 : cB;
        for (int t = 0; t < nt; t += 2) {
            const bool last = (t == nt - 2);
            const char* a1 = cA + (size_t)(t + 1) * kstep;
            const char* a2 = last ? nA : cA + (size_t)(t + 2) * kstep; const char* b2 = last ? nB : cB + (size_t)(t + 2) * kstep;
            const char* a3 = a2 + kstep; const char* b3 = b2 + kstep;
            PG8_LDB(B0, 0, 0); PG8_LDB(B1, 0, 1); PG8_SCHED; PG8_LDA(At, 0, 0); PG8_STAGE(PG8_SA(1, 1), a1 + hstepA, voffA);
            PG8_WAIT_V(8); PG8_WAIT_L(0); PG8_BAR; PG8_MMA(0, 0, At, B0); PG8_MMA(0, 1, At, B1); PG8_BAR; PG8_SCHED;
            PG8_LDA(At, 0, 1); PG8_STAGE(PG8_SB(0, 0), b2, voffB); PG8_STAGE(PG8_SB(0, 1), b2 + hstepB, voffB); PG8_STAGE(PG8_SA(0, 0), a2, voffA);
            PG8_WAIT_V(8); PG8_WAIT_L(0); PG8_BAR; PG8_MMA(1, 0, At, B0); PG8_MMA(1, 1, At, B1); PG8_BAR; PG8_SCHED;
            PG8_LDB(B0, 1, 0); PG8_LDB(B1, 1, 1); PG8_SCHED; PG8_LDA(At, 1, 0); PG8_STAGE(PG8_SA(0, 1), a2 + hstepA, voffA);
            PG8_WAIT_V(8); PG8_WAIT_L(0); PG8_BAR; PG8_MMA(0, 0, At, B0); PG8_MMA(0, 1, At, B1); PG8_BAR; PG8_SCHED;
            PG8_LDA(At, 1, 1); PG8_STAGE(PG8_SB(1, 0), b3, voffB); PG8_STAGE(PG8_SB(1, 1), b3 + hstepB, voffB); PG8_STAGE(PG8_SA(1, 0), a3, voffA);
            PG8_WAIT_V(8); PG8_WAIT_L(0); PG8_BAR; PG8_MMA(1, 0, At, B0); PG8_MMA(1, 1, At, B1); PG8_BAR; PG8_SCHED;
        }
        if (wr == 0) PG8_BAR;
        E(acc, cur, wr, wc, fr, fq, lds);
        if (!has_next) break;
#pragma unroll
        for (int a = 0; a < 2; ++a)
#pragma unroll
            for (int b = 0; b < 2; ++b)
#pragma unroll
                for (int m = 0; m < 4; ++m)
#pragma unroll
                    for (int n = 0; n < 2; ++n) acc[a][b][m][n] = (f32x4){0.f, 0.f, 0.f, 0.f};
        cur = nxt; cA = nA; cB = nB; ++ui;
        if (wr == 1) PG8_BAR;
    }
    PG8_WAIT_V(0);
    PG8_BAR;
#undef PG8_SA
#undef PG8_SB
#undef PG8_STAGE
#undef PG8_LDA
#undef PG8_LDB
#undef PG8_MMA
#undef PG8_WAIT_V
#undef PG8_WAIT_L
#undef PG8_BAR
#undef PG8_SCHED
}

struct MapStd { int coff; __device__ __forceinline__ void operator()(Unit& u) const { u.arow = u.pm * 256; u.brow = u.pn * 256; u.orow = u.pm * 256; u.ocol = coff + u.pn * 256; u.aux = 0; u.bt = 0; } };
struct MapRes { int all;
    __device__ __forceinline__ void operator()(Unit& u) const {
        int b, j; if (all) { b = u.pm / 17; j = u.pm % 17; } else { b = u.pm / 16; j = u.pm % 16 + 1; }
        u.arow = (b * 17 + j) * 256; u.brow = u.pn * 256; u.ocol = u.pn * 256; u.bt = b;
        if (j == 0) { u.aux = 1; u.orow = b * 256; } else { u.aux = 0; u.orow = b * SEQ + (j - 1) * 256; } asm volatile("" : "+s"(u.aux)); } };
struct MapUp { int all;
    __device__ __forceinline__ void operator()(Unit& u) const {
        const int per = all ? 17 : 16, nmain = 16 * per;
        u.brow = u.pn * 256; u.ocol = u.pn * 128;
        if (u.pm >= nmain) { u.aux = 2; u.arow = TAILROW0 + (u.pm - nmain) * 256; u.orow = (u.pm - nmain) * 256; u.bt = 0; return; }
        const int b = u.pm / per, j = all ? u.pm % per : u.pm % per + 1;
        if (j == 0) { u.aux = 1; u.arow = b * U2B; u.orow = b * TB; u.bt = 255; }
        else { const int i = j - 1; u.aux = 0; u.arow = b * U2B + 263 + 254 * i; u.orow = b * TB + NCTX + 254 * i - 1; u.bt = 254; } } };
struct MapZ {
    __device__ __forceinline__ void operator()(Unit& u) const {
        const int b = u.pn / 17, j = u.pn % 17; u.arow = u.pm * 256; u.brow = u.pn * 256; u.orow = b * 256; u.bt = b;
        if (j == 0) { u.aux = 1; u.ocol = u.pm * NCTX; } else { u.aux = 0; u.ocol = u.pm * SEQ + (j - 1) * 256; } } };
struct MapFnetL { __device__ __forceinline__ void operator()(Unit& u) const { const int b = u.pm / 16, mt = u.pm % 16; u.arow = mt * 256; u.brow = b * 256; u.orow = b * TB + NCTX + mt * 256; u.ocol = 768; u.aux = 0; u.bt = b; } };
struct MapFnetC { __device__ __forceinline__ void operator()(Unit& u) const { const int b = u.pm; u.arow = 0; u.brow = b * 256; u.orow = b * TB; u.ocol = 768; u.aux = 0; u.bt = b; } };
}

typedef short v4i16_t __attribute__((ext_vector_type(4)));
__device__ __forceinline__ v4i16_t vtr(const LAS unsigned char* p) { return __builtin_amdgcn_ds_read_tr16_b64_v4i16((LAS v4i16_t*)p); }
#define MX3(a_, b_, c_) __builtin_fmaxf(__builtin_fmaxf((a_), (b_)), (c_))
__device__ __forceinline__ float tile_max(const f32x16& s0, const f32x16& s1) {
    float ma = MX3(s0[0], s0[1], s1[0]), mb = MX3(s0[2], s0[3], s1[1]); ma = MX3(ma, s1[2], s1[3]);
#pragma unroll
    for (int r = 4; r < 16; r += 4) { ma = MX3(ma, s0[r], s0[r + 1]); mb = MX3(mb, s0[r + 2], s0[r + 3]); ma = MX3(ma, s1[r], s1[r + 1]); mb = MX3(mb, s1[r + 2], s1[r + 3]); }
    return __builtin_fmaxf(ma, mb);
}
#undef MX3
__device__ __forceinline__ void band_mask(f32x16& s0, f32x16& s1, int k0pos, int qp, int hi) {
#pragma unroll
    for (int r = 0; r < 16; ++r) { const int kp = k0pos + (r & 3) + 8 * (r >> 2) + 4 * hi; const int d0 = kp - qp, d1 = d0 + 32;
        if (d0 > 128 || d0 < -128) s0[r] = -1e30f; if (d1 > 128 || d1 < -128) s1[r] = -1e30f; }
}
__device__ __forceinline__ void exp4(f32x16& s, int r0, float& acc0, float& acc1) {
    s[r0] = __builtin_amdgcn_exp2f(s[r0]); s[r0 + 1] = __builtin_amdgcn_exp2f(s[r0 + 1]); s[r0 + 2] = __builtin_amdgcn_exp2f(s[r0 + 2]); s[r0 + 3] = __builtin_amdgcn_exp2f(s[r0 + 3]);
    acc0 += s[r0] + s[r0 + 2]; acc1 += s[r0 + 1] + s[r0 + 3];
}
__device__ __forceinline__ bf16x8 pack8(const f32x16& s, int r0) {
    u32x4 w; w.x = cvt_pk_bf16(s[r0], s[r0 + 1]); w.y = cvt_pk_bf16(s[r0 + 2], s[r0 + 3]); w.z = cvt_pk_bf16(s[r0 + 4], s[r0 + 5]); w.w = cvt_pk_bf16(s[r0 + 6], s[r0 + 7]);
    return __builtin_bit_cast(bf16x8, w);
}
__device__ __forceinline__ void pv_slab(const LAS unsigned char* vb, int koff, const bf16x8 pj, f32x16& o0, f32x16& o1) {
    const v4i16_t a0 = vtr(vb + koff), a1 = vtr(vb + koff + 512), b0 = vtr(vb + 8192 + koff), b1 = vtr(vb + 8192 + koff + 512);
    const bf16x8 v0 = {a0[0], a0[1], a0[2], a0[3], a1[0], a1[1], a1[2], a1[3]}, v1 = {b0[0], b0[1], b0[2], b0[3], b1[0], b1[1], b1[2], b1[3]};
    o0 = __builtin_amdgcn_mfma_f32_32x32x16_bf16(v0, pj, o0, 0, 0, 0);
    o1 = __builtin_amdgcn_mfma_f32_32x32x16_bf16(v1, pj, o1, 0, 0, 0);
}

#define ATT_SCHED() __builtin_amdgcn_sched_barrier(0)
template <int DQ, bool WIN>
__device__ __forceinline__ void attn_qk(LAS unsigned char* lds, int kbufoff, int t, const bf16x8 (&qf)[DQ / 16], f32x16& o0, f32x16& o1, float& mrun, float& lsum,
                                        f32x16& sa0, f32x16& sa1, f32x16& sb0, f32x16& sb1, int l31, int hi, int qw) {
    constexpr int NDK = DQ / 16, KST = DQ * 2 + 16;
    const LAS unsigned char* kb = lds + kbufoff + l31 * KST + hi * 16;
    bf16x8 kf[2][4];
#define KLOAD(dst, dk) do { dst[0] = *(const LAS bf16x8*)(kb + (dk) * 32); dst[1] = *(const LAS bf16x8*)(kb + 32 * KST + (dk) * 32); \
                            dst[2] = *(const LAS bf16x8*)(kb + 64 * KST + (dk) * 32); dst[3] = *(const LAS bf16x8*)(kb + 96 * KST + (dk) * 32); } while (0)
    KLOAD(kf[0], 0);
#pragma unroll
    for (int dk = 0; dk < NDK; ++dk) {
        if (dk + 1 < NDK) KLOAD(kf[(dk + 1) & 1], dk + 1);
        ATT_SCHED();
        const bf16x8 (&f)[4] = kf[dk & 1];
        if (dk == 0) { f32x16 z16;
#pragma unroll
                       for (int r = 0; r < 16; ++r) z16[r] = 0.f;
                       sa0 = __builtin_amdgcn_mfma_f32_32x32x16_bf16(f[0], qf[0], z16, 0, 0, 0); sa1 = __builtin_amdgcn_mfma_f32_32x32x16_bf16(f[1], qf[0], z16, 0, 0, 0);
                       sb0 = __builtin_amdgcn_mfma_f32_32x32x16_bf16(f[2], qf[0], z16, 0, 0, 0); sb1 = __builtin_amdgcn_mfma_f32_32x32x16_bf16(f[3], qf[0], z16, 0, 0, 0); }
        else { sa0 = __builtin_amdgcn_mfma_f32_32x32x16_bf16(f[0], qf[dk], sa0, 0, 0, 0); sa1 = __builtin_amdgcn_mfma_f32_32x32x16_bf16(f[1], qf[dk], sa1, 0, 0, 0);
               sb0 = __builtin_amdgcn_mfma_f32_32x32x16_bf16(f[2], qf[dk], sb0, 0, 0, 0); sb1 = __builtin_amdgcn_mfma_f32_32x32x16_bf16(f[3], qf[dk], sb1, 0, 0, 0); }
        ATT_SCHED();
    }
#undef KLOAD
    if (__builtin_expect(__any(mrun != 0.f), 0)) {
#pragma unroll
        for (int r = 0; r < 16; ++r) { sa0[r] -= mrun; sa1[r] -= mrun; sb0[r] -= mrun; sb1[r] -= mrun; }
    }
    if (WIN && t >= 4) { const int qp = qw + l31, k0pos = (t - 4) * 64; band_mask(sa0, sa1, k0pos, qp, hi); band_mask(sb0, sb1, k0pos + 64, qp, hi); }
    float mx = __builtin_fmaxf(tile_max(sa0, sa1), tile_max(sb0, sb1));
    { auto rr = __builtin_amdgcn_permlane32_swap(__float_as_uint(mx), __float_as_uint(mx), false, false); mx = __builtin_fmaxf(__uint_as_float(rr[0]), __uint_as_float(rr[1])); }
    if (__builtin_expect(__any(mx > 8.0f), 0)) {
        const float dl = mx > 8.0f ? mx : 0.f; mrun += dl;
        const float alpha = __builtin_amdgcn_exp2f(-dl); lsum *= alpha;
#pragma unroll
        for (int r = 0; r < 16; ++r) { sa0[r] -= dl; sa1[r] -= dl; sb0[r] -= dl; sb1[r] -= dl; o0[r] *= alpha; o1[r] *= alpha; }
    }
}
#define VLOAD(dst, j) do { dst[0] = vtr(vb + (j) * 1024); dst[1] = vtr(vb + (j) * 1024 + 512); dst[2] = vtr(vb + 8192 + (j) * 1024); dst[3] = vtr(vb + 8192 + (j) * 1024 + 512); } while (0)
#define PVMMA(src, P_) do { const bf16x8 v0_ = {src[0][0], src[0][1], src[0][2], src[0][3], src[1][0], src[1][1], src[1][2], src[1][3]}, v1_ = {src[2][0], src[2][1], src[2][2], src[2][3], src[3][0], src[3][1], src[3][2], src[3][3]}; \
        const bf16x8 p_ = (P_); o0 = __builtin_amdgcn_mfma_f32_32x32x16_bf16(v0_, p_, o0, 0, 0, 0); o1 = __builtin_amdgcn_mfma_f32_32x32x16_bf16(v1_, p_, o1, 0, 0, 0); } while (0)
__device__ __forceinline__ void attn_softmax_pv(const LAS unsigned char* vb, f32x16& sa0, f32x16& sa1, f32x16& sb0, f32x16& sb1, f32x16& o0, f32x16& o1, float& lsum) {
    v4i16_t vf[2][4];
    VLOAD(vf[0], 0);
    float p0 = 0.f, p1 = 0.f, p2 = 0.f, p3 = 0.f;
    exp4(sa0, 0, p0, p1); exp4(sa0, 4, p2, p3); exp4(sa0, 8, p0, p1); exp4(sa0, 12, p2, p3);
    exp4(sa1, 0, p0, p1); exp4(sa1, 4, p2, p3); exp4(sa1, 8, p0, p1); exp4(sa1, 12, p2, p3);
    VLOAD(vf[1], 1); ATT_SCHED(); PVMMA(vf[0], pack8(sa0, 0)); exp4(sb0, 0, p0, p1); exp4(sb0, 4, p2, p3); ATT_SCHED();
    VLOAD(vf[0], 2); ATT_SCHED(); PVMMA(vf[1], pack8(sa0, 8)); exp4(sb0, 8, p0, p1); exp4(sb0, 12, p2, p3); ATT_SCHED();
    VLOAD(vf[1], 3); ATT_SCHED(); PVMMA(vf[0], pack8(sa1, 0)); exp4(sb1, 0, p0, p1); exp4(sb1, 4, p2, p3); ATT_SCHED();
    VLOAD(vf[0], 4); ATT_SCHED(); PVMMA(vf[1], pack8(sa1, 8)); exp4(sb1, 8, p0, p1); exp4(sb1, 12, p2, p3); ATT_SCHED();
    lsum += (p0 + p1) + (p2 + p3);
    VLOAD(vf[1], 5); ATT_SCHED(); PVMMA(vf[0], pack8(sb0, 0)); ATT_SCHED();
    VLOAD(vf[0], 6); ATT_SCHED(); PVMMA(vf[1], pack8(sb0, 8)); ATT_SCHED();
    VLOAD(vf[1], 7); ATT_SCHED(); PVMMA(vf[0], pack8(sb1, 0)); ATT_SCHED();
    PVMMA(vf[1], pack8(sb1, 8));
}
__device__ __forceinline__ void attn_softmax_keep(f32x16& sa0, f32x16& sa1, f32x16& sb0, f32x16& sb1, bf16x8 (&pw)[8], float& lsum) {
    float p0 = 0.f, p1 = 0.f, p2 = 0.f, p3 = 0.f;
    exp4(sa0, 0, p0, p1); exp4(sa0, 4, p2, p3); exp4(sa0, 8, p0, p1); exp4(sa0, 12, p2, p3); pw[0] = pack8(sa0, 0); pw[1] = pack8(sa0, 8);
    exp4(sa1, 0, p0, p1); exp4(sa1, 4, p2, p3); exp4(sa1, 8, p0, p1); exp4(sa1, 12, p2, p3); pw[2] = pack8(sa1, 0); pw[3] = pack8(sa1, 8);
    exp4(sb0, 0, p0, p1); exp4(sb0, 4, p2, p3); exp4(sb0, 8, p0, p1); exp4(sb0, 12, p2, p3); pw[4] = pack8(sb0, 0); pw[5] = pack8(sb0, 8);
    exp4(sb1, 0, p0, p1); exp4(sb1, 4, p2, p3); exp4(sb1, 8, p0, p1); exp4(sb1, 12, p2, p3); pw[6] = pack8(sb1, 0); pw[7] = pack8(sb1, 8);
    lsum += (p0 + p1) + (p2 + p3);
}
__device__ __forceinline__ void attn_pv_all(const LAS unsigned char* vb, const bf16x8 (&pw)[8], f32x16& o0, f32x16& o1) {
    v4i16_t vf[2][4];
    VLOAD(vf[0], 0);
    VLOAD(vf[1], 1); ATT_SCHED(); PVMMA(vf[0], pw[0]); ATT_SCHED();
    VLOAD(vf[0], 2); ATT_SCHED(); PVMMA(vf[1], pw[1]); ATT_SCHED();
    VLOAD(vf[1], 3); ATT_SCHED(); PVMMA(vf[0], pw[2]); ATT_SCHED();
    VLOAD(vf[0], 4); ATT_SCHED(); PVMMA(vf[1], pw[3]); ATT_SCHED();
    VLOAD(vf[1], 5); ATT_SCHED(); PVMMA(vf[0], pw[4]); ATT_SCHED();
    VLOAD(vf[0], 6); ATT_SCHED(); PVMMA(vf[1], pw[5]); ATT_SCHED();
    VLOAD(vf[1], 7); ATT_SCHED(); PVMMA(vf[0], pw[6]); ATT_SCHED();
    PVMMA(vf[1], pw[7]);
}
#undef VLOAD
#undef PVMMA
#undef ATT_SCHED

template <int DQ, bool WIN, int MODE = 0>
__device__ __forceinline__ void attn_unit(LAS unsigned char* lds, const bf16_t* Qp, int ldq, const bf16_t* Kp, int ldk, const bf16_t* Vp, int ldv, bf16_t* Op,
                                          int n1, int s2, int e2, int q0pos, float m_init, bool has_sink, const float* qgain = nullptr, const f32x2v* ropeT = nullptr, bool qrope = false) {
    constexpr int NDK = DQ / 16, CH = DQ / 8, NKC = DQ / 32, KST = DQ * 2 + 16, KBUF = 128 * KST, VBUF = 16384, VOFF = 2 * KBUF;
    int tid = threadIdx.x; asm volatile("" : "+v"(tid));
    const int lane = tid & 63, wid = __builtin_amdgcn_readfirstlane(tid >> 6), l31 = lane & 31, hi = lane >> 5;
    const bool late = wid >= 4;
    bf16x8 qf[NDK];
    { const bf16_t* qrow = Qp + (size_t)(32 * wid + l31) * ldq + 8 * hi;
#pragma unroll
      for (int dk = 0; dk < NDK; ++dk) qf[dk] = *(const bf16x8*)(qrow + 16 * dk); }
    if (DQ == 64 && qgain != nullptr) {
        float y[4][8]; float ss = 0.f;
#pragma unroll
        for (int dk = 0; dk < 4; ++dk) { const u32x4 w = __builtin_bit_cast(u32x4, qf[dk < NDK ? dk : 0]);
#pragma unroll
            for (int i = 0; i < 4; ++i) { y[dk][2 * i] = bflo(w[i]); y[dk][2 * i + 1] = bfhi(w[i]); ss += y[dk][2 * i] * y[dk][2 * i] + y[dk][2 * i + 1] * y[dk][2 * i + 1]; } }
        ss += __shfl_xor(ss, 32);
        const float rn = rsqrtf(ss * (1.0f / 64.0f) + EPS);
#pragma unroll
        for (int dk = 0; dk < 4; ++dk)
#pragma unroll
            for (int e = 0; e < 8; ++e) y[dk][e] *= rn * qgain[16 * dk + 8 * hi + e];
        if (qrope) { const int pos = q0pos + 32 * wid + l31;
#pragma unroll
            for (int dk = 0; dk < 2; ++dk)
#pragma unroll
                for (int e = 0; e < 8; ++e) { const f32x2v t = ropeT[pos * 32 + 16 * dk + 8 * hi + e]; const float x1 = y[dk][e], x2 = y[dk + 2][e]; y[dk][e] = x1 * t.x - x2 * t.y; y[dk + 2][e] = x1 * t.y + x2 * t.x; } }
        const float QS_ = 0.125f * LOG2E;
#pragma unroll
        for (int dk = 0; dk < 4; ++dk) { u32x4 w;
#pragma unroll
            for (int i = 0; i < 4; ++i) w[i] = cvt_pk_bf16(y[dk][2 * i] * QS_, y[dk][2 * i + 1] * QS_);
            if (dk < NDK) qf[dk] = __builtin_bit_cast(bf16x8, w); }
    }
    f32x16 o0, o1;
#pragma unroll
    for (int r = 0; r < 16; ++r) { o0[r] = 0.f; o1[r] = 0.f; }
    float mrun = 0.f, lsum = (has_sink && hi == 0) ? __builtin_amdgcn_exp2f(m_init) : 0.f;
    const int qw = q0pos + 32 * wid;
    const int vlane = (4 * hi + ((lane & 15) >> 2)) * 64 + ((lane >> 4) & 1) * 32 + (lane & 3) * 8;
    u32x4 kr[NKC], vr[2];
#define ATT_TILE(i_) ((i_) < n1 ? (i_) : s2 + ((i_) - n1))
#define ATT_LOAD(t) do { const bf16_t* kp_ = Kp + (size_t)(t) * 64 * ldk; const bf16_t* vp_ = Vp + (size_t)(t) * 64 * ldv; \
        _Pragma("unroll") for (int m_ = 0; m_ < NKC; ++m_) { const int c_ = tid + 512 * m_; kr[m_] = *(const GAS u32x4*)(kp_ + (size_t)(c_ / CH) * ldk + (c_ % CH) * 8); } \
        _Pragma("unroll") for (int m_ = 0; m_ < 2; ++m_) { const int c_ = tid + 512 * m_; vr[m_] = *(const GAS u32x4*)(vp_ + (size_t)(c_ >> 3) * ldv + (c_ & 7) * 8); } } while (0)
#define ATT_STORE(kb_, vb_) do { \
        _Pragma("unroll") for (int m_ = 0; m_ < NKC; ++m_) { const int c_ = tid + 512 * m_; *(LAS u32x4*)(lds + (kb_) * KBUF + (c_ / CH) * KST + (c_ % CH) * 16) = kr[m_]; } \
        _Pragma("unroll") for (int m_ = 0; m_ < 2; ++m_) { const int c_ = tid + 512 * m_; *(LAS u32x4*)(lds + VOFF + (vb_) * VBUF + ((c_ & 7) >> 2) * 8192 + (c_ >> 3) * 64 + (c_ & 3) * 16) = vr[m_]; } } while (0)
#define ATT_BAR() asm volatile("s_waitcnt lgkmcnt(0)\n\ts_barrier" ::: "memory")
    const int nst = (n1 + (e2 - s2)) >> 1;
    ATT_LOAD(0); ATT_STORE(0, 0);
    ATT_BAR();
    if (!late) {
        int vcur = 0;
        for (int I = 0; I < nst; ++I) {
            const int t = ATT_TILE(2 * I);
            if (I + 1 < nst) { const int tn = ATT_TILE(2 * I + 2); ATT_LOAD(tn); }
            bool active = true; if (WIN && t >= 4) { const int k0 = (t - 4) * 64; active = (k0 + 127 >= qw - 128) && (k0 <= qw + 31 + 128); }
            const int vnext = vcur == 2 ? 0 : vcur + 1;
            if (active) { f32x16 sa0, sa1, sb0, sb1;
                attn_qk<DQ, WIN>(lds, (I & 1) * KBUF, t, qf, o0, o1, mrun, lsum, sa0, sa1, sb0, sb1, l31, hi, qw);
                attn_softmax_pv(lds + VOFF + vcur * VBUF + vlane, sa0, sa1, sb0, sb1, o0, o1, lsum); }
            if (I + 1 < nst) ATT_STORE((I + 1) & 1, vnext);
            vcur = vnext;
            ATT_BAR();
        }
    } else {
        bf16x8 pw[8]; bool havep = false; int pvoff = 0;
        int vcur = 0;
        for (int I = 0; I < nst; ++I) {
            const int t = ATT_TILE(2 * I);
            if (I + 1 < nst) { const int tn = ATT_TILE(2 * I + 2); ATT_LOAD(tn); }
            bool active = true; if (WIN && t >= 4) { const int k0 = (t - 4) * 64; active = (k0 + 127 >= qw - 128) && (k0 <= qw + 31 + 128); }
            const int vnext = vcur == 2 ? 0 : vcur + 1;
            if (havep) attn_pv_all(lds + VOFF + pvoff + vlane, pw, o0, o1);
            havep = false;
            if (active) { f32x16 sa0, sa1, sb0, sb1;
                attn_qk<DQ, WIN>(lds, (I & 1) * KBUF, t, qf, o0, o1, mrun, lsum, sa0, sa1, sb0, sb1, l31, hi, qw);
                attn_softmax_keep(sa0, sa1, sb0, sb1, pw, lsum); havep = true; pvoff = vcur * VBUF; }
            if (I + 1 < nst) ATT_STORE((I + 1) & 1, vnext);
            vcur = vnext;
            ATT_BAR();
        }
        if (havep) attn_pv_all(lds + VOFF + pvoff + vlane, pw, o0, o1);
    }
    ATT_BAR();
#undef ATT_TILE
#undef ATT_LOAD
#undef ATT_STORE
#undef ATT_BAR
    const float lt = lsum + __shfl_xor(lsum, 32), inv = 1.0f / lt;
    bf16_t* orow = Op + (size_t)(32 * wid + l31) * DM + 4 * hi;
#pragma unroll
    for (int g = 0; g < 4; ++g) {
        u32x2 w0, w1;
        w0.x = cvt_pk_bf16(o0[4 * g] * inv, o0[4 * g + 1] * inv); w0.y = cvt_pk_bf16(o0[4 * g + 2] * inv, o0[4 * g + 3] * inv);
        w1.x = cvt_pk_bf16(o1[4 * g] * inv, o1[4 * g + 1] * inv); w1.y = cvt_pk_bf16(o1[4 * g + 2] * inv, o1[4 * g + 3] * inv);
        *(u32x2*)(orow + 8 * g) = w0; *(u32x2*)(orow + 32 + 8 * g) = w1;
    }
}

struct Args { const float* in[28]; float* out; unsigned char* ws; int lo, hi; };
typedef const GAS float* cfp_t;
struct Ctx { const __attribute__((address_space(4))) cfp_t* in; float* out; unsigned char* ws;
    __device__ __forceinline__ const float* inp(int i) const { return (const float*)in[i]; } };
enum { I_X = 0, I_C, I_CTX, I_CCTX, I_MODW, I_MODB, I_N1G, I_N2G, I_MLAWIN, I_CQG, I_CKVG, I_WUQ, I_WUKV, I_QG, I_KG, I_FNETW, I_EWOUT,
       I_WINWIN, I_WQG, I_WKG, I_SINK, I_POOLW, I_POOLS, I_OWOUT, I_FFNUP, I_CONVW, I_CONVB, I_FFNDN };

__device__ __forceinline__ void tr_item(const float* W, int K, int Nsrc, bf16_t* WT, int nblk, int item, LAS float* scr, int lane, int mode, const float* ksc) {
    const int kb = item / nblk, nb = item % nblk, k0 = 64 * kb, n0 = 32 * nb;
    int s0 = n0;
    if (mode == 1) s0 = n0 < 672 ? n0 : -1;
    else if (mode == 2) { const int hd = n0 >> 7, d0 = n0 & 127; s0 = d0 < 96 ? hd * 96 + d0 : -1; }
    else if (mode == 3) { const int pn = n0 >> 8, bj = (n0 >> 7) & 1, c = n0 & 127; s0 = bj * DFF + pn * 128 + c; }
#pragma unroll 16
    for (int i = 0; i < 32; ++i) { const int kk = 2 * i + (lane >> 5); float v = 0.f;
        if (s0 >= 0) { v = W[(size_t)(k0 + kk) * Nsrc + s0 + (lane & 31)]; if (ksc) v *= ksc[k0 + kk]; }
        scr[kk * 33 + (lane & 31)] = v; }
    asm volatile("s_waitcnt lgkmcnt(0)" ::: "memory");
    const int c = lane & 7;
#pragma unroll
    for (int j = 0; j < 4; ++j) { const int n = (lane >> 3) + 8 * j; const LAS float* s = scr + (8 * c) * 33 + n;
        u32x4 o; o.x = cvt_pk_bf16(s[0 * 33], s[1 * 33]); o.y = cvt_pk_bf16(s[2 * 33], s[3 * 33]); o.z = cvt_pk_bf16(s[4 * 33], s[5 * 33]); o.w = cvt_pk_bf16(s[6 * 33], s[7 * 33]);
        *(u32x4*)(WT + (size_t)(n0 + n) * K + k0 + 8 * c) = o; }
    asm volatile("s_waitcnt lgkmcnt(0)" ::: "memory");
}
__device__ __forceinline__ void tr_job(const float* W, int K, int Nsrc, bf16_t* WT, int Nout, int mode, const float* ksc, LAS float* scr, int gw, int ngw, int lane) {
    const int nblk = Nout / 32, nitems = (K / 64) * nblk;
    for (int it = gw; it < nitems; it += ngw) tr_item(W, K, Nsrc, WT, nblk, it, scr, lane, mode, ksc);
}
__device__ __forceinline__ void ffn_weights(const Ctx& a, int layer, LAS float* scr, int gw, int ngw, int lane) {
    tr_job(a.inp(I_FFNUP) + (size_t)layer * DM * 2 * DFF, DM, 2 * DFF, (bf16_t*)(a.ws + WS_WUP), 2 * DFF, 3, nullptr, scr, gw, ngw, lane);
    tr_job(a.inp(I_FFNDN) + (size_t)layer * DFF * DM, DFF, DM, (bf16_t*)(a.ws + ((layer & 1) ? WS_WDN2 : WS_WDN)), DM, 0, nullptr, scr, gw, ngw, lane);
}

__device__ __forceinline__ void mods_item(const Ctx& a, int item, LAS float* sl) {
    int tid = threadIdx.x; asm volatile("" : "+v"(tid)); const int l = item / 48, nb = item % 48;
    LAS float* red = sl + 17 * 1024;
    for (int idx = tid; idx < 17 * 1024; idx += 512) { const int r = idx >> 10, k = idx & 1023; const float v = r < 16 ? a.inp(I_C)[r * 1024 + k] : a.inp(I_CCTX)[k]; sl[idx] = v / (1.0f + __expf(-v)); }
    __syncthreads();
    const int cn = tid & 127, ks = tid >> 7, n = 128 * nb + cn;
    float acc[17];
#pragma unroll
    for (int r = 0; r < 17; ++r) acc[r] = 0.f;
    const float* wp = a.inp(I_MODW) + ((size_t)l * 1024 + 256 * ks) * 6144 + n;
#pragma unroll 4
    for (int k = 0; k < 256; k += 4) {
        const float w0 = wp[(size_t)(k + 0) * 6144], w1 = wp[(size_t)(k + 1) * 6144], w2 = wp[(size_t)(k + 2) * 6144], w3 = wp[(size_t)(k + 3) * 6144];
#pragma unroll
        for (int r = 0; r < 17; ++r) { const f32x4 s4 = *(const LAS f32x4*)(sl + r * 1024 + 256 * ks + k); acc[r] += s4[0] * w0 + s4[1] * w1 + s4[2] * w2 + s4[3] * w3; }
    }
#pragma unroll
    for (int r = 0; r < 17; ++r) red[(ks * 17 + r) * 128 + cn] = acc[r];
    __syncthreads();
    float* mods = (float*)(a.ws + WS_MODS);
    for (int idx = tid; idx < 17 * 128; idx += 512) { const int r = idx >> 7, c2 = idx & 127;
        const float s = red[(0 * 17 + r) * 128 + c2] + red[(1 * 17 + r) * 128 + c2] + red[(2 * 17 + r) * 128 + c2] + red[(3 * 17 + r) * 128 + c2];
        mods[((size_t)l * 17 + r) * 6144 + 128 * nb + c2] = s + a.inp(I_MODB)[l * 6144 + 128 * nb + c2]; }
    __syncthreads();
}

__device__ __forceinline__ void norm_pass(const float* xsrc, const float* csrc, const float* g, const float* mods_l, int shift_idx, int scale_idx,
                                          bf16_t* U, bool ffn_layout, bool skip_ctx, int gw, int ngw, int lane) {
    for (int R0 = gw; R0 < T; R0 += 2 * ngw) {
        f32x4 v[2][4]; bool ok[2]; int bb[2], pp[2];
#pragma unroll
        for (int s = 0; s < 2; ++s) { const int R = R0 + s * ngw; const int b = R / TB, p = R % TB; const bool isctx = p < NCTX; bb[s] = b; pp[s] = p;
            ok[s] = (R < T) && !(isctx && skip_ctx);
            const float* src = isctx ? csrc + (size_t)(b * NCTX + p) * DM : xsrc + (size_t)(b * SEQ + p - NCTX) * DM;
            if (ok[s]) {
#pragma unroll
                for (int j = 0; j < 4; ++j) v[s][j] = *(const f32x4*)(src + (lane + 64 * j) * 4); } }
#pragma unroll
        for (int s = 0; s < 2; ++s) if (ok[s]) {
            const int R = R0 + s * ngw, b = bb[s], p = pp[s]; const bool isctx = p < NCTX;
            const float* mrow = mods_l + (size_t)(isctx ? 16 : b) * 6144;
            float ss = 0.f;
#pragma unroll
            for (int j = 0; j < 4; ++j) ss += (v[s][j][0] * v[s][j][0] + v[s][j][1] * v[s][j][1]) + (v[s][j][2] * v[s][j][2] + v[s][j][3] * v[s][j][3]);
            const float rs = rsqrtf(wave_sum(ss) * (1.0f / DM) + EPS);
            const size_t orow = ffn_layout ? (size_t)b * U2B + (isctx ? p : 264 + p - NCTX) : (size_t)R;
#pragma unroll
            for (int j = 0; j < 4; ++j) { const int c4 = (lane + 64 * j) * 4;
                const f32x4 gg = *(const f32x4*)(g + c4), sh = *(const f32x4*)(mrow + shift_idx * 1024 + c4), sc = *(const f32x4*)(mrow + scale_idx * 1024 + c4);
                const f32x4 y = v[s][j] * rs * gg * (sc + 1.0f) + sh;
                u32x2 w; w.x = cvt_pk_bf16(y[0], y[1]); w.y = cvt_pk_bf16(y[2], y[3]);
                *(u32x2*)(U + orow * DM + c4) = w;
                if (ffn_layout && !isctx && p - NCTX >= SEQ - 33) *(u32x2*)(U + ((size_t)TAILROW0 + (b / 7) * 256 + (b % 7) * TAILSEG + (p - NCTX - (SEQ - 33))) * DM + c4) = w; }
        }
    }
    if (ffn_layout && gw >= 32 && gw < 48) {
        const int tb_ = gw - 32; const size_t orow = (size_t)TAILROW0 + (tb_ / 7) * 256 + (tb_ % 7) * TAILSEG + 33;
#pragma unroll
        for (int j = 0; j < 4; ++j) *(u32x2*)(U + orow * DM + (lane + 64 * j) * 4) = (u32x2){0u, 0u};
    }
    if (ffn_layout && gw < 32) {
        const int b = gw >> 1; const size_t orow = (size_t)b * U2B + ((gw & 1) ? 264 + SEQ : 263);
#pragma unroll
        for (int j = 0; j < 4; ++j) *(u32x2*)(U + orow * DM + (lane + 64 * j) * 4) = (u32x2){0u, 0u};
    }
}

template <int NF> __device__ __forceinline__ void rope_cs(int pos, int i, float& cs, float& sn) {
    const int row = pos >> 6, col = pos & 63; const int f = i < NF ? i : i - NF;
    const float inv = exp2f(-(float)f * (13.287712379549449f / NF));
    const float ang = (float)(i < NF ? row : col) * inv;
    sincosf(ang, &sn, &cs);
}

__device__ __forceinline__ void unpack8(const u32x4 v, float (&x)[8]) {
#pragma unroll
    for (int i = 0; i < 4; ++i) { x[2 * i] = bflo(v[i]); x[2 * i + 1] = bfhi(v[i]); }
}
__device__ __forceinline__ u32x4 pack8f(const float (&x)[8]) { u32x4 o; o.x = cvt_pk_bf16(x[0], x[1]); o.y = cvt_pk_bf16(x[2], x[3]); o.z = cvt_pk_bf16(x[4], x[5]); o.w = cvt_pk_bf16(x[6], x[7]); return o; }

__device__ __forceinline__ void ew_even(const Ctx& a, int j, int gw, int ngw, int lane) {
    const bf16_t* H = (const bf16_t*)(a.ws + WS_H); bf16_t* Qb = (bf16_t*)(a.ws + WS_Q); bf16_t* KVb = (bf16_t*)(a.ws + WS_KV); bf16_t* Kout = (bf16_t*)(a.ws + WS_U);
    const float QS = 0.10206207261596577f * LOG2E;
    const f32x2v* ropeT = (const f32x2v*)(a.ws + WS_ROPE_E);
    const int g16 = lane >> 4, c16 = lane & 15; const bool act = c16 < 12; const int cc = act ? c16 : 0;
    float qg[8], kg[8];
#pragma unroll
    for (int e = 0; e < 8; ++e) { qg[e] = a.inp(I_QG)[j * 96 + 8 * cc + e]; kg[e] = a.inp(I_KG)[j * 96 + 8 * cc + e]; }
    for (int R = gw; R < T; R += ngw) {
        const int p = R % TB; const int pos = p - NCTX; const bool lat = pos >= 0;
        const bf16_t* hrow = H + (size_t)R * 768; bf16_t* qrow = Qb + (size_t)R * 1536; bf16_t* kvrow = KVb + (size_t)R * 1536;
        const u32x4 z4 = {0u, 0u, 0u, 0u};
        u32x4 hv = z4; if (lane < 48) hv = *(const u32x4*)(hrow + 8 * lane);
        u32x4 qv[3], kv[3], vv[2];
#pragma unroll
        for (int rd = 0; rd < 3; ++rd) { const int hd = 4 * rd + g16; qv[rd] = z4; kv[rd] = z4;
            if (act) { qv[rd] = *(const u32x4*)(qrow + hd * 128 + 8 * c16); kv[rd] = c16 < 8 ? *(const u32x4*)(kvrow + hd * 128 + 8 * c16) : *(const u32x4*)(hrow + 384 + 8 * (c16 - 8)); } }
        vv[0] = *(const u32x4*)(kvrow + (lane >> 3) * 128 + 64 + 8 * (lane & 7)); vv[1] = z4;
        if (lane < 32) vv[1] = *(const u32x4*)(kvrow + ((lane + 64) >> 3) * 128 + 64 + 8 * (lane & 7));
        float cs[8], sn[8];
#pragma unroll
        for (int e = 0; e < 8; ++e) { cs[e] = 1.f; sn[e] = 0.f; }
        if (lat && c16 >= 8 && act) {
#pragma unroll
            for (int e = 0; e < 8; ++e) { const f32x2v t = ropeT[pos * 16 + 8 * (c16 & 1) + e]; cs[e] = t.x; sn[e] = t.y; } }
        float x[8]; unpack8(hv, x); float ss = 0.f;
#pragma unroll
        for (int e = 0; e < 8; ++e) ss += x[e] * x[e];
        ss = half_sum(ss);
        const float r_q = rsqrtf(__shfl(ss, 0) * (1.0f / 256.0f) + EPS), r_kv = rsqrtf(__shfl(ss, 32) * (1.0f / 128.0f) + EPS);
#pragma unroll
        for (int rd = 0; rd < 3; ++rd) {
            const int hd = 4 * rd + g16;
            { float y[8], o[8]; unpack8(qv[rd], y); float s2 = 0.f;
#pragma unroll
              for (int e = 0; e < 8; ++e) { y[e] *= r_q; s2 += y[e] * y[e]; }
              s2 += __shfl_xor(s2, 8); s2 += __shfl_xor(s2, 4); s2 += __shfl_xor(s2, 2); s2 += __shfl_xor(s2, 1);
              const float sc = rsqrtf(s2 * (1.0f / 96.0f) + EPS);
#pragma unroll
              for (int e = 0; e < 8; ++e) { y[e] *= sc * qg[e]; o[e] = __shfl_xor(y[e], 2); }
              if (c16 >= 8) {
#pragma unroll
                  for (int e = 0; e < 8; ++e) y[e] = c16 < 10 ? y[e] * cs[e] - o[e] * sn[e] : o[e] * sn[e] + y[e] * cs[e]; }
#pragma unroll
              for (int e = 0; e < 8; ++e) y[e] *= QS;
              if (act) *(u32x4*)(qrow + hd * 128 + 8 * c16) = pack8f(y); }
            { float y[8], o[8]; unpack8(kv[rd], y); float s2 = 0.f; const float pre = c16 < 8 ? r_kv : 1.0f;
#pragma unroll
              for (int e = 0; e < 8; ++e) { y[e] *= pre; s2 += y[e] * y[e]; }
              s2 += __shfl_xor(s2, 8); s2 += __shfl_xor(s2, 4); s2 += __shfl_xor(s2, 2); s2 += __shfl_xor(s2, 1);
              const float sc = rsqrtf(s2 * (1.0f / 96.0f) + EPS);
#pragma unroll
              for (int e = 0; e < 8; ++e) { y[e] *= sc * kg[e]; o[e] = __shfl_xor(y[e], 2); }
              if (c16 >= 8) {
#pragma unroll
                  for (int e = 0; e < 8; ++e) y[e] = c16 < 10 ? y[e] * cs[e] - o[e] * sn[e] : o[e] * sn[e] + y[e] * cs[e]; }
              if (act) *(u32x4*)(Kout + (size_t)R * 1152 + hd * 96 + 8 * c16) = pack8f(y); }
        }
        { float y[8]; unpack8(vv[0], y);
#pragma unroll
          for (int e = 0; e < 8; ++e) y[e] *= r_kv;
          *(u32x4*)(kvrow + (lane >> 3) * 128 + 64 + 8 * (lane & 7)) = pack8f(y);
          if (lane < 32) { unpack8(vv[1], y);
#pragma unroll
              for (int e = 0; e < 8; ++e) y[e] *= r_kv;
              *(u32x4*)(kvrow + ((lane + 64) >> 3) * 128 + 64 + 8 * (lane & 7)) = pack8f(y); } }
    }
}

__device__ __forceinline__ void ew_odd(const Ctx& a, int j, int gw, int ngw, int lane) {
    bf16_t* H = (bf16_t*)(a.ws + WS_H); bf16_t* PO = (bf16_t*)(a.ws + WS_POOL);
    const float QS = 0.125f * LOG2E;
    const f32x2v* ropeT = (const f32x2v*)(a.ws + WS_ROPE_O);
    const int c8 = lane & 7, hl = lane >> 3;
    float qg[8], kg[8];
#pragma unroll
    for (int e = 0; e < 8; ++e) { qg[e] = a.inp(I_WQG)[j * 64 + 8 * c8 + e]; kg[e] = a.inp(I_WKG)[j * 64 + 8 * c8 + e]; }
    for (int R = gw; R < T; R += ngw) {
        const int p = R % TB; const int pos = p - NCTX; const bool lat = pos >= 0;
        bf16_t* hrow = H + (size_t)R * 1536;
        u32x4 qk[2]; qk[1] = (u32x4){0u, 0u, 0u, 0u}; if (lane >= 32) qk[1] = *(const u32x4*)(hrow + 512 + 8 * lane);
        float cs[8], sn[8];
#pragma unroll
        for (int e = 0; e < 8; ++e) { cs[e] = 1.f; sn[e] = 0.f; }
        if (lat) {
#pragma unroll
            for (int e = 0; e < 8; ++e) { const f32x2v t = ropeT[pos * 32 + 8 * (c8 & 3) + e]; cs[e] = t.x; sn[e] = t.y; } }
        const int tpos = lat ? pos : p, Ls = lat ? SEQ : NCTX;
        { const int pc = lane & 31, g = pc >> 3, half = 1 << g;
          const int lo = tpos - half < 0 ? 0 : tpos - half, hi = tpos + half > Ls ? Ls : tpos + half;
          float sum[8];
#pragma unroll
          for (int e = 0; e < 8; ++e) sum[e] = 0.f;
          if (lane < 32) {
              for (int tt = lo; tt < hi; ++tt) { float z[8]; unpack8(*(const u32x4*)(hrow + (ptrdiff_t)(tt - tpos) * 1536 + 1280 + 8 * pc), z);
#pragma unroll
                  for (int e = 0; e < 8; ++e) sum[e] += z[e]; }
              const float rc = 1.0f / (float)(hi - lo); float z[8]; unpack8(*(const u32x4*)(hrow + 1280 + 8 * pc), z);
#pragma unroll
              for (int e = 0; e < 8; ++e) sum[e] = sum[e] * rc - z[e];
              *(u32x4*)(PO + (size_t)R * 256 + 8 * pc) = pack8f(sum); } }
        if (lane >= 32) {
            float y[8], o[8]; unpack8(qk[1], y); float s2 = 0.f;
#pragma unroll
            for (int e = 0; e < 8; ++e) s2 += y[e] * y[e];
            s2 += __shfl_xor(s2, 4); s2 += __shfl_xor(s2, 2); s2 += __shfl_xor(s2, 1);
            const float sc = rsqrtf(s2 * (1.0f / 64.0f) + EPS);
#pragma unroll
            for (int e = 0; e < 8; ++e) { y[e] *= sc * kg[e]; o[e] = __shfl_xor(y[e], 4); }
#pragma unroll
            for (int e = 0; e < 8; ++e) y[e] = c8 < 4 ? y[e] * cs[e] - o[e] * sn[e] : o[e] * sn[e] + y[e] * cs[e];
            *(u32x4*)(hrow + 512 + 8 * lane) = pack8f(y);
        }
    }
}

#define XB_TMO      128
#define XB_XCNT(j)  (256  + 64 * (j))
#define XB_XSUB(j)  (1280 + 64 * (j))
#define XB_XGEN(j)  (2304 + 64 * (j))
#define XB_TOP      3328
#define XB_TOPGEN   3392
#define XCD_BAR_WORDS 3456
#define XB_SPIN_CAP (1u << 18)
__device__ __forceinline__ unsigned xb_ld(unsigned* p)              { return __hip_atomic_load(p, __ATOMIC_RELAXED, __HIP_MEMORY_SCOPE_AGENT); }
__device__ __forceinline__ unsigned xb_add(unsigned* p, unsigned v) { return __hip_atomic_fetch_add(p, v, __ATOMIC_RELAXED, __HIP_MEMORY_SCOPE_AGENT); }
__device__ __forceinline__ unsigned xb_xcc_id() { return (unsigned)__builtin_amdgcn_s_getreg((3 << 11) | 20) & 0xFu; }
#define XB_SPIN(cond, bar) do { unsigned _sp = 0; while (cond) { __builtin_amdgcn_s_sleep(1); \
    if ((++_sp & 255u) == 0u) { if (xb_ld(&(bar)[XB_TMO])) break; if (_sp > XB_SPIN_CAP) { atomicAdd(&(bar)[XB_TMO], 1u); break; } } } } while (0)
struct XcdBarrier { unsigned* bar; unsigned x; volatile LAS unsigned* st; };
__device__ __forceinline__ XcdBarrier xcd_barrier_post(unsigned* bar, volatile LAS unsigned* st) {
    XcdBarrier b; b.bar = bar; b.x = xb_xcc_id(); b.st = st;
    int tid_ = threadIdx.x; asm volatile("" : "+v"(tid_));
    if (tid_ == 0) (void)xb_add(&bar[XB_XCNT(b.x)], 1u);
    return b;
}
__device__ __forceinline__ void xcd_barrier_complete(unsigned* bar, unsigned x, unsigned& nloc, unsigned& nx) {
    const unsigned G = gridDim.x * gridDim.y * gridDim.z;
    unsigned sum, cnt, mine, sp = 0u;
    for (;;) {
        sum = 0u; cnt = 0u; mine = 0u;
#pragma unroll
        for (unsigned j = 0; j < 16; ++j) { const unsigned c = xb_ld(&bar[XB_XCNT(j)]); sum += c; cnt += (c > 0u) ? 1u : 0u; mine = (j == x) ? c : mine; }
        if (sum == G) break;
        __builtin_amdgcn_s_sleep(1);
        if ((++sp & 255u) == 0u) { if (xb_ld(&bar[XB_TMO])) break; if (sp > XB_SPIN_CAP) { atomicAdd(&bar[XB_TMO], 1u); break; } }
    }
    nloc = mine > 0u ? mine : 1u; nx = cnt > 0u ? cnt : 1u;
}
__device__ __forceinline__ void xcd_barrier(const XcdBarrier& b) {
    asm volatile("s_waitcnt vmcnt(0)" ::: "memory");
    __syncthreads();
    int tid_ = threadIdx.x; asm volatile("" : "+v"(tid_));
    if (tid_ == 0) {
        unsigned* bar = b.bar;
        __builtin_amdgcn_s_waitcnt(0);
        unsigned nloc = b.st[0], nx = b.st[1];
        if (nloc == 0u) { xcd_barrier_complete(bar, b.x, nloc, nx); b.st[0] = nloc; b.st[1] = nx; }
        const unsigned old = xb_add(&bar[XB_XSUB(b.x)], 1u);
        const unsigned gen = old / nloc;
        if (old + 1u == (gen + 1u) * nloc) {
            __builtin_amdgcn_fence(__ATOMIC_RELEASE, "agent");
            asm volatile("s_waitcnt vmcnt(0)" ::: "memory");
            const unsigned og = xb_add(&bar[XB_TOP], 1u);
            const unsigned tg = og / nx;
            if (og + 1u == (tg + 1u) * nx) xb_add(&bar[XB_TOPGEN], 1u);
            else XB_SPIN(xb_ld(&bar[XB_TOPGEN]) == tg, bar);
            __builtin_amdgcn_fence(__ATOMIC_ACQUIRE, "agent");
            xb_add(&bar[XB_XGEN(b.x)], 1u);
            asm volatile("s_waitcnt vmcnt(0)" ::: "memory");
        } else {
            XB_SPIN(xb_ld(&bar[XB_XGEN(b.x)]) == gen, bar);
            __builtin_amdgcn_fence(__ATOMIC_ACQUIRE, "agent");
            asm volatile("s_waitcnt vmcnt(0)" ::: "memory");
        }
    }
    __syncthreads();
}

constexpr int LDS_BYTES = 147456;
constexpr int NPHASES = 1 + 2 * 9 + 2 * 8;

__global__ void __launch_bounds__(512, 2) mega_fwd(Args ka) {
    extern __shared__ __attribute__((aligned(16))) unsigned char lds_raw[];
    LAS unsigned char* lds = (LAS unsigned char*)lds_raw;
    cg::grid_group grid = cg::this_grid();
    volatile LAS unsigned* xbst = (volatile LAS unsigned*)(lds + 139264);
    { int tid_ = threadIdx.x; asm volatile("" : "+v"(tid_)); if (tid_ < 2) xbst[tid_] = 0u; }
    __syncthreads();
    XcdBarrier xbar; xbar.bar = (unsigned*)ka.ws; xbar.x = 0; xbar.st = xbst;
    if (ka.hi - ka.lo > 1) xbar = xcd_barrier_post((unsigned*)ka.ws, xbst);
#define U ((bf16_t*)(wsl + WS_U))
#define MIX ((bf16_t*)(wsl + WS_MIX))
#define Hb ((bf16_t*)(wsl + WS_H))
#define Qb ((bf16_t*)(wsl + WS_Q))
#define KVb ((bf16_t*)(wsl + WS_KV))
#define ZL ((bf16_t*)(wsl + WS_ZL))
#define ZC ((bf16_t*)(wsl + WS_ZC))
#define HID ((bf16_t*)(wsl + WS_HID))
#define POOL ((bf16_t*)(wsl + WS_POOL))
#define DFTL ((bf16_t*)(wsl + WS_DFTL))
#define DFTC ((bf16_t*)(wsl + WS_DFTC))
#define hctx ((float*)(wsl + WS_HCTX))
    int ph = 0, layer_ = 0;
#define PHASE_BEGIN if (ph >= ka.lo && ph < ka.hi) { GAS unsigned char* wsg_ = (GAS unsigned char*)ka.ws; asm volatile("" : "+s"(wsg_)); unsigned char* wsl = (unsigned char*)wsg_; \
        const __attribute__((address_space(4))) cfp_t* ain_ = (const __attribute__((address_space(4))) cfp_t*)__builtin_amdgcn_kernarg_segment_ptr(); asm volatile("" : "+s"(ain_)); \
        const Ctx a{ain_, ka.out, wsl}; \
        int lyr_ = layer_; asm volatile("" : "+s"(lyr_)); const float* mods_l = (const float*)(wsl + WS_MODS) + (size_t)lyr_ * 17 * 6144; const float* xin = lyr_ == 0 ? a.inp(I_X) : a.out; const float* cin = lyr_ == 0 ? a.inp(I_CTX) : (const float*)(wsl + WS_HCTX); (void)mods_l; (void)xin; (void)cin; int tid = threadIdx.x; asm volatile("" : "+v"(tid)); int G = gridDim.x, bx = blockIdx.x; asm volatile("" : "+s"(G), "+s"(bx)); \
        const int vcu = (G % 8 == 0) ? (bx % 8) * (G / 8) + bx / 8 : bx, ngw = G * 8, ngt = G * 512; (void)vcu; (void)ngw; (void)ngt; \
        const int lane = tid & 63, wave = __builtin_amdgcn_readfirstlane(tid >> 6), gw = bx * 8 + wave, gtid = bx * 512 + tid; LAS float* scr = (LAS float*)(lds + wave * 8448); \
        (void)lane; (void)gw; (void)gtid; (void)scr;
#define PHASE_END } if (ph >= ka.lo && ph + 1 < ka.hi) { for (int sr_ = 0; sr_ < REP_SYNC; ++sr_) { if (ph == 0) grid.sync(); else xcd_barrier(xbar); } } ++ph;

    PHASE_BEGIN
#ifndef SKIP_P0
        { REPLOOP(REP_P0) {
        for (int it = bx; it < 192; it += G) mods_item(a, it, (LAS float*)lds);
        for (int j = 0; j < 2; ++j) {
            tr_job(a.inp(I_MLAWIN) + (size_t)j * DM * 672, DM, 672, (bf16_t*)(wsl + WS_WINE) + (size_t)j * 768 * DM, 768, 1, nullptr, scr, gw, ngw, lane);
            tr_job(a.inp(I_WUQ) + (size_t)j * 256 * 1152, 256, 1152, (bf16_t*)(wsl + WS_WUQ) + (size_t)j * 1536 * 256, 1536, 2, a.inp(I_CQG) + j * 256, scr, gw, ngw, lane);
            tr_job(a.inp(I_WUKV) + (size_t)j * 128 * 1536, 128, 1536, (bf16_t*)(wsl + WS_WUKV) + (size_t)j * 1536 * 128, 1536, 0, a.inp(I_CKVG) + j * 128, scr, gw, ngw, lane);
            tr_job(a.inp(I_EWOUT) + (size_t)j * DM * DM, DM, DM, (bf16_t*)(wsl + WS_WOUTE) + (size_t)j * DM * DM, DM, 0, nullptr, scr, gw, ngw, lane);
            tr_job(a.inp(I_WINWIN) + (size_t)j * DM * 1536, DM, 1536, (bf16_t*)(wsl + WS_WINO) + (size_t)j * 1536 * DM, 1536, 0, nullptr, scr, gw, ngw, lane);
            tr_job(a.inp(I_OWOUT) + (size_t)j * DM * DM, DM, DM, (bf16_t*)(wsl + WS_WOUTO) + (size_t)j * DM * DM, DM, 0, nullptr, scr, gw, ngw, lane);
        }
        ffn_weights(a, 0, scr, gw, ngw, lane);
        __syncthreads();
        LAS float* ctab = (LAS float*)lds;
        for (int m = tid; m < 4096; m += 512) ctab[m] = cospif((float)m * (1.0f / 2048.0f)) * (1.0f / 64.0f);
        __syncthreads();
        for (int idx = gtid; idx < 4096 * 1024; idx += ngt) { const int k = idx >> 10, col0 = (idx & 1023) * 8, cs = col0 >> 12, l0 = col0 & 4095; float v[8];
#pragma unroll
            for (int e = 0; e < 8; ++e) { const int m = (k * (l0 + e) + cs * 1024) & 4095; v[e] = ctab[m]; }
            u32x4 o; o.x = cvt_pk_bf16(v[0], v[1]); o.y = cvt_pk_bf16(v[2], v[3]); o.z = cvt_pk_bf16(v[4], v[5]); o.w = cvt_pk_bf16(v[6], v[7]);
            *(u32x4*)(DFTL + (size_t)k * 8192 + col0) = o; }
        for (int idx = gtid; idx < 256 * 64; idx += ngt) { const int k = idx >> 6, col0 = (idx & 63) * 8, cs = col0 >> 8, l0 = col0 & 255; float v[8];
#pragma unroll
            for (int e = 0; e < 8; ++e) { const int m = (k * (l0 + e)) & 255; const float x = (float)m * (1.0f / 128.0f); v[e] = (cs ? -sinpif(x) : cospif(x)) * (1.0f / 16.0f); }
            u32x4 o; o.x = cvt_pk_bf16(v[0], v[1]); o.y = cvt_pk_bf16(v[2], v[3]); o.z = cvt_pk_bf16(v[4], v[5]); o.w = cvt_pk_bf16(v[6], v[7]);
            *(u32x4*)(DFTC + (size_t)k * 512 + col0) = o; }
        for (int idx = gtid; idx < 2 * 512 * 256; idx += ngt) { const int j = idx >> 17, n = (idx >> 8) & 511, k = idx & 255; const int cs = n >> 8, g = (n >> 6) & 3, d = n & 63, g2 = k >> 6, c = k & 63;
            float s = 0.f;
            if (g2 == g) { const float* wf = a.inp(I_FNETW) + ((size_t)(j * 4 + g) * 64) * 64 + d;
                for (int c2 = 0; c2 < 64; ++c2) { const int m = (c * c2) & 63; s += (cs ? -ctab[(m * 64 + 1024) & 4095] : ctab[m * 64]) * wf[c2 * 64]; }
                s *= 8.0f; }
            ((bf16_t*)(wsl + WS_WF))[idx] = (bf16_t)(cvt_pk_bf16(s, 0.f) & 0xffffu); }
        for (int idx = gtid; idx < 4096 * 16; idx += ngt) { float cs, sn; rope_cs<8>(idx >> 4, idx & 15, cs, sn); ((f32x2v*)(wsl + WS_ROPE_E))[idx] = (f32x2v){cs, sn}; }
        for (int idx = gtid; idx < 4096 * 32; idx += ngt) { float cs, sn; rope_cs<16>(idx >> 5, idx & 31, cs, sn); ((f32x2v*)(wsl + WS_ROPE_O))[idx] = (f32x2v){cs, sn}; }
        for (int idx = gtid; idx < 2 * 256 * 256; idx += ngt) { const int j = idx >> 16, n = (idx >> 8) & 255, k = idx & 255; const int g = n >> 6, d = n & 63, g2 = k >> 6, c = k & 63;
            float s = 0.f; if (g2 == g) s = a.inp(I_POOLW)[((size_t)(j * 4 + g) * 64 + c) * 64 + d] * a.inp(I_POOLS)[j * 256 + n];
            ((bf16_t*)(wsl + WS_WP))[idx] = (bf16_t)(cvt_pk_bf16(s, 0.f) & 0xffffu); }
        __syncthreads(); } }
#endif
    PHASE_END

    for (int layer = 0; layer < 4; ++layer) {
        const int j = layer >> 1; const bool even = !(layer & 1); const bool ctx_out = layer < 3;
        layer_ = layer;

        PHASE_BEGIN
#ifndef SKIP_NORM
            { REPLOOP(REP_NORM)
            norm_pass(xin, cin, a.inp(I_N1G) + layer * DM, mods_l, 0, 1, U, false, false, gw, ngw, lane); }
#endif
        PHASE_END

        PHASE_BEGIN
#ifndef SKIP_GIN
            { REPLOOP(REP_GIN) {
            if (even) { pg8::Gemm g{U, (const bf16_t*)(wsl + WS_WINE) + (size_t)j * 768 * DM, DM, DM, DM};
                pg8::Order<pg8::MapStd> S; S.init(T / 256, 3, G, bx, pg8::MapStd{0}); pg8::EpiBf16 E{Hb, 768, Hb, 768}; pg8::gemm_phase(lds, g, S, E); }
            else { pg8::Gemm g{U, (const bf16_t*)(wsl + WS_WINO) + (size_t)j * 1536 * DM, DM, DM, DM};
                pg8::Order<pg8::MapStd> S; S.init(T / 256, 6, G, bx, pg8::MapStd{0}); pg8::EpiBf16 E{Hb, 1536, Hb, 1536}; pg8::gemm_phase(lds, g, S, E); }
            } }
#endif
        PHASE_END

        if (even) {
            PHASE_BEGIN
#ifndef SKIP_G3
                { REPLOOP(REP_G3) {
                { pg8::Gemm g{Hb, (const bf16_t*)(wsl + WS_WUQ) + (size_t)j * 1536 * 256, 768, 256, 256};
                  pg8::Order<pg8::MapStd> S; S.init(T / 256, 6, G, bx, pg8::MapStd{0}); pg8::EpiBf16 E{Qb, 1536, Qb, 1536}; pg8::gemm_phase(lds, g, S, E); }
                { pg8::Gemm g{Hb + 256, (const bf16_t*)(wsl + WS_WUKV) + (size_t)j * 1536 * 128, 768, 128, 128};
                  pg8::Order<pg8::MapStd> S; S.init(T / 256, 6, G, bx, pg8::MapStd{0}); pg8::EpiBf16 E{KVb, 1536, KVb, 1536}; pg8::gemm_phase(lds, g, S, E); }
                { pg8::Gemm g{(const bf16_t*)(wsl + WS_WF) + (size_t)j * 512 * 256, Hb + 416, 256, 768, 256};
                  pg8::Order<pg8::MapZ> S; S.init(2, T / 256, G, bx, pg8::MapZ{}); pg8::EpiBf16 E{ZL, 8192, ZC, 512}; pg8::gemm_phase(lds, g, S, E); }
                } }
#endif
            PHASE_END
            PHASE_BEGIN
#ifndef SKIP_EWE
                ew_even(a, j, gw, ngw, lane);
#endif
            PHASE_END
            PHASE_BEGIN
#ifndef SKIP_ATTE
                const bf16_t* Kb = (const bf16_t*)(wsl + WS_U);
                const int nu = 3072 + (ctx_out ? 192 : 0);
                { REPLOOP(REP_ATTE)
                for (int uid = vcu; uid < nu; uid += G) {
                    if (uid < 3072) { const int bh = uid >> 4, qb = uid & 15, b = bh / 12, h = bh % 12; const size_t base = (size_t)b * TB, qrow = base + NCTX + qb * 256;
                        attn_unit<96, false>(lds, Qb + qrow * 1536 + h * 128, 1536, Kb + base * 1152 + h * 96, 1152, KVb + base * 1536 + h * 128 + 64, 1536, MIX + qrow * DM + h * 64, 68, 0, 0, 0, -1e30f, false); }
                    else { const int bh = uid - 3072, b = bh / 12, h = bh % 12; const size_t base = (size_t)b * TB;
                        attn_unit<96, false>(lds, Qb + base * 1536 + h * 128, 1536, Kb + base * 1152 + h * 96, 1152, KVb + base * 1536 + h * 128 + 64, 1536, MIX + base * DM + h * 64, 4, 0, 0, 0, -1e30f, false); }
                } }
#ifndef SKIP_ATTE_G
                { REPLOOP(REP_FNET) {
                { pg8::Gemm g{DFTL, ZL, 8192, 8192, 8192};
                  pg8::Order<pg8::MapFnetL> S; S.init(256, 1, G, bx, pg8::MapFnetL{}); pg8::EpiBf16 E{MIX, DM, MIX, DM}; pg8::gemm_phase(lds, g, S, E); }
                if (ctx_out) { pg8::Gemm g{DFTC, ZC, 512, 512, 512};
                  pg8::Order<pg8::MapFnetC> S; S.init(16, 1, G, bx, pg8::MapFnetC{}); pg8::EpiBf16 E{MIX, DM, MIX, DM}; pg8::gemm_phase(lds, g, S, E); }
                } }
#endif
#endif
            PHASE_END
        } else {
            PHASE_BEGIN
#ifndef SKIP_EWO
                ew_odd(a, j, gw, ngw, lane);
#endif
            PHASE_END
            PHASE_BEGIN
#ifndef SKIP_ATTO
                const float* sink = a.inp(I_SINK) + j * 12;
                const int nu = 3072 + (ctx_out ? 192 : 0);
                { REPLOOP(REP_ATTO)
                for (int uid = vcu; uid < nu; uid += G) {
                    if (uid < 3072) { const int bh = uid >> 4, qb = uid & 15, b = bh / 12, h = bh % 12, kvh = h / 3; const size_t base = (size_t)b * TB, qrow = base + NCTX + qb * 256;
                        int lt0 = qb * 4 - 2, lt1 = qb * 4 + 6; if (lt0 < 0) lt0 = 0; if (lt1 > 64) lt1 = 64;
                        attn_unit<64, true>(lds, Hb + qrow * 1536 + h * 64, 1536, Hb + base * 1536 + 768 + kvh * 64, 1536, Hb + base * 1536 + 1024 + kvh * 64, 1536, MIX + qrow * DM + h * 64,
                                            4, 4 + lt0, 4 + lt1, qb * 256, sink[h] * LOG2E, true, a.inp(I_WQG) + j * 64, (const f32x2v*)(wsl + WS_ROPE_O), true); }
                    else { const int bh = uid - 3072, b = bh / 12, h = bh % 12, kvh = h / 3; const size_t base = (size_t)b * TB;
                        attn_unit<64, true>(lds, Hb + base * 1536 + h * 64, 1536, Hb + base * 1536 + 768 + kvh * 64, 1536, Hb + base * 1536 + 1024 + kvh * 64, 1536, MIX + base * DM + h * 64,
                                            4, 0, 0, 0, sink[h] * LOG2E, true, a.inp(I_WQG) + j * 64, (const f32x2v*)(wsl + WS_ROPE_O), false); }
                } }
                { pg8::Gemm g{POOL, (const bf16_t*)(wsl + WS_WP) + (size_t)j * 256 * 256, 256, 256, 256};
                  pg8::Order<pg8::MapStd> S; S.init(T / 256, 1, G, bx, pg8::MapStd{768}); pg8::EpiBf16 E{MIX, DM, MIX, DM}; pg8::gemm_phase(lds, g, S, E); }
#endif
            PHASE_END
        }

        PHASE_BEGIN
#ifndef SKIP_WOUT
            pg8::Gemm g{MIX, (const bf16_t*)(wsl + (even ? WS_WOUTE : WS_WOUTO)) + (size_t)j * DM * DM, DM, DM, DM};
            pg8::Order<pg8::MapRes> S; S.init(ctx_out ? 272 : 256, 4, G, bx, pg8::MapRes{ctx_out ? 1 : 0});
            { REPLOOP(REP_WOUT) { pg8::EpiRes E{rep_ ? (const float*)a.out : xin, a.out, rep_ ? (const float*)hctx : cin, hctx, mods_l, 2, rep_ ? 0.f : 1.f}; pg8::gemm_phase(lds, g, S, E); } }
#endif
        PHASE_END

        PHASE_BEGIN
#ifndef SKIP_NORM2
            { REPLOOP(REP_NORM)
            norm_pass(a.out, hctx, a.inp(I_N2G) + layer * DM, mods_l, 3, 4, U, true, !ctx_out, gw, ngw, lane); }
#endif
        PHASE_END

        PHASE_BEGIN
#ifndef SKIP_UP
            pg8::Gemm g{U, (const bf16_t*)(wsl + WS_WUP), DM, DM, DM};
            pg8::Order<pg8::MapUp> S; S.init(ctx_out ? 275 : 259, 22, G, bx, pg8::MapUp{ctx_out ? 1 : 0});
            pg8::EpiUp E{HID, a.inp(I_CONVW) + (size_t)layer * 3 * 2 * DFF, a.inp(I_CONVB) + (size_t)layer * 2 * DFF}; { REPLOOP(REP_UP) pg8::gemm_phase(lds, g, S, E); }
#endif
        PHASE_END

        PHASE_BEGIN
#ifndef SKIP_DN
            pg8::Gemm g{HID, (const bf16_t*)(wsl + ((layer & 1) ? WS_WDN2 : WS_WDN)), DFF, DFF, DFF};
            pg8::Order<pg8::MapRes> S; S.init(ctx_out ? 272 : 256, 4, G, bx, pg8::MapRes{ctx_out ? 1 : 0});
            { REPLOOP(REP_DN) { pg8::EpiRes E{a.out, a.out, hctx, hctx, mods_l, 5, rep_ ? 0.f : 1.f}; pg8::gemm_phase(lds, g, S, E); } }
            if (layer < 3) {
                const int nfree = (ctx_out && G == 256) ? 192 : G, first = (ctx_out && G == 256) ? 64 : 0;
                if (bx >= first) ffn_weights(a, layer + 1, scr, (bx - first) * 8 + wave, nfree * 8, lane);
            }
#endif
        PHASE_END
    }
#undef PHASE_BEGIN
#undef PHASE_END
#undef U
#undef MIX
#undef Hb
#undef Qb
#undef KVb
#undef ZL
#undef ZC
#undef HID
#undef POOL
#undef DFTL
#undef DFTC
#undef hctx
}

extern "C" void kernel_launch(void* const* d_in, const int* in_sizes, int n_in, void* d_out, int out_size, void* d_ws, size_t ws_size, hipStream_t stream) {
    static int grid = 0;
    if (grid == 0) {
        if (n_in != 28 || out_size != NB * SEQ * DM || ws_size < WS_END) { fprintf(stderr, "kernel_launch: unexpected shapes (n_in %d, out %d, ws %zu); nothing launched\n", n_in, out_size, ws_size); grid = -1; return; }
        int dev = 0, cus = 0, per_cu = 0;
        if (hipGetDevice(&dev) != hipSuccess || hipDeviceGetAttribute(&cus, hipDeviceAttributeMultiprocessorCount, dev) != hipSuccess) { grid = -1; return; }
        if (hipFuncSetAttribute((const void*)mega_fwd, hipFuncAttributeMaxDynamicSharedMemorySize, LDS_BYTES) != hipSuccess) { fprintf(stderr, "kernel_launch: hipFuncSetAttribute failed\n"); grid = -1; return; }
        if (hipOccupancyMaxActiveBlocksPerMultiprocessor(&per_cu, (const void*)mega_fwd, 512, LDS_BYTES) != hipSuccess || per_cu < 1) { fprintf(stderr, "kernel_launch: occupancy query says %d\n", per_cu); per_cu = 1; }
        (void)hipGetLastError();
        grid = cus * 1;
    }
    if (grid < 0) return;
    Args a{};
    for (int i = 0; i < 28; ++i) a.in[i] = (const float*)d_in[i];
    a.out = (float*)d_out; a.ws = (unsigned char*)d_ws; a.lo = 0; a.hi = NPHASES;
    (void)hipMemsetAsync(d_ws, 0, 16384, stream);
    void* args[] = {&a};
    hipError_t e = hipLaunchCooperativeKernel((const void*)mega_fwd, dim3(grid), dim3(512), args, LDS_BYTES, stream);
    if (e != hipSuccess) {
        fprintf(stderr, "kernel_launch: cooperative launch failed: %s (grid %d); falling back to one launch per phase\n", hipGetErrorString(e), grid);
        (void)hipGetLastError();
        for (int p = 0; p < NPHASES; ++p) { a.lo = p; a.hi = p + 1; hipLaunchKernelGGL(mega_fwd, dim3(grid), dim3(512), LDS_BYTES, stream, a); }
    }
}
```

```cpp
#include <hip/hip_runtime.h>
#include <hip/hip_cooperative_groups.h>
#include <cstdio>
#include <cstdint>
namespace cg = cooperative_groups;

#define REP_NORM 1
#define REP_GIN 1
#define REP_G3 1
#define REP_ATTE 1
#define REP_FNET 1
#define REP_ATTO 1
#define REP_WOUT 1
#define REP_UP 1
#define REP_DN 1
#define REP_P0 1
#define REP_EW 1
#define REP_SYNC 1
#define PROBE_MODE 0
#define REPLOOP(N) int nrep_ = (N); asm volatile("" : "+s"(nrep_)); for (int rep_ = 0; rep_ < nrep_; ++rep_)

constexpr int NB = 16, SEQ = 4096, NCTX = 256, DM = 1024, TB = SEQ + NCTX, T = NB * TB;
constexpr int DFF = 2816, U2B = 4608, TAILROW0 = 16 * 4608, TAILSEG = 34;
constexpr float EPS = 1e-6f;
constexpr float LOG2E = 1.4426950408889634f;

constexpr size_t MiB = 1u << 20;
constexpr size_t WS_MODS = 1 * MiB;
constexpr size_t WS_WINE = 3 * MiB;
constexpr size_t WS_WUQ = 6 * MiB;
constexpr size_t WS_WUKV = WS_WUQ + 3 * MiB / 2;
constexpr size_t WS_WF = WS_WUKV + 3 * MiB / 4;
constexpr size_t WS_WP = WS_WF + MiB / 2;
constexpr size_t WS_WOUTE = 9 * MiB;
constexpr size_t WS_WOUTO = 13 * MiB;
constexpr size_t WS_WINO = 17 * MiB;
constexpr size_t WS_WUP = 23 * MiB;
constexpr size_t WS_WDN = 34 * MiB;
constexpr size_t WS_DFTC = 40 * MiB;
constexpr size_t WS_DFTL = 41 * MiB;
constexpr size_t WS_ZF = 73 * MiB;
constexpr size_t WS_HCTX = 105 * MiB;
constexpr size_t WS_U = 121 * MiB;
constexpr size_t WS_MIX = 275 * MiB;
constexpr size_t WS_ARENA = 411 * MiB;
constexpr size_t WS_H = WS_ARENA;
constexpr size_t WS_Q = WS_ARENA + 102 * MiB;
constexpr size_t WS_KV = WS_Q + 204 * MiB;
constexpr size_t WS_ZL = WS_KV + 204 * MiB;
constexpr size_t WS_ZC = WS_ZL + 64 * MiB;
constexpr size_t WS_POOL = WS_ARENA + 204 * MiB;
constexpr size_t WS_HID = WS_ARENA;
constexpr size_t WS_ROPE_E = WS_ZC + 4 * MiB;
constexpr size_t WS_ROPE_O = WS_ROPE_E + 1 * MiB;
constexpr size_t WS_WDN2 = WS_ROPE_O + 1 * MiB;
constexpr size_t WS_END = WS_WDN2 + 6 * MiB;
static_assert(WS_END <= 1024 * MiB, "ws map");

#define LAS __attribute__((address_space(3)))
#define GAS __attribute__((address_space(1)))
typedef unsigned short bf16_t;
typedef short bf16x8 __attribute__((ext_vector_type(8)));
typedef float f32x4 __attribute__((ext_vector_type(4)));
typedef float f32x16 __attribute__((ext_vector_type(16)));
typedef unsigned u32x4 __attribute__((ext_vector_type(4)));
typedef unsigned u32x2 __attribute__((ext_vector_type(2)));
typedef float f32x2v __attribute__((ext_vector_type(2)));

__device__ __forceinline__ unsigned cvt_pk_bf16(float lo, float hi) { unsigned r; asm volatile("v_cvt_pk_bf16_f32 %0, %1, %2" : "=v"(r) : "v"(lo), "v"(hi)); return r; }
__device__ __forceinline__ float bflo(unsigned u) { return __uint_as_float(u << 16); }
__device__ __forceinline__ float bfhi(unsigned u) { return __uint_as_float(u & 0xffff0000u); }
__device__ __forceinline__ float bf2f(bf16_t b) { return __uint_as_float((unsigned)b << 16); }
__device__ __forceinline__ float wave_sum(float v) {
#pragma unroll
    for (int o = 1; o < 64; o <<= 1) v += __shfl_xor(v, o);
    return v;
}
__device__ __forceinline__ float half_sum(float v) {
#pragma unroll
    for (int o = 1; o < 32; o <<= 1) v += __shfl_xor(v, o);
    return v;
}

namespace pg8 {
constexpr int BM = 256, BK = 64, HALF = 128, HTB = HALF * BK * 2, STAGE_BYTES = 8 * HTB, NXCD = 8, WGM = 8;
__device__ __forceinline__ int lds_byte(int r, int c) { const int st = (r >> 4) * 2 + (c >> 5), rr = r & 15, cc = c & 31, ob = rr * 64 + cc * 2; return st * 1024 + (ob ^ (((ob >> 9) & 1) << 5)); }
__device__ __forceinline__ void stage_rc(int b, int& R, int& C) { const int st = b / 1024, sb = b % 1024, swz = sb ^ (((sb >> 9) & 1) << 5); R = (st >> 1) * 16 + swz / 64; C = (st & 1) * 32 + (swz % 64) / 2; }
__device__ __forceinline__ int perm32(int rho) { const int n = rho >> 4, i = rho & 15; return 8 * (i >> 2) + 4 * n + (i & 3); }

struct Unit { int pm, pn, arow, brow, orow, ocol, aux, bt; };
struct Gemm { const bf16_t* A; const bf16_t* Bt; int lda, ldb, K; };

template <class Map> struct Order {
    int nM, nN, nwg, G, c; Map map;
    __device__ __forceinline__ void init(int nM_, int nN_, int G_, int c_, const Map& m) { nM = nM_; nN = nN_; nwg = nM * nN; G = G_; c = c_; map = m; }
    __device__ __forceinline__ bool next(int i, Unit& u) const {
        const long L = (long)i * G + c; if (L >= nwg) return false;
        int wgid = (int)L; { const int q = nwg / NXCD, r = nwg % NXCD, xcd = wgid % NXCD, off = wgid / NXCD; wgid = (xcd < r ? xcd * (q + 1) : r * (q + 1) + (xcd - r) * q) + off; }
        const int nig = WGM * nN, gid = wgid / nig, fm = gid * WGM, gsz = (nM - fm) < WGM ? (nM - fm) : WGM;
        u.pm = fm + ((wgid % nig) % gsz); u.pn = (wgid % nig) / gsz; map(u); return true;
    }
};

struct EpiBf16 {
    static constexpr bool PERM = true;
    bf16_t* O0; int ld0; bf16_t* O1; int ld1;
    __device__ __forceinline__ void operator()(const f32x4 (&acc)[2][2][4][2], const Unit& u, int wr, int wc, int fr, int fq, LAS unsigned char*) const {
        bf16_t* base = u.aux ? O1 : O0; const int ldc = u.aux ? ld1 : ld0;
        const int row0 = u.orow + wr * 64 + fr, col0 = u.ocol + wc * 32 + 8 * fq;
#pragma unroll
        for (int ai = 0; ai < 2; ++ai)
#pragma unroll
            for (int m = 0; m < 4; ++m) { bf16_t* rowp = base + (size_t)(row0 + ai * HALF + m * 16) * ldc + col0;
#pragma unroll
                for (int bj = 0; bj < 2; ++bj) { const f32x4 v0 = acc[ai][bj][m][0], v1 = acc[ai][bj][m][1];
                    u32x4 w; w.x = cvt_pk_bf16(v0[0], v0[1]); w.y = cvt_pk_bf16(v0[2], v0[3]); w.z = cvt_pk_bf16(v1[0], v1[1]); w.w = cvt_pk_bf16(v1[2], v1[3]);
                    *(u32x4*)(rowp + bj * HALF) = w; } }
    }
};

struct EpiRes {
    static constexpr bool PERM = false;
    const float* xin; float* xout; const float* cin; float* cout; const float* mods_l; int gidx; float gs;
    __device__ __forceinline__ void operator()(const f32x4 (&acc)[2][2][4][2], const Unit& u, int wr, int wc, int fr, int fq, LAS unsigned char*) const {
        const float* src = u.aux ? cin : xin; float* dst = u.aux ? cout : xout;
        const float* gate = mods_l + (size_t)(u.aux ? 16 : u.bt) * 6144 + gidx * 1024;
        const int row0 = u.orow + wr * 64 + fr, col0 = u.ocol + wc * 32 + 4 * fq;
        const __amdgpu_buffer_rsrc_t rs = __builtin_amdgcn_make_buffer_rsrc((void*)dst, 0, 0x40000000, 0x00020000);
#pragma unroll
        for (int bj = 0; bj < 2; ++bj)
#pragma unroll
            for (int n = 0; n < 2; ++n) { const int col = col0 + bj * HALF + n * 16; const f32x4 g4 = *(const f32x4*)(gate + col) * gs;
#pragma unroll
                for (int ai = 0; ai < 2; ++ai)
#pragma unroll
                    for (int m = 0; m < 4; ++m) { const size_t off = (size_t)(row0 + ai * HALF + m * 16) * DM + col;
                        const f32x4 x4 = *(const f32x4*)(src + off); __builtin_amdgcn_raw_buffer_store_b128(__builtin_bit_cast(u32x4, x4 + g4 * acc[ai][bj][m][n]), rs, (unsigned)(off * 4), 0, 16); } }
    }
};

__device__ __forceinline__ float dpp_ror1(float v) { return __int_as_float(__builtin_amdgcn_update_dpp(__float_as_int(v), __float_as_int(v), 0x121, 0xf, 0xf, false)); }
__device__ __forceinline__ float dpp_ror15(float v) { return __int_as_float(__builtin_amdgcn_update_dpp(__float_as_int(v), __float_as_int(v), 0x12F, 0xf, 0xf, false)); }
__device__ __forceinline__ float silu_f(float x) { return x * __builtin_amdgcn_rcpf(1.0f + __expf(-x)); }

struct EpiUp {
    static constexpr bool PERM = false;
    bf16_t* Hd; const float* cw; const float* cb;
    __device__ __forceinline__ void operator()(const f32x4 (&acc)[2][2][4][2], const Unit& u, int wr, int wc, int fr, int fq, LAS unsigned char* lds) const {
        LAS float* hal = (LAS float*)(lds + STAGE_BYTES);
        LAS float* cwl = (LAS float*)(lds + 140288);
        const int tid_ = (wr * 4 + wc) * 64 + fq * 16 + fr;
        float cwv[2];
#pragma unroll
        for (int q = 0; q < 2; ++q) { const int e = tid_ + 512 * q, t = e >> 8, bj = (e >> 7) & 1, c = e & 127; cwv[q] = t < 3 ? cw[t * (2 * DFF) + bj * DFF + u.ocol + c] : cb[bj * DFF + u.ocol + c]; }
        if (fr == 0) {
#pragma unroll
            for (int ai = 0; ai < 2; ++ai)
#pragma unroll
                for (int bj = 0; bj < 2; ++bj)
#pragma unroll
                    for (int n = 0; n < 2; ++n) *(LAS f32x4*)(hal + ((2 * ai + wr) * 2 + 0) * 256 + bj * 128 + wc * 32 + n * 16 + 4 * fq) = acc[ai][bj][0][n];
        }
        if (fr == 15) {
#pragma unroll
            for (int ai = 0; ai < 2; ++ai)
#pragma unroll
                for (int bj = 0; bj < 2; ++bj)
#pragma unroll
                    for (int n = 0; n < 2; ++n) *(LAS f32x4*)(hal + ((2 * ai + wr) * 2 + 1) * 256 + bj * 128 + wc * 32 + n * 16 + 4 * fq) = acc[ai][bj][3][n];
        }
        cwl[tid_] = cwv[0]; cwl[tid_ + 512] = cwv[1];
        asm volatile("s_waitcnt lgkmcnt(0)" ::: "memory"); __builtin_amdgcn_s_barrier(); asm volatile("" ::: "memory");
        int fr_ = fr, fq_ = fq; asm volatile("" : "+v"(fr_), "+v"(fq_));
        const int rmin = u.aux == 1 ? 0 : 1, rmax = u.bt;
        const f32x4 zero4 = {0.f, 0.f, 0.f, 0.f};
#pragma unroll
        for (int ai = 0; ai < 2; ++ai) {
            const int g = 2 * ai + wr;
#pragma unroll
            for (int n = 0; n < 2; ++n) {
                const int chb = u.ocol + wc * 32 + n * 16 + 4 * fq_;
                const int colh = wc * 32 + n * 16 + 4 * fq_;
                f32x4 w0[2], w1[2], w2[2], bb[2], uh[2], dh[2];
#pragma unroll
                for (int bj = 0; bj < 2; ++bj) { const int cl = bj * 128 + colh;
                    w0[bj] = *(const LAS f32x4*)(cwl + 0 * 256 + cl); w1[bj] = *(const LAS f32x4*)(cwl + 1 * 256 + cl); w2[bj] = *(const LAS f32x4*)(cwl + 2 * 256 + cl); bb[bj] = *(const LAS f32x4*)(cwl + 3 * 256 + cl);
                    uh[bj] = zero4; dh[bj] = zero4;
                    if (g > 0) uh[bj] = *(LAS f32x4*)(hal + ((g - 1) * 2 + 1) * 256 + bj * 128 + colh);
                    if (g < 3) dh[bj] = *(LAS f32x4*)(hal + ((g + 1) * 2 + 0) * 256 + bj * 128 + colh); }
#pragma unroll
                for (int m = 0; m < 4; ++m) {
                    f32x4 res[2];
#pragma unroll
                    for (int bj = 0; bj < 2; ++bj) {
                        const f32x4 cur = acc[ai][bj][m][n];
                        const f32x4 prv = m > 0 ? acc[ai][bj][m > 0 ? m - 1 : 0][n] : uh[bj];
                        const f32x4 nxt = m < 3 ? acc[ai][bj][m < 3 ? m + 1 : 3][n] : dh[bj];
                        f32x4 up, dn;
#pragma unroll
                        for (int j = 0; j < 4; ++j) { up[j] = dpp_ror1(fr_ == 15 ? prv[j] : cur[j]); dn[j] = dpp_ror15(fr_ == 0 ? nxt[j] : cur[j]); }
                        if (m == 0) { if (fr_ == 0) up = uh[bj]; }
                        if (m == 3) { if (fr_ == 15) dn = dh[bj]; }
                        res[bj] = w0[bj] * up + w1[bj] * cur + w2[bj] * dn + bb[bj];
                    }
                    const int r = ai * HALF + wr * 64 + m * 16 + fr_;
                    bool okr = r >= rmin && r <= rmax; int trow = u.orow + r;
                    if (u.aux == 2) { const int seg = r / TAILSEG, sq = r - seg * TAILSEG, sb = 7 * (u.orow >> 8) + seg;
                        okr = seg < 7 && sb < NB && sq >= 1 && sq <= 32; trow = sb * TB + NCTX + (SEQ - 33) + sq; }
                    if (okr) {
                        const f32x4 gq = res[0], vq = res[1];
                        u32x2 w; w.x = cvt_pk_bf16(silu_f(gq[0]) * vq[0], silu_f(gq[1]) * vq[1]); w.y = cvt_pk_bf16(silu_f(gq[2]) * vq[2], silu_f(gq[3]) * vq[3]);
                        *(u32x2*)(Hd + (size_t)trow * DFF + chb) = w;
                    }
                }
            }
        }
    }
};

template <class Epi, class Sched>
__device__ __forceinline__ void gemm_phase(LAS unsigned char* lds, const Gemm g, const Sched& S, const Epi& E) {
    int tid = threadIdx.x; asm volatile("" : "+v"(tid));
    const int wid = __builtin_amdgcn_readfirstlane(tid >> 6), lane = tid & 63, wr = wid >> 2, wc = wid & 3, fr = lane & 15, fq = lane >> 4;
    int K = g.K, lda_ = g.lda, ldb_ = g.ldb; asm volatile("" : "+s"(K), "+s"(lda_), "+s"(ldb_));
    const int nt = K / BK;
    unsigned voffA[2], voffB[2];
#pragma unroll
    for (int i = 0; i < 2; ++i) { int R, C; stage_rc(tid * 16 + i * 8192, R, C); const int Rb = Epi::PERM ? ((R & ~31) + perm32(R & 31)) : R;
        voffA[i] = (unsigned)(R * lda_ + C) * 2u; voffB[i] = (unsigned)(Rb * ldb_ + C) * 2u; }
    const size_t kstep = (size_t)(BK * 2);
    const size_t hstepA = (size_t)HALF * lda_ * 2, hstepB = (size_t)HALF * ldb_ * 2;
    const unsigned ldsw = (unsigned)wid * 1024u;
    const int aoff = lds_byte(wr * 64 + fr, fq * 8), boff = lds_byte(wc * 32 + fr, fq * 8);
#define PG8_SA(b, h) (((b) * 2 + (h)) * HTB)
#define PG8_SB(b, h) ((4 + (b) * 2 + (h)) * HTB)
#define PG8_STAGE(bufoff, gbase, voff) do { _Pragma("unroll") for (int _i = 0; _i < 2; ++_i) \
        __builtin_amdgcn_global_load_lds((const unsigned*)((const char*)(gbase) + (voff)[_i]), (LAS unsigned*)(lds + (bufoff) + ldsw + _i * 8192), 16, 0, 0); } while (0)
#define PG8_LDA(dst, b, h) do { _Pragma("unroll") for (int m = 0; m < 4; ++m) _Pragma("unroll") for (int k = 0; k < 2; ++k) dst[m][k] = *(const LAS bf16x8*)(lds + PG8_SA(b, h) + aoff + m * 2048 + k * 1024); } while (0)
#define PG8_LDB(dst, b, h) do { _Pragma("unroll") for (int n = 0; n < 2; ++n) _Pragma("unroll") for (int k = 0; k < 2; ++k) dst[n][k] = *(const LAS bf16x8*)(lds + PG8_SB(b, h) + boff + n * 2048 + k * 1024); } while (0)
#define PG8_MMA(ai, bj, At, Bt) do { __builtin_amdgcn_s_setprio(1); _Pragma("unroll") for (int m = 0; m < 4; ++m) _Pragma("unroll") for (int n = 0; n < 2; ++n) _Pragma("unroll") for (int k = 0; k < 2; ++k) \
        acc[ai][bj][m][n] = __builtin_amdgcn_mfma_f32_16x16x32_bf16(Bt[n][k], At[m][k], acc[ai][bj][m][n], 0, 0, 0); __builtin_amdgcn_s_setprio(0); } while (0)
#define PG8_WAIT_V(n) asm volatile("s_waitcnt vmcnt(" #n ")" ::: "memory")
#define PG8_WAIT_L(n) asm volatile("s_waitcnt lgkmcnt(" #n ")" ::: "memory")
#define PG8_BAR __builtin_amdgcn_s_barrier()
#define PG8_SCHED __builtin_amdgcn_sched_barrier(0)
    Unit cur, nxt; int ui = 0;
    if (!S.next(0, cur)) return;
    f32x4 acc[2][2][4][2];
#pragma unroll
    for (int a = 0; a < 2; ++a)
#pragma unroll
        for (int b = 0; b < 2; ++b)
#pragma unroll
            for (int m = 0; m < 4; ++m)
#pragma unroll
                for (int n = 0; n < 2; ++n) acc[a][b][m][n] = (f32x4){0.f, 0.f, 0.f, 0.f};
    bf16x8 At[4][2], B0[2][2], B1[2][2];
    const char* cA = (const char*)g.A + (size_t)cur.arow * lda_ * 2; const char* cB = (const char*)g.Bt + (size_t)cur.brow * ldb_ * 2;
    PG8_STAGE(PG8_SB(0, 0), cB, voffB); PG8_STAGE(PG8_SB(0, 1), cB + hstepB, voffB); PG8_STAGE(PG8_SA(0, 0), cA, voffA); PG8_STAGE(PG8_SA(0, 1), cA + hstepA, voffA);
    if (wr == 1) PG8_BAR;
    PG8_WAIT_V(2); PG8_BAR;
    PG8_STAGE(PG8_SB(1, 0), cB + kstep, voffB); PG8_STAGE(PG8_SA(1, 0), cA + kstep, voffA); PG8_STAGE(PG8_SB(1, 1), cB + hstepB + kstep, voffB);
    PG8_WAIT_V(6); PG8_BAR;
    for (;;) {
        const bool has_next = S.next(ui + 1, nxt);
        const char* nA = has_next ? (const char*)g.A + (size_t)nxt.arow * lda_ * 2 : cA; const char* nB = has_next ? (const char*)g.Bt + (size_t)nxt.brow * ldb_ * 2 : cB;
        for (int t = 0; t < nt; t += 2) {
            const bool last = (t == nt - 2);
            const char* a1 = cA + (size_t)(t + 1) * kstep;
            const char* a2 = last ? nA : cA + (size_t)(t + 2) * kstep; const char* b2 = last ? nB : cB + (size_t)(t + 2) * kstep;
            const char* a3 = a2 + kstep; const char* b3 = b2 + kstep;
            PG8_LDB(B0, 0, 0); PG8_LDB(B1, 0, 1); PG8_SCHED; PG8_LDA(At, 0, 0); PG8_STAGE(PG8_SA(1, 1), a1 + hstepA, voffA);
            PG8_WAIT_V(8); PG8_WAIT_L(0); PG8_BAR; PG8_MMA(0, 0, At, B0); PG8_MMA(0, 1, At, B1); PG8_BAR; PG8_SCHED;
            PG8_LDA(At, 0, 1); PG8_STAGE(PG8_SB(0, 0), b2, voffB); PG8_STAGE(PG8_SB(0, 1), b2 + hstepB, voffB); PG8_STAGE(PG8_SA(0, 0), a2, voffA);
            PG8_WAIT_V(8); PG8_WAIT_L(0); PG8_BAR; PG8_MMA(1, 0, At, B0); PG8_MMA(1, 1, At, B1); PG8_BAR; PG8_SCHED;
            PG8_LDB(B0, 1, 0); PG8_LDB(B1, 1, 1); PG8_SCHED; PG8_LDA(At, 1, 0); PG8_STAGE(PG8_SA(0, 1), a2 + hstepA, voffA);
            PG8_WAIT_V(8); PG8_WAIT_L(0); PG8_BAR; PG8_MMA(0, 0, At, B0); PG8_MMA(0, 1, At, B1); PG8_BAR; PG8_SCHED;
            PG8_LDA(At, 1, 1); PG8_STAGE(PG8_SB(1, 0), b3, voffB); PG8_STAGE(PG8_SB(1, 1), b3 + hstepB, voffB); PG8_STAGE(PG8_SA(1, 0), a3, voffA);
            PG8_WAIT_V(8); PG8_WAIT_L(0); PG8_BAR; PG8_MMA(1, 0, At, B0); PG8_MMA(1, 1, At, B1); PG8_BAR; PG8_SCHED;
        }
        if (wr == 0) PG8_BAR;
        E(acc, cur, wr, wc, fr, fq, lds);
        if (!has_next) break;
#pragma unroll
        for (int a = 0; a < 2; ++a)
#pragma unroll
            for (int b = 0; b < 2; ++b)
#pragma unroll
                for (int m = 0; m < 4; ++m)
#pragma unroll
                    for (int n = 0; n < 2; ++n) acc[a][b][m][n] = (f32x4){0.f, 0.f, 0.f, 0.f};
        cur = nxt; cA = nA; cB = nB; ++ui;
        if (wr == 1) PG8_BAR;
    }
    PG8_WAIT_V(0);
    PG8_BAR;
#undef PG8_SA
#undef PG8_SB
#undef PG8_STAGE
#undef PG8_LDA
#undef PG8_LDB
#undef PG8_MMA
#undef PG8_WAIT_V
#undef PG8_WAIT_L
#undef PG8_BAR
#undef PG8_SCHED
}

struct MapStd { int coff; __device__ __forceinline__ void operator()(Unit& u) const { u.arow = u.pm * 256; u.brow = u.pn * 256; u.orow = u.pm * 256; u.ocol = coff + u.pn * 256; u.aux = 0; u.bt = 0; } };
struct MapRes { int all;
    __device__ __forceinline__ void operator()(Unit& u) const {
        int b, j; if (all) { b = u.pm / 17; j = u.pm % 17; } else { b = u.pm / 16; j = u.pm % 16 + 1; }
        u.arow = (b * 17 + j) * 256; u.brow = u.pn * 256; u.ocol = u.pn * 256; u.bt = b;
        if (j == 0) { u.aux = 1; u.orow = b * 256; } else { u.aux = 0; u.orow = b * SEQ + (j - 1) * 256; } asm volatile("" : "+s"(u.aux)); } };
struct MapUp { int all;
    __device__ __forceinline__ void operator()(Unit& u) const {
        const int per = all ? 17 : 16, nmain = 16 * per;
        u.brow = u.pn * 256; u.ocol = u.pn * 128;
        if (u.pm >= nmain) { u.aux = 2; u.arow = TAILROW0 + (u.pm - nmain) * 256; u.orow = (u.pm - nmain) * 256; u.bt = 0; return; }
        const int b = u.pm / per, j = all ? u.pm % per : u.pm % per + 1;
        if (j == 0) { u.aux = 1; u.arow = b * U2B; u.orow = b * TB; u.bt = 255; }
        else { const int i = j - 1; u.aux = 0; u.arow = b * U2B + 263 + 254 * i; u.orow = b * TB + NCTX + 254 * i - 1; u.bt = 254; } } };
struct MapZ {
    __device__ __forceinline__ void operator()(Unit& u) const {
        const int b = u.pn / 17, j = u.pn % 17; u.arow = u.pm * 256; u.brow = u.pn * 256; u.orow = b * 256; u.bt = b;
        if (j == 0) { u.aux = 1; u.ocol = u.pm * NCTX; } else { u.aux = 0; u.ocol = u.pm * SEQ + (j - 1) * 256; } } };
struct MapFnetL { __device__ __forceinline__ void operator()(Unit& u) const { const int b = u.pm / 16, mt = u.pm % 16; u.arow = mt * 256; u.brow = b * 256; u.orow = b * TB + NCTX + mt * 256; u.ocol = 768; u.aux = 0; u.bt = b; } };
struct MapFnetC { __device__ __forceinline__ void operator()(Unit& u) const { const int b = u.pm; u.arow = 0; u.brow = b * 256; u.orow = b * TB; u.ocol = 768; u.aux = 0; u.bt = b; } };
}

typedef short v4i16_t __attribute__((ext_vector_type(4)));
__device__ __forceinline__ v4i16_t vtr(const LAS unsigned char* p) { return __builtin_amdgcn_ds_read_tr16_b64_v4i16((LAS v4i16_t*)p); }
#define MX3(a_, b_, c_) __builtin_fmaxf(__builtin_fmaxf((a_), (b_)), (c_))
__device__ __forceinline__ float tile_max(const f32x16& s0, const f32x16& s1) {
    float ma = MX3(s0[0], s0[1], s1[0]), mb = MX3(s0[2], s0[3], s1[1]); ma = MX3(ma, s1[2], s1[3]);
#pragma unroll
    for (int r = 4; r < 16; r += 4) { ma = MX3(ma, s0[r], s0[r + 1]); mb = MX3(mb, s0[r + 2], s0[r + 3]); ma = MX3(ma, s1[r], s1[r + 1]); mb = MX3(mb, s1[r + 2], s1[r + 3]); }
    return __builtin_fmaxf(ma, mb);
}
#undef MX3
__device__ __forceinline__ void band_mask(f32x16& s0, f32x16& s1, int k0pos, int qp, int hi) {
#pragma unroll
    for (int r = 0; r < 16; ++r) { const int kp = k0pos + (r & 3) + 8 * (r >> 2) + 4 * hi; const int d0 = kp - qp, d1 = d0 + 32;
        if (d0 > 128 || d0 < -128) s0[r] = -1e30f; if (d1 > 128 || d1 < -128) s1[r] = -1e30f; }
}
__device__ __forceinline__ void exp4(f32x16& s, int r0, float& acc0, float& acc1) {
    s[r0] = __builtin_amdgcn_exp2f(s[r0]); s[r0 + 1] = __builtin_amdgcn_exp2f(s[r0 + 1]); s[r0 + 2] = __builtin_amdgcn_exp2f(s[r0 + 2]); s[r0 + 3] = __builtin_amdgcn_exp2f(s[r0 + 3]);
    acc0 += s[r0] + s[r0 + 2]; acc1 += s[r0 + 1] + s[r0 + 3];
}
__device__ __forceinline__ bf16x8 pack8(const f32x16& s, int r0) {
    u32x4 w; w.x = cvt_pk_bf16(s[r0], s[r0 + 1]); w.y = cvt_pk_bf16(s[r0 + 2], s[r0 + 3]); w.z = cvt_pk_bf16(s[r0 + 4], s[r0 + 5]); w.w = cvt_pk_bf16(s[r0 + 6], s[r0 + 7]);
    return __builtin_bit_cast(bf16x8, w);
}
__device__ __forceinline__ void pv_slab(const LAS unsigned char* vb, int koff, const bf16x8 pj, f32x16& o0, f32x16& o1) {
    const v4i16_t a0 = vtr(vb + koff), a1 = vtr(vb + koff + 512), b0 = vtr(vb + 8192 + koff), b1 = vtr(vb + 8192 + koff + 512);
    const bf16x8 v0 = {a0[0], a0[1], a0[2], a0[3], a1[0], a1[1], a1[2], a1[3]}, v1 = {b0[0], b0[1], b0[2], b0[3], b1[0], b1[1], b1[2], b1[3]};
    o0 = __builtin_amdgcn_mfma_f32_32x32x16_bf16(v0, pj, o0, 0, 0, 0);
    o1 = __builtin_amdgcn_mfma_f32_32x32x16_bf16(v1, pj, o1, 0, 0, 0);
}

#define ATT_SCHED() __builtin_amdgcn_sched_barrier(0)
template <int DQ, bool WIN>
__device__ __forceinline__ void attn_qk(LAS unsigned char* lds, int kbufoff, int t, const bf16x8 (&qf)[DQ / 16], f32x16& o0, f32x16& o1, float& mrun, float& lsum,
                                        f32x16& sa0, f32x16& sa1, f32x16& sb0, f32x16& sb1, int l31, int hi, int qw) {
    constexpr int NDK = DQ / 16, KST = DQ * 2 + 16;
    const LAS unsigned char* kb = lds + kbufoff + l31 * KST + hi * 16;
    bf16x8 kf[2][4];
#define KLOAD(dst, dk) do { dst[0] = *(const LAS bf16x8*)(kb + (dk) * 32); dst[1] = *(const LAS bf16x8*)(kb + 32 * KST + (dk) * 32); \
                            dst[2] = *(const LAS bf16x8*)(kb + 64 * KST + (dk) * 32); dst[3] = *(const LAS bf16x8*)(kb + 96 * KST + (dk) * 32); } while (0)
    KLOAD(kf[0], 0);
#pragma unroll
    for (int dk = 0; dk < NDK; ++dk) {
        if (dk + 1 < NDK) KLOAD(kf[(dk + 1) & 1], dk + 1);
        ATT_SCHED();
        const bf16x8 (&f)[4] = kf[dk & 1];
        if (dk == 0) { f32x16 z16;
#pragma unroll
                       for (int r = 0; r < 16; ++r) z16[r] = 0.f;
                       sa0 = __builtin_amdgcn_mfma_f32_32x32x16_bf16(f[0], qf[0], z16, 0, 0, 0); sa1 = __builtin_amdgcn_mfma_f32_32x32x16_bf16(f[1], qf[0], z16, 0, 0, 0);
                       sb0 = __builtin_amdgcn_mfma_f32_32x32x16_bf16(f[2], qf[0], z16, 0, 0, 0); sb1 = __builtin_amdgcn_mfma_f32_32x32x16_bf16(f[3], qf[0], z16, 0, 0, 0); }
        else { sa0 = __builtin_amdgcn_mfma_f32_32x32x16_bf16(f[0], qf[dk], sa0, 0, 0, 0); sa1 = __builtin_amdgcn_mfma_f32_32x32x16_bf16(f[1], qf[dk], sa1, 0, 0, 0);
               sb0 = __builtin_amdgcn_mfma_f32_32x32x16_bf16(f[2], qf[dk], sb0, 0, 0, 0); sb1 = __builtin_amdgcn_mfma_f32_32x32x16_bf16(f[3], qf[dk], sb1, 0, 0, 0); }
        ATT_SCHED();
    }
#undef KLOAD
    if (__builtin_expect(__any(mrun != 0.f), 0)) {
#pragma unroll
        for (int r = 0; r < 16; ++r) { sa0[r] -= mrun; sa1[r] -= mrun; sb0[r] -= mrun; sb1[r] -= mrun; }
    }
    if (WIN && t >= 4) { const int qp = qw + l31, k0pos = (t - 4) * 64; band_mask(sa0, sa1, k0pos, qp, hi); band_mask(sb0, sb1, k0pos + 64, qp, hi); }
    float mx = __builtin_fmaxf(tile_max(sa0, sa1), tile_max(sb0, sb1));
    { auto rr = __builtin_amdgcn_permlane32_swap(__float_as_uint(mx), __float_as_uint(mx), false, false); mx = __builtin_fmaxf(__uint_as_float(rr[0]), __uint_as_float(rr[1])); }
    if (__builtin_expect(__any(mx > 8.0f), 0)) {
        const float dl = mx > 8.0f ? mx : 0.f; mrun += dl;
        const float alpha = __builtin_amdgcn_exp2f(-dl); lsum *= alpha;
#pragma unroll
        for (int r = 0; r < 16; ++r) { sa0[r] -= dl; sa1[r] -= dl; sb0[r] -= dl; sb1[r] -= dl; o0[r] *= alpha; o1[r] *= alpha; }
    }
}
#define VLOAD(dst, j) do { dst[0] = vtr(vb + (j) * 1024); dst[1] = vtr(vb + (j) * 1024 + 512); dst[2] = vtr(vb + 8192 + (j) * 1024); dst[3] = vtr(vb + 8192 + (j) * 1024 + 512); } while (0)
#define PVMMA(src, P_) do { const bf16x8 v0_ = {src[0][0], src[0][1], src[0][2], src[0][3], src[1][0], src[1][1], src[1][2], src[1][3]}, v1_ = {src[2][0], src[2][1], src[2][2], src[2][3], src[3][0], src[3][1], src[3][2], src[3][3]}; \
        const bf16x8 p_ = (P_); o0 = __builtin_amdgcn_mfma_f32_32x32x16_bf16(v0_, p_, o0, 0, 0, 0); o1 = __builtin_amdgcn_mfma_f32_32x32x16_bf16(v1_, p_, o1, 0, 0, 0); } while (0)
__device__ __forceinline__ void attn_softmax_pv(const LAS unsigned char* vb, f32x16& sa0, f32x16& sa1, f32x16& sb0, f32x16& sb1, f32x16& o0, f32x16& o1, float& lsum) {
    v4i16_t vf[2][4];
    VLOAD(vf[0], 0);
    float p0 = 0.f, p1 = 0.f, p2 = 0.f, p3 = 0.f;
    exp4(sa0, 0, p0, p1); exp4(sa0, 4, p2, p3); exp4(sa0, 8, p0, p1); exp4(sa0, 12, p2, p3);
    exp4(sa1, 0, p0, p1); exp4(sa1, 4, p2, p3); exp4(sa1, 8, p0, p1); exp4(sa1, 12, p2, p3);
    VLOAD(vf[1], 1); ATT_SCHED(); PVMMA(vf[0], pack8(sa0, 0)); exp4(sb0, 0, p0, p1); exp4(sb0, 4, p2, p3); ATT_SCHED();
    VLOAD(vf[0], 2); ATT_SCHED(); PVMMA(vf[1], pack8(sa0, 8)); exp4(sb0, 8, p0, p1); exp4(sb0, 12, p2, p3); ATT_SCHED();
    VLOAD(vf[1], 3); ATT_SCHED(); PVMMA(vf[0], pack8(sa1, 0)); exp4(sb1, 0, p0, p1); exp4(sb1, 4, p2, p3); ATT_SCHED();
    VLOAD(vf[0], 4); ATT_SCHED(); PVMMA(vf[1], pack8(sa1, 8)); exp4(sb1, 8, p0, p1); exp4(sb1, 12, p2, p3); ATT_SCHED();
    lsum += (p0 + p1) + (p2 + p3);
    VLOAD(vf[1], 5); ATT_SCHED(); PVMMA(vf[0], pack8(sb0, 0)); ATT_SCHED();
    VLOAD(vf[0], 6); ATT_SCHED(); PVMMA(vf[1], pack8(sb0, 8)); ATT_SCHED();
    VLOAD(vf[1], 7); ATT_SCHED(); PVMMA(vf[0], pack8(sb1, 0)); ATT_SCHED();
    PVMMA(vf[1], pack8(sb1, 8));
}
__device__ __forceinline__ void attn_softmax_keep(f32x16& sa0, f32x16& sa1, f32x16& sb0, f32x16& sb1, bf16x8 (&pw)[8], float& lsum) {
    float p0 = 0.f, p1 = 0.f, p2 = 0.f, p3 = 0.f;
    exp4(sa0, 0, p0, p1); exp4(sa0, 4, p2, p3); exp4(sa0, 8, p0, p1); exp4(sa0, 12, p2, p3); pw[0] = pack8(sa0, 0); pw[1] = pack8(sa0, 8);
    exp4(sa1, 0, p0, p1); exp4(sa1, 4, p2, p3); exp4(sa1, 8, p0, p1); exp4(sa1, 12, p2, p3); pw[2] = pack8(sa1, 0); pw[3] = pack8(sa1, 8);
    exp4(sb0, 0, p0, p1); exp4(sb0, 4, p2, p3); exp4(sb0, 8, p0, p1); exp4(sb0, 12, p2, p3); pw[4] = pack8(sb0, 0); pw[5] = pack8(sb0, 8);
    exp4(sb1, 0, p0, p1); exp4(sb1, 4, p2, p3); exp4(sb1, 8, p0, p1); exp4(sb1, 12, p2, p3); pw[6] = pack8(sb1, 0); pw[7] = pack8(sb1, 8);
    lsum += (p0 + p1) + (p2 + p3);
}
__device__ __forceinline__ void attn_pv_all(const LAS unsigned char* vb, const bf16x8 (&pw)[8], f32x16& o0, f32x16& o1) {
    v4i16_t vf[2][4];
    VLOAD(vf[0], 0);
    VLOAD(vf[1], 1); ATT_SCHED(); PVMMA(vf[0], pw[0]); ATT_SCHED();
    VLOAD(vf[0], 2); ATT_SCHED(); PVMMA(vf[1], pw[1]); ATT_SCHED();
    VLOAD(vf[1], 3); ATT_SCHED(); PVMMA(vf[0], pw[2]); ATT_SCHED();
    VLOAD(vf[0], 4); ATT_SCHED(); PVMMA(vf[1], pw[3]); ATT_SCHED();
    VLOAD(vf[1], 5); ATT_SCHED(); PVMMA(vf[0], pw[4]); ATT_SCHED();
    VLOAD(vf[0], 6); ATT_SCHED(); PVMMA(vf[1], pw[5]); ATT_SCHED();
    VLOAD(vf[1], 7); ATT_SCHED(); PVMMA(vf[0], pw[6]); ATT_SCHED();
    PVMMA(vf[1], pw[7]);
}
#undef VLOAD
#undef PVMMA
#undef ATT_SCHED

template <int DQ, bool WIN, int MODE = 0>
__device__ __forceinline__ void attn_unit(LAS unsigned char* lds, const bf16_t* Qp, int ldq, const bf16_t* Kp, int ldk, const bf16_t* Vp, int ldv, bf16_t* Op,
                                          int n1, int s2, int e2, int q0pos, float m_init, bool has_sink, const float* qgain = nullptr, const f32x2v* ropeT = nullptr, bool qrope = false) {
    constexpr int NDK = DQ / 16, CH = DQ / 8, NKC = DQ / 32, KST = DQ * 2 + 16, KBUF = 128 * KST, VBUF = 16384, VOFF = 2 * KBUF;
    int tid = threadIdx.x; asm volatile("" : "+v"(tid));
    const int lane = tid & 63, wid = __builtin_amdgcn_readfirstlane(tid >> 6), l31 = lane & 31, hi = lane >> 5;
    const bool late = wid >= 4;
    bf16x8 qf[NDK];
    { const bf16_t* qrow = Qp + (size_t)(32 * wid + l31) * ldq + 8 * hi;
#pragma unroll
      for (int dk = 0; dk < NDK; ++dk) qf[dk] = *(const bf16x8*)(qrow + 16 * dk); }
    if (DQ == 64 && qgain != nullptr) {
        float y[4][8]; float ss = 0.f;
#pragma unroll
        for (int dk = 0; dk < 4; ++dk) { const u32x4 w = __builtin_bit_cast(u32x4, qf[dk < NDK ? dk : 0]);
#pragma unroll
            for (int i = 0; i < 4; ++i) { y[dk][2 * i] = bflo(w[i]); y[dk][2 * i + 1] = bfhi(w[i]); ss += y[dk][2 * i] * y[dk][2 * i] + y[dk][2 * i + 1] * y[dk][2 * i + 1]; } }
        ss += __shfl_xor(ss, 32);
        const float rn = rsqrtf(ss * (1.0f / 64.0f) + EPS);
#pragma unroll
        for (int dk = 0; dk < 4; ++dk)
#pragma unroll
            for (int e = 0; e < 8; ++e) y[dk][e] *= rn * qgain[16 * dk + 8 * hi + e];
        if (qrope) { const int pos = q0pos + 32 * wid + l31;
#pragma unroll
            for (int dk = 0; dk < 2; ++dk)
#pragma unroll
                for (int e = 0; e < 8; ++e) { const f32x2v t = ropeT[pos * 32 + 16 * dk + 8 * hi + e]; const float x1 = y[dk][e], x2 = y[dk + 2][e]; y[dk][e] = x1 * t.x - x2 * t.y; y[dk + 2][e] = x1 * t.y + x2 * t.x; } }
        const float QS_ = 0.125f * LOG2E;
#pragma unroll
        for (int dk = 0; dk < 4; ++dk) { u32x4 w;
#pragma unroll
            for (int i = 0; i < 4; ++i) w[i] = cvt_pk_bf16(y[dk][2 * i] * QS_, y[dk][2 * i + 1] * QS_);
            if (dk < NDK) qf[dk] = __builtin_bit_cast(bf16x8, w); }
    }
    f32x16 o0, o1;
#pragma unroll
    for (int r = 0; r < 16; ++r) { o0[r] = 0.f; o1[r] = 0.f; }
    float mrun = 0.f, lsum = (has_sink && hi == 0) ? __builtin_amdgcn_exp2f(m_init) : 0.f;
    const int qw = q0pos + 32 * wid;
    const int vlane = (4 * hi + ((lane & 15) >> 2)) * 64 + ((lane >> 4) & 1) * 32 + (lane & 3) * 8;
    u32x4 kr[NKC], vr[2];
#define ATT_TILE(i_) ((i_) < n1 ? (i_) : s2 + ((i_) - n1))
#define ATT_LOAD(t) do { const bf16_t* kp_ = Kp + (size_t)(t) * 64 * ldk; const bf16_t* vp_ = Vp + (size_t)(t) * 64 * ldv; \
        _Pragma("unroll") for (int m_ = 0; m_ < NKC; ++m_) { const int c_ = tid + 512 * m_; kr[m_] = *(const GAS u32x4*)(kp_ + (size_t)(c_ / CH) * ldk + (c_ % CH) * 8); } \
        _Pragma("unroll") for (int m_ = 0; m_ < 2; ++m_) { const int c_ = tid + 512 * m_; vr[m_] = *(const GAS u32x4*)(vp_ + (size_t)(c_ >> 3) * ldv + (c_ & 7) * 8); } } while (0)
#define ATT_STORE(kb_, vb_) do { \
        _Pragma("unroll") for (int m_ = 0; m_ < NKC; ++m_) { const int c_ = tid + 512 * m_; *(LAS u32x4*)(lds + (kb_) * KBUF + (c_ / CH) * KST + (c_ % CH) * 16) = kr[m_]; } \
        _Pragma("unroll") for (int m_ = 0; m_ < 2; ++m_) { const int c_ = tid + 512 * m_; *(LAS u32x4*)(lds + VOFF + (vb_) * VBUF + ((c_ & 7) >> 2) * 8192 + (c_ >> 3) * 64 + (c_ & 3) * 16) = vr[m_]; } } while (0)
#define ATT_BAR() asm volatile("s_waitcnt lgkmcnt(0)\n\ts_barrier" ::: "memory")
    const int nst = (n1 + (e2 - s2)) >> 1;
    ATT_LOAD(0); ATT_STORE(0, 0);
    ATT_BAR();
    if (!late) {
        int vcur = 0;
        for (int I = 0; I < nst; ++I) {
            const int t = ATT_TILE(2 * I);
            if (I + 1 < nst) { const int tn = ATT_TILE(2 * I + 2); ATT_LOAD(tn); }
            bool active = true; if (WIN && t >= 4) { const int k0 = (t - 4) * 64; active = (k0 + 127 >= qw - 128) && (k0 <= qw + 31 + 128); }
            const int vnext = vcur == 2 ? 0 : vcur + 1;
            if (active) { f32x16 sa0, sa1, sb0, sb1;
                attn_qk<DQ, WIN>(lds, (I & 1) * KBUF, t, qf, o0, o1, mrun, lsum, sa0, sa1, sb0, sb1, l31, hi, qw);
                attn_softmax_pv(lds + VOFF + vcur * VBUF + vlane, sa0, sa1, sb0, sb1, o0, o1, lsum); }
            if (I + 1 < nst) ATT_STORE((I + 1) & 1, vnext);
            vcur = vnext;
            ATT_BAR();
        }
    } else {
        bf16x8 pw[8]; bool havep = false; int pvoff = 0;
        int vcur = 0;
        for (int I = 0; I < nst; ++I) {
            const int t = ATT_TILE(2 * I);
            if (I + 1 < nst) { const int tn = ATT_TILE(2 * I + 2); ATT_LOAD(tn); }
            bool active = true; if (WIN && t >= 4) { const int k0 = (t - 4) * 64; active = (k0 + 127 >= qw - 128) && (k0 <= qw + 31 + 128); }
            const int vnext = vcur == 2 ? 0 : vcur + 1;
            if (havep) attn_pv_all(lds + VOFF + pvoff + vlane, pw, o0, o1);
            havep = false;
            if (active) { f32x16 sa0, sa1, sb0, sb1;
                attn_qk<DQ, WIN>(lds, (I & 1) * KBUF, t, qf, o0, o1, mrun, lsum, sa0, sa1, sb0, sb1, l31, hi, qw);
                attn_softmax_keep(sa0, sa1, sb0, sb1, pw, lsum); havep = true; pvoff = vcur * VBUF; }
            if (I + 1 < nst) ATT_STORE((I + 1) & 1, vnext);
            vcur = vnext;
            ATT_BAR();
        }
        if (havep) attn_pv_all(lds + VOFF + pvoff + vlane, pw, o0, o1);
    }
    ATT_BAR();
#undef ATT_TILE
#undef ATT_LOAD
#undef ATT_STORE
#undef ATT_BAR
    const float lt = lsum + __shfl_xor(lsum, 32), inv = 1.0f / lt;
    bf16_t* orow = Op + (size_t)(32 * wid + l31) * DM + 4 * hi;
#pragma unroll
    for (int g = 0; g < 4; ++g) {
        u32x2 w0, w1;
        w0.x = cvt_pk_bf16(o0[4 * g] * inv, o0[4 * g + 1] * inv); w0.y = cvt_pk_bf16(o0[4 * g + 2] * inv, o0[4 * g + 3] * inv);
        w1.x = cvt_pk_bf16(o1[4 * g] * inv, o1[4 * g + 1] * inv); w1.y = cvt_pk_bf16(o1[4 * g + 2] * inv, o1[4 * g + 3] * inv);
        *(u32x2*)(orow + 8 * g) = w0; *(u32x2*)(orow + 32 + 8 * g) = w1;
    }
}

struct Args { const float* in[28]; float* out; unsigned char* ws; int lo, hi; };
typedef const GAS float* cfp_t;
struct Ctx { const __attribute__((address_space(4))) cfp_t* in; float* out; unsigned char* ws;
    __device__ __forceinline__ const float* inp(int i) const { return (const float*)in[i]; } };
enum { I_X = 0, I_C, I_CTX, I_CCTX, I_MODW, I_MODB, I_N1G, I_N2G, I_MLAWIN, I_CQG, I_CKVG, I_WUQ, I_WUKV, I_QG, I_KG, I_FNETW, I_EWOUT,
       I_WINWIN, I_WQG, I_WKG, I_SINK, I_POOLW, I_POOLS, I_OWOUT, I_FFNUP, I_CONVW, I_CONVB, I_FFNDN };

__device__ __forceinline__ void tr_item(const float* W, int K, int Nsrc, bf16_t* WT, int nblk, int item, LAS float* scr, int lane, int mode, const float* ksc) {
    const int kb = item / nblk, nb = item % nblk, k0 = 64 * kb, n0 = 32 * nb;
    int s0 = n0;
    if (mode == 1) s0 = n0 < 672 ? n0 : -1;
    else if (mode == 2) { const int hd = n0 >> 7, d0 = n0 & 127; s0 = d0 < 96 ? hd * 96 + d0 : -1; }
    else if (mode == 3) { const int pn = n0 >> 8, bj = (n0 >> 7) & 1, c = n0 & 127; s0 = bj * DFF + pn * 128 + c; }
#pragma unroll 16
    for (int i = 0; i < 32; ++i) { const int kk = 2 * i + (lane >> 5); float v = 0.f;
        if (s0 >= 0) { v = W[(size_t)(k0 + kk) * Nsrc + s0 + (lane & 31)]; if (ksc) v *= ksc[k0 + kk]; }
        scr[kk * 33 + (lane & 31)] = v; }
    asm volatile("s_waitcnt lgkmcnt(0)" ::: "memory");
    const int c = lane & 7;
#pragma unroll
    for (int j = 0; j < 4; ++j) { const int n = (lane >> 3) + 8 * j; const LAS float* s = scr + (8 * c) * 33 + n;
        u32x4 o; o.x = cvt_pk_bf16(s[0 * 33], s[1 * 33]); o.y = cvt_pk_bf16(s[2 * 33], s[3 * 33]); o.z = cvt_pk_bf16(s[4 * 33], s[5 * 33]); o.w = cvt_pk_bf16(s[6 * 33], s[7 * 33]);
        *(u32x4*)(WT + (size_t)(n0 + n) * K + k0 + 8 * c) = o; }
    asm volatile("s_waitcnt lgkmcnt(0)" ::: "memory");
}
__device__ __forceinline__ void tr_job(const float* W, int K, int Nsrc, bf16_t* WT, int Nout, int mode, const float* ksc, LAS float* scr, int gw, int ngw, int lane) {
    const int nblk = Nout / 32, nitems = (K / 64) * nblk;
    for (int it = gw; it < nitems; it += ngw) tr_item(W, K, Nsrc, WT, nblk, it, scr, lane, mode, ksc);
}
__device__ __forceinline__ void ffn_weights(const Ctx& a, int layer, LAS float* scr, int gw, int ngw, int lane) {
    tr_job(a.inp(I_FFNUP) + (size_t)layer * DM * 2 * DFF, DM, 2 * DFF, (bf16_t*)(a.ws + WS_WUP), 2 * DFF, 3, nullptr, scr, gw, ngw, lane);
    tr_job(a.inp(I_FFNDN) + (size_t)layer * DFF * DM, DFF, DM, (bf16_t*)(a.ws + ((layer & 1) ? WS_WDN2 : WS_WDN)), DM, 0, nullptr, scr, gw, ngw, lane);
}

__device__ __forceinline__ void mods_item(const Ctx& a, int item, LAS float* sl) {
    int tid = threadIdx.x; asm volatile("" : "+v"(tid)); const int l = item / 48, nb = item % 48;
    LAS float* red = sl + 17 * 1024;
    for (int idx = tid; idx < 17 * 1024; idx += 512) { const int r = idx >> 10, k = idx & 1023; const float v = r < 16 ? a.inp(I_C)[r * 1024 + k] : a.inp(I_CCTX)[k]; sl[idx] = v / (1.0f + __expf(-v)); }
    __syncthreads();
    const int cn = tid & 127, ks = tid >> 7, n = 128 * nb + cn;
    float acc[17];
#pragma unroll
    for (int r = 0; r < 17; ++r) acc[r] = 0.f;
    const float* wp = a.inp(I_MODW) + ((size_t)l * 1024 + 256 * ks) * 6144 + n;
#pragma unroll 4
    for (int k = 0; k < 256; k += 4) {
        const float w0 = wp[(size_t)(k + 0) * 6144], w1 = wp[(size_t)(k + 1) * 6144], w2 = wp[(size_t)(k + 2) * 6144], w3 = wp[(size_t)(k + 3) * 6144];
#pragma unroll
        for (int r = 0; r < 17; ++r) { const f32x4 s4 = *(const LAS f32x4*)(sl + r * 1024 + 256 * ks + k); acc[r] += s4[0] * w0 + s4[1] * w1 + s4[2] * w2 + s4[3] * w3; }
    }
#pragma unroll
    for (int r = 0; r < 17; ++r) red[(ks * 17 + r) * 128 + cn] = acc[r];
    __syncthreads();
    float* mods = (float*)(a.ws + WS_MODS);
    for (int idx = tid; idx < 17 * 128; idx += 512) { const int r = idx >> 7, c2 = idx & 127;
        const float s = red[(0 * 17 + r) * 128 + c2] + red[(1 * 17 + r) * 128 + c2] + red[(2 * 17 + r) * 128 + c2] + red[(3 * 17 + r) * 128 + c2];
        mods[((size_t)l * 17 + r) * 6144 + 128 * nb + c2] = s + a.inp(I_MODB)[l * 6144 + 128 * nb + c2]; }
    __syncthreads();
}

__device__ __forceinline__ void norm_pass(const float* xsrc, const float* csrc, const float* g, const float* mods_l, int shift_idx, int scale_idx,
                                          bf16_t* U, bool ffn_layout, bool skip_ctx, int gw, int ngw, int lane) {
    for (int R0 = gw; R0 < T; R0 += 2 * ngw) {
        f32x4 v[2][4]; bool ok[2]; int bb[2], pp[2];
#pragma unroll
        for (int s = 0; s < 2; ++s) { const int R = R0 + s * ngw; const int b = R / TB, p = R % TB; const bool isctx = p < NCTX; bb[s] = b; pp[s] = p;
            ok[s] = (R < T) && !(isctx && skip_ctx);
            const float* src = isctx ? csrc + (size_t)(b * NCTX + p) * DM : xsrc + (size_t)(b * SEQ + p - NCTX) * DM;
            if (ok[s]) {
#pragma unroll
                for (int j = 0; j < 4; ++j) v[s][j] = *(const f32x4*)(src + (lane + 64 * j) * 4); } }
#pragma unroll
        for (int s = 0; s < 2; ++s) if (ok[s]) {
            const int R = R0 + s * ngw, b = bb[s], p = pp[s]; const bool isctx = p < NCTX;
            const float* mrow = mods_l + (size_t)(isctx ? 16 : b) * 6144;
            float ss = 0.f;
#pragma unroll
            for (int j = 0; j < 4; ++j) ss += (v[s][j][0] * v[s][j][0] + v[s][j][1] * v[s][j][1]) + (v[s][j][2] * v[s][j][2] + v[s][j][3] * v[s][j][3]);
            const float rs = rsqrtf(wave_sum(ss) * (1.0f / DM) + EPS);
            const size_t orow = ffn_layout ? (size_t)b * U2B + (isctx ? p : 264 + p - NCTX) : (size_t)R;
#pragma unroll
            for (int j = 0; j < 4; ++j) { const int c4 = (lane + 64 * j) * 4;
                const f32x4 gg = *(const f32x4*)(g + c4), sh = *(const f32x4*)(mrow + shift_idx * 1024 + c4), sc = *(const f32x4*)(mrow + scale_idx * 1024 + c4);
                const f32x4 y = v[s][j] * rs * gg * (sc + 1.0f) + sh;
                u32x2 w; w.x = cvt_pk_bf16(y[0], y[1]); w.y = cvt_pk_bf16(y[2], y[3]);
                *(u32x2*)(U + orow * DM + c4) = w;
                if (ffn_layout && !isctx && p - NCTX >= SEQ - 33) *(u32x2*)(U + ((size_t)TAILROW0 + (b / 7) * 256 + (b % 7) * TAILSEG + (p - NCTX - (SEQ - 33))) * DM + c4) = w; }
        }
    }
    if (ffn_layout && gw >= 32 && gw < 48) {
        const int tb_ = gw - 32; const size_t orow = (size_t)TAILROW0 + (tb_ / 7) * 256 + (tb_ % 7) * TAILSEG + 33;
#pragma unroll
        for (int j = 0; j < 4; ++j) *(u32x2*)(U + orow * DM + (lane + 64 * j) * 4) = (u32x2){0u, 0u};
    }
    if (ffn_layout && gw < 32) {
        const int b = gw >> 1; const size_t orow = (size_t)b * U2B + ((gw & 1) ? 264 + SEQ : 263);
#pragma unroll
        for (int j = 0; j < 4; ++j) *(u32x2*)(U + orow * DM + (lane + 64 * j) * 4) = (u32x2){0u, 0u};
    }
}

template <int NF> __device__ __forceinline__ void rope_cs(int pos, int i, float& cs, float& sn) {
    const int row = pos >> 6, col = pos & 63; const int f = i < NF ? i : i - NF;
    const float inv = exp2f(-(float)f * (13.287712379549449f / NF));
    const float ang = (float)(i < NF ? row : col) * inv;
    sincosf(ang, &sn, &cs);
}

__device__ __forceinline__ void unpack8(const u32x4 v, float (&x)[8]) {
#pragma unroll
    for (int i = 0; i < 4; ++i) { x[2 * i] = bflo(v[i]); x[2 * i + 1] = bfhi(v[i]); }
}
__device__ __forceinline__ u32x4 pack8f(const float (&x)[8]) { u32x4 o; o.x = cvt_pk_bf16(x[0], x[1]); o.y = cvt_pk_bf16(x[2], x[3]); o.z = cvt_pk_bf16(x[4], x[5]); o.w = cvt_pk_bf16(x[6], x[7]); return o; }

__device__ __forceinline__ void ew_even(const Ctx& a, int j, int gw, int ngw, int lane) {
    const bf16_t* H = (const bf16_t*)(a.ws + WS_H); bf16_t* Qb = (bf16_t*)(a.ws + WS_Q); bf16_t* KVb = (bf16_t*)(a.ws + WS_KV); bf16_t* Kout = (bf16_t*)(a.ws + WS_U);
    const float QS = 0.10206207261596577f * LOG2E;
    const f32x2v* ropeT = (const f32x2v*)(a.ws + WS_ROPE_E);
    const int g16 = lane >> 4, c16 = lane & 15; const bool act = c16 < 12; const int cc = act ? c16 : 0;
    float qg[8], kg[8];
#pragma unroll
    for (int e = 0; e < 8; ++e) { qg[e] = a.inp(I_QG)[j * 96 + 8 * cc + e]; kg[e] = a.inp(I_KG)[j * 96 + 8 * cc + e]; }
    for (int R = gw; R < T; R += ngw) {
        const int p = R % TB; const int pos = p - NCTX; const bool lat = pos >= 0;
        const bf16_t* hrow = H + (size_t)R * 768; bf16_t* qrow = Qb + (size_t)R * 1536; bf16_t* kvrow = KVb + (size_t)R * 1536;
        const u32x4 z4 = {0u, 0u, 0u, 0u};
        u32x4 hv = z4; if (lane < 48) hv = *(const u32x4*)(hrow + 8 * lane);
        u32x4 qv[3], kv[3], vv[2];
#pragma unroll
        for (int rd = 0; rd < 3; ++rd) { const int hd = 4 * rd + g16; qv[rd] = z4; kv[rd] = z4;
            if (act) { qv[rd] = *(const u32x4*)(qrow + hd * 128 + 8 * c16); kv[rd] = c16 < 8 ? *(const u32x4*)(kvrow + hd * 128 + 8 * c16) : *(const u32x4*)(hrow + 384 + 8 * (c16 - 8)); } }
        vv[0] = *(const u32x4*)(kvrow + (lane >> 3) * 128 + 64 + 8 * (lane & 7)); vv[1] = z4;
        if (lane < 32) vv[1] = *(const u32x4*)(kvrow + ((lane + 64) >> 3) * 128 + 64 + 8 * (lane & 7));
        float cs[8], sn[8];
#pragma unroll
        for (int e = 0; e < 8; ++e) { cs[e] = 1.f; sn[e] = 0.f; }
        if (lat && c16 >= 8 && act) {
#pragma unroll
            for (int e = 0; e < 8; ++e) { const f32x2v t = ropeT[pos * 16 + 8 * (c16 & 1) + e]; cs[e] = t.x; sn[e] = t.y; } }
        float x[8]; unpack8(hv, x); float ss = 0.f;
#pragma unroll
        for (int e = 0; e < 8; ++e) ss += x[e] * x[e];
        ss = half_sum(ss);
        const float r_q = rsqrtf(__shfl(ss, 0) * (1.0f / 256.0f) + EPS), r_kv = rsqrtf(__shfl(ss, 32) * (1.0f / 128.0f) + EPS);
#pragma unroll
        for (int rd = 0; rd < 3; ++rd) {
            const int hd = 4 * rd + g16;
            { float y[8], o[8]; unpack8(qv[rd], y); float s2 = 0.f;
#pragma unroll
              for (int e = 0; e < 8; ++e) { y[e] *= r_q; s2 += y[e] * y[e]; }
              s2 += __shfl_xor(s2, 8); s2 += __shfl_xor(s2, 4); s2 += __shfl_xor(s2, 2); s2 += __shfl_xor(s2, 1);
              const float sc = rsqrtf(s2 * (1.0f / 96.0f) + EPS);
#pragma unroll
              for (int e = 0; e < 8; ++e) { y[e] *= sc * qg[e]; o[e] = __shfl_xor(y[e], 2); }
              if (c16 >= 8) {
#pragma unroll
                  for (int e = 0; e < 8; ++e) y[e] = c16 < 10 ? y[e] * cs[e] - o[e] * sn[e] : o[e] * sn[e] + y[e] * cs[e]; }
#pragma unroll
              for (int e = 0; e < 8; ++e) y[e] *= QS;
              if (act) *(u32x4*)(qrow + hd * 128 + 8 * c16) = pack8f(y); }
            { float y[8], o[8]; unpack8(kv[rd], y); float s2 = 0.f; const float pre = c16 < 8 ? r_kv : 1.0f;
#pragma unroll
              for (int e = 0; e < 8; ++e) { y[e] *= pre; s2 += y[e] * y[e]; }
              s2 += __shfl_xor(s2, 8); s2 += __shfl_xor(s2, 4); s2 += __shfl_xor(s2, 2); s2 += __shfl_xor(s2, 1);
              const float sc = rsqrtf(s2 * (1.0f / 96.0f) + EPS);
#pragma unroll
              for (int e = 0; e < 8; ++e) { y[e] *= sc * kg[e]; o[e] = __shfl_xor(y[e], 2); }
              if (c16 >= 8) {
#pragma unroll
                  for (int e = 0; e < 8; ++e) y[e] = c16 < 10 ? y[e] * cs[e] - o[e] * sn[e] : o[e] * sn[e] + y[e] * cs[e]; }
              if (act) *(u32x4*)(Kout + (size_t)R * 1152 + hd * 96 + 8 * c16) = pack8f(y); }
        }
        { float y[8]; unpack8(vv[0], y);
#pragma unroll
          for (int e = 0; e < 8; ++e) y[e] *= r_kv;
          *(u32x4*)(kvrow + (lane >> 3) * 128 + 64 + 8 * (lane & 7)) = pack8f(y);
          if (lane < 32) { unpack8(vv[1], y);
#pragma unroll
              for (int e = 0; e < 8; ++e) y[e] *= r_kv;
              *(u32x4*)(kvrow + ((lane + 64) >> 3) * 128 + 64 + 8 * (lane & 7)) = pack8f(y); } }
    }
}

__device__ __forceinline__ void z_fold(const Ctx& a, LAS unsigned char* lds, int gw, int ngw, int wave, int lane) {
    const bf16_t* ZLp = (const bf16_t*)(a.ws + WS_ZL); bf16_t* ZF = (bf16_t*)(a.ws + WS_ZF);
    LAS bf16_t* zr = (LAS bf16_t*)(lds + wave * 16384);
    for (int row = gw; row < 4096; row += ngw) {
        const bf16_t* src = ZLp + (size_t)row * 8192;
#pragma unroll
        for (int i = 0; i < 16; ++i) *(LAS u32x4*)(zr + 8 * (lane + 64 * i)) = *(const u32x4*)(src + 8 * (lane + 64 * i));
        asm volatile("s_waitcnt lgkmcnt(0)" ::: "memory");
#pragma unroll
        for (int i = 0; i < 8; ++i) { const int k0 = 8 * (lane + 64 * i); float y[8];
#pragma unroll
            for (int e = 0; e < 8; ++e) { const int kap = k0 + e; float v;
                if (kap <= 2048) { v = bf2f(zr[kap]); if (kap != 0 && kap != 2048) v += bf2f(zr[4096 - kap]); }
                else { const int l = kap - 2048; v = bf2f(zr[4096 + l]) - bf2f(zr[8192 - l]); }
                y[e] = v; }
            *(u32x4*)(ZF + (size_t)row * 4096 + k0) = pack8f(y); }
        asm volatile("s_waitcnt lgkmcnt(0)" ::: "memory");
    }
}

__device__ __forceinline__ void ew_odd(const Ctx& a, int j, int gw, int ngw, int lane) {
    bf16_t* H = (bf16_t*)(a.ws + WS_H); bf16_t* PO = (bf16_t*)(a.ws + WS_POOL);
    const float QS = 0.125f * LOG2E;
    const f32x2v* ropeT = (const f32x2v*)(a.ws + WS_ROPE_O);
    const int c8 = lane & 7, hl = lane >> 3;
    float qg[8], kg[8];
#pragma unroll
    for (int e = 0; e < 8; ++e) { qg[e] = a.inp(I_WQG)[j * 64 + 8 * c8 + e]; kg[e] = a.inp(I_WKG)[j * 64 + 8 * c8 + e]; }
    for (int R = gw; R < T; R += ngw) {
        const int p = R % TB; const int pos = p - NCTX; const bool lat = pos >= 0;
        bf16_t* hrow = H + (size_t)R * 1536;
        u32x4 qk[2]; qk[1] = (u32x4){0u, 0u, 0u, 0u}; if (lane >= 32) qk[1] = *(const u32x4*)(hrow + 512 + 8 * lane);
        float cs[8], sn[8];
#pragma unroll
        for (int e = 0; e < 8; ++e) { cs[e] = 1.f; sn[e] = 0.f; }
        if (lat) {
#pragma unroll
            for (int e = 0; e < 8; ++e) { const f32x2v t = ropeT[pos * 32 + 8 * (c8 & 3) + e]; cs[e] = t.x; sn[e] = t.y; } }
        const int tpos = lat ? pos : p, Ls = lat ? SEQ : NCTX;
        { const int pc = lane & 31, g = pc >> 3, half = 1 << g;
          const int lo = tpos - half < 0 ? 0 : tpos - half, hi = tpos + half > Ls ? Ls : tpos + half;
          float sum[8];
#pragma unroll
          for (int e = 0; e < 8; ++e) sum[e] = 0.f;
          if (lane < 32) {
              for (int tt = lo; tt < hi; ++tt) { float z[8]; unpack8(*(const u32x4*)(hrow + (ptrdiff_t)(tt - tpos) * 1536 + 1280 + 8 * pc), z);
#pragma unroll
                  for (int e = 0; e < 8; ++e) sum[e] += z[e]; }
              const float rc = 1.0f / (float)(hi - lo); float z[8]; unpack8(*(const u32x4*)(hrow + 1280 + 8 * pc), z);
#pragma unroll
              for (int e = 0; e < 8; ++e) sum[e] = sum[e] * rc - z[e];
              *(u32x4*)(PO + (size_t)R * 256 + 8 * pc) = pack8f(sum); } }
        if (lane >= 32) {
            float y[8], o[8]; unpack8(qk[1], y); float s2 = 0.f;
#pragma unroll
            for (int e = 0; e < 8; ++e) s2 += y[e] * y[e];
            s2 += __shfl_xor(s2, 4); s2 += __shfl_xor(s2, 2); s2 += __shfl_xor(s2, 1);
            const float sc = rsqrtf(s2 * (1.0f / 64.0f) + EPS);
#pragma unroll
            for (int e = 0; e < 8; ++e) { y[e] *= sc * kg[e]; o[e] = __shfl_xor(y[e], 4); }
#pragma unroll
            for (int e = 0; e < 8; ++e) y[e] = c8 < 4 ? y[e] * cs[e] - o[e] * sn[e] : o[e] * sn[e] + y[e] * cs[e];
            *(u32x4*)(hrow + 512 + 8 * lane) = pack8f(y);
        }
    }
}

#define XB_TMO      128
#define XB_XCNT(j)  (256  + 64 * (j))
#define XB_XSUB(j)  (1280 + 64 * (j))
#define XB_XGEN(j)  (2304 + 64 * (j))
#define XB_TOP      3328
#define XB_TOPGEN   3392
#define XCD_BAR_WORDS 3456
#define XB_SPIN_CAP (1u << 18)
__device__ __forceinline__ unsigned xb_ld(unsigned* p)              { return __hip_atomic_load(p, __ATOMIC_RELAXED, __HIP_MEMORY_SCOPE_AGENT); }
__device__ __forceinline__ unsigned xb_add(unsigned* p, unsigned v) { return __hip_atomic_fetch_add(p, v, __ATOMIC_RELAXED, __HIP_MEMORY_SCOPE_AGENT); }
__device__ __forceinline__ unsigned xb_xcc_id() { return (unsigned)__builtin_amdgcn_s_getreg((3 << 11) | 20) & 0xFu; }
#define XB_SPIN(cond, bar) do { unsigned _sp = 0; while (cond) { __builtin_amdgcn_s_sleep(1); \
    if ((++_sp & 255u) == 0u) { if (xb_ld(&(bar)[XB_TMO])) break; if (_sp > XB_SPIN_CAP) { atomicAdd(&(bar)[XB_TMO], 1u); break; } } } } while (0)
struct XcdBarrier { unsigned* bar; unsigned x; volatile LAS unsigned* st; };
__device__ __forceinline__ XcdBarrier xcd_barrier_post(unsigned* bar, volatile LAS unsigned* st) {
    XcdBarrier b; b.bar = bar; b.x = xb_xcc_id(); b.st = st;
    int tid_ = threadIdx.x; asm volatile("" : "+v"(tid_));
    if (tid_ == 0) (void)xb_add(&bar[XB_XCNT(b.x)], 1u);
    return b;
}
__device__ __forceinline__ void xcd_barrier_complete(unsigned* bar, unsigned x, unsigned& nloc, unsigned& nx) {
    const unsigned G = gridDim.x * gridDim.y * gridDim.z;
    unsigned sum, cnt, mine, sp = 0u;
    for (;;) {
        sum = 0u; cnt = 0u; mine = 0u;
#pragma unroll
        for (unsigned j = 0; j < 16; ++j) { const unsigned c = xb_ld(&bar[XB_XCNT(j)]); sum += c; cnt += (c > 0u) ? 1u : 0u; mine = (j == x) ? c : mine; }
        if (sum == G) break;
        __builtin_amdgcn_s_sleep(1);
        if ((++sp & 255u) == 0u) { if (xb_ld(&bar[XB_TMO])) break; if (sp > XB_SPIN_CAP) { atomicAdd(&bar[XB_TMO], 1u); break; } }
    }
    nloc = mine > 0u ? mine : 1u; nx = cnt > 0u ? cnt : 1u;
}
__device__ __forceinline__ void xcd_barrier(const XcdBarrier& b) {
    asm volatile("s_waitcnt vmcnt(0)" ::: "memory");
    __syncthreads();
    int tid_ = threadIdx.x; asm volatile("" : "+v"(tid_));
    if (tid_ == 0) {
        unsigned* bar = b.bar;
        __builtin_amdgcn_s_waitcnt(0);
        unsigned nloc = b.st[0], nx = b.st[1];
        if (nloc == 0u) { xcd_barrier_complete(bar, b.x, nloc, nx); b.st[0] = nloc; b.st[1] = nx; }
        const unsigned old = xb_add(&bar[XB_XSUB(b.x)], 1u);
        const unsigned gen = old / nloc;
        if (old + 1u == (gen + 1u) * nloc) {
            __builtin_amdgcn_fence(__ATOMIC_RELEASE, "agent");
            asm volatile("s_waitcnt vmcnt(0)" ::: "memory");
            const unsigned og = xb_add(&bar[XB_TOP], 1u);
            const unsigned tg = og / nx;
            if (og + 1u == (tg + 1u) * nx) xb_add(&bar[XB_TOPGEN], 1u);
            else XB_SPIN(xb_ld(&bar[XB_TOPGEN]) == tg, bar);
            __builtin_amdgcn_fence(__ATOMIC_ACQUIRE, "agent");
            xb_add(&bar[XB_XGEN(b.x)], 1u);
            asm volatile("s_waitcnt vmcnt(0)" ::: "memory");
        } else {
            XB_SPIN(xb_ld(&bar[XB_XGEN(b.x)]) == gen, bar);
            __builtin_amdgcn_fence(__ATOMIC_ACQUIRE, "agent");
            asm volatile("s_waitcnt vmcnt(0)" ::: "memory");
        }
    }
    __syncthreads();
}

constexpr int LDS_BYTES = 147456;
constexpr int NPHASES = 1 + 2 * 9 + 2 * 8;

__global__ void __launch_bounds__(512, 2) mega_fwd(Args ka) {
    extern __shared__ __attribute__((aligned(16))) unsigned char lds_raw[];
    LAS unsigned char* lds = (LAS unsigned char*)lds_raw;
    cg::grid_group grid = cg::this_grid();
    volatile LAS unsigned* xbst = (volatile LAS unsigned*)(lds + 139264);
    { int tid_ = threadIdx.x; asm volatile("" : "+v"(tid_)); if (tid_ < 2) xbst[tid_] = 0u; }
    __syncthreads();
    XcdBarrier xbar; xbar.bar = (unsigned*)ka.ws; xbar.x = 0; xbar.st = xbst;
    if (ka.hi - ka.lo > 1) xbar = xcd_barrier_post((unsigned*)ka.ws, xbst);
#define U ((bf16_t*)(wsl + WS_U))
#define MIX ((bf16_t*)(wsl + WS_MIX))
#define Hb ((bf16_t*)(wsl + WS_H))
#define Qb ((bf16_t*)(wsl + WS_Q))
#define KVb ((bf16_t*)(wsl + WS_KV))
#define ZL ((bf16_t*)(wsl + WS_ZL))
#define ZC ((bf16_t*)(wsl + WS_ZC))
#define HID ((bf16_t*)(wsl + WS_HID))
#define POOL ((bf16_t*)(wsl + WS_POOL))
#define DFTL ((bf16_t*)(wsl + WS_DFTL))
#define DFTC ((bf16_t*)(wsl + WS_DFTC))
#define hctx ((float*)(wsl + WS_HCTX))
    int ph = 0, layer_ = 0;
#define PHASE_BEGIN if (ph >= ka.lo && ph < ka.hi) { GAS unsigned char* wsg_ = (GAS unsigned char*)ka.ws; asm volatile("" : "+s"(wsg_)); unsigned char* wsl = (unsigned char*)wsg_; \
        const __attribute__((address_space(4))) cfp_t* ain_ = (const __attribute__((address_space(4))) cfp_t*)__builtin_amdgcn_kernarg_segment_ptr(); asm volatile("" : "+s"(ain_)); \
        const Ctx a{ain_, ka.out, wsl}; \
        int lyr_ = layer_; asm volatile("" : "+s"(lyr_)); const float* mods_l = (const float*)(wsl + WS_MODS) + (size_t)lyr_ * 17 * 6144; const float* xin = lyr_ == 0 ? a.inp(I_X) : a.out; const float* cin = lyr_ == 0 ? a.inp(I_CTX) : (const float*)(wsl + WS_HCTX); (void)mods_l; (void)xin; (void)cin; int tid = threadIdx.x; asm volatile("" : "+v"(tid)); int G = gridDim.x, bx = blockIdx.x; asm volatile("" : "+s"(G), "+s"(bx)); \
        const int vcu = (G % 8 == 0) ? (bx % 8) * (G / 8) + bx / 8 : bx, ngw = G * 8, ngt = G * 512; (void)vcu; (void)ngw; (void)ngt; \
        const int lane = tid & 63, wave = __builtin_amdgcn_readfirstlane(tid >> 6), gw = bx * 8 + wave, gtid = bx * 512 + tid; LAS float* scr = (LAS float*)(lds + wave * 8448); \
        (void)lane; (void)gw; (void)gtid; (void)scr;
#define PHASE_END } if (ph >= ka.lo && ph + 1 < ka.hi) { for (int sr_ = 0; sr_ < REP_SYNC; ++sr_) { if (ph == 0) grid.sync(); else xcd_barrier(xbar); } } ++ph;

    PHASE_BEGIN
#ifndef SKIP_P0
        { REPLOOP(REP_P0) {
        for (int it = bx; it < 192; it += G) mods_item(a, it, (LAS float*)lds);
        for (int j = 0; j < 2; ++j) {
            tr_job(a.inp(I_MLAWIN) + (size_t)j * DM * 672, DM, 672, (bf16_t*)(wsl + WS_WINE) + (size_t)j * 768 * DM, 768, 1, nullptr, scr, gw, ngw, lane);
            tr_job(a.inp(I_WUQ) + (size_t)j * 256 * 1152, 256, 1152, (bf16_t*)(wsl + WS_WUQ) + (size_t)j * 1536 * 256, 1536, 2, a.inp(I_CQG) + j * 256, scr, gw, ngw, lane);
            tr_job(a.inp(I_WUKV) + (size_t)j * 128 * 1536, 128, 1536, (bf16_t*)(wsl + WS_WUKV) + (size_t)j * 1536 * 128, 1536, 0, a.inp(I_CKVG) + j * 128, scr, gw, ngw, lane);
            tr_job(a.inp(I_EWOUT) + (size_t)j * DM * DM, DM, DM, (bf16_t*)(wsl + WS_WOUTE) + (size_t)j * DM * DM, DM, 0, nullptr, scr, gw, ngw, lane);
            tr_job(a.inp(I_WINWIN) + (size_t)j * DM * 1536, DM, 1536, (bf16_t*)(wsl + WS_WINO) + (size_t)j * 1536 * DM, 1536, 0, nullptr, scr, gw, ngw, lane);
            tr_job(a.inp(I_OWOUT) + (size_t)j * DM * DM, DM, DM, (bf16_t*)(wsl + WS_WOUTO) + (size_t)j * DM * DM, DM, 0, nullptr, scr, gw, ngw, lane);
        }
        ffn_weights(a, 0, scr, gw, ngw, lane);
        __syncthreads();
        LAS float* ctab = (LAS float*)lds;
        for (int m = tid; m < 4096; m += 512) ctab[m] = cospif((float)m * (1.0f / 2048.0f)) * (1.0f / 64.0f);
        __syncthreads();
        for (int idx = gtid; idx < 4096 * 512; idx += ngt) { const int k = idx >> 9, col0 = (idx & 511) * 8; float v[8];
#pragma unroll
            for (int e = 0; e < 8; ++e) { const int kap = col0 + e; const int m = kap <= 2048 ? (k * kap) & 4095 : (k * (kap - 2048) + 1024) & 4095; v[e] = ctab[m]; }
            u32x4 o; o.x = cvt_pk_bf16(v[0], v[1]); o.y = cvt_pk_bf16(v[2], v[3]); o.z = cvt_pk_bf16(v[4], v[5]); o.w = cvt_pk_bf16(v[6], v[7]);
            *(u32x4*)(DFTL + (size_t)k * 4096 + col0) = o; }
        for (int idx = gtid; idx < 256 * 64; idx += ngt) { const int k = idx >> 6, col0 = (idx & 63) * 8, cs = col0 >> 8, l0 = col0 & 255; float v[8];
#pragma unroll
            for (int e = 0; e < 8; ++e) { const int m = (k * (l0 + e)) & 255; const float x = (float)m * (1.0f / 128.0f); v[e] = (cs ? -sinpif(x) : cospif(x)) * (1.0f / 16.0f); }
            u32x4 o; o.x = cvt_pk_bf16(v[0], v[1]); o.y = cvt_pk_bf16(v[2], v[3]); o.z = cvt_pk_bf16(v[4], v[5]); o.w = cvt_pk_bf16(v[6], v[7]);
            *(u32x4*)(DFTC + (size_t)k * 512 + col0) = o; }
        for (int idx = gtid; idx < 2 * 512 * 256; idx += ngt) { const int j = idx >> 17, n = (idx >> 8) & 511, k = idx & 255; const int cs = n >> 8, g = (n >> 6) & 3, d = n & 63, g2 = k >> 6, c = k & 63;
            float s = 0.f;
            if (g2 == g) { const float* wf = a.inp(I_FNETW) + ((size_t)(j * 4 + g) * 64) * 64 + d;
                for (int c2 = 0; c2 < 64; ++c2) { const int m = (c * c2) & 63; s += (cs ? -ctab[(m * 64 + 1024) & 4095] : ctab[m * 64]) * wf[c2 * 64]; }
                s *= 8.0f; }
            ((bf16_t*)(wsl + WS_WF))[idx] = (bf16_t)(cvt_pk_bf16(s, 0.f) & 0xffffu); }
        for (int idx = gtid; idx < 4096 * 16; idx += ngt) { float cs, sn; rope_cs<8>(idx >> 4, idx & 15, cs, sn); ((f32x2v*)(wsl + WS_ROPE_E))[idx] = (f32x2v){cs, sn}; }
        for (int idx = gtid; idx < 4096 * 32; idx += ngt) { float cs, sn; rope_cs<16>(idx >> 5, idx & 31, cs, sn); ((f32x2v*)(wsl + WS_ROPE_O))[idx] = (f32x2v){cs, sn}; }
        for (int idx = gtid; idx < 2 * 256 * 256; idx += ngt) { const int j = idx >> 16, n = (idx >> 8) & 255, k = idx & 255; const int g = n >> 6, d = n & 63, g2 = k >> 6, c = k & 63;
            float s = 0.f; if (g2 == g) s = a.inp(I_POOLW)[((size_t)(j * 4 + g) * 64 + c) * 64 + d] * a.inp(I_POOLS)[j * 256 + n];
            ((bf16_t*)(wsl + WS_WP))[idx] = (bf16_t)(cvt_pk_bf16(s, 0.f) & 0xffffu); }
        __syncthreads(); } }
#endif
    PHASE_END

    for (int layer = 0; layer < 4; ++layer) {
        const int j = layer >> 1; const bool even = !(layer & 1); const bool ctx_out = layer < 3;
        layer_ = layer;

        PHASE_BEGIN
#ifndef SKIP_NORM
            { REPLOOP(REP_NORM)
            norm_pass(xin, cin, a.inp(I_N1G) + layer * DM, mods_l, 0, 1, U, false, false, gw, ngw, lane); }
#endif
        PHASE_END

        PHASE_BEGIN
#ifndef SKIP_GIN
            { REPLOOP(REP_GIN) {
            if (even) { pg8::Gemm g{U, (const bf16_t*)(wsl + WS_WINE) + (size_t)j * 768 * DM, DM, DM, DM};
                pg8::Order<pg8::MapStd> S; S.init(T / 256, 3, G, bx, pg8::MapStd{0}); pg8::EpiBf16 E{Hb, 768, Hb, 768}; pg8::gemm_phase(lds, g, S, E); }
            else { pg8::Gemm g{U, (const bf16_t*)(wsl + WS_WINO) + (size_t)j * 1536 * DM, DM, DM, DM};
                pg8::Order<pg8::MapStd> S; S.init(T / 256, 6, G, bx, pg8::MapStd{0}); pg8::EpiBf16 E{Hb, 1536, Hb, 1536}; pg8::gemm_phase(lds, g, S, E); }
            } }
#endif
        PHASE_END

        if (even) {
            PHASE_BEGIN
#ifndef SKIP_G3
                { REPLOOP(REP_G3) {
                { pg8::Gemm g{Hb, (const bf16_t*)(wsl + WS_WUQ) + (size_t)j * 1536 * 256, 768, 256, 256};
                  pg8::Order<pg8::MapStd> S; S.init(T / 256, 6, G, bx, pg8::MapStd{0}); pg8::EpiBf16 E{Qb, 1536, Qb, 1536}; pg8::gemm_phase(lds, g, S, E); }
                { pg8::Gemm g{Hb + 256, (const bf16_t*)(wsl + WS_WUKV) + (size_t)j * 1536 * 128, 768, 128, 128};
                  pg8::Order<pg8::MapStd> S; S.init(T / 256, 6, G, bx, pg8::MapStd{0}); pg8::EpiBf16 E{KVb, 1536, KVb, 1536}; pg8::gemm_phase(lds, g, S, E); }
                { pg8::Gemm g{(const bf16_t*)(wsl + WS_WF) + (size_t)j * 512 * 256, Hb + 416, 256, 768, 256};
                  pg8::Order<pg8::MapZ> S; S.init(2, T / 256, G, bx, pg8::MapZ{}); pg8::EpiBf16 E{ZL, 8192, ZC, 512}; pg8::gemm_phase(lds, g, S, E); }
                } }
#endif
            PHASE_END
            PHASE_BEGIN
#ifndef SKIP_EWE
                ew_even(a, j, gw, ngw, lane);
                z_fold(a, lds, gw, ngw, wave, lane);
#endif
            PHASE_END
            PHASE_BEGIN
#ifndef SKIP_ATTE
                const bf16_t* Kb = (const bf16_t*)(wsl + WS_U);
                const int nu = 3072 + (ctx_out ? 192 : 0);
                { REPLOOP(REP_ATTE)
                for (int uid = vcu; uid < nu; uid += G) {
                    if (uid < 3072) { const int bh = uid >> 4, qb = uid & 15, b = bh / 12, h = bh % 12; const size_t base = (size_t)b * TB, qrow = base + NCTX + qb * 256;
                        attn_unit<96, false>(lds, Qb + qrow * 1536 + h * 128, 1536, Kb + base * 1152 + h * 96, 1152, KVb + base * 1536 + h * 128 + 64, 1536, MIX + qrow * DM + h * 64, 68, 0, 0, 0, -1e30f, false); }
                    else { const int bh = uid - 3072, b = bh / 12, h = bh % 12; const size_t base = (size_t)b * TB;
                        attn_unit<96, false>(lds, Qb + base * 1536 + h * 128, 1536, Kb + base * 1152 + h * 96, 1152, KVb + base * 1536 + h * 128 + 64, 1536, MIX + base * DM + h * 64, 4, 0, 0, 0, -1e30f, false); }
                } }
#ifndef SKIP_ATTE_G
                { REPLOOP(REP_FNET) {
                { pg8::Gemm g{DFTL, (const bf16_t*)(wsl + WS_ZF), 4096, 4096, 4096};
                  pg8::Order<pg8::MapFnetL> S; S.init(256, 1, G, bx, pg8::MapFnetL{}); pg8::EpiBf16 E{MIX, DM, MIX, DM}; pg8::gemm_phase(lds, g, S, E); }
                if (ctx_out) { pg8::Gemm g{DFTC, ZC, 512, 512, 512};
                  pg8::Order<pg8::MapFnetC> S; S.init(16, 1, G, bx, pg8::MapFnetC{}); pg8::EpiBf16 E{MIX, DM, MIX, DM}; pg8::gemm_phase(lds, g, S, E); }
                } }
#endif
#endif
            PHASE_END
        } else {
            PHASE_BEGIN
#ifndef SKIP_EWO
                ew_odd(a, j, gw, ngw, lane);
#endif
            PHASE_END
            PHASE_BEGIN
#ifndef SKIP_ATTO
                const float* sink = a.inp(I_SINK) + j * 12;
                const int nu = 3072 + (ctx_out ? 192 : 0);
                { REPLOOP(REP_ATTO)
                for (int uid = vcu; uid < nu; uid += G) {
                    if (uid < 3072) { const int bh = uid >> 4, qb = uid & 15, b = bh / 12, h = bh % 12, kvh = h / 3; const size_t base = (size_t)b * TB, qrow = base + NCTX + qb * 256;
                        int lt0 = qb * 4 - 2, lt1 = qb * 4 + 6; if (lt0 < 0) lt0 = 0; if (lt1 > 64) lt1 = 64;
                        attn_unit<64, true>(lds, Hb + qrow * 1536 + h * 64, 1536, Hb + base * 1536 + 768 + kvh * 64, 1536, Hb + base * 1536 + 1024 + kvh * 64, 1536, MIX + qrow * DM + h * 64,
                                            4, 4 + lt0, 4 + lt1, qb * 256, sink[h] * LOG2E, true, a.inp(I_WQG) + j * 64, (const f32x2v*)(wsl + WS_ROPE_O), true); }
                    else { const int bh = uid - 3072, b = bh / 12, h = bh % 12, kvh = h / 3; const size_t base = (size_t)b * TB;
                        attn_unit<64, true>(lds, Hb + base * 1536 + h * 64, 1536, Hb + base * 1536 + 768 + kvh * 64, 1536, Hb + base * 1536 + 1024 + kvh * 64, 1536, MIX + base * DM + h * 64,
                                            4, 0, 0, 0, sink[h] * LOG2E, true, a.inp(I_WQG) + j * 64, (const f32x2v*)(wsl + WS_ROPE_O), false); }
                } }
                { pg8::Gemm g{POOL, (const bf16_t*)(wsl + WS_WP) + (size_t)j * 256 * 256, 256, 256, 256};
                  pg8::Order<pg8::MapStd> S; S.init(T / 256, 1, G, bx, pg8::MapStd{768}); pg8::EpiBf16 E{MIX, DM, MIX, DM}; pg8::gemm_phase(lds, g, S, E); }
#endif
            PHASE_END
        }

        PHASE_BEGIN
#ifndef SKIP_WOUT
            pg8::Gemm g{MIX, (const bf16_t*)(wsl + (even ? WS_WOUTE : WS_WOUTO)) + (size_t)j * DM * DM, DM, DM, DM};
            pg8::Order<pg8::MapRes> S; S.init(ctx_out ? 272 : 256, 4, G, bx, pg8::MapRes{ctx_out ? 1 : 0});
            { REPLOOP(REP_WOUT) { pg8::EpiRes E{rep_ ? (const float*)a.out : xin, a.out, rep_ ? (const float*)hctx : cin, hctx, mods_l, 2, rep_ ? 0.f : 1.f}; pg8::gemm_phase(lds, g, S, E); } }
#endif
        PHASE_END

        PHASE_BEGIN
#ifndef SKIP_NORM2
            { REPLOOP(REP_NORM)
            norm_pass(a.out, hctx, a.inp(I_N2G) + layer * DM, mods_l, 3, 4, U, true, !ctx_out, gw, ngw, lane); }
#endif
        PHASE_END

        PHASE_BEGIN
#ifndef SKIP_UP
            pg8::Gemm g{U, (const bf16_t*)(wsl + WS_WUP), DM, DM, DM};
            pg8::Order<pg8::MapUp> S; S.init(ctx_out ? 275 : 259, 22, G, bx, pg8::MapUp{ctx_out ? 1 : 0});
            pg8::EpiUp E{HID, a.inp(I_CONVW) + (size_t)layer * 3 * 2 * DFF, a.inp(I_CONVB) + (size_t)layer * 2 * DFF}; { REPLOOP(REP_UP) pg8::gemm_phase(lds, g, S, E); }
#endif
        PHASE_END

        PHASE_BEGIN
#ifndef SKIP_DN
            pg8::Gemm g{HID, (const bf16_t*)(wsl + ((layer & 1) ? WS_WDN2 : WS_WDN)), DFF, DFF, DFF};
            pg8::Order<pg8::MapRes> S; S.init(ctx_out ? 272 : 256, 4, G, bx, pg8::MapRes{ctx_out ? 1 : 0});
            { REPLOOP(REP_DN) { pg8::EpiRes E{a.out, a.out, hctx, hctx, mods_l, 5, rep_ ? 0.f : 1.f}; pg8::gemm_phase(lds, g, S, E); } }
            if (layer < 3) {
                const int nfree = (ctx_out && G == 256) ? 192 : G, first = (ctx_out && G == 256) ? 64 : 0;
                if (bx >= first) ffn_weights(a, layer + 1, scr, (bx - first) * 8 + wave, nfree * 8, lane);
            }
#endif
        PHASE_END
    }
#undef PHASE_BEGIN
#undef PHASE_END
#undef U
#undef MIX
#undef Hb
#undef Qb
#undef KVb
#undef ZL
#undef ZC
#undef HID
#undef POOL
#undef DFTL
#undef DFTC
#undef hctx
}

extern "C" void kernel_launch(void* const* d_in, const int* in_sizes, int n_in, void* d_out, int out_size, void* d_ws, size_t ws_size, hipStream_t stream) {
    static int grid = 0;
    if (grid == 0) {
        if (n_in != 28 || out_size != NB * SEQ * DM || ws_size < WS_END) { fprintf(stderr, "kernel_launch: unexpected shapes (n_in %d, out %d, ws %zu); nothing launched\n", n_in, out_size, ws_size); grid = -1; return; }
        int dev = 0, cus = 0, per_cu = 0;
        if (hipGetDevice(&dev) != hipSuccess || hipDeviceGetAttribute(&cus, hipDeviceAttributeMultiprocessorCount, dev) != hipSuccess) { grid = -1; return; }
        if (hipFuncSetAttribute((const void*)mega_fwd, hipFuncAttributeMaxDynamicSharedMemorySize, LDS_BYTES) != hipSuccess) { fprintf(stderr, "kernel_launch: hipFuncSetAttribute failed\n"); grid = -1; return; }
        if (hipOccupancyMaxActiveBlocksPerMultiprocessor(&per_cu, (const void*)mega_fwd, 512, LDS_BYTES) != hipSuccess || per_cu < 1) { fprintf(stderr, "kernel_launch: occupancy query says %d\n", per_cu); per_cu = 1; }
        (void)hipGetLastError();
        grid = cus * 1;
    }
    if (grid < 0) return;
    Args a{};
    for (int i = 0; i < 28; ++i) a.in[i] = (const float*)d_in[i];
    a.out = (float*)d_out; a.ws = (unsigned char*)d_ws; a.lo = 0; a.hi = NPHASES;
    (void)hipMemsetAsync(d_ws, 0, 16384, stream);
    void* args[] = {&a};
    hipError_t e = hipLaunchCooperativeKernel((const void*)mega_fwd, dim3(grid), dim3(512), args, LDS_BYTES, stream);
    if (e != hipSuccess) {
        fprintf(stderr, "kernel_launch: cooperative launch failed: %s (grid %d); falling back to one launch per phase\n", hipGetErrorString(e), grid);
        (void)hipGetLastError();
        for (int p = 0; p < NPHASES; ++p) { a.lo = p; a.hi = p + 1; hipLaunchKernelGGL(mega_fwd, dim3(grid), dim3(512), LDS_BYTES, stream, a); }
    }
}
```

```cpp
#include <hip/hip_runtime.h>
#include <hip/hip_cooperative_groups.h>
#include <cstdio>
#include <cstdint>
namespace cg = cooperative_groups;

#define REP_NORM 1
#define REP_GIN 1
#define REP_G3 1
#define REP_ATTE 1
#define REP_FNET 1
#define REP_ATTO 1
#define REP_WOUT 1
#define REP_UP 1
#define REP_DN 1
#define REP_P0 1
#define REP_EW 1
#define REP_SYNC 1
#define PROBE_MODE 0
#define REPLOOP(N) int nrep_ = (N); asm volatile("" : "+s"(nrep_)); for (int rep_ = 0; rep_ < nrep_; ++rep_)

constexpr int NB = 16, SEQ = 4096, NCTX = 256, DM = 1024, TB = SEQ + NCTX, T = NB * TB;
constexpr int DFF = 2816, U2B = 4608, TAILROW0 = 16 * 4608, TAILSEG = 34;
constexpr float EPS = 1e-6f;
constexpr float LOG2E = 1.4426950408889634f;

constexpr size_t MiB = 1u << 20;
constexpr size_t WS_MODS = 1 * MiB;
constexpr size_t WS_WINE = 3 * MiB;
constexpr size_t WS_WUQ = 6 * MiB;
constexpr size_t WS_WUKV = WS_WUQ + 3 * MiB / 2;
constexpr size_t WS_WF = WS_WUKV + 3 * MiB / 4;
constexpr size_t WS_WP = WS_WF + MiB / 2;
constexpr size_t WS_WOUTE = 9 * MiB;
constexpr size_t WS_WOUTO = 13 * MiB;
constexpr size_t WS_WINO = 17 * MiB;
constexpr size_t WS_WUP = 23 * MiB;
constexpr size_t WS_WDN = 34 * MiB;
constexpr size_t WS_DFTC = 40 * MiB;
constexpr size_t WS_DFTL = 41 * MiB;
constexpr size_t WS_ZF = 73 * MiB;
constexpr size_t WS_HCTX = 105 * MiB;
constexpr size_t WS_U = 121 * MiB;
constexpr size_t WS_MIX = 275 * MiB;
constexpr size_t WS_ARENA = 411 * MiB;
constexpr size_t WS_H = WS_ARENA;
constexpr size_t WS_Q = WS_ARENA + 102 * MiB;
constexpr size_t WS_KV = WS_Q + 204 * MiB;
constexpr size_t WS_ZL = WS_KV + 204 * MiB;
constexpr size_t WS_ZC = WS_ZL + 64 * MiB;
constexpr size_t WS_POOL = WS_ARENA + 204 * MiB;
constexpr size_t WS_HID = WS_ARENA;
constexpr size_t WS_ROPE_E = WS_ZC + 4 * MiB;
constexpr size_t WS_ROPE_O = WS_ROPE_E + 1 * MiB;
constexpr size_t WS_WDN2 = WS_ROPE_O + 1 * MiB;
constexpr size_t WS_END = WS_WDN2 + 6 * MiB;
static_assert(WS_END <= 1024 * MiB, "ws map");

#define LAS __attribute__((address_space(3)))
#define GAS __attribute__((address_space(1)))
typedef unsigned short bf16_t;
typedef short bf16x8 __attribute__((ext_vector_type(8)));
typedef float f32x4 __attribute__((ext_vector_type(4)));
typedef float f32x16 __attribute__((ext_vector_type(16)));
typedef unsigned u32x4 __attribute__((ext_vector_type(4)));
typedef unsigned u32x2 __attribute__((ext_vector_type(2)));
typedef float f32x2v __attribute__((ext_vector_type(2)));

__device__ __forceinline__ unsigned cvt_pk_bf16(float lo, float hi) { unsigned r; asm volatile("v_cvt_pk_bf16_f32 %0, %1, %2" : "=v"(r) : "v"(lo), "v"(hi)); return r; }
__device__ __forceinline__ float bflo(unsigned u) { return __uint_as_float(u << 16); }
__device__ __forceinline__ float bfhi(unsigned u) { return __uint_as_float(u & 0xffff0000u); }
__device__ __forceinline__ float bf2f(bf16_t b) { return __uint_as_float((unsigned)b << 16); }
__device__ __forceinline__ float wave_sum(float v) {
#pragma unroll
    for (int o = 1; o < 64; o <<= 1) v += __shfl_xor(v, o);
    return v;
}
__device__ __forceinline__ float half_sum(float v) {
#pragma unroll
    for (int o = 1; o < 32; o <<= 1) v += __shfl_xor(v, o);
    return v;
}

namespace pg8 {
constexpr int BM = 256, BK = 64, HALF = 128, HTB = HALF * BK * 2, STAGE_BYTES = 8 * HTB, NXCD = 8, WGM = 8;
__device__ __forceinline__ int lds_byte(int r, int c) { const int st = (r >> 4) * 2 + (c >> 5), rr = r & 15, cc = c & 31, ob = rr * 64 + cc * 2; return st * 1024 + (ob ^ (((ob >> 9) & 1) << 5)); }
__device__ __forceinline__ void stage_rc(int b, int& R, int& C) { const int st = b / 1024, sb = b % 1024, swz = sb ^ (((sb >> 9) & 1) << 5); R = (st >> 1) * 16 + swz / 64; C = (st & 1) * 32 + (swz % 64) / 2; }
__device__ __forceinline__ int perm32(int rho) { const int n = rho >> 4, i = rho & 15; return 8 * (i >> 2) + 4 * n + (i & 3); }

struct Unit { int pm, pn, arow, brow, orow, ocol, aux, bt; };
struct Gemm { const bf16_t* A; const bf16_t* Bt; int lda, ldb, K; };

template <class Map> struct Order {
    int nM, nN, nwg, G, c; Map map;
    __device__ __forceinline__ void init(int nM_, int nN_, int G_, int c_, const Map& m) { nM = nM_; nN = nN_; nwg = nM * nN; G = G_; c = c_; map = m; }
    __device__ __forceinline__ bool next(int i, Unit& u) const {
        const long L = (long)i * G + c; if (L >= nwg) return false;
        int wgid = (int)L; { const int q = nwg / NXCD, r = nwg % NXCD, xcd = wgid % NXCD, off = wgid / NXCD; wgid = (xcd < r ? xcd * (q + 1) : r * (q + 1) + (xcd - r) * q) + off; }
        const int nig = WGM * nN, gid = wgid / nig, fm = gid * WGM, gsz = (nM - fm) < WGM ? (nM - fm) : WGM;
        u.pm = fm + ((wgid % nig) % gsz); u.pn = (wgid % nig) / gsz; map(u); return true;
    }
};

struct EpiBf16 {
    static constexpr bool PERM = true;
    bf16_t* O0; int ld0; bf16_t* O1; int ld1;
    __device__ __forceinline__ void operator()(const f32x4 (&acc)[2][2][4][2], const Unit& u, int wr, int wc, int fr, int fq, LAS unsigned char*) const {
        bf16_t* base = u.aux ? O1 : O0; const int ldc = u.aux ? ld1 : ld0;
        const int row0 = u.orow + wr * 64 + fr, col0 = u.ocol + wc * 32 + 8 * fq;
#pragma unroll
        for (int ai = 0; ai < 2; ++ai)
#pragma unroll
            for (int m = 0; m < 4; ++m) { bf16_t* rowp = base + (size_t)(row0 + ai * HALF + m * 16) * ldc + col0;
#pragma unroll
                for (int bj = 0; bj < 2; ++bj) { const f32x4 v0 = acc[ai][bj][m][0], v1 = acc[ai][bj][m][1];
                    u32x4 w; w.x = cvt_pk_bf16(v0[0], v0[1]); w.y = cvt_pk_bf16(v0[2], v0[3]); w.z = cvt_pk_bf16(v1[0], v1[1]); w.w = cvt_pk_bf16(v1[2], v1[3]);
                    *(u32x4*)(rowp + bj * HALF) = w; } }
    }
};

struct EpiRes {
    static constexpr bool PERM = false;
    const float* xin; float* xout; const float* cin; float* cout; const float* mods_l; int gidx; float gs;
    __device__ __forceinline__ void operator()(const f32x4 (&acc)[2][2][4][2], const Unit& u, int wr, int wc, int fr, int fq, LAS unsigned char*) const {
        const float* src = u.aux ? cin : xin; float* dst = u.aux ? cout : xout;
        const float* gate = mods_l + (size_t)(u.aux ? 16 : u.bt) * 6144 + gidx * 1024;
        const int row0 = u.orow + wr * 64 + fr, col0 = u.ocol + wc * 32 + 4 * fq;
        const __amdgpu_buffer_rsrc_t rs = __builtin_amdgcn_make_buffer_rsrc((void*)dst, 0, 0x40000000, 0x00020000);
#pragma unroll
        for (int bj = 0; bj < 2; ++bj)
#pragma unroll
            for (int n = 0; n < 2; ++n) { const int col = col0 + bj * HALF + n * 16; const f32x4 g4 = *(const f32x4*)(gate + col) * gs;
#pragma unroll
                for (int ai = 0; ai < 2; ++ai)
#pragma unroll
                    for (int m = 0; m < 4; ++m) { const size_t off = (size_t)(row0 + ai * HALF + m * 16) * DM + col;
                        const f32x4 x4 = *(const f32x4*)(src + off); __builtin_amdgcn_raw_buffer_store_b128(__builtin_bit_cast(u32x4, x4 + g4 * acc[ai][bj][m][n]), rs, (unsigned)(off * 4), 0, 16); } }
    }
};

__device__ __forceinline__ float dpp_ror1(float v) { return __int_as_float(__builtin_amdgcn_update_dpp(__float_as_int(v), __float_as_int(v), 0x121, 0xf, 0xf, false)); }
__device__ __forceinline__ float dpp_ror15(float v) { return __int_as_float(__builtin_amdgcn_update_dpp(__float_as_int(v), __float_as_int(v), 0x12F, 0xf, 0xf, false)); }
__device__ __forceinline__ float silu_f(float x) { return x * __builtin_amdgcn_rcpf(1.0f + __expf(-x)); }

struct EpiUp {
    static constexpr bool PERM = false;
    bf16_t* Hd; const float* cw; const float* cb;
    __device__ __forceinline__ void operator()(const f32x4 (&acc)[2][2][4][2], const Unit& u, int wr, int wc, int fr, int fq, LAS unsigned char* lds) const {
        LAS float* hal = (LAS float*)(lds + STAGE_BYTES);
        LAS float* cwl = (LAS float*)(lds + 140288);
        const int tid_ = (wr * 4 + wc) * 64 + fq * 16 + fr;
        float cwv[2];
#pragma unroll
        for (int q = 0; q < 2; ++q) { const int e = tid_ + 512 * q, t = e >> 8, bj = (e >> 7) & 1, c = e & 127; cwv[q] = t < 3 ? cw[t * (2 * DFF) + bj * DFF + u.ocol + c] : cb[bj * DFF + u.ocol + c]; }
        if (fr == 0) {
#pragma unroll
            for (int ai = 0; ai < 2; ++ai)
#pragma unroll
                for (int bj = 0; bj < 2; ++bj)
#pragma unroll
                    for (int n = 0; n < 2; ++n) *(LAS f32x4*)(hal + ((2 * ai + wr) * 2 + 0) * 256 + bj * 128 + wc * 32 + n * 16 + 4 * fq) = acc[ai][bj][0][n];
        }
        if (fr == 15) {
#pragma unroll
            for (int ai = 0; ai < 2; ++ai)
#pragma unroll
                for (int bj = 0; bj < 2; ++bj)
#pragma unroll
                    for (int n = 0; n < 2; ++n) *(LAS f32x4*)(hal + ((2 * ai + wr) * 2 + 1) * 256 + bj * 128 + wc * 32 + n * 16 + 4 * fq) = acc[ai][bj][3][n];
        }
        cwl[tid_] = cwv[0]; cwl[tid_ + 512] = cwv[1];
        asm volatile("s_waitcnt lgkmcnt(0)" ::: "memory"); __builtin_amdgcn_s_barrier(); asm volatile("" ::: "memory");
        int fr_ = fr, fq_ = fq; asm volatile("" : "+v"(fr_), "+v"(fq_));
        const int rmin = u.aux == 1 ? 0 : 1, rmax = u.bt;
        const f32x4 zero4 = {0.f, 0.f, 0.f, 0.f};
#pragma unroll
        for (int ai = 0; ai < 2; ++ai) {
            const int g = 2 * ai + wr;
#pragma unroll
            for (int n = 0; n < 2; ++n) {
                const int chb = u.ocol + wc * 32 + n * 16 + 4 * fq_;
                const int colh = wc * 32 + n * 16 + 4 * fq_;
                f32x4 w0[2], w1[2], w2[2], bb[2], uh[2], dh[2];
#pragma unroll
                for (int bj = 0; bj < 2; ++bj) { const int cl = bj * 128 + colh;
                    w0[bj] = *(const LAS f32x4*)(cwl + 0 * 256 + cl); w1[bj] = *(const LAS f32x4*)(cwl + 1 * 256 + cl); w2[bj] = *(const LAS f32x4*)(cwl + 2 * 256 + cl); bb[bj] = *(const LAS f32x4*)(cwl + 3 * 256 + cl);
                    uh[bj] = zero4; dh[bj] = zero4;
                    if (g > 0) uh[bj] = *(LAS f32x4*)(hal + ((g - 1) * 2 + 1) * 256 + bj * 128 + colh);
                    if (g < 3) dh[bj] = *(LAS f32x4*)(hal + ((g + 1) * 2 + 0) * 256 + bj * 128 + colh); }
#pragma unroll
                for (int m = 0; m < 4; ++m) {
                    f32x4 res[2];
#pragma unroll
                    for (int bj = 0; bj < 2; ++bj) {
                        const f32x4 cur = acc[ai][bj][m][n];
                        const f32x4 prv = m > 0 ? acc[ai][bj][m > 0 ? m - 1 : 0][n] : uh[bj];
                        const f32x4 nxt = m < 3 ? acc[ai][bj][m < 3 ? m + 1 : 3][n] : dh[bj];
                        f32x4 su, sd;
#pragma unroll
                        for (int j = 0; j < 4; ++j) { su[j] = fr_ == 15 ? prv[j] : cur[j]; sd[j] = fr_ == 0 ? nxt[j] : cur[j]; }
                        f32x4 rr = w1[bj] * cur + bb[bj];
                        asm volatile("s_nop 1\n\t"
                                     "v_fmac_f32_dpp %0, %4, %12 row_ror:1 row_mask:0xf bank_mask:0xf\n\t"
                                     "v_fmac_f32_dpp %1, %5, %13 row_ror:1 row_mask:0xf bank_mask:0xf\n\t"
                                     "v_fmac_f32_dpp %2, %6, %14 row_ror:1 row_mask:0xf bank_mask:0xf\n\t"
                                     "v_fmac_f32_dpp %3, %7, %15 row_ror:1 row_mask:0xf bank_mask:0xf\n\t"
                                     "v_fmac_f32_dpp %0, %8, %16 row_ror:15 row_mask:0xf bank_mask:0xf\n\t"
                                     "v_fmac_f32_dpp %1, %9, %17 row_ror:15 row_mask:0xf bank_mask:0xf\n\t"
                                     "v_fmac_f32_dpp %2, %10, %18 row_ror:15 row_mask:0xf bank_mask:0xf\n\t"
                                     "v_fmac_f32_dpp %3, %11, %19 row_ror:15 row_mask:0xf bank_mask:0xf"
                                     : "+v"(rr[0]), "+v"(rr[1]), "+v"(rr[2]), "+v"(rr[3])
                                     : "v"(su[0]), "v"(su[1]), "v"(su[2]), "v"(su[3]), "v"(sd[0]), "v"(sd[1]), "v"(sd[2]), "v"(sd[3]),
                                       "v"(w0[bj][0]), "v"(w0[bj][1]), "v"(w0[bj][2]), "v"(w0[bj][3]), "v"(w2[bj][0]), "v"(w2[bj][1]), "v"(w2[bj][2]), "v"(w2[bj][3]));
                        res[bj] = rr;
                    }
                    const int r = ai * HALF + wr * 64 + m * 16 + fr_;
                    bool okr = r >= rmin && r <= rmax; int trow = u.orow + r;
                    if (u.aux == 2) { const int seg = r / TAILSEG, sq = r - seg * TAILSEG, sb = 7 * (u.orow >> 8) + seg;
                        okr = seg < 7 && sb < NB && sq >= 1 && sq <= 32; trow = sb * TB + NCTX + (SEQ - 33) + sq; }
                    if (okr) {
                        const f32x4 gq = res[0], vq = res[1];
                        u32x2 w; w.x = cvt_pk_bf16(silu_f(gq[0]) * vq[0], silu_f(gq[1]) * vq[1]); w.y = cvt_pk_bf16(silu_f(gq[2]) * vq[2], silu_f(gq[3]) * vq[3]);
                        *(u32x2*)(Hd + (size_t)trow * DFF + chb) = w;
                    }
                }
            }
        }
    }
};

template <class Epi, class Sched>
__device__ __forceinline__ void gemm_phase(LAS unsigned char* lds, const Gemm g, const Sched& S, const Epi& E) {
    int tid = threadIdx.x; asm volatile("" : "+v"(tid));
    const int wid = __builtin_amdgcn_readfirstlane(tid >> 6), lane = tid & 63, wr = wid >> 2, wc = wid & 3, fr = lane & 15, fq = lane >> 4;
    int K = g.K, lda_ = g.lda, ldb_ = g.ldb; asm volatile("" : "+s"(K), "+s"(lda_), "+s"(ldb_));
    const int nt = K / BK;
    unsigned voffA[2], voffB[2];
#pragma unroll
    for (int i = 0; i < 2; ++i) { int R, C; stage_rc(tid * 16 + i * 8192, R, C); const int Rb = Epi::PERM ? ((R & ~31) + perm32(R & 31)) : R;
        voffA[i] = (unsigned)(R * lda_ + C) * 2u; voffB[i] = (unsigned)(Rb * ldb_ + C) * 2u; }
    const size_t kstep = (size_t)(BK * 2);
    const size_t hstepA = (size_t)HALF * lda_ * 2, hstepB = (size_t)HALF * ldb_ * 2;
    const unsigned ldsw = (unsigned)wid * 1024u;
    const int aoff = lds_byte(wr * 64 + fr, fq * 8), boff = lds_byte(wc * 32 + fr, fq * 8);
#define PG8_SA(b, h) (((b) * 2 + (h)) * HTB)
#define PG8_SB(b, h) ((4 + (b) * 2 + (h)) * HTB)
#define PG8_STAGE(bufoff, gbase, voff) do { _Pragma("unroll") for (int _i = 0; _i < 2; ++_i) \
        __builtin_amdgcn_global_load_lds((const unsigned*)((const char*)(gbase) + (voff)[_i]), (LAS unsigned*)(lds + (bufoff) + ldsw + _i * 8192), 16, 0, 0); } while (0)
#define PG8_LDA(dst, b, h) do { _Pragma("unroll") for (int m = 0; m < 4; ++m) _Pragma("unroll") for (int k = 0; k < 2; ++k) dst[m][k] = *(const LAS bf16x8*)(lds + PG8_SA(b, h) + aoff + m * 2048 + k * 1024); } while (0)
#define PG8_LDB(dst, b, h) do { _Pragma("unroll") for (int n = 0; n < 2; ++n) _Pragma("unroll") for (int k = 0; k < 2; ++k) dst[n][k] = *(const LAS bf16x8*)(lds + PG8_SB(b, h) + boff + n * 2048 + k * 1024); } while (0)
#define PG8_MMA(ai, bj, At, Bt) do { __builtin_amdgcn_s_setprio(1); _Pragma("unroll") for (int m = 0; m < 4; ++m) _Pragma("unroll") for (int n = 0; n < 2; ++n) _Pragma("unroll") for (int k = 0; k < 2; ++k) \
        acc[ai][bj][m][n] = __builtin_amdgcn_mfma_f32_16x16x32_bf16(Bt[n][k], At[m][k], acc[ai][bj][m][n], 0, 0, 0); __builtin_amdgcn_s_setprio(0); } while (0)
#define PG8_WAIT_V(n) asm volatile("s_waitcnt vmcnt(" #n ")" ::: "memory")
#define PG8_WAIT_L(n) asm volatile("s_waitcnt lgkmcnt(" #n ")" ::: "memory")
#define PG8_BAR __builtin_amdgcn_s_barrier()
#define PG8_SCHED __builtin_amdgcn_sched_barrier(0)
    Unit cur, nxt; int ui = 0;
    if (!S.next(0, cur)) return;
    f32x4 acc[2][2][4][2];
#pragma unroll
    for (int a = 0; a < 2; ++a)
#pragma unroll
        for (int b = 0; b < 2; ++b)
#pragma unroll
            for (int m = 0; m < 4; ++m)
#pragma unroll
                for (int n = 0; n < 2; ++n) acc[a][b][m][n] = (f32x4){0.f, 0.f, 0.f, 0.f};
    bf16x8 At[4][2], B0[2][2], B1[2][2];
    const char* cA = (const char*)g.A + (size_t)cur.arow * lda_ * 2; const char* cB = (const char*)g.Bt + (size_t)cur.brow * ldb_ * 2;
    PG8_STAGE(PG8_SB(0, 0), cB, voffB); PG8_STAGE(PG8_SB(0, 1), cB + hstepB, voffB); PG8_STAGE(PG8_SA(0, 0), cA, voffA); PG8_STAGE(PG8_SA(0, 1), cA + hstepA, voffA);
    if (wr == 1) PG8_BAR;
    PG8_WAIT_V(2); PG8_BAR;
    PG8_STAGE(PG8_SB(1, 0), cB + kstep, voffB); PG8_STAGE(PG8_SA(1, 0), cA + kstep, voffA); PG8_STAGE(PG8_SB(1, 1), cB + hstepB + kstep, voffB);
    PG8_WAIT_V(6); PG8_BAR;
    for (;;) {
        const bool has_next = S.next(ui + 1, nxt);
        const char* nA = has_next ? (const char*)g.A + (size_t)nxt.arow * lda_ * 2 : cA; const char* nB = has_next ? (const char*)g.Bt + (size_t)nxt.brow * ldb_ * 2 : cB;
        for (int t = 0; t < nt; t += 2) {
            const bool last = (t == nt - 2);
            const char* a1 = cA + (size_t)(t + 1) * kstep;
            const char* a2 = last ? nA : cA + (size_t)(t + 2) * kstep; const char* b2 = last ? nB : cB + (size_t)(t + 2) * kstep;
            const char* a3 = a2 + kstep; const char* b3 = b2 + kstep;
            PG8_LDB(B0, 0, 0); PG8_LDB(B1, 0, 1); PG8_SCHED; PG8_LDA(At, 0, 0); PG8_STAGE(PG8_SA(1, 1), a1 + hstepA, voffA);
            PG8_WAIT_V(8); PG8_WAIT_L(0); PG8_BAR; PG8_MMA(0, 0, At, B0); PG8_MMA(0, 1, At, B1); PG8_BAR; PG8_SCHED;
            PG8_LDA(At, 0, 1); PG8_STAGE(PG8_SB(0, 0), b2, voffB); PG8_STAGE(PG8_SB(0, 1), b2 + hstepB, voffB); PG8_STAGE(PG8_SA(0, 0), a2, voffA);
            PG8_WAIT_V(8); PG8_WAIT_L(0); PG8_BAR; PG8_MMA(1, 0, At, B0); PG8_MMA(1, 1, At, B1); PG8_BAR; PG8_SCHED;
            PG8_LDB(B0, 1, 0); PG8_LDB(B1, 1, 1); PG8_SCHED; PG8_LDA(At, 1, 0); PG8_STAGE(PG8_SA(0, 1), a2 + hstepA, voffA);
            PG8_WAIT_V(8); PG8_WAIT_L(0); PG8_BAR; PG8_MMA(0, 0, At, B0); PG8_MMA(0, 1, At, B1); PG8_BAR; PG8_SCHED;
            PG8_LDA(At, 1, 1); PG8_STAGE(PG8_SB(1, 0), b3, voffB); PG8_STAGE(PG8_SB(1, 1), b3 + hstepB, voffB); PG8_STAGE(PG8_SA(1, 0), a3, voffA);
            PG8_WAIT_V(8); PG8_WAIT_L(0); PG8_BAR; PG8_MMA(1, 0, At, B0); PG8_MMA(1, 1, At, B1); PG8_BAR; PG8_SCHED;
        }
        if (wr == 0) PG8_BAR;
        E(acc, cur, wr, wc, fr, fq, lds);
        if (!has_next) break;
#pragma unroll
        for (int a = 0; a < 2; ++a)
#pragma unroll
            for (int b = 0; b < 2; ++b)
#pragma unroll
                for (int m = 0; m < 4; ++m)
#pragma unroll
                    for (int n = 0; n < 2; ++n) acc[a][b][m][n] = (f32x4){0.f, 0.f, 0.f, 0.f};
        cur = nxt; cA = nA; cB = nB; ++ui;
        if (wr == 1) PG8_BAR;
    }
    PG8_WAIT_V(0);
    PG8_BAR;
#undef PG8_SA
#undef PG8_SB
#undef PG8_STAGE
#undef PG8_LDA
#undef PG8_LDB
#undef PG8_MMA
#undef PG8_WAIT_V
#undef PG8_WAIT_L
#undef PG8_BAR
#undef PG8_SCHED
}

struct MapStd { int coff; __device__ __forceinline__ void operator()(Unit& u) const { u.arow = u.pm * 256; u.brow = u.pn * 256; u.orow = u.pm * 256; u.ocol = coff + u.pn * 256; u.aux = 0; u.bt = 0; } };
struct MapRes { int all;
    __device__ __forceinline__ void operator()(Unit& u) const {
        int b, j; if (all) { b = u.pm / 17; j = u.pm % 17; } else { b = u.pm / 16; j = u.pm % 16 + 1; }
        u.arow = (b * 17 + j) * 256; u.brow = u.pn * 256; u.ocol = u.pn * 256; u.bt = b;
        if (j == 0) { u.aux = 1; u.orow = b * 256; } else { u.aux = 0; u.orow = b * SEQ + (j - 1) * 256; } asm volatile("" : "+s"(u.aux)); } };
struct MapUp { int all;
    __device__ __forceinline__ void operator()(Unit& u) const {
        const int per = all ? 17 : 16, nmain = 16 * per;
        u.brow = u.pn * 256; u.ocol = u.pn * 128;
        if (u.pm >= nmain) { u.aux = 2; u.arow = TAILROW0 + (u.pm - nmain) * 256; u.orow = (u.pm - nmain) * 256; u.bt = 0; return; }
        const int b = u.pm / per, j = all ? u.pm % per : u.pm % per + 1;
        if (j == 0) { u.aux = 1; u.arow = b * U2B; u.orow = b * TB; u.bt = 255; }
        else { const int i = j - 1; u.aux = 0; u.arow = b * U2B + 263 + 254 * i; u.orow = b * TB + NCTX + 254 * i - 1; u.bt = 254; } } };
struct MapZ {
    __device__ __forceinline__ void operator()(Unit& u) const {
        const int b = u.pn / 17, j = u.pn % 17; u.arow = u.pm * 256; u.brow = u.pn * 256; u.orow = b * 256; u.bt = b;
        if (j == 0) { u.aux = 1; u.ocol = u.pm * NCTX; } else { u.aux = 0; u.ocol = u.pm * SEQ + (j - 1) * 256; } } };
struct MapFnetL { __device__ __forceinline__ void operator()(Unit& u) const { const int b = u.pm / 16, mt = u.pm % 16; u.arow = mt * 256; u.brow = b * 256; u.orow = b * TB + NCTX + mt * 256; u.ocol = 768; u.aux = 0; u.bt = b; } };
struct MapFnetC { __device__ __forceinline__ void operator()(Unit& u) const { const int b = u.pm; u.arow = 0; u.brow = b * 256; u.orow = b * TB; u.ocol = 768; u.aux = 0; u.bt = b; } };
}

typedef short v4i16_t __attribute__((ext_vector_type(4)));
__device__ __forceinline__ v4i16_t vtr(const LAS unsigned char* p) { return __builtin_amdgcn_ds_read_tr16_b64_v4i16((LAS v4i16_t*)p); }
#define MX3(a_, b_, c_) __builtin_fmaxf(__builtin_fmaxf((a_), (b_)), (c_))
__device__ __forceinline__ float tile_max(const f32x16& s0, const f32x16& s1) {
    float ma = MX3(s0[0], s0[1], s1[0]), mb = MX3(s0[2], s0[3], s1[1]); ma = MX3(ma, s1[2], s1[3]);
#pragma unroll
    for (int r = 4; r < 16; r += 4) { ma = MX3(ma, s0[r], s0[r + 1]); mb = MX3(mb, s0[r + 2], s0[r + 3]); ma = MX3(ma, s1[r], s1[r + 1]); mb = MX3(mb, s1[r + 2], s1[r + 3]); }
    return __builtin_fmaxf(ma, mb);
}
#undef MX3
__device__ __forceinline__ void band_mask(f32x16& s0, f32x16& s1, int k0pos, int qp, int hi) {
#pragma unroll
    for (int r = 0; r < 16; ++r) { const int kp = k0pos + (r & 3) + 8 * (r >> 2) + 4 * hi; const int d0 = kp - qp, d1 = d0 + 32;
        if (d0 > 128 || d0 < -128) s0[r] = -1e30f; if (d1 > 128 || d1 < -128) s1[r] = -1e30f; }
}
__device__ __forceinline__ void exp4(f32x16& s, int r0, float& acc0, float& acc1) {
    s[r0] = __builtin_amdgcn_exp2f(s[r0]); s[r0 + 1] = __builtin_amdgcn_exp2f(s[r0 + 1]); s[r0 + 2] = __builtin_amdgcn_exp2f(s[r0 + 2]); s[r0 + 3] = __builtin_amdgcn_exp2f(s[r0 + 3]);
    acc0 += s[r0] + s[r0 + 2]; acc1 += s[r0 + 1] + s[r0 + 3];
}
__device__ __forceinline__ bf16x8 pack8(const f32x16& s, int r0) {
    u32x4 w; w.x = cvt_pk_bf16(s[r0], s[r0 + 1]); w.y = cvt_pk_bf16(s[r0 + 2], s[r0 + 3]); w.z = cvt_pk_bf16(s[r0 + 4], s[r0 + 5]); w.w = cvt_pk_bf16(s[r0 + 6], s[r0 + 7]);
    return __builtin_bit_cast(bf16x8, w);
}
__device__ __forceinline__ void pv_slab(const LAS unsigned char* vb, int koff, const bf16x8 pj, f32x16& o0, f32x16& o1) {
    const v4i16_t a0 = vtr(vb + koff), a1 = vtr(vb + koff + 512), b0 = vtr(vb + 8192 + koff), b1 = vtr(vb + 8192 + koff + 512);
    const bf16x8 v0 = {a0[0], a0[1], a0[2], a0[3], a1[0], a1[1], a1[2], a1[3]}, v1 = {b0[0], b0[1], b0[2], b0[3], b1[0], b1[1], b1[2], b1[3]};
    o0 = __builtin_amdgcn_mfma_f32_32x32x16_bf16(v0, pj, o0, 0, 0, 0);
    o1 = __builtin_amdgcn_mfma_f32_32x32x16_bf16(v1, pj, o1, 0, 0, 0);
}

#define ATT_SCHED() __builtin_amdgcn_sched_barrier(0)
template <int DQ, bool WIN>
__device__ __forceinline__ void attn_qk(LAS unsigned char* lds, int kbufoff, int t, const bf16x8 (&qf)[DQ / 16], f32x16& o0, f32x16& o1, float& mrun, float& lsum,
                                        f32x16& sa0, f32x16& sa1, f32x16& sb0, f32x16& sb1, int l31, int hi, int qw) {
    constexpr int NDK = DQ / 16, KST = DQ * 2 + 16;
    const LAS unsigned char* kb = lds + kbufoff + l31 * KST + hi * 16;
    bf16x8 kf[2][4];
#define KLOAD(dst, dk) do { dst[0] = *(const LAS bf16x8*)(kb + (dk) * 32); dst[1] = *(const LAS bf16x8*)(kb + 32 * KST + (dk) * 32); \
                            dst[2] = *(const LAS bf16x8*)(kb + 64 * KST + (dk) * 32); dst[3] = *(const LAS bf16x8*)(kb + 96 * KST + (dk) * 32); } while (0)
    KLOAD(kf[0], 0);
#pragma unroll
    for (int dk = 0; dk < NDK; ++dk) {
        if (dk + 1 < NDK) KLOAD(kf[(dk + 1) & 1], dk + 1);
        ATT_SCHED();
        const bf16x8 (&f)[4] = kf[dk & 1];
        if (dk == 0) { f32x16 z16;
#pragma unroll
                       for (int r = 0; r < 16; ++r) z16[r] = 0.f;
                       sa0 = __builtin_amdgcn_mfma_f32_32x32x16_bf16(f[0], qf[0], z16, 0, 0, 0); sa1 = __builtin_amdgcn_mfma_f32_32x32x16_bf16(f[1], qf[0], z16, 0, 0, 0);
                       sb0 = __builtin_amdgcn_mfma_f32_32x32x16_bf16(f[2], qf[0], z16, 0, 0, 0); sb1 = __builtin_amdgcn_mfma_f32_32x32x16_bf16(f[3], qf[0], z16, 0, 0, 0); }
        else { sa0 = __builtin_amdgcn_mfma_f32_32x32x16_bf16(f[0], qf[dk], sa0, 0, 0, 0); sa1 = __builtin_amdgcn_mfma_f32_32x32x16_bf16(f[1], qf[dk], sa1, 0, 0, 0);
               sb0 = __builtin_amdgcn_mfma_f32_32x32x16_bf16(f[2], qf[dk], sb0, 0, 0, 0); sb1 = __builtin_amdgcn_mfma_f32_32x32x16_bf16(f[3], qf[dk], sb1, 0, 0, 0); }
        ATT_SCHED();
    }
#undef KLOAD
    if (__builtin_expect(__any(mrun != 0.f), 0)) {
#pragma unroll
        for (int r = 0; r < 16; ++r) { sa0[r] -= mrun; sa1[r] -= mrun; sb0[r] -= mrun; sb1[r] -= mrun; }
    }
    if (WIN && t >= 4) { const int qp = qw + l31, k0pos = (t - 4) * 64; band_mask(sa0, sa1, k0pos, qp, hi); band_mask(sb0, sb1, k0pos + 64, qp, hi); }
    float mx = __builtin_fmaxf(tile_max(sa0, sa1), tile_max(sb0, sb1));
    { auto rr = __builtin_amdgcn_permlane32_swap(__float_as_uint(mx), __float_as_uint(mx), false, false); mx = __builtin_fmaxf(__uint_as_float(rr[0]), __uint_as_float(rr[1])); }
    if (__builtin_expect(__any(mx > 8.0f), 0)) {
        const float dl = mx > 8.0f ? mx : 0.f; mrun += dl;
        const float alpha = __builtin_amdgcn_exp2f(-dl); lsum *= alpha;
#pragma unroll
        for (int r = 0; r < 16; ++r) { sa0[r] -= dl; sa1[r] -= dl; sb0[r] -= dl; sb1[r] -= dl; o0[r] *= alpha; o1[r] *= alpha; }
    }
}
#define VLOAD(dst, j) do { dst[0] = vtr(vb + (j) * 1024); dst[1] = vtr(vb + (j) * 1024 + 512); dst[2] = vtr(vb + 8192 + (j) * 1024); dst[3] = vtr(vb + 8192 + (j) * 1024 + 512); } while (0)
#define PVMMA(src, P_) do { const bf16x8 v0_ = {src[0][0], src[0][1], src[0][2], src[0][3], src[1][0], src[1][1], src[1][2], src[1][3]}, v1_ = {src[2][0], src[2][1], src[2][2], src[2][3], src[3][0], src[3][1], src[3][2], src[3][3]}; \
        const bf16x8 p_ = (P_); o0 = __builtin_amdgcn_mfma_f32_32x32x16_bf16(v0_, p_, o0, 0, 0, 0); o1 = __builtin_amdgcn_mfma_f32_32x32x16_bf16(v1_, p_, o1, 0, 0, 0); } while (0)
__device__ __forceinline__ void attn_softmax_pv(const LAS unsigned char* vb, f32x16& sa0, f32x16& sa1, f32x16& sb0, f32x16& sb1, f32x16& o0, f32x16& o1, float& lsum) {
    v4i16_t vf[2][4];
    VLOAD(vf[0], 0);
    float p0 = 0.f, p1 = 0.f, p2 = 0.f, p3 = 0.f;
    exp4(sa0, 0, p0, p1); exp4(sa0, 4, p2, p3); exp4(sa0, 8, p0, p1); exp4(sa0, 12, p2, p3);
    exp4(sa1, 0, p0, p1); exp4(sa1, 4, p2, p3); exp4(sa1, 8, p0, p1); exp4(sa1, 12, p2, p3);
    VLOAD(vf[1], 1); ATT_SCHED(); PVMMA(vf[0], pack8(sa0, 0)); exp4(sb0, 0, p0, p1); exp4(sb0, 4, p2, p3); ATT_SCHED();
    VLOAD(vf[0], 2); ATT_SCHED(); PVMMA(vf[1], pack8(sa0, 8)); exp4(sb0, 8, p0, p1); exp4(sb0, 12, p2, p3); ATT_SCHED();
    VLOAD(vf[1], 3); ATT_SCHED(); PVMMA(vf[0], pack8(sa1, 0)); exp4(sb1, 0, p0, p1); exp4(sb1, 4, p2, p3); ATT_SCHED();
    VLOAD(vf[0], 4); ATT_SCHED(); PVMMA(vf[1], pack8(sa1, 8)); exp4(sb1, 8, p0, p1); exp4(sb1, 12, p2, p3); ATT_SCHED();
    lsum += (p0 + p1) + (p2 + p3);
    VLOAD(vf[1], 5); ATT_SCHED(); PVMMA(vf[0], pack8(sb0, 0)); ATT_SCHED();
    VLOAD(vf[0], 6); ATT_SCHED(); PVMMA(vf[1], pack8(sb0, 8)); ATT_SCHED();
    VLOAD(vf[1], 7); ATT_SCHED(); PVMMA(vf[0], pack8(sb1, 0)); ATT_SCHED();
    PVMMA(vf[1], pack8(sb1, 8));
}
__device__ __forceinline__ void attn_softmax_keep(f32x16& sa0, f32x16& sa1, f32x16& sb0, f32x16& sb1, bf16x8 (&pw)[8], float& lsum) {
    float p0 = 0.f, p1 = 0.f, p2 = 0.f, p3 = 0.f;
    exp4(sa0, 0, p0, p1); exp4(sa0, 4, p2, p3); exp4(sa0, 8, p0, p1); exp4(sa0, 12, p2, p3); pw[0] = pack8(sa0, 0); pw[1] = pack8(sa0, 8);
    exp4(sa1, 0, p0, p1); exp4(sa1, 4, p2, p3); exp4(sa1, 8, p0, p1); exp4(sa1, 12, p2, p3); pw[2] = pack8(sa1, 0); pw[3] = pack8(sa1, 8);
    exp4(sb0, 0, p0, p1); exp4(sb0, 4, p2, p3); exp4(sb0, 8, p0, p1); exp4(sb0, 12, p2, p3); pw[4] = pack8(sb0, 0); pw[5] = pack8(sb0, 8);
    exp4(sb1, 0, p0, p1); exp4(sb1, 4, p2, p3); exp4(sb1, 8, p0, p1); exp4(sb1, 12, p2, p3); pw[6] = pack8(sb1, 0); pw[7] = pack8(sb1, 8);
    lsum += (p0 + p1) + (p2 + p3);
}
__device__ __forceinline__ void attn_pv_all(const LAS unsigned char* vb, const bf16x8 (&pw)[8], f32x16& o0, f32x16& o1) {
    v4i16_t vf[2][4];
    VLOAD(vf[0], 0);
    VLOAD(vf[1], 1); ATT_SCHED(); PVMMA(vf[0], pw[0]); ATT_SCHED();
    VLOAD(vf[0], 2); ATT_SCHED(); PVMMA(vf[1], pw[1]); ATT_SCHED();
    VLOAD(vf[1], 3); ATT_SCHED(); PVMMA(vf[0], pw[2]); ATT_SCHED();
    VLOAD(vf[0], 4); ATT_SCHED(); PVMMA(vf[1], pw[3]); ATT_SCHED();
    VLOAD(vf[1], 5); ATT_SCHED(); PVMMA(vf[0], pw[4]); ATT_SCHED();
    VLOAD(vf[0], 6); ATT_SCHED(); PVMMA(vf[1], pw[5]); ATT_SCHED();
    VLOAD(vf[1], 7); ATT_SCHED(); PVMMA(vf[0], pw[6]); ATT_SCHED();
    PVMMA(vf[1], pw[7]);
}
#undef VLOAD
#undef PVMMA
#undef ATT_SCHED

template <int DQ, bool WIN, int MODE = 0>
__device__ __forceinline__ void attn_unit(LAS unsigned char* lds, const bf16_t* Qp, int ldq, const bf16_t* Kp, int ldk, const bf16_t* Vp, int ldv, bf16_t* Op,
                                          int n1, int s2, int e2, int q0pos, float m_init, bool has_sink, const float* qgain = nullptr, const f32x2v* ropeT = nullptr, bool qrope = false) {
    constexpr int NDK = DQ / 16, CH = DQ / 8, NKC = DQ / 32, KST = DQ * 2 + 16, KBUF = 128 * KST, VBUF = 16384, VOFF = 2 * KBUF;
    int tid = threadIdx.x; asm volatile("" : "+v"(tid));
    const int lane = tid & 63, wid = __builtin_amdgcn_readfirstlane(tid >> 6), l31 = lane & 31, hi = lane >> 5;
    const bool late = wid >= 4;
    bf16x8 qf[NDK];
    { const bf16_t* qrow = Qp + (size_t)(32 * wid + l31) * ldq + 8 * hi;
#pragma unroll
      for (int dk = 0; dk < NDK; ++dk) qf[dk] = *(const bf16x8*)(qrow + 16 * dk); }
    if (DQ == 64 && qgain != nullptr) {
        float y[4][8]; float ss = 0.f;
#pragma unroll
        for (int dk = 0; dk < 4; ++dk) { const u32x4 w = __builtin_bit_cast(u32x4, qf[dk < NDK ? dk : 0]);
#pragma unroll
            for (int i = 0; i < 4; ++i) { y[dk][2 * i] = bflo(w[i]); y[dk][2 * i + 1] = bfhi(w[i]); ss += y[dk][2 * i] * y[dk][2 * i] + y[dk][2 * i + 1] * y[dk][2 * i + 1]; } }
        ss += __shfl_xor(ss, 32);
        const float rn = rsqrtf(ss * (1.0f / 64.0f) + EPS);
#pragma unroll
        for (int dk = 0; dk < 4; ++dk)
#pragma unroll
            for (int e = 0; e < 8; ++e) y[dk][e] *= rn * qgain[16 * dk + 8 * hi + e];
        if (qrope) { const int pos = q0pos + 32 * wid + l31;
#pragma unroll
            for (int dk = 0; dk < 2; ++dk)
#pragma unroll
                for (int e = 0; e < 8; ++e) { const f32x2v t = ropeT[pos * 32 + 16 * dk + 8 * hi + e]; const float x1 = y[dk][e], x2 = y[dk + 2][e]; y[dk][e] = x1 * t.x - x2 * t.y; y[dk + 2][e] = x1 * t.y + x2 * t.x; } }
        const float QS_ = 0.125f * LOG2E;
#pragma unroll
        for (int dk = 0; dk < 4; ++dk) { u32x4 w;
#pragma unroll
            for (int i = 0; i < 4; ++i) w[i] = cvt_pk_bf16(y[dk][2 * i] * QS_, y[dk][2 * i + 1] * QS_);
            if (dk < NDK) qf[dk] = __builtin_bit_cast(bf16x8, w); }
    }
    f32x16 o0, o1;
#pragma unroll
    for (int r = 0; r < 16; ++r) { o0[r] = 0.f; o1[r] = 0.f; }
    float mrun = 0.f, lsum = (has_sink && hi == 0) ? __builtin_amdgcn_exp2f(m_init) : 0.f;
    const int qw = q0pos + 32 * wid;
    const int vlane = (4 * hi + ((lane & 15) >> 2)) * 64 + ((lane >> 4) & 1) * 32 + (lane & 3) * 8;
    u32x4 kr[NKC], vr[2];
#define ATT_TILE(i_) ((i_) < n1 ? (i_) : s2 + ((i_) - n1))
#define ATT_LOAD(t) do { const bf16_t* kp_ = Kp + (size_t)(t) * 64 * ldk; const bf16_t* vp_ = Vp + (size_t)(t) * 64 * ldv; \
        _Pragma("unroll") for (int m_ = 0; m_ < NKC; ++m_) { const int c_ = tid + 512 * m_; kr[m_] = *(const GAS u32x4*)(kp_ + (size_t)(c_ / CH) * ldk + (c_ % CH) * 8); } \
        _Pragma("unroll") for (int m_ = 0; m_ < 2; ++m_) { const int c_ = tid + 512 * m_; vr[m_] = *(const GAS u32x4*)(vp_ + (size_t)(c_ >> 3) * ldv + (c_ & 7) * 8); } } while (0)
#define ATT_STORE(kb_, vb_) do { \
        _Pragma("unroll") for (int m_ = 0; m_ < NKC; ++m_) { const int c_ = tid + 512 * m_; *(LAS u32x4*)(lds + (kb_) * KBUF + (c_ / CH) * KST + (c_ % CH) * 16) = kr[m_]; } \
        _Pragma("unroll") for (int m_ = 0; m_ < 2; ++m_) { const int c_ = tid + 512 * m_; *(LAS u32x4*)(lds + VOFF + (vb_) * VBUF + ((c_ & 7) >> 2) * 8192 + (c_ >> 3) * 64 + (c_ & 3) * 16) = vr[m_]; } } while (0)
#define ATT_BAR() asm volatile("s_waitcnt lgkmcnt(0)\n\ts_barrier" ::: "memory")
    const int nst = (n1 + (e2 - s2)) >> 1;
    ATT_LOAD(0); ATT_STORE(0, 0);
    ATT_BAR();
    if (!late) {
        int vcur = 0;
        for (int I = 0; I < nst; ++I) {
            const int t = ATT_TILE(2 * I);
            if (I + 1 < nst) { const int tn = ATT_TILE(2 * I + 2); ATT_LOAD(tn); }
            bool active = true; if (WIN && t >= 4) { const int k0 = (t - 4) * 64; active = (k0 + 127 >= qw - 128) && (k0 <= qw + 31 + 128); }
            const int vnext = vcur == 2 ? 0 : vcur + 1;
            if (active) { f32x16 sa0, sa1, sb0, sb1;
                attn_qk<DQ, WIN>(lds, (I & 1) * KBUF, t, qf, o0, o1, mrun, lsum, sa0, sa1, sb0, sb1, l31, hi, qw);
                attn_softmax_pv(lds + VOFF + vcur * VBUF + vlane, sa0, sa1, sb0, sb1, o0, o1, lsum); }
            if (I + 1 < nst) ATT_STORE((I + 1) & 1, vnext);
            vcur = vnext;
            ATT_BAR();
        }
    } else {
        bf16x8 pw[8]; bool havep = false; int pvoff = 0;
        int vcur = 0;
        for (int I = 0; I < nst; ++I) {
            const int t = ATT_TILE(2 * I);
            if (I + 1 < nst) { const int tn = ATT_TILE(2 * I + 2); ATT_LOAD(tn); }
            bool active = true; if (WIN && t >= 4) { const int k0 = (t - 4) * 64; active = (k0 + 127 >= qw - 128) && (k0 <= qw + 31 + 128); }
            const int vnext = vcur == 2 ? 0 : vcur + 1;
            if (havep) attn_pv_all(lds + VOFF + pvoff + vlane, pw, o0, o1);
            havep = false;
            if (active) { f32x16 sa0, sa1, sb0, sb1;
                attn_qk<DQ, WIN>(lds, (I & 1) * KBUF, t, qf, o0, o1, mrun, lsum, sa0, sa1, sb0, sb1, l31, hi, qw);
                attn_softmax_keep(sa0, sa1, sb0, sb1, pw, lsum); havep = true; pvoff = vcur * VBUF; }
            if (I + 1 < nst) ATT_STORE((I + 1) & 1, vnext);
            vcur = vnext;
            ATT_BAR();
        }
        if (havep) attn_pv_all(lds + VOFF + pvoff + vlane, pw, o0, o1);
    }
    ATT_BAR();
#undef ATT_TILE
#undef ATT_LOAD
#undef ATT_STORE
#undef ATT_BAR
    const float lt = lsum + __shfl_xor(lsum, 32), inv = 1.0f / lt;
    bf16_t* orow = Op + (size_t)(32 * wid + l31) * DM + 4 * hi;
#pragma unroll
    for (int g = 0; g < 4; ++g) {
        u32x2 w0, w1;
        w0.x = cvt_pk_bf16(o0[4 * g] * inv, o0[4 * g + 1] * inv); w0.y = cvt_pk_bf16(o0[4 * g + 2] * inv, o0[4 * g + 3] * inv);
        w1.x = cvt_pk_bf16(o1[4 * g] * inv, o1[4 * g + 1] * inv); w1.y = cvt_pk_bf16(o1[4 * g + 2] * inv, o1[4 * g + 3] * inv);
        *(u32x2*)(orow + 8 * g) = w0; *(u32x2*)(orow + 32 + 8 * g) = w1;
    }
}

struct Args { const float* in[28]; float* out; unsigned char* ws; int lo, hi; };
typedef const GAS float* cfp_t;
struct Ctx { const __attribute__((address_space(4))) cfp_t* in; float* out; unsigned char* ws;
    __device__ __forceinline__ const float* inp(int i) const { return (const float*)in[i]; } };
enum { I_X = 0, I_C, I_CTX, I_CCTX, I_MODW, I_MODB, I_N1G, I_N2G, I_MLAWIN, I_CQG, I_CKVG, I_WUQ, I_WUKV, I_QG, I_KG, I_FNETW, I_EWOUT,
       I_WINWIN, I_WQG, I_WKG, I_SINK, I_POOLW, I_POOLS, I_OWOUT, I_FFNUP, I_CONVW, I_CONVB, I_FFNDN };

__device__ __forceinline__ void tr_item(const float* W, int K, int Nsrc, bf16_t* WT, int nblk, int item, LAS float* scr, int lane, int mode, const float* ksc) {
    const int kb = item / nblk, nb = item % nblk, k0 = 64 * kb, n0 = 32 * nb;
    int s0 = n0;
    if (mode == 1) s0 = n0 < 672 ? n0 : -1;
    else if (mode == 2) { const int hd = n0 >> 7, d0 = n0 & 127; s0 = d0 < 96 ? hd * 96 + d0 : -1; }
    else if (mode == 3) { const int pn = n0 >> 8, bj = (n0 >> 7) & 1, c = n0 & 127; s0 = bj * DFF + pn * 128 + c; }
#pragma unroll 16
    for (int i = 0; i < 32; ++i) { const int kk = 2 * i + (lane >> 5); float v = 0.f;
        if (s0 >= 0) { v = W[(size_t)(k0 + kk) * Nsrc + s0 + (lane & 31)]; if (ksc) v *= ksc[k0 + kk]; }
        scr[kk * 33 + (lane & 31)] = v; }
    asm volatile("s_waitcnt lgkmcnt(0)" ::: "memory");
    const int c = lane & 7;
#pragma unroll
    for (int j = 0; j < 4; ++j) { const int n = (lane >> 3) + 8 * j; const LAS float* s = scr + (8 * c) * 33 + n;
        u32x4 o; o.x = cvt_pk_bf16(s[0 * 33], s[1 * 33]); o.y = cvt_pk_bf16(s[2 * 33], s[3 * 33]); o.z = cvt_pk_bf16(s[4 * 33], s[5 * 33]); o.w = cvt_pk_bf16(s[6 * 33], s[7 * 33]);
        *(u32x4*)(WT + (size_t)(n0 + n) * K + k0 + 8 * c) = o; }
    asm volatile("s_waitcnt lgkmcnt(0)" ::: "memory");
}
__device__ __forceinline__ void tr_job(const float* W, int K, int Nsrc, bf16_t* WT, int Nout, int mode, const float* ksc, LAS float* scr, int gw, int ngw, int lane) {
    const int nblk = Nout / 32, nitems = (K / 64) * nblk;
    for (int it = gw; it < nitems; it += ngw) tr_item(W, K, Nsrc, WT, nblk, it, scr, lane, mode, ksc);
}
__device__ __forceinline__ void ffn_weights(const Ctx& a, int layer, LAS float* scr, int gw, int ngw, int lane) {
    tr_job(a.inp(I_FFNUP) + (size_t)layer * DM * 2 * DFF, DM, 2 * DFF, (bf16_t*)(a.ws + WS_WUP), 2 * DFF, 3, nullptr, scr, gw, ngw, lane);
    tr_job(a.inp(I_FFNDN) + (size_t)layer * DFF * DM, DFF, DM, (bf16_t*)(a.ws + ((layer & 1) ? WS_WDN2 : WS_WDN)), DM, 0, nullptr, scr, gw, ngw, lane);
}

__device__ __forceinline__ void mods_item(const Ctx& a, int item, LAS float* sl) {
    int tid = threadIdx.x; asm volatile("" : "+v"(tid)); const int l = item / 48, nb = item % 48;
    LAS float* red = sl + 17 * 1024;
    for (int idx = tid; idx < 17 * 1024; idx += 512) { const int r = idx >> 10, k = idx & 1023; const float v = r < 16 ? a.inp(I_C)[r * 1024 + k] : a.inp(I_CCTX)[k]; sl[idx] = v / (1.0f + __expf(-v)); }
    __syncthreads();
    const int cn = tid & 127, ks = tid >> 7, n = 128 * nb + cn;
    float acc[17];
#pragma unroll
    for (int r = 0; r < 17; ++r) acc[r] = 0.f;
    const float* wp = a.inp(I_MODW) + ((size_t)l * 1024 + 256 * ks) * 6144 + n;
#pragma unroll 4
    for (int k = 0; k < 256; k += 4) {
        const float w0 = wp[(size_t)(k + 0) * 6144], w1 = wp[(size_t)(k + 1) * 6144], w2 = wp[(size_t)(k + 2) * 6144], w3 = wp[(size_t)(k + 3) * 6144];
#pragma unroll
        for (int r = 0; r < 17; ++r) { const f32x4 s4 = *(const LAS f32x4*)(sl + r * 1024 + 256 * ks + k); acc[r] += s4[0] * w0 + s4[1] * w1 + s4[2] * w2 + s4[3] * w3; }
    }
#pragma unroll
    for (int r = 0; r < 17; ++r) red[(ks * 17 + r) * 128 + cn] = acc[r];
    __syncthreads();
    float* mods = (float*)(a.ws + WS_MODS);
    for (int idx = tid; idx < 17 * 128; idx += 512) { const int r = idx >> 7, c2 = idx & 127;
        const float s = red[(0 * 17 + r) * 128 + c2] + red[(1 * 17 + r) * 128 + c2] + red[(2 * 17 + r) * 128 + c2] + red[(3 * 17 + r) * 128 + c2];
        mods[((size_t)l * 17 + r) * 6144 + 128 * nb + c2] = s + a.inp(I_MODB)[l * 6144 + 128 * nb + c2]; }
    __syncthreads();
}

__device__ __forceinline__ void norm_pass(const float* xsrc, const float* csrc, const float* g, const float* mods_l, int shift_idx, int scale_idx,
                                          bf16_t* U, bool ffn_layout, bool skip_ctx, int gw, int ngw, int lane) {
    for (int R0 = gw; R0 < T; R0 += 2 * ngw) {
        f32x4 v[2][4]; bool ok[2]; int bb[2], pp[2];
#pragma unroll
        for (int s = 0; s < 2; ++s) { const int R = R0 + s * ngw; const int b = R / TB, p = R % TB; const bool isctx = p < NCTX; bb[s] = b; pp[s] = p;
            ok[s] = (R < T) && !(isctx && skip_ctx);
            const float* src = isctx ? csrc + (size_t)(b * NCTX + p) * DM : xsrc + (size_t)(b * SEQ + p - NCTX) * DM;
            if (ok[s]) {
#pragma unroll
                for (int j = 0; j < 4; ++j) v[s][j] = *(const f32x4*)(src + (lane + 64 * j) * 4); } }
#pragma unroll
        for (int s = 0; s < 2; ++s) if (ok[s]) {
            const int R = R0 + s * ngw, b = bb[s], p = pp[s]; const bool isctx = p < NCTX;
            const float* mrow = mods_l + (size_t)(isctx ? 16 : b) * 6144;
            float ss = 0.f;
#pragma unroll
            for (int j = 0; j < 4; ++j) ss += (v[s][j][0] * v[s][j][0] + v[s][j][1] * v[s][j][1]) + (v[s][j][2] * v[s][j][2] + v[s][j][3] * v[s][j][3]);
            const float rs = rsqrtf(wave_sum(ss) * (1.0f / DM) + EPS);
            const size_t orow = ffn_layout ? (size_t)b * U2B + (isctx ? p : 264 + p - NCTX) : (size_t)R;
#pragma unroll
            for (int j = 0; j < 4; ++j) { const int c4 = (lane + 64 * j) * 4;
                const f32x4 gg = *(const f32x4*)(g + c4), sh = *(const f32x4*)(mrow + shift_idx * 1024 + c4), sc = *(const f32x4*)(mrow + scale_idx * 1024 + c4);
                const f32x4 y = v[s][j] * rs * gg * (sc + 1.0f) + sh;
                u32x2 w; w.x = cvt_pk_bf16(y[0], y[1]); w.y = cvt_pk_bf16(y[2], y[3]);
                *(u32x2*)(U + orow * DM + c4) = w;
                if (ffn_layout && !isctx && p - NCTX >= SEQ - 33) *(u32x2*)(U + ((size_t)TAILROW0 + (b / 7) * 256 + (b % 7) * TAILSEG + (p - NCTX - (SEQ - 33))) * DM + c4) = w; }
        }
    }
    if (ffn_layout && gw >= 32 && gw < 48) {
        const int tb_ = gw - 32; const size_t orow = (size_t)TAILROW0 + (tb_ / 7) * 256 + (tb_ % 7) * TAILSEG + 33;
#pragma unroll
        for (int j = 0; j < 4; ++j) *(u32x2*)(U + orow * DM + (lane + 64 * j) * 4) = (u32x2){0u, 0u};
    }
    if (ffn_layout && gw < 32) {
        const int b = gw >> 1; const size_t orow = (size_t)b * U2B + ((gw & 1) ? 264 + SEQ : 263);
#pragma unroll
        for (int j = 0; j < 4; ++j) *(u32x2*)(U + orow * DM + (lane + 64 * j) * 4) = (u32x2){0u, 0u};
    }
}

template <int NF> __device__ __forceinline__ void rope_cs(int pos, int i, float& cs, float& sn) {
    const int row = pos >> 6, col = pos & 63; const int f = i < NF ? i : i - NF;
    const float inv = exp2f(-(float)f * (13.287712379549449f / NF));
    const float ang = (float)(i < NF ? row : col) * inv;
    sincosf(ang, &sn, &cs);
}

__device__ __forceinline__ void unpack8(const u32x4 v, float (&x)[8]) {
#pragma unroll
    for (int i = 0; i < 4; ++i) { x[2 * i] = bflo(v[i]); x[2 * i + 1] = bfhi(v[i]); }
}
__device__ __forceinline__ u32x4 pack8f(const float (&x)[8]) { u32x4 o; o.x = cvt_pk_bf16(x[0], x[1]); o.y = cvt_pk_bf16(x[2], x[3]); o.z = cvt_pk_bf16(x[4], x[5]); o.w = cvt_pk_bf16(x[6], x[7]); return o; }

__device__ __forceinline__ void ew_even(const Ctx& a, int j, int gw, int ngw, int lane) {
    const bf16_t* H = (const bf16_t*)(a.ws + WS_H); bf16_t* Qb = (bf16_t*)(a.ws + WS_Q); bf16_t* KVb = (bf16_t*)(a.ws + WS_KV); bf16_t* Kout = (bf16_t*)(a.ws + WS_U);
    const float QS = 0.10206207261596577f * LOG2E;
    const f32x2v* ropeT = (const f32x2v*)(a.ws + WS_ROPE_E);
    const int g16 = lane >> 4, c16 = lane & 15; const bool act = c16 < 12; const int cc = act ? c16 : 0;
    float qg[8], kg[8];
#pragma unroll
    for (int e = 0; e < 8; ++e) { qg[e] = a.inp(I_QG)[j * 96 + 8 * cc + e]; kg[e] = a.inp(I_KG)[j * 96 + 8 * cc + e]; }
    for (int R = gw; R < T; R += ngw) {
        const int p = R % TB; const int pos = p - NCTX; const bool lat = pos >= 0;
        const bf16_t* hrow = H + (size_t)R * 768; bf16_t* qrow = Qb + (size_t)R * 1536; bf16_t* kvrow = KVb + (size_t)R * 1536;
        const u32x4 z4 = {0u, 0u, 0u, 0u};
        u32x4 hv = z4; if (lane < 48) hv = *(const u32x4*)(hrow + 8 * lane);
        u32x4 qv[3], kv[3], vv[2];
#pragma unroll
        for (int rd = 0; rd < 3; ++rd) { const int hd = 4 * rd + g16; qv[rd] = z4; kv[rd] = z4;
            if (act) { qv[rd] = *(const u32x4*)(qrow + hd * 128 + 8 * c16); kv[rd] = c16 < 8 ? *(const u32x4*)(kvrow + hd * 128 + 8 * c16) : *(const u32x4*)(hrow + 384 + 8 * (c16 - 8)); } }
        vv[0] = *(const u32x4*)(kvrow + (lane >> 3) * 128 + 64 + 8 * (lane & 7)); vv[1] = z4;
        if (lane < 32) vv[1] = *(const u32x4*)(kvrow + ((lane + 64) >> 3) * 128 + 64 + 8 * (lane & 7));
        float cs[8], sn[8];
#pragma unroll
        for (int e = 0; e < 8; ++e) { cs[e] = 1.f; sn[e] = 0.f; }
        if (lat && c16 >= 8 && act) {
#pragma unroll
            for (int e = 0; e < 8; ++e) { const f32x2v t = ropeT[pos * 16 + 8 * (c16 & 1) + e]; cs[e] = t.x; sn[e] = t.y; } }
        float x[8]; unpack8(hv, x); float ss = 0.f;
#pragma unroll
        for (int e = 0; e < 8; ++e) ss += x[e] * x[e];
        ss = half_sum(ss);
        const float r_q = rsqrtf(__shfl(ss, 0) * (1.0f / 256.0f) + EPS), r_kv = rsqrtf(__shfl(ss, 32) * (1.0f / 128.0f) + EPS);
#pragma unroll
        for (int rd = 0; rd < 3; ++rd) {
            const int hd = 4 * rd + g16;
            { float y[8], o[8]; unpack8(qv[rd], y); float s2 = 0.f;
#pragma unroll
              for (int e = 0; e < 8; ++e) { y[e] *= r_q; s2 += y[e] * y[e]; }
              s2 += __shfl_xor(s2, 8); s2 += __shfl_xor(s2, 4); s2 += __shfl_xor(s2, 2); s2 += __shfl_xor(s2, 1);
              const float sc = rsqrtf(s2 * (1.0f / 96.0f) + EPS);
#pragma unroll
              for (int e = 0; e < 8; ++e) { y[e] *= sc * qg[e]; o[e] = __shfl_xor(y[e], 2); }
              if (c16 >= 8) {
#pragma unroll
                  for (int e = 0; e < 8; ++e) y[e] = c16 < 10 ? y[e] * cs[e] - o[e] * sn[e] : o[e] * sn[e] + y[e] * cs[e]; }
#pragma unroll
              for (int e = 0; e < 8; ++e) y[e] *= QS;
              if (act) *(u32x4*)(qrow + hd * 128 + 8 * c16) = pack8f(y); }
            { float y[8], o[8]; unpack8(kv[rd], y); float s2 = 0.f; const float pre = c16 < 8 ? r_kv : 1.0f;
#pragma unroll
              for (int e = 0; e < 8; ++e) { y[e] *= pre; s2 += y[e] * y[e]; }
              s2 += __shfl_xor(s2, 8); s2 += __shfl_xor(s2, 4); s2 += __shfl_xor(s2, 2); s2 += __shfl_xor(s2, 1);
              const float sc = rsqrtf(s2 * (1.0f / 96.0f) + EPS);
#pragma unroll
              for (int e = 0; e < 8; ++e) { y[e] *= sc * kg[e]; o[e] = __shfl_xor(y[e], 2); }
              if (c16 >= 8) {
#pragma unroll
                  for (int e = 0; e < 8; ++e) y[e] = c16 < 10 ? y[e] * cs[e] - o[e] * sn[e] : o[e] * sn[e] + y[e] * cs[e]; }
              if (act) *(u32x4*)(Kout + (size_t)R * 1152 + hd * 96 + 8 * c16) = pack8f(y); }
        }
        { float y[8]; unpack8(vv[0], y);
#pragma unroll
          for (int e = 0; e < 8; ++e) y[e] *= r_kv;
          *(u32x4*)(kvrow + (lane >> 3) * 128 + 64 + 8 * (lane & 7)) = pack8f(y);
          if (lane < 32) { unpack8(vv[1], y);
#pragma unroll
              for (int e = 0; e < 8; ++e) y[e] *= r_kv;
              *(u32x4*)(kvrow + ((lane + 64) >> 3) * 128 + 64 + 8 * (lane & 7)) = pack8f(y); } }
    }
}

__device__ __forceinline__ void z_fold(const Ctx& a, LAS unsigned char* lds, int gw, int ngw, int wave, int lane) {
    const bf16_t* ZLp = (const bf16_t*)(a.ws + WS_ZL); bf16_t* ZF = (bf16_t*)(a.ws + WS_ZF);
    LAS bf16_t* zr = (LAS bf16_t*)(lds + wave * 16384);
    for (int row = gw; row < 4096; row += ngw) {
        const bf16_t* src = ZLp + (size_t)row * 8192;
#pragma unroll
        for (int i = 0; i < 16; ++i) *(LAS u32x4*)(zr + 8 * (lane + 64 * i)) = *(const u32x4*)(src + 8 * (lane + 64 * i));
        asm volatile("s_waitcnt lgkmcnt(0)" ::: "memory");
#pragma unroll
        for (int i = 0; i < 8; ++i) { const int k0 = 8 * (lane + 64 * i); float y[8];
#pragma unroll
            for (int e = 0; e < 8; ++e) { const int kap = k0 + e; float v;
                if (kap <= 2048) { v = bf2f(zr[kap]); if (kap != 0 && kap != 2048) v += bf2f(zr[4096 - kap]); }
                else { const int l = kap - 2048; v = bf2f(zr[4096 + l]) - bf2f(zr[8192 - l]); }
                y[e] = v; }
            *(u32x4*)(ZF + (size_t)row * 4096 + k0) = pack8f(y); }
        asm volatile("s_waitcnt lgkmcnt(0)" ::: "memory");
    }
}

__device__ __forceinline__ void ew_odd(const Ctx& a, int j, int gw, int ngw, int lane) {
    bf16_t* H = (bf16_t*)(a.ws + WS_H); bf16_t* PO = (bf16_t*)(a.ws + WS_POOL);
    const float QS = 0.125f * LOG2E;
    const f32x2v* ropeT = (const f32x2v*)(a.ws + WS_ROPE_O);
    const int c8 = lane & 7, hl = lane >> 3;
    float qg[8], kg[8];
#pragma unroll
    for (int e = 0; e < 8; ++e) { qg[e] = a.inp(I_WQG)[j * 64 + 8 * c8 + e]; kg[e] = a.inp(I_WKG)[j * 64 + 8 * c8 + e]; }
    for (int R = gw; R < T; R += ngw) {
        const int p = R % TB; const int pos = p - NCTX; const bool lat = pos >= 0;
        bf16_t* hrow = H + (size_t)R * 1536;
        u32x4 qk[2]; qk[1] = (u32x4){0u, 0u, 0u, 0u}; if (lane >= 32) qk[1] = *(const u32x4*)(hrow + 512 + 8 * lane);
        float cs[8], sn[8];
#pragma unroll
        for (int e = 0; e < 8; ++e) { cs[e] = 1.f; sn[e] = 0.f; }
        if (lat) {
#pragma unroll
            for (int e = 0; e < 8; ++e) { const f32x2v t = ropeT[pos * 32 + 8 * (c8 & 3) + e]; cs[e] = t.x; sn[e] = t.y; } }
        const int tpos = lat ? pos : p, Ls = lat ? SEQ : NCTX;
        { const int pc = lane & 31, g = pc >> 3, half = 1 << g;
          const int lo = tpos - half < 0 ? 0 : tpos - half, hi = tpos + half > Ls ? Ls : tpos + half;
          float sum[8];
#pragma unroll
          for (int e = 0; e < 8; ++e) sum[e] = 0.f;
          if (lane < 32) {
              for (int tt = lo; tt < hi; ++tt) { float z[8]; unpack8(*(const u32x4*)(hrow + (ptrdiff_t)(tt - tpos) * 1536 + 1280 + 8 * pc), z);
#pragma unroll
                  for (int e = 0; e < 8; ++e) sum[e] += z[e]; }
              const float rc = 1.0f / (float)(hi - lo); float z[8]; unpack8(*(const u32x4*)(hrow + 1280 + 8 * pc), z);
#pragma unroll
              for (int e = 0; e < 8; ++e) sum[e] = sum[e] * rc - z[e];
              *(u32x4*)(PO + (size_t)R * 256 + 8 * pc) = pack8f(sum); } }
        if (lane >= 32) {
            float y[8], o[8]; unpack8(qk[1], y); float s2 = 0.f;
#pragma unroll
            for (int e = 0; e < 8; ++e) s2 += y[e] * y[e];
            s2 += __shfl_xor(s2, 4); s2 += __shfl_xor(s2, 2); s2 += __shfl_xor(s2, 1);
            const float sc = rsqrtf(s2 * (1.0f / 64.0f) + EPS);
#pragma unroll
            for (int e = 0; e < 8; ++e) { y[e] *= sc * kg[e]; o[e] = __shfl_xor(y[e], 4); }
#pragma unroll
            for (int e = 0; e < 8; ++e) y[e] = c8 < 4 ? y[e] * cs[e] - o[e] * sn[e] : o[e] * sn[e] + y[e] * cs[e];
            *(u32x4*)(hrow + 512 + 8 * lane) = pack8f(y);
        }
    }
}

#define XB_TMO      128
#define XB_XCNT(j)  (256  + 64 * (j))
#define XB_XSUB(j)  (1280 + 64 * (j))
#define XB_XGEN(j)  (2304 + 64 * (j))
#define XB_TOP      3328
#define XB_TOPGEN   3392
#define XCD_BAR_WORDS 3456
#define XB_SPIN_CAP (1u << 18)
__device__ __forceinline__ unsigned xb_ld(unsigned* p)              { return __hip_atomic_load(p, __ATOMIC_RELAXED, __HIP_MEMORY_SCOPE_AGENT); }
__device__ __forceinline__ unsigned xb_add(unsigned* p, unsigned v) { return __hip_atomic_fetch_add(p, v, __ATOMIC_RELAXED, __HIP_MEMORY_SCOPE_AGENT); }
__device__ __forceinline__ unsigned xb_xcc_id() { return (unsigned)__builtin_amdgcn_s_getreg((3 << 11) | 20) & 0xFu; }
#define XB_SPIN(cond, bar) do { unsigned _sp = 0; while (cond) { __builtin_amdgcn_s_sleep(1); \
    if ((++_sp & 255u) == 0u) { if (xb_ld(&(bar)[XB_TMO])) break; if (_sp > XB_SPIN_CAP) { atomicAdd(&(bar)[XB_TMO], 1u); break; } } } } while (0)
struct XcdBarrier { unsigned* bar; unsigned x; volatile LAS unsigned* st; };
__device__ __forceinline__ XcdBarrier xcd_barrier_post(unsigned* bar, volatile LAS unsigned* st) {
    XcdBarrier b; b.bar = bar; b.x = xb_xcc_id(); b.st = st;
    int tid_ = threadIdx.x; asm volatile("" : "+v"(tid_));
    if (tid_ == 0) (void)xb_add(&bar[XB_XCNT(b.x)], 1u);
    return b;
}
__device__ __forceinline__ void xcd_barrier_complete(unsigned* bar, unsigned x, unsigned& nloc, unsigned& nx) {
    const unsigned G = gridDim.x * gridDim.y * gridDim.z;
    unsigned sum, cnt, mine, sp = 0u;
    for (;;) {
        sum = 0u; cnt = 0u; mine = 0u;
#pragma unroll
        for (unsigned j = 0; j < 16; ++j) { const unsigned c = xb_ld(&bar[XB_XCNT(j)]); sum += c; cnt += (c > 0u) ? 1u : 0u; mine = (j == x) ? c : mine; }
        if (sum == G) break;
        __builtin_amdgcn_s_sleep(1);
        if ((++sp & 255u) == 0u) { if (xb_ld(&bar[XB_TMO])) break; if (sp > XB_SPIN_CAP) { atomicAdd(&bar[XB_TMO], 1u); break; } }
    }
    nloc = mine > 0u ? mine : 1u; nx = cnt > 0u ? cnt : 1u;
}
__device__ __forceinline__ void xcd_barrier(const XcdBarrier& b) {
    asm volatile("s_waitcnt vmcnt(0)" ::: "memory");
    __syncthreads();
    int tid_ = threadIdx.x; asm volatile("" : "+v"(tid_));
    if (tid_ == 0) {
        unsigned* bar = b.bar;
        __builtin_amdgcn_s_waitcnt(0);
        unsigned nloc = b.st[0], nx = b.st[1];
        if (nloc == 0u) { xcd_barrier_complete(bar, b.x, nloc, nx); b.st[0] = nloc; b.st[1] = nx; }
        const unsigned old = xb_add(&bar[XB_XSUB(b.x)], 1u);
        const unsigned gen = old / nloc;
        if (old + 1u == (gen + 1u) * nloc) {
            __builtin_amdgcn_fence(__ATOMIC_RELEASE, "agent");
            asm volatile("s_waitcnt vmcnt(0)" ::: "memory");
            const unsigned og = xb_add(&bar[XB_TOP], 1u);
            const unsigned tg = og / nx;
            if (og + 1u == (tg + 1u) * nx) xb_add(&bar[XB_TOPGEN], 1u);
            else XB_SPIN(xb_ld(&bar[XB_TOPGEN]) == tg, bar);
            __builtin_amdgcn_fence(__ATOMIC_ACQUIRE, "agent");
            xb_add(&bar[XB_XGEN(b.x)], 1u);
            asm volatile("s_waitcnt vmcnt(0)" ::: "memory");
        } else {
            XB_SPIN(xb_ld(&bar[XB_XGEN(b.x)]) == gen, bar);
            __builtin_amdgcn_fence(__ATOMIC_ACQUIRE, "agent");
            asm volatile("s_waitcnt vmcnt(0)" ::: "memory");
        }
    }
    __syncthreads();
}

constexpr int LDS_BYTES = 147456;
constexpr int NPHASES = 1 + 2 * 9 + 2 * 8;

__global__ void __launch_bounds__(512, 2) mega_fwd(Args ka) {
    extern __shared__ __attribute__((aligned(16))) unsigned char lds_raw[];
    LAS unsigned char* lds = (LAS unsigned char*)lds_raw;
    cg::grid_group grid = cg::this_grid();
    volatile LAS unsigned* xbst = (volatile LAS unsigned*)(lds + 139264);
    { int tid_ = threadIdx.x; asm volatile("" : "+v"(tid_)); if (tid_ < 2) xbst[tid_] = 0u; }
    __syncthreads();
    XcdBarrier xbar; xbar.bar = (unsigned*)ka.ws; xbar.x = 0; xbar.st = xbst;
    if (ka.hi - ka.lo > 1) xbar = xcd_barrier_post((unsigned*)ka.ws, xbst);
#define U ((bf16_t*)(wsl + WS_U))
#define MIX ((bf16_t*)(wsl + WS_MIX))
#define Hb ((bf16_t*)(wsl + WS_H))
#define Qb ((bf16_t*)(wsl + WS_Q))
#define KVb ((bf16_t*)(wsl + WS_KV))
#define ZL ((bf16_t*)(wsl + WS_ZL))
#define ZC ((bf16_t*)(wsl + WS_ZC))
#define HID ((bf16_t*)(wsl + WS_HID))
#define POOL ((bf16_t*)(wsl + WS_POOL))
#define DFTL ((bf16_t*)(wsl + WS_DFTL))
#define DFTC ((bf16_t*)(wsl + WS_DFTC))
#define hctx ((float*)(wsl + WS_HCTX))
    int ph = 0, layer_ = 0;
#define PHASE_BEGIN if (ph >= ka.lo && ph < ka.hi) { GAS unsigned char* wsg_ = (GAS unsigned char*)ka.ws; asm volatile("" : "+s"(wsg_)); unsigned char* wsl = (unsigned char*)wsg_; \
        const __attribute__((address_space(4))) cfp_t* ain_ = (const __attribute__((address_space(4))) cfp_t*)__builtin_amdgcn_kernarg_segment_ptr(); asm volatile("" : "+s"(ain_)); \
        const Ctx a{ain_, ka.out, wsl}; \
        int lyr_ = layer_; asm volatile("" : "+s"(lyr_)); const float* mods_l = (const float*)(wsl + WS_MODS) + (size_t)lyr_ * 17 * 6144; const float* xin = lyr_ == 0 ? a.inp(I_X) : a.out; const float* cin = lyr_ == 0 ? a.inp(I_CTX) : (const float*)(wsl + WS_HCTX); (void)mods_l; (void)xin; (void)cin; int tid = threadIdx.x; asm volatile("" : "+v"(tid)); int G = gridDim.x, bx = blockIdx.x; asm volatile("" : "+s"(G), "+s"(bx)); \
        const int vcu = (G % 8 == 0) ? (bx % 8) * (G / 8) + bx / 8 : bx, ngw = G * 8, ngt = G * 512; (void)vcu; (void)ngw; (void)ngt; \
        const int lane = tid & 63, wave = __builtin_amdgcn_readfirstlane(tid >> 6), gw = bx * 8 + wave, gtid = bx * 512 + tid; LAS float* scr = (LAS float*)(lds + wave * 8448); \
        (void)lane; (void)gw; (void)gtid; (void)scr;
#define PHASE_END } if (ph >= ka.lo && ph + 1 < ka.hi) { for (int sr_ = 0; sr_ < REP_SYNC; ++sr_) { if (ph == 0) grid.sync(); else xcd_barrier(xbar); } } ++ph;

    PHASE_BEGIN
#ifndef SKIP_P0
        { REPLOOP(REP_P0) {
        for (int it = bx; it < 192; it += G) mods_item(a, it, (LAS float*)lds);
        for (int j = 0; j < 2; ++j) {
            tr_job(a.inp(I_MLAWIN) + (size_t)j * DM * 672, DM, 672, (bf16_t*)(wsl + WS_WINE) + (size_t)j * 768 * DM, 768, 1, nullptr, scr, gw, ngw, lane);
            tr_job(a.inp(I_WUQ) + (size_t)j * 256 * 1152, 256, 1152, (bf16_t*)(wsl + WS_WUQ) + (size_t)j * 1536 * 256, 1536, 2, a.inp(I_CQG) + j * 256, scr, gw, ngw, lane);
            tr_job(a.inp(I_WUKV) + (size_t)j * 128 * 1536, 128, 1536, (bf16_t*)(wsl + WS_WUKV) + (size_t)j * 1536 * 128, 1536, 0, a.inp(I_CKVG) + j * 128, scr, gw, ngw, lane);
            tr_job(a.inp(I_EWOUT) + (size_t)j * DM * DM, DM, DM, (bf16_t*)(wsl + WS_WOUTE) + (size_t)j * DM * DM, DM, 0, nullptr, scr, gw, ngw, lane);
            tr_job(a.inp(I_WINWIN) + (size_t)j * DM * 1536, DM, 1536, (bf16_t*)(wsl + WS_WINO) + (size_t)j * 1536 * DM, 1536, 0, nullptr, scr, gw, ngw, lane);
            tr_job(a.inp(I_OWOUT) + (size_t)j * DM * DM, DM, DM, (bf16_t*)(wsl + WS_WOUTO) + (size_t)j * DM * DM, DM, 0, nullptr, scr, gw, ngw, lane);
        }
        ffn_weights(a, 0, scr, gw, ngw, lane);
        __syncthreads();
        LAS float* ctab = (LAS float*)lds;
        for (int m = tid; m < 4096; m += 512) ctab[m] = cospif((float)m * (1.0f / 2048.0f)) * (1.0f / 64.0f);
        __syncthreads();
        for (int idx = gtid; idx < 4096 * 512; idx += ngt) { const int k = idx >> 9, col0 = (idx & 511) * 8; float v[8];
#pragma unroll
            for (int e = 0; e < 8; ++e) { const int kap = col0 + e; const int m = kap <= 2048 ? (k * kap) & 4095 : (k * (kap - 2048) + 1024) & 4095; v[e] = ctab[m]; }
            u32x4 o; o.x = cvt_pk_bf16(v[0], v[1]); o.y = cvt_pk_bf16(v[2], v[3]); o.z = cvt_pk_bf16(v[4], v[5]); o.w = cvt_pk_bf16(v[6], v[7]);
            *(u32x4*)(DFTL + (size_t)k * 4096 + col0) = o; }
        for (int idx = gtid; idx < 256 * 64; idx += ngt) { const int k = idx >> 6, col0 = (idx & 63) * 8, cs = col0 >> 8, l0 = col0 & 255; float v[8];
#pragma unroll
            for (int e = 0; e < 8; ++e) { const int m = (k * (l0 + e)) & 255; const float x = (float)m * (1.0f / 128.0f); v[e] = (cs ? -sinpif(x) : cospif(x)) * (1.0f / 16.0f); }
            u32x4 o; o.x = cvt_pk_bf16(v[0], v[1]); o.y = cvt_pk_bf16(v[2], v[3]); o.z = cvt_pk_bf16(v[4], v[5]); o.w = cvt_pk_bf16(v[6], v[7]);
            *(u32x4*)(DFTC + (size_t)k * 512 + col0) = o; }
        for (int idx = gtid; idx < 2 * 512 * 256; idx += ngt) { const int j = idx >> 17, n = (idx >> 8) & 511, k = idx & 255; const int cs = n >> 8, g = (n >> 6) & 3, d = n & 63, g2 = k >> 6, c = k & 63;
            float s = 0.f;
            if (g2 == g) { const float* wf = a.inp(I_FNETW) + ((size_t)(j * 4 + g) * 64) * 64 + d;
                for (int c2 = 0; c2 < 64; ++c2) { const int m = (c * c2) & 63; s += (cs ? -ctab[(m * 64 + 1024) & 4095] : ctab[m * 64]) * wf[c2 * 64]; }
                s *= 8.0f; }
            ((bf16_t*)(wsl + WS_WF))[idx] = (bf16_t)(cvt_pk_bf16(s, 0.f) & 0xffffu); }
        for (int idx = gtid; idx < 4096 * 16; idx += ngt) { float cs, sn; rope_cs<8>(idx >> 4, idx & 15, cs, sn); ((f32x2v*)(wsl + WS_ROPE_E))[idx] = (f32x2v){cs, sn}; }
        for (int idx = gtid; idx < 4096 * 32; idx += ngt) { float cs, sn; rope_cs<16>(idx >> 5, idx & 31, cs, sn); ((f32x2v*)(wsl + WS_ROPE_O))[idx] = (f32x2v){cs, sn}; }
        for (int idx = gtid; idx < 2 * 256 * 256; idx += ngt) { const int j = idx >> 16, n = (idx >> 8) & 255, k = idx & 255; const int g = n >> 6, d = n & 63, g2 = k >> 6, c = k & 63;
            float s = 0.f; if (g2 == g) s = a.inp(I_POOLW)[((size_t)(j * 4 + g) * 64 + c) * 64 + d] * a.inp(I_POOLS)[j * 256 + n];
            ((bf16_t*)(wsl + WS_WP))[idx] = (bf16_t)(cvt_pk_bf16(s, 0.f) & 0xffffu); }
        __syncthreads(); } }
#endif
    PHASE_END

    for (int layer = 0; layer < 4; ++layer) {
        const int j = layer >> 1; const bool even = !(layer & 1); const bool ctx_out = layer < 3;
        layer_ = layer;

        PHASE_BEGIN
#ifndef SKIP_NORM
            { REPLOOP(REP_NORM)
            norm_pass(xin, cin, a.inp(I_N1G) + layer * DM, mods_l, 0, 1, U, false, false, gw, ngw, lane); }
#endif
        PHASE_END

        PHASE_BEGIN
#ifndef SKIP_GIN
            { REPLOOP(REP_GIN) {
            if (even) { pg8::Gemm g{U, (const bf16_t*)(wsl + WS_WINE) + (size_t)j * 768 * DM, DM, DM, DM};
                pg8::Order<pg8::MapStd> S; S.init(T / 256, 3, G, bx, pg8::MapStd{0}); pg8::EpiBf16 E{Hb, 768, Hb, 768}; pg8::gemm_phase(lds, g, S, E); }
            else { pg8::Gemm g{U, (const bf16_t*)(wsl + WS_WINO) + (size_t)j * 1536 * DM, DM, DM, DM};
                pg8::Order<pg8::MapStd> S; S.init(T / 256, 6, G, bx, pg8::MapStd{0}); pg8::EpiBf16 E{Hb, 1536, Hb, 1536}; pg8::gemm_phase(lds, g, S, E); }
            } }
#endif
        PHASE_END

        if (even) {
            PHASE_BEGIN
#ifndef SKIP_G3
                { REPLOOP(REP_G3) {
                { pg8::Gemm g{Hb, (const bf16_t*)(wsl + WS_WUQ) + (size_t)j * 1536 * 256, 768, 256, 256};
                  pg8::Order<pg8::MapStd> S; S.init(T / 256, 6, G, bx, pg8::MapStd{0}); pg8::EpiBf16 E{Qb, 1536, Qb, 1536}; pg8::gemm_phase(lds, g, S, E); }
                { pg8::Gemm g{Hb + 256, (const bf16_t*)(wsl + WS_WUKV) + (size_t)j * 1536 * 128, 768, 128, 128};
                  pg8::Order<pg8::MapStd> S; S.init(T / 256, 6, G, bx, pg8::MapStd{0}); pg8::EpiBf16 E{KVb, 1536, KVb, 1536}; pg8::gemm_phase(lds, g, S, E); }
                { pg8::Gemm g{(const bf16_t*)(wsl + WS_WF) + (size_t)j * 512 * 256, Hb + 416, 256, 768, 256};
                  pg8::Order<pg8::MapZ> S; S.init(2, T / 256, G, bx, pg8::MapZ{}); pg8::EpiBf16 E{ZL, 8192, ZC, 512}; pg8::gemm_phase(lds, g, S, E); }
                } }
#endif
            PHASE_END
            PHASE_BEGIN
#ifndef SKIP_EWE
                ew_even(a, j, gw, ngw, lane);
                z_fold(a, lds, gw, ngw, wave, lane);
#endif
            PHASE_END
            PHASE_BEGIN
#ifndef SKIP_ATTE
                const bf16_t* Kb = (const bf16_t*)(wsl + WS_U);
                const int nu = 3072 + (ctx_out ? 192 : 0);
                { REPLOOP(REP_ATTE)
                for (int uid = vcu; uid < nu; uid += G) {
                    if (uid < 3072) { const int bh = uid >> 4, qb = uid & 15, b = bh / 12, h = bh % 12; const size_t base = (size_t)b * TB, qrow = base + NCTX + qb * 256;
                        attn_unit<96, false>(lds, Qb + qrow * 1536 + h * 128, 1536, Kb + base * 1152 + h * 96, 1152, KVb + base * 1536 + h * 128 + 64, 1536, MIX + qrow * DM + h * 64, 68, 0, 0, 0, -1e30f, false); }
                    else { const int bh = uid - 3072, b = bh / 12, h = bh % 12; const size_t base = (size_t)b * TB;
                        attn_unit<96, false>(lds, Qb + base * 1536 + h * 128, 1536, Kb + base * 1152 + h * 96, 1152, KVb + base * 1536 + h * 128 + 64, 1536, MIX + base * DM + h * 64, 4, 0, 0, 0, -1e30f, false); }
                } }
#ifndef SKIP_ATTE_G
                { REPLOOP(REP_FNET) {
                { pg8::Gemm g{DFTL, (const bf16_t*)(wsl + WS_ZF), 4096, 4096, 4096};
                  pg8::Order<pg8::MapFnetL> S; S.init(256, 1, G, bx, pg8::MapFnetL{}); pg8::EpiBf16 E{MIX, DM, MIX, DM}; pg8::gemm_phase(lds, g, S, E); }
                if (ctx_out) { pg8::Gemm g{DFTC, ZC, 512, 512, 512};
                  pg8::Order<pg8::MapFnetC> S; S.init(16, 1, G, bx, pg8::MapFnetC{}); pg8::EpiBf16 E{MIX, DM, MIX, DM}; pg8::gemm_phase(lds, g, S, E); }
                } }
#endif
#endif
            PHASE_END
        } else {
            PHASE_BEGIN
#ifndef SKIP_EWO
                ew_odd(a, j, gw, ngw, lane);
#endif
            PHASE_END
            PHASE_BEGIN
#ifndef SKIP_ATTO
                const float* sink = a.inp(I_SINK) + j * 12;
                const int nu = 3072 + (ctx_out ? 192 : 0);
                { REPLOOP(REP_ATTO)
                for (int uid = vcu; uid < nu; uid += G) {
                    if (uid < 3072) { const int bh = uid >> 4, qb = uid & 15, b = bh / 12, h = bh % 12, kvh = h / 3; const size_t base = (size_t)b * TB, qrow = base + NCTX + qb * 256;
                        int lt0 = qb * 4 - 2, lt1 = qb * 4 + 6; if (lt0 < 0) lt0 = 0; if (lt1 > 64) lt1 = 64;
                        attn_unit<64, true>(lds, Hb + qrow * 1536 + h * 64, 1536, Hb + base * 1536 + 768 + kvh * 64, 1536, Hb + base * 1536 + 1024 + kvh * 64, 1536, MIX + qrow * DM + h * 64,
                                            4, 4 + lt0, 4 + lt1, qb * 256, sink[h] * LOG2E, true, a.inp(I_WQG) + j * 64, (const f32x2v*)(wsl + WS_ROPE_O), true); }
                    else { const int bh = uid - 3072, b = bh / 12, h = bh % 12, kvh = h / 3; const size_t base = (size_t)b * TB;
                        attn_unit<64, true>(lds, Hb + base * 1536 + h * 64, 1536, Hb + base * 1536 + 768 + kvh * 64, 1536, Hb + base * 1536 + 1024 + kvh * 64, 1536, MIX + base * DM + h * 64,
                                            4, 0, 0, 0, sink[h] * LOG2E, true, a.inp(I_WQG) + j * 64, (const f32x2v*)(wsl + WS_ROPE_O), false); }
                } }
                { pg8::Gemm g{POOL, (const bf16_t*)(wsl + WS_WP) + (size_t)j * 256 * 256, 256, 256, 256};
                  pg8::Order<pg8::MapStd> S; S.init(T / 256, 1, G, bx, pg8::MapStd{768}); pg8::EpiBf16 E{MIX, DM, MIX, DM}; pg8::gemm_phase(lds, g, S, E); }
#endif
            PHASE_END
        }

        PHASE_BEGIN
#ifndef SKIP_WOUT
            pg8::Gemm g{MIX, (const bf16_t*)(wsl + (even ? WS_WOUTE : WS_WOUTO)) + (size_t)j * DM * DM, DM, DM, DM};
            pg8::Order<pg8::MapRes> S; S.init(ctx_out ? 272 : 256, 4, G, bx, pg8::MapRes{ctx_out ? 1 : 0});
            { REPLOOP(REP_WOUT) { pg8::EpiRes E{rep_ ? (const float*)a.out : xin, a.out, rep_ ? (const float*)hctx : cin, hctx, mods_l, 2, rep_ ? 0.f : 1.f}; pg8::gemm_phase(lds, g, S, E); } }
#endif
        PHASE_END

        PHASE_BEGIN
#ifndef SKIP_NORM2
            { REPLOOP(REP_NORM)
            norm_pass(a.out, hctx, a.inp(I_N2G) + layer * DM, mods_l, 3, 4, U, true, !ctx_out, gw, ngw, lane); }
#endif
        PHASE_END

        PHASE_BEGIN
#ifndef SKIP_UP
            pg8::Gemm g{U, (const bf16_t*)(wsl + WS_WUP), DM, DM, DM};
            pg8::Order<pg8::MapUp> S; S.init(ctx_out ? 275 : 259, 22, G, bx, pg8::MapUp{ctx_out ? 1 : 0});
            pg8::EpiUp E{HID, a.inp(I_CONVW) + (size_t)layer * 3 * 2 * DFF, a.inp(I_CONVB) + (size_t)layer * 2 * DFF}; { REPLOOP(REP_UP) pg8::gemm_phase(lds, g, S, E); }
#endif
        PHASE_END

        PHASE_BEGIN
#ifndef SKIP_DN
            pg8::Gemm g{HID, (const bf16_t*)(wsl + ((layer & 1) ? WS_WDN2 : WS_WDN)), DFF, DFF, DFF};
            pg8::Order<pg8::MapRes> S; S.init(ctx_out ? 272 : 256, 4, G, bx, pg8::MapRes{ctx_out ? 1 : 0});
            { REPLOOP(REP_DN) { pg8::EpiRes E{a.out, a.out, hctx, hctx, mods_l, 5, rep_ ? 0.f : 1.f}; pg8::gemm_phase(lds, g, S, E); } }
            if (layer < 3) {
                const int nfree = (ctx_out && G == 256) ? 192 : G, first = (ctx_out && G == 256) ? 64 : 0;
                if (bx >= first) ffn_weights(a, layer + 1, scr, (bx - first) * 8 + wave, nfree * 8, lane);
            }
#endif
        PHASE_END
    }
#undef PHASE_BEGIN
#undef PHASE_END
#undef U
#undef MIX
#undef Hb
#undef Qb
#undef KVb
#undef ZL
#undef ZC
#undef HID
#undef POOL
#undef DFTL
#undef DFTC
#undef hctx
}

extern "C" void kernel_launch(void* const* d_in, const int* in_sizes, int n_in, void* d_out, int out_size, void* d_ws, size_t ws_size, hipStream_t stream) {
    static int grid = 0;
    if (grid == 0) {
        if (n_in != 28 || out_size != NB * SEQ * DM || ws_size < WS_END) { fprintf(stderr, "kernel_launch: unexpected shapes (n_in %d, out %d, ws %zu); nothing launched\n", n_in, out_size, ws_size); grid = -1; return; }
        int dev = 0, cus = 0, per_cu = 0;
        if (hipGetDevice(&dev) != hipSuccess || hipDeviceGetAttribute(&cus, hipDeviceAttributeMultiprocessorCount, dev) != hipSuccess) { grid = -1; return; }
        if (hipFuncSetAttribute((const void*)mega_fwd, hipFuncAttributeMaxDynamicSharedMemorySize, LDS_BYTES) != hipSuccess) { fprintf(stderr, "kernel_launch: hipFuncSetAttribute failed\n"); grid = -1; return; }
        if (hipOccupancyMaxActiveBlocksPerMultiprocessor(&per_cu, (const void*)mega_fwd, 512, LDS_BYTES) != hipSuccess || per_cu < 1) { fprintf(stderr, "kernel_launch: occupancy query says %d\n", per_cu); per_cu = 1; }
        (void)hipGetLastError();
        grid = cus * 1;
    }
    if (grid < 0) return;
    Args a{};
    for (int i = 0; i < 28; ++i) a.in[i] = (const float*)d_in[i];
    a.out = (float*)d_out; a.ws = (unsigned char*)d_ws; a.lo = 0; a.hi = NPHASES;
    (void)hipMemsetAsync(d_ws, 0, 16384, stream);
    void* args[] = {&a};
    hipError_t e = hipLaunchCooperativeKernel((const void*)mega_fwd, dim3(grid), dim3(512), args, LDS_BYTES, stream);
    if (e != hipSuccess) {
        fprintf(stderr, "kernel_launch: cooperative launch failed: %s (grid %d); falling back to one launch per phase\n", hipGetErrorString(e), grid);
        (void)hipGetLastError();
        for (int p = 0; p < NPHASES; ++p) { a.lo = p; a.hi = p + 1; hipLaunchKernelGGL(mega_fwd, dim3(grid), dim3(512), LDS_BYTES, stream, a); }
    }
}
```

```cpp
#include <hip/hip_runtime.h>
#include <hip/hip_cooperative_groups.h>
#include <cstdio>
#include <cstdint>
namespace cg = cooperative_groups;

#define REP_NORM 1
#define REP_GIN 1
#define REP_G3 1
#define REP_ATTE 1
#define REP_FNET 1
#define REP_ATTO 1
#define REP_WOUT 1
#define REP_UP 1
#define REP_DN 1
#define REP_P0 1
#define REP_EW 1
#define REP_SYNC 1
#define PROBE_MODE 0
#define REPLOOP(N) int nrep_ = (N); asm volatile("" : "+s"(nrep_)); for (int rep_ = 0; rep_ < nrep_; ++rep_)

constexpr int NB = 16, SEQ = 4096, NCTX = 256, DM = 1024, TB = SEQ + NCTX, T = NB * TB;
constexpr int DFF = 2816, U2B = 4608, TAILROW0 = 16 * 4608, TAILSEG = 34;
constexpr float EPS = 1e-6f;
constexpr float LOG2E = 1.4426950408889634f;

constexpr size_t MiB = 1u << 20;
constexpr size_t WS_MODS = 1 * MiB;
constexpr size_t WS_WINE = 3 * MiB;
constexpr size_t WS_WUQ = 6 * MiB;
constexpr size_t WS_WUKV = WS_WUQ + 3 * MiB / 2;
constexpr size_t WS_WF = WS_WUKV + 3 * MiB / 4;
constexpr size_t WS_WP = WS_WF + MiB / 2;
constexpr size_t WS_WOUTE = 9 * MiB;
constexpr size_t WS_WOUTO = 13 * MiB;
constexpr size_t WS_WINO = 17 * MiB;
constexpr size_t WS_WUP = 23 * MiB;
constexpr size_t WS_WDN = 34 * MiB;
constexpr size_t WS_DFTC = 40 * MiB;
constexpr size_t WS_DFTL = 41 * MiB;
constexpr size_t WS_ZF = 73 * MiB;
constexpr size_t WS_HCTX = 105 * MiB;
constexpr size_t WS_U = 121 * MiB;
constexpr size_t WS_MIX = 275 * MiB;
constexpr size_t WS_ARENA = 411 * MiB;
constexpr size_t WS_H = WS_ARENA;
constexpr size_t WS_Q = WS_ARENA + 102 * MiB;
constexpr size_t WS_KV = WS_Q + 204 * MiB;
constexpr size_t WS_ZL = WS_KV + 204 * MiB;
constexpr size_t WS_ZC = WS_ZL + 64 * MiB;
constexpr size_t WS_POOL = WS_ARENA + 204 * MiB;
constexpr size_t WS_HID = WS_ARENA;
constexpr size_t WS_ROPE_E = WS_ZC + 4 * MiB;
constexpr size_t WS_ROPE_O = WS_ROPE_E + 1 * MiB;
constexpr size_t WS_WDN2 = WS_ROPE_O + 1 * MiB;
constexpr size_t WS_END = WS_WDN2 + 6 * MiB;
static_assert(WS_END <= 1024 * MiB, "ws map");

#define LAS __attribute__((address_space(3)))
#define GAS __attribute__((address_space(1)))
typedef unsigned short bf16_t;
typedef short bf16x8 __attribute__((ext_vector_type(8)));
typedef float f32x4 __attribute__((ext_vector_type(4)));
typedef float f32x16 __attribute__((ext_vector_type(16)));
typedef unsigned u32x4 __attribute__((ext_vector_type(4)));
typedef unsigned u32x2 __attribute__((ext_vector_type(2)));
typedef float f32x2v __attribute__((ext_vector_type(2)));

__device__ __forceinline__ unsigned cvt_pk_bf16(float lo, float hi) { unsigned r; asm volatile("v_cvt_pk_bf16_f32 %0, %1, %2" : "=v"(r) : "v"(lo), "v"(hi)); return r; }
__device__ __forceinline__ float bflo(unsigned u) { return __uint_as_float(u << 16); }
__device__ __forceinline__ float bfhi(unsigned u) { return __uint_as_float(u & 0xffff0000u); }
__device__ __forceinline__ float bf2f(bf16_t b) { return __uint_as_float((unsigned)b << 16); }
__device__ __forceinline__ float wave_sum(float v) {
#pragma unroll
    for (int o = 1; o < 64; o <<= 1) v += __shfl_xor(v, o);
    return v;
}
__device__ __forceinline__ float half_sum(float v) {
#pragma unroll
    for (int o = 1; o < 32; o <<= 1) v += __shfl_xor(v, o);
    return v;
}

namespace pg8 {
constexpr int BM = 256, BK = 64, HALF = 128, HTB = HALF * BK * 2, STAGE_BYTES = 8 * HTB, NXCD = 8, WGM = 8;
__device__ __forceinline__ int lds_byte(int r, int c) { const int st = (r >> 4) * 2 + (c >> 5), rr = r & 15, cc = c & 31, ob = rr * 64 + cc * 2; return st * 1024 + (ob ^ (((ob >> 9) & 1) << 5)); }
__device__ __forceinline__ void stage_rc(int b, int& R, int& C) { const int st = b / 1024, sb = b % 1024, swz = sb ^ (((sb >> 9) & 1) << 5); R = (st >> 1) * 16 + swz / 64; C = (st & 1) * 32 + (swz % 64) / 2; }
__device__ __forceinline__ int perm32(int rho) { const int n = rho >> 4, i = rho & 15; return 8 * (i >> 2) + 4 * n + (i & 3); }

struct Unit { int pm, pn, arow, brow, orow, ocol, aux, bt; };
struct Gemm { const bf16_t* A; const bf16_t* Bt; int lda, ldb, K; };

template <class Map> struct Order {
    int nM, nN, nwg, G, c; Map map;
    __device__ __forceinline__ void init(int nM_, int nN_, int G_, int c_, const Map& m) { nM = nM_; nN = nN_; nwg = nM * nN; G = G_; c = c_; map = m; }
    __device__ __forceinline__ bool next(int i, Unit& u) const {
        const long L = (long)i * G + c; if (L >= nwg) return false;
        int wgid = (int)L; { const int q = nwg / NXCD, r = nwg % NXCD, xcd = wgid % NXCD, off = wgid / NXCD; wgid = (xcd < r ? xcd * (q + 1) : r * (q + 1) + (xcd - r) * q) + off; }
        const int nig = WGM * nN, gid = wgid / nig, fm = gid * WGM, gsz = (nM - fm) < WGM ? (nM - fm) : WGM;
        u.pm = fm + ((wgid % nig) % gsz); u.pn = (wgid % nig) / gsz; map(u); return true;
    }
};

struct EpiBf16 {
    static constexpr bool PERM = true;
    bf16_t* O0; int ld0; bf16_t* O1; int ld1;
    __device__ __forceinline__ void operator()(const f32x4 (&acc)[2][2][4][2], const Unit& u, int wr, int wc, int fr, int fq, LAS unsigned char*) const {
        bf16_t* base = u.aux ? O1 : O0; const int ldc = u.aux ? ld1 : ld0;
        const int row0 = u.orow + wr * 64 + fr, col0 = u.ocol + wc * 32 + 8 * fq;
#pragma unroll
        for (int ai = 0; ai < 2; ++ai)
#pragma unroll
            for (int m = 0; m < 4; ++m) { bf16_t* rowp = base + (size_t)(row0 + ai * HALF + m * 16) * ldc + col0;
#pragma unroll
                for (int bj = 0; bj < 2; ++bj) { const f32x4 v0 = acc[ai][bj][m][0], v1 = acc[ai][bj][m][1];
                    u32x4 w; w.x = cvt_pk_bf16(v0[0], v0[1]); w.y = cvt_pk_bf16(v0[2], v0[3]); w.z = cvt_pk_bf16(v1[0], v1[1]); w.w = cvt_pk_bf16(v1[2], v1[3]);
                    *(u32x4*)(rowp + bj * HALF) = w; } }
    }
};

struct EpiRes {
    static constexpr bool PERM = false;
    const float* xin; float* xout; const float* cin; float* cout; const float* mods_l; int gidx; float gs;
    __device__ __forceinline__ void operator()(const f32x4 (&acc)[2][2][4][2], const Unit& u, int wr, int wc, int fr, int fq, LAS unsigned char*) const {
        const float* src = u.aux ? cin : xin; float* dst = u.aux ? cout : xout;
        const float* gate = mods_l + (size_t)(u.aux ? 16 : u.bt) * 6144 + gidx * 1024;
        const int row0 = u.orow + wr * 64 + fr, col0 = u.ocol + wc * 32 + 4 * fq;
        const __amdgpu_buffer_rsrc_t rs = __builtin_amdgcn_make_buffer_rsrc((void*)dst, 0, 0x40000000, 0x00020000);
#pragma unroll
        for (int bj = 0; bj < 2; ++bj) {
            f32x4 g4[2], xv[2][2][4];
#pragma unroll
            for (int n = 0; n < 2; ++n) { const int col = col0 + bj * HALF + n * 16; g4[n] = *(const f32x4*)(gate + col) * gs;
#pragma unroll
                for (int ai = 0; ai < 2; ++ai)
#pragma unroll
                    for (int m = 0; m < 4; ++m) xv[n][ai][m] = *(const f32x4*)(src + (size_t)(row0 + ai * HALF + m * 16) * DM + col); }
            asm volatile("" ::: "memory");
#pragma unroll
            for (int n = 0; n < 2; ++n) { const int col = col0 + bj * HALF + n * 16;
#pragma unroll
                for (int ai = 0; ai < 2; ++ai)
#pragma unroll
                    for (int m = 0; m < 4; ++m) { const size_t off = (size_t)(row0 + ai * HALF + m * 16) * DM + col;
                        __builtin_amdgcn_raw_buffer_store_b128(__builtin_bit_cast(u32x4, xv[n][ai][m] + g4[n] * acc[ai][bj][m][n]), rs, (unsigned)(off * 4), 0, 16); } }
            asm volatile("" ::: "memory");
        }
    }
};

__device__ __forceinline__ float dpp_ror1(float v) { return __int_as_float(__builtin_amdgcn_update_dpp(__float_as_int(v), __float_as_int(v), 0x121, 0xf, 0xf, false)); }
__device__ __forceinline__ float dpp_ror15(float v) { return __int_as_float(__builtin_amdgcn_update_dpp(__float_as_int(v), __float_as_int(v), 0x12F, 0xf, 0xf, false)); }
__device__ __forceinline__ float silu_f(float x) { return x * __builtin_amdgcn_rcpf(1.0f + __expf(-x)); }

struct EpiUp {
    static constexpr bool PERM = false;
    bf16_t* Hd; const float* cw; const float* cb;
    __device__ __forceinline__ void operator()(const f32x4 (&acc)[2][2][4][2], const Unit& u, int wr, int wc, int fr, int fq, LAS unsigned char* lds) const {
        LAS float* hal = (LAS float*)(lds + STAGE_BYTES);
        LAS float* cwl = (LAS float*)(lds + 140288);
        const int tid_ = (wr * 4 + wc) * 64 + fq * 16 + fr;
        float cwv[2];
#pragma unroll
        for (int q = 0; q < 2; ++q) { const int e = tid_ + 512 * q, t = e >> 8, bj = (e >> 7) & 1, c = e & 127; cwv[q] = t < 3 ? cw[t * (2 * DFF) + bj * DFF + u.ocol + c] : cb[bj * DFF + u.ocol + c]; }
        if (fr == 0) {
#pragma unroll
            for (int ai = 0; ai < 2; ++ai)
#pragma unroll
                for (int bj = 0; bj < 2; ++bj)
#pragma unroll
                    for (int n = 0; n < 2; ++n) *(LAS f32x4*)(hal + ((2 * ai + wr) * 2 + 0) * 256 + bj * 128 + wc * 32 + n * 16 + 4 * fq) = acc[ai][bj][0][n];
        }
        if (fr == 15) {
#pragma unroll
            for (int ai = 0; ai < 2; ++ai)
#pragma unroll
                for (int bj = 0; bj < 2; ++bj)
#pragma unroll
                    for (int n = 0; n < 2; ++n) *(LAS f32x4*)(hal + ((2 * ai + wr) * 2 + 1) * 256 + bj * 128 + wc * 32 + n * 16 + 4 * fq) = acc[ai][bj][3][n];
        }
        cwl[tid_] = cwv[0]; cwl[tid_ + 512] = cwv[1];
        asm volatile("s_waitcnt lgkmcnt(0)" ::: "memory"); __builtin_amdgcn_s_barrier(); asm volatile("" ::: "memory");
        int fr_ = fr, fq_ = fq; asm volatile("" : "+v"(fr_), "+v"(fq_));
        const int rmin = u.aux == 1 ? 0 : 1, rmax = u.bt;
        const f32x4 zero4 = {0.f, 0.f, 0.f, 0.f};
#pragma unroll
        for (int ai = 0; ai < 2; ++ai) {
            const int g = 2 * ai + wr;
#pragma unroll
            for (int n = 0; n < 2; ++n) {
                const int chb = u.ocol + wc * 32 + n * 16 + 4 * fq_;
                const int colh = wc * 32 + n * 16 + 4 * fq_;
                f32x4 w0[2], w1[2], w2[2], bb[2], uh[2], dh[2];
#pragma unroll
                for (int bj = 0; bj < 2; ++bj) { const int cl = bj * 128 + colh;
                    w0[bj] = *(const LAS f32x4*)(cwl + 0 * 256 + cl); w1[bj] = *(const LAS f32x4*)(cwl + 1 * 256 + cl); w2[bj] = *(const LAS f32x4*)(cwl + 2 * 256 + cl); bb[bj] = *(const LAS f32x4*)(cwl + 3 * 256 + cl);
                    uh[bj] = zero4; dh[bj] = zero4;
                    if (g > 0) uh[bj] = *(LAS f32x4*)(hal + ((g - 1) * 2 + 1) * 256 + bj * 128 + colh);
                    if (g < 3) dh[bj] = *(LAS f32x4*)(hal + ((g + 1) * 2 + 0) * 256 + bj * 128 + colh); }
#pragma unroll
                for (int m = 0; m < 4; ++m) {
                    f32x4 res[2];
#pragma unroll
                    for (int bj = 0; bj < 2; ++bj) {
                        const f32x4 cur = acc[ai][bj][m][n];
                        const f32x4 prv = m > 0 ? acc[ai][bj][m > 0 ? m - 1 : 0][n] : uh[bj];
                        const f32x4 nxt = m < 3 ? acc[ai][bj][m < 3 ? m + 1 : 3][n] : dh[bj];
                        f32x4 su, sd;
#pragma unroll
                        for (int j = 0; j < 4; ++j) { su[j] = fr_ == 15 ? prv[j] : cur[j]; sd[j] = fr_ == 0 ? nxt[j] : cur[j]; }
                        f32x4 rr = w1[bj] * cur + bb[bj];
                        asm volatile("s_nop 1\n\t"
                                     "v_fmac_f32_dpp %0, %4, %12 row_ror:1 row_mask:0xf bank_mask:0xf\n\t"
                                     "v_fmac_f32_dpp %1, %5, %13 row_ror:1 row_mask:0xf bank_mask:0xf\n\t"
                                     "v_fmac_f32_dpp %2, %6, %14 row_ror:1 row_mask:0xf bank_mask:0xf\n\t"
                                     "v_fmac_f32_dpp %3, %7, %15 row_ror:1 row_mask:0xf bank_mask:0xf\n\t"
                                     "v_fmac_f32_dpp %0, %8, %16 row_ror:15 row_mask:0xf bank_mask:0xf\n\t"
                                     "v_fmac_f32_dpp %1, %9, %17 row_ror:15 row_mask:0xf bank_mask:0xf\n\t"
                                     "v_fmac_f32_dpp %2, %10, %18 row_ror:15 row_mask:0xf bank_mask:0xf\n\t"
                                     "v_fmac_f32_dpp %3, %11, %19 row_ror:15 row_mask:0xf bank_mask:0xf"
                                     : "+v"(rr[0]), "+v"(rr[1]), "+v"(rr[2]), "+v"(rr[3])
                                     : "v"(su[0]), "v"(su[1]), "v"(su[2]), "v"(su[3]), "v"(sd[0]), "v"(sd[1]), "v"(sd[2]), "v"(sd[3]),
                                       "v"(w0[bj][0]), "v"(w0[bj][1]), "v"(w0[bj][2]), "v"(w0[bj][3]), "v"(w2[bj][0]), "v"(w2[bj][1]), "v"(w2[bj][2]), "v"(w2[bj][3]));
                        res[bj] = rr;
                    }
                    const int r = ai * HALF + wr * 64 + m * 16 + fr_;
                    bool okr = r >= rmin && r <= rmax; int trow = u.orow + r;
                    if (u.aux == 2) { const int seg = r / TAILSEG, sq = r - seg * TAILSEG, sb = 7 * (u.orow >> 8) + seg;
                        okr = seg < 7 && sb < NB && sq >= 1 && sq <= 32; trow = sb * TB + NCTX + (SEQ - 33) + sq; }
                    if (okr) {
                        const f32x4 gq = res[0], vq = res[1];
                        u32x2 w; w.x = cvt_pk_bf16(silu_f(gq[0]) * vq[0], silu_f(gq[1]) * vq[1]); w.y = cvt_pk_bf16(silu_f(gq[2]) * vq[2], silu_f(gq[3]) * vq[3]);
                        *(u32x2*)(Hd + (size_t)trow * DFF + chb) = w;
                    }
                }
            }
        }
    }
};

template <class Epi, class Sched>
__device__ __forceinline__ void gemm_phase(LAS unsigned char* lds, const Gemm g, const Sched& S, const Epi& E) {
    int tid = threadIdx.x; asm volatile("" : "+v"(tid));
    const int wid = __builtin_amdgcn_readfirstlane(tid >> 6), lane = tid & 63, wr = wid >> 2, wc = wid & 3, fr = lane & 15, fq = lane >> 4;
    int K = g.K, lda_ = g.lda, ldb_ = g.ldb; asm volatile("" : "+s"(K), "+s"(lda_), "+s"(ldb_));
    const int nt = K / BK;
    unsigned voffA[2], voffB[2];
#pragma unroll
    for (int i = 0; i < 2; ++i) { int R, C; stage_rc(tid * 16 + i * 8192, R, C); const int Rb = Epi::PERM ? ((R & ~31) + perm32(R & 31)) : R;
        voffA[i] = (unsigned)(R * lda_ + C) * 2u; voffB[i] = (unsigned)(Rb * ldb_ + C) * 2u; }
    const size_t kstep = (size_t)(BK * 2);
    const size_t hstepA = (size_t)HALF * lda_ * 2, hstepB = (size_t)HALF * ldb_ * 2;
    const unsigned ldsw = (unsigned)wid * 1024u;
    const int aoff = lds_byte(wr * 64 + fr, fq * 8), boff = lds_byte(wc * 32 + fr, fq * 8);
#define PG8_SA(b, h) (((b) * 2 + (h)) * HTB)
#define PG8_SB(b, h) ((4 + (b) * 2 + (h)) * HTB)
#define PG8_STAGE(bufoff, gbase, voff) do { _Pragma("unroll") for (int _i = 0; _i < 2; ++_i) \
        __builtin_amdgcn_global_load_lds((const unsigned*)((const char*)(gbase) + (voff)[_i]), (LAS unsigned*)(lds + (bufoff) + ldsw + _i * 8192), 16, 0, 0); } while (0)
#define PG8_LDA(dst, b, h) do { _Pragma("unroll") for (int m = 0; m < 4; ++m) _Pragma("unroll") for (int k = 0; k < 2; ++k) dst[m][k] = *(const LAS bf16x8*)(lds + PG8_SA(b, h) + aoff + m * 2048 + k * 1024); } while (0)
#define PG8_LDB(dst, b, h) do { _Pragma("unroll") for (int n = 0; n < 2; ++n) _Pragma("unroll") for (int k = 0; k < 2; ++k) dst[n][k] = *(const LAS bf16x8*)(lds + PG8_SB(b, h) + boff + n * 2048 + k * 1024); } while (0)
#define PG8_MMA(ai, bj, At, Bt) do { __builtin_amdgcn_s_setprio(1); _Pragma("unroll") for (int m = 0; m < 4; ++m) _Pragma("unroll") for (int n = 0; n < 2; ++n) _Pragma("unroll") for (int k = 0; k < 2; ++k) \
        acc[ai][bj][m][n] = __builtin_amdgcn_mfma_f32_16x16x32_bf16(Bt[n][k], At[m][k], acc[ai][bj][m][n], 0, 0, 0); __builtin_amdgcn_s_setprio(0); } while (0)
#define PG8_WAIT_V(n) asm volatile("s_waitcnt vmcnt(" #n ")" ::: "memory")
#define PG8_WAIT_L(n) asm volatile("s_waitcnt lgkmcnt(" #n ")" ::: "memory")
#define PG8_BAR __builtin_amdgcn_s_barrier()
#define PG8_SCHED __builtin_amdgcn_sched_barrier(0)
    Unit cur, nxt; int ui = 0;
    if (!S.next(0, cur)) return;
    f32x4 acc[2][2][4][2];
#pragma unroll
    for (int a = 0; a < 2; ++a)
#pragma unroll
        for (int b = 0; b < 2; ++b)
#pragma unroll
            for (int m = 0; m < 4; ++m)
#pragma unroll
                for (int n = 0; n < 2; ++n) acc[a][b][m][n] = (f32x4){0.f, 0.f, 0.f, 0.f};
    bf16x8 At[4][2], B0[2][2], B1[2][2];
    const char* cA = (const char*)g.A + (size_t)cur.arow * lda_ * 2; const char* cB = (const char*)g.Bt + (size_t)cur.brow * ldb_ * 2;
    PG8_STAGE(PG8_SB(0, 0), cB, voffB); PG8_STAGE(PG8_SB(0, 1), cB + hstepB, voffB); PG8_STAGE(PG8_SA(0, 0), cA, voffA); PG8_STAGE(PG8_SA(0, 1), cA + hstepA, voffA);
    if (wr == 1) PG8_BAR;
    PG8_WAIT_V(2); PG8_BAR;
    PG8_STAGE(PG8_SB(1, 0), cB + kstep, voffB); PG8_STAGE(PG8_SA(1, 0), cA + kstep, voffA); PG8_STAGE(PG8_SB(1, 1), cB + hstepB + kstep, voffB);
    PG8_WAIT_V(6); PG8_BAR;
    for (;;) {
        const bool has_next = S.next(ui + 1, nxt);
        const char* nA = has_next ? (const char*)g.A + (size_t)nxt.arow * lda_ * 2 : cA; const char* nB = has_next ? (const char*)g.Bt + (size_t)nxt.brow * ldb_ * 2 : cB;
        for (int t = 0; t < nt; t += 2) {
            const bool last = (t == nt - 2);
            const char* a1 = cA + (size_t)(t + 1) * kstep;
            const char* a2 = last ? nA : cA + (size_t)(t + 2) * kstep; const char* b2 = last ? nB : cB + (size_t)(t + 2) * kstep;
            const char* a3 = a2 + kstep; const char* b3 = b2 + kstep;
            PG8_LDB(B0, 0, 0); PG8_LDB(B1, 0, 1); PG8_SCHED; PG8_LDA(At, 0, 0); PG8_STAGE(PG8_SA(1, 1), a1 + hstepA, voffA);
            PG8_WAIT_V(8); PG8_WAIT_L(0); PG8_BAR; PG8_MMA(0, 0, At, B0); PG8_MMA(0, 1, At, B1); PG8_BAR; PG8_SCHED;
            PG8_LDA(At, 0, 1); PG8_STAGE(PG8_SB(0, 0), b2, voffB); PG8_STAGE(PG8_SB(0, 1), b2 + hstepB, voffB); PG8_STAGE(PG8_SA(0, 0), a2, voffA);
            PG8_WAIT_V(8); PG8_WAIT_L(0); PG8_BAR; PG8_MMA(1, 0, At, B0); PG8_MMA(1, 1, At, B1); PG8_BAR; PG8_SCHED;
            PG8_LDB(B0, 1, 0); PG8_LDB(B1, 1, 1); PG8_SCHED; PG8_LDA(At, 1, 0); PG8_STAGE(PG8_SA(0, 1), a2 + hstepA, voffA);
            PG8_WAIT_V(8); PG8_WAIT_L(0); PG8_BAR; PG8_MMA(0, 0, At, B0); PG8_MMA(0, 1, At, B1); PG8_BAR; PG8_SCHED;
            PG8_LDA(At, 1, 1); PG8_STAGE(PG8_SB(1, 0), b3, voffB); PG8_STAGE(PG8_SB(1, 1), b3 + hstepB, voffB); PG8_STAGE(PG8_SA(1, 0), a3, voffA);
            PG8_WAIT_V(8); PG8_WAIT_L(0); PG8_BAR; PG8_MMA(1, 0, At, B0); PG8_MMA(1, 1, At, B1); PG8_BAR; PG8_SCHED;
        }
        if (wr == 0) PG8_BAR;
        E(acc, cur, wr, wc, fr, fq, lds);
        if (!has_next) break;
#pragma unroll
        for (int a = 0; a < 2; ++a)
#pragma unroll
            for (int b = 0; b < 2; ++b)
#pragma unroll
                for (int m = 0; m < 4; ++m)
#pragma unroll
                    for (int n = 0; n < 2; ++n) acc[a][b][m][n] = (f32x4){0.f, 0.f, 0.f, 0.f};
        cur = nxt; cA = nA; cB = nB; ++ui;
        if (wr == 1) PG8_BAR;
    }
    PG8_WAIT_V(0);
    PG8_BAR;
#undef PG8_SA
#undef PG8_SB
#undef PG8_STAGE
#undef PG8_LDA
#undef PG8_LDB
#undef PG8_MMA
#undef PG8_WAIT_V
#undef PG8_WAIT_L
#undef PG8_BAR
#undef PG8_SCHED
}

struct MapStd { int coff; __device__ __forceinline__ void operator()(Unit& u) const { u.arow = u.pm * 256; u.brow = u.pn * 256; u.orow = u.pm * 256; u.ocol = coff + u.pn * 256; u.aux = 0; u.bt = 0; } };
struct MapRes { int all;
    __device__ __forceinline__ void operator()(Unit& u) const {
        int b, j; if (all) { b = u.pm / 17; j = u.pm % 17; } else { b = u.pm / 16; j = u.pm % 16 + 1; }
        u.arow = (b * 17 + j) * 256; u.brow = u.pn * 256; u.ocol = u.pn * 256; u.bt = b;
        if (j == 0) { u.aux = 1; u.orow = b * 256; } else { u.aux = 0; u.orow = b * SEQ + (j - 1) * 256; } asm volatile("" : "+s"(u.aux)); } };
struct MapUp { int all;
    __device__ __forceinline__ void operator()(Unit& u) const {
        const int per = all ? 17 : 16, nmain = 16 * per;
        u.brow = u.pn * 256; u.ocol = u.pn * 128;
        if (u.pm >= nmain) { u.aux = 2; u.arow = TAILROW0 + (u.pm - nmain) * 256; u.orow = (u.pm - nmain) * 256; u.bt = 0; return; }
        const int b = u.pm / per, j = all ? u.pm % per : u.pm % per + 1;
        if (j == 0) { u.aux = 1; u.arow = b * U2B; u.orow = b * TB; u.bt = 255; }
        else { const int i = j - 1; u.aux = 0; u.arow = b * U2B + 263 + 254 * i; u.orow = b * TB + NCTX + 254 * i - 1; u.bt = 254; } } };
struct MapZ {
    __device__ __forceinline__ void operator()(Unit& u) const {
        const int b = u.pn / 17, j = u.pn % 17; u.arow = u.pm * 256; u.brow = u.pn * 256; u.orow = b * 256; u.bt = b;
        if (j == 0) { u.aux = 1; u.ocol = u.pm * NCTX; } else { u.aux = 0; u.ocol = u.pm * SEQ + (j - 1) * 256; } } };
struct MapFnetL { __device__ __forceinline__ void operator()(Unit& u) const { const int b = u.pm / 16, mt = u.pm % 16; u.arow = mt * 256; u.brow = b * 256; u.orow = b * TB + NCTX + mt * 256; u.ocol = 768; u.aux = 0; u.bt = b; } };
struct MapFnetC { __device__ __forceinline__ void operator()(Unit& u) const { const int b = u.pm; u.arow = 0; u.brow = b * 256; u.orow = b * TB; u.ocol = 768; u.aux = 0; u.bt = b; } };
}

typedef short v4i16_t __attribute__((ext_vector_type(4)));
__device__ __forceinline__ v4i16_t vtr(const LAS unsigned char* p) { return __builtin_amdgcn_ds_read_tr16_b64_v4i16((LAS v4i16_t*)p); }
#define MX3(a_, b_, c_) __builtin_fmaxf(__builtin_fmaxf((a_), (b_)), (c_))
__device__ __forceinline__ float tile_max(const f32x16& s0, const f32x16& s1) {
    float ma = MX3(s0[0], s0[1], s1[0]), mb = MX3(s0[2], s0[3], s1[1]); ma = MX3(ma, s1[2], s1[3]);
#pragma unroll
    for (int r = 4; r < 16; r += 4) { ma = MX3(ma, s0[r], s0[r + 1]); mb = MX3(mb, s0[r + 2], s0[r + 3]); ma = MX3(ma, s1[r], s1[r + 1]); mb = MX3(mb, s1[r + 2], s1[r + 3]); }
    return __builtin_fmaxf(ma, mb);
}
#undef MX3
__device__ __forceinline__ void band_mask(f32x16& s0, f32x16& s1, int k0pos, int qp, int hi) {
#pragma unroll
    for (int r = 0; r < 16; ++r) { const int kp = k0pos + (r & 3) + 8 * (r >> 2) + 4 * hi; const int d0 = kp - qp, d1 = d0 + 32;
        if (d0 > 128 || d0 < -128) s0[r] = -1e30f; if (d1 > 128 || d1 < -128) s1[r] = -1e30f; }
}
__device__ __forceinline__ void exp4(f32x16& s, int r0, float& acc0, float& acc1) {
    s[r0] = __builtin_amdgcn_exp2f(s[r0]); s[r0 + 1] = __builtin_amdgcn_exp2f(s[r0 + 1]); s[r0 + 2] = __builtin_amdgcn_exp2f(s[r0 + 2]); s[r0 + 3] = __builtin_amdgcn_exp2f(s[r0 + 3]);
    acc0 += s[r0] + s[r0 + 2]; acc1 += s[r0 + 1] + s[r0 + 3];
}
__device__ __forceinline__ bf16x8 pack8(const f32x16& s, int r0) {
    u32x4 w; w.x = cvt_pk_bf16(s[r0], s[r0 + 1]); w.y = cvt_pk_bf16(s[r0 + 2], s[r0 + 3]); w.z = cvt_pk_bf16(s[r0 + 4], s[r0 + 5]); w.w = cvt_pk_bf16(s[r0 + 6], s[r0 + 7]);
    return __builtin_bit_cast(bf16x8, w);
}
__device__ __forceinline__ void pv_slab(const LAS unsigned char* vb, int koff, const bf16x8 pj, f32x16& o0, f32x16& o1) {
    const v4i16_t a0 = vtr(vb + koff), a1 = vtr(vb + koff + 512), b0 = vtr(vb + 8192 + koff), b1 = vtr(vb + 8192 + koff + 512);
    const bf16x8 v0 = {a0[0], a0[1], a0[2], a0[3], a1[0], a1[1], a1[2], a1[3]}, v1 = {b0[0], b0[1], b0[2], b0[3], b1[0], b1[1], b1[2], b1[3]};
    o0 = __builtin_amdgcn_mfma_f32_32x32x16_bf16(v0, pj, o0, 0, 0, 0);
    o1 = __builtin_amdgcn_mfma_f32_32x32x16_bf16(v1, pj, o1, 0, 0, 0);
}

#define ATT_SCHED() __builtin_amdgcn_sched_barrier(0)
template <int DQ, bool WIN>
__device__ __forceinline__ void attn_qk(LAS unsigned char* lds, int kbufoff, int t, const bf16x8 (&qf)[DQ / 16], f32x16& o0, f32x16& o1, float& mrun, float& lsum,
                                        f32x16& sa0, f32x16& sa1, f32x16& sb0, f32x16& sb1, int l31, int hi, int qw) {
    constexpr int NDK = DQ / 16, KST = DQ * 2 + 16;
    const LAS unsigned char* kb = lds + kbufoff + l31 * KST + hi * 16;
    bf16x8 kf[2][4];
#define KLOAD(dst, dk) do { dst[0] = *(const LAS bf16x8*)(kb + (dk) * 32); dst[1] = *(const LAS bf16x8*)(kb + 32 * KST + (dk) * 32); \
                            dst[2] = *(const LAS bf16x8*)(kb + 64 * KST + (dk) * 32); dst[3] = *(const LAS bf16x8*)(kb + 96 * KST + (dk) * 32); } while (0)
    KLOAD(kf[0], 0);
#pragma unroll
    for (int dk = 0; dk < NDK; ++dk) {
        if (dk + 1 < NDK) KLOAD(kf[(dk + 1) & 1], dk + 1);
        ATT_SCHED();
        const bf16x8 (&f)[4] = kf[dk & 1];
        if (dk == 0) { f32x16 z16;
#pragma unroll
                       for (int r = 0; r < 16; ++r) z16[r] = 0.f;
                       sa0 = __builtin_amdgcn_mfma_f32_32x32x16_bf16(f[0], qf[0], z16, 0, 0, 0); sa1 = __builtin_amdgcn_mfma_f32_32x32x16_bf16(f[1], qf[0], z16, 0, 0, 0);
                       sb0 = __builtin_amdgcn_mfma_f32_32x32x16_bf16(f[2], qf[0], z16, 0, 0, 0); sb1 = __builtin_amdgcn_mfma_f32_32x32x16_bf16(f[3], qf[0], z16, 0, 0, 0); }
        else { sa0 = __builtin_amdgcn_mfma_f32_32x32x16_bf16(f[0], qf[dk], sa0, 0, 0, 0); sa1 = __builtin_amdgcn_mfma_f32_32x32x16_bf16(f[1], qf[dk], sa1, 0, 0, 0);
               sb0 = __builtin_amdgcn_mfma_f32_32x32x16_bf16(f[2], qf[dk], sb0, 0, 0, 0); sb1 = __builtin_amdgcn_mfma_f32_32x32x16_bf16(f[3], qf[dk], sb1, 0, 0, 0); }
        ATT_SCHED();
    }
#undef KLOAD
    if (__builtin_expect(__any(mrun != 0.f), 0)) {
#pragma unroll
        for (int r = 0; r < 16; ++r) { sa0[r] -= mrun; sa1[r] -= mrun; sb0[r] -= mrun; sb1[r] -= mrun; }
    }
    if (WIN && t >= 4) { const int qp = qw + l31, k0pos = (t - 4) * 64; band_mask(sa0, sa1, k0pos, qp, hi); band_mask(sb0, sb1, k0pos + 64, qp, hi); }
    float mx = __builtin_fmaxf(tile_max(sa0, sa1), tile_max(sb0, sb1));
    { auto rr = __builtin_amdgcn_permlane32_swap(__float_as_uint(mx), __float_as_uint(mx), false, false); mx = __builtin_fmaxf(__uint_as_float(rr[0]), __uint_as_float(rr[1])); }
    if (__builtin_expect(__any(mx > 8.0f), 0)) {
        const float dl = mx > 8.0f ? mx : 0.f; mrun += dl;
        const float alpha = __builtin_amdgcn_exp2f(-dl); lsum *= alpha;
#pragma unroll
        for (int r = 0; r < 16; ++r) { sa0[r] -= dl; sa1[r] -= dl; sb0[r] -= dl; sb1[r] -= dl; o0[r] *= alpha; o1[r] *= alpha; }
    }
}
#define VLOAD(dst, j) do { dst[0] = vtr(vb + (j) * 1024); dst[1] = vtr(vb + (j) * 1024 + 512); dst[2] = vtr(vb + 8192 + (j) * 1024); dst[3] = vtr(vb + 8192 + (j) * 1024 + 512); } while (0)
#define PVMMA(src, P_) do { const bf16x8 v0_ = {src[0][0], src[0][1], src[0][2], src[0][3], src[1][0], src[1][1], src[1][2], src[1][3]}, v1_ = {src[2][0], src[2][1], src[2][2], src[2][3], src[3][0], src[3][1], src[3][2], src[3][3]}; \
        const bf16x8 p_ = (P_); o0 = __builtin_amdgcn_mfma_f32_32x32x16_bf16(v0_, p_, o0, 0, 0, 0); o1 = __builtin_amdgcn_mfma_f32_32x32x16_bf16(v1_, p_, o1, 0, 0, 0); } while (0)
__device__ __forceinline__ void attn_softmax_pv(const LAS unsigned char* vb, f32x16& sa0, f32x16& sa1, f32x16& sb0, f32x16& sb1, f32x16& o0, f32x16& o1, float& lsum) {
    v4i16_t vf[2][4];
    VLOAD(vf[0], 0);
    float p0 = 0.f, p1 = 0.f, p2 = 0.f, p3 = 0.f;
    exp4(sa0, 0, p0, p1); exp4(sa0, 4, p2, p3); exp4(sa0, 8, p0, p1); exp4(sa0, 12, p2, p3);
    exp4(sa1, 0, p0, p1); exp4(sa1, 4, p2, p3); exp4(sa1, 8, p0, p1); exp4(sa1, 12, p2, p3);
    VLOAD(vf[1], 1); ATT_SCHED(); PVMMA(vf[0], pack8(sa0, 0)); exp4(sb0, 0, p0, p1); exp4(sb0, 4, p2, p3); ATT_SCHED();
    VLOAD(vf[0], 2); ATT_SCHED(); PVMMA(vf[1], pack8(sa0, 8)); exp4(sb0, 8, p0, p1); exp4(sb0, 12, p2, p3); ATT_SCHED();
    VLOAD(vf[1], 3); ATT_SCHED(); PVMMA(vf[0], pack8(sa1, 0)); exp4(sb1, 0, p0, p1); exp4(sb1, 4, p2, p3); ATT_SCHED();
    VLOAD(vf[0], 4); ATT_SCHED(); PVMMA(vf[1], pack8(sa1, 8)); exp4(sb1, 8, p0, p1); exp4(sb1, 12, p2, p3); ATT_SCHED();
    lsum += (p0 + p1) + (p2 + p3);
    VLOAD(vf[1], 5); ATT_SCHED(); PVMMA(vf[0], pack8(sb0, 0)); ATT_SCHED();
    VLOAD(vf[0], 6); ATT_SCHED(); PVMMA(vf[1], pack8(sb0, 8)); ATT_SCHED();
    VLOAD(vf[1], 7); ATT_SCHED(); PVMMA(vf[0], pack8(sb1, 0)); ATT_SCHED();
    PVMMA(vf[1], pack8(sb1, 8));
}
__device__ __forceinline__ void attn_softmax_keep(f32x16& sa0, f32x16& sa1, f32x16& sb0, f32x16& sb1, bf16x8 (&pw)[8], float& lsum) {
    float p0 = 0.f, p1 = 0.f, p2 = 0.f, p3 = 0.f;
    exp4(sa0, 0, p0, p1); exp4(sa0, 4, p2, p3); exp4(sa0, 8, p0, p1); exp4(sa0, 12, p2, p3); pw[0] = pack8(sa0, 0); pw[1] = pack8(sa0, 8);
    exp4(sa1, 0, p0, p1); exp4(sa1, 4, p2, p3); exp4(sa1, 8, p0, p1); exp4(sa1, 12, p2, p3); pw[2] = pack8(sa1, 0); pw[3] = pack8(sa1, 8);
    exp4(sb0, 0, p0, p1); exp4(sb0, 4, p2, p3); exp4(sb0, 8, p0, p1); exp4(sb0, 12, p2, p3); pw[4] = pack8(sb0, 0); pw[5] = pack8(sb0, 8);
    exp4(sb1, 0, p0, p1); exp4(sb1, 4, p2, p3); exp4(sb1, 8, p0, p1); exp4(sb1, 12, p2, p3); pw[6] = pack8(sb1, 0); pw[7] = pack8(sb1, 8);
    lsum += (p0 + p1) + (p2 + p3);
}
__device__ __forceinline__ void attn_pv_all(const LAS unsigned char* vb, const bf16x8 (&pw)[8], f32x16& o0, f32x16& o1) {
    v4i16_t vf[2][4];
    VLOAD(vf[0], 0);
    VLOAD(vf[1], 1); ATT_SCHED(); PVMMA(vf[0], pw[0]); ATT_SCHED();
    VLOAD(vf[0], 2); ATT_SCHED(); PVMMA(vf[1], pw[1]); ATT_SCHED();
    VLOAD(vf[1], 3); ATT_SCHED(); PVMMA(vf[0], pw[2]); ATT_SCHED();
    VLOAD(vf[0], 4); ATT_SCHED(); PVMMA(vf[1], pw[3]); ATT_SCHED();
    VLOAD(vf[1], 5); ATT_SCHED(); PVMMA(vf[0], pw[4]); ATT_SCHED();
    VLOAD(vf[0], 6); ATT_SCHED(); PVMMA(vf[1], pw[5]); ATT_SCHED();
    VLOAD(vf[1], 7); ATT_SCHED(); PVMMA(vf[0], pw[6]); ATT_SCHED();
    PVMMA(vf[1], pw[7]);
}
#undef VLOAD
#undef PVMMA
#undef ATT_SCHED

template <int DQ, bool WIN, int MODE = 0>
__device__ __forceinline__ void attn_unit(LAS unsigned char* lds, const bf16_t* Qp, int ldq, const bf16_t* Kp, int ldk, const bf16_t* Vp, int ldv, bf16_t* Op,
                                          int n1, int s2, int e2, int q0pos, float m_init, bool has_sink, const float* qgain = nullptr, const f32x2v* ropeT = nullptr, bool qrope = false) {
    constexpr int NDK = DQ / 16, CH = DQ / 8, NKC = DQ / 32, KST = DQ * 2 + 16, KBUF = 128 * KST, VBUF = 16384, VOFF = 2 * KBUF;
    int tid = threadIdx.x; asm volatile("" : "+v"(tid));
    const int lane = tid & 63, wid = __builtin_amdgcn_readfirstlane(tid >> 6), l31 = lane & 31, hi = lane >> 5;
    const bool late = wid >= 4;
    bf16x8 qf[NDK];
    { const bf16_t* qrow = Qp + (size_t)(32 * wid + l31) * ldq + 8 * hi;
#pragma unroll
      for (int dk = 0; dk < NDK; ++dk) qf[dk] = *(const bf16x8*)(qrow + 16 * dk); }
    if (DQ == 64 && qgain != nullptr) {
        float y[4][8]; float ss = 0.f;
#pragma unroll
        for (int dk = 0; dk < 4; ++dk) { const u32x4 w = __builtin_bit_cast(u32x4, qf[dk < NDK ? dk : 0]);
#pragma unroll
            for (int i = 0; i < 4; ++i) { y[dk][2 * i] = bflo(w[i]); y[dk][2 * i + 1] = bfhi(w[i]); ss += y[dk][2 * i] * y[dk][2 * i] + y[dk][2 * i + 1] * y[dk][2 * i + 1]; } }
        ss += __shfl_xor(ss, 32);
        const float rn = rsqrtf(ss * (1.0f / 64.0f) + EPS);
#pragma unroll
        for (int dk = 0; dk < 4; ++dk)
#pragma unroll
            for (int e = 0; e < 8; ++e) y[dk][e] *= rn * qgain[16 * dk + 8 * hi + e];
        if (qrope) { const int pos = q0pos + 32 * wid + l31;
#pragma unroll
            for (int dk = 0; dk < 2; ++dk)
#pragma unroll
                for (int e = 0; e < 8; ++e) { const f32x2v t = ropeT[pos * 32 + 16 * dk + 8 * hi + e]; const float x1 = y[dk][e], x2 = y[dk + 2][e]; y[dk][e] = x1 * t.x - x2 * t.y; y[dk + 2][e] = x1 * t.y + x2 * t.x; } }
        const float QS_ = 0.125f * LOG2E;
#pragma unroll
        for (int dk = 0; dk < 4; ++dk) { u32x4 w;
#pragma unroll
            for (int i = 0; i < 4; ++i) w[i] = cvt_pk_bf16(y[dk][2 * i] * QS_, y[dk][2 * i + 1] * QS_);
            if (dk < NDK) qf[dk] = __builtin_bit_cast(bf16x8, w); }
    }
    f32x16 o0, o1;
#pragma unroll
    for (int r = 0; r < 16; ++r) { o0[r] = 0.f; o1[r] = 0.f; }
    float mrun = 0.f, lsum = (has_sink && hi == 0) ? __builtin_amdgcn_exp2f(m_init) : 0.f;
    const int qw = q0pos + 32 * wid;
    const int vlane = (4 * hi + ((lane & 15) >> 2)) * 64 + ((lane >> 4) & 1) * 32 + (lane & 3) * 8;
    u32x4 kr[NKC], vr[2];
#define ATT_TILE(i_) ((i_) < n1 ? (i_) : s2 + ((i_) - n1))
#define ATT_LOAD(t) do { const bf16_t* kp_ = Kp + (size_t)(t) * 64 * ldk; const bf16_t* vp_ = Vp + (size_t)(t) * 64 * ldv; \
        _Pragma("unroll") for (int m_ = 0; m_ < NKC; ++m_) { const int c_ = tid + 512 * m_; kr[m_] = *(const GAS u32x4*)(kp_ + (size_t)(c_ / CH) * ldk + (c_ % CH) * 8); } \
        _Pragma("unroll") for (int m_ = 0; m_ < 2; ++m_) { const int c_ = tid + 512 * m_; vr[m_] = *(const GAS u32x4*)(vp_ + (size_t)(c_ >> 3) * ldv + (c_ & 7) * 8); } } while (0)
#define ATT_STORE(kb_, vb_) do { \
        _Pragma("unroll") for (int m_ = 0; m_ < NKC; ++m_) { const int c_ = tid + 512 * m_; *(LAS u32x4*)(lds + (kb_) * KBUF + (c_ / CH) * KST + (c_ % CH) * 16) = kr[m_]; } \
        _Pragma("unroll") for (int m_ = 0; m_ < 2; ++m_) { const int c_ = tid + 512 * m_; *(LAS u32x4*)(lds + VOFF + (vb_) * VBUF + ((c_ & 7) >> 2) * 8192 + (c_ >> 3) * 64 + (c_ & 3) * 16) = vr[m_]; } } while (0)
#define ATT_BAR() asm volatile("s_waitcnt lgkmcnt(0)\n\ts_barrier" ::: "memory")
    const int nst = (n1 + (e2 - s2)) >> 1;
    ATT_LOAD(0); ATT_STORE(0, 0);
    ATT_BAR();
    if (!late) {
        int vcur = 0;
        for (int I = 0; I < nst; ++I) {
            const int t = ATT_TILE(2 * I);
            if (I + 1 < nst) { const int tn = ATT_TILE(2 * I + 2); ATT_LOAD(tn); }
            bool active = true; if (WIN && t >= 4) { const int k0 = (t - 4) * 64; active = (k0 + 127 >= qw - 128) && (k0 <= qw + 31 + 128); }
            const int vnext = vcur == 2 ? 0 : vcur + 1;
            if (active) { f32x16 sa0, sa1, sb0, sb1;
                attn_qk<DQ, WIN>(lds, (I & 1) * KBUF, t, qf, o0, o1, mrun, lsum, sa0, sa1, sb0, sb1, l31, hi, qw);
                attn_softmax_pv(lds + VOFF + vcur * VBUF + vlane, sa0, sa1, sb0, sb1, o0, o1, lsum); }
            if (I + 1 < nst) ATT_STORE((I + 1) & 1, vnext);
            vcur = vnext;
            ATT_BAR();
        }
    } else {
        bf16x8 pw[8]; bool havep = false; int pvoff = 0;
        int vcur = 0;
        for (int I = 0; I < nst; ++I) {
            const int t = ATT_TILE(2 * I);
            if (I + 1 < nst) { const int tn = ATT_TILE(2 * I + 2); ATT_LOAD(tn); }
            bool active = true; if (WIN && t >= 4) { const int k0 = (t - 4) * 64; active = (k0 + 127 >= qw - 128) && (k0 <= qw + 31 + 128); }
            const int vnext = vcur == 2 ? 0 : vcur + 1;
            if (havep) attn_pv_all(lds + VOFF + pvoff + vlane, pw, o0, o1);
            havep = false;
            if (active) { f32x16 sa0, sa1, sb0, sb1;
                attn_qk<DQ, WIN>(lds, (I & 1) * KBUF, t, qf, o0, o1, mrun, lsum, sa0, sa1, sb0, sb1, l31, hi, qw);
                attn_softmax_keep(sa0, sa1, sb0, sb1, pw, lsum); havep = true; pvoff = vcur * VBUF; }
            if (I + 1 < nst) ATT_STORE((I + 1) & 1, vnext);
            vcur = vnext;
            ATT_BAR();
        }
        if (havep) attn_pv_all(lds + VOFF + pvoff + vlane, pw, o0, o1);
    }
    ATT_BAR();
#undef ATT_TILE
#undef ATT_LOAD
#undef ATT_STORE
#undef ATT_BAR
    const float lt = lsum + __shfl_xor(lsum, 32), inv = 1.0f / lt;
    bf16_t* orow = Op + (size_t)(32 * wid + l31) * DM + 4 * hi;
#pragma unroll
    for (int g = 0; g < 4; ++g) {
        u32x2 w0, w1;
        w0.x = cvt_pk_bf16(o0[4 * g] * inv, o0[4 * g + 1] * inv); w0.y = cvt_pk_bf16(o0[4 * g + 2] * inv, o0[4 * g + 3] * inv);
        w1.x = cvt_pk_bf16(o1[4 * g] * inv, o1[4 * g + 1] * inv); w1.y = cvt_pk_bf16(o1[4 * g + 2] * inv, o1[4 * g + 3] * inv);
        *(u32x2*)(orow + 8 * g) = w0; *(u32x2*)(orow + 32 + 8 * g) = w1;
    }
}

struct Args { const float* in[28]; float* out; unsigned char* ws; int lo, hi; };
typedef const GAS float* cfp_t;
struct Ctx { const __attribute__((address_space(4))) cfp_t* in; float* out; unsigned char* ws;
    __device__ __forceinline__ const float* inp(int i) const { return (const float*)in[i]; } };
enum { I_X = 0, I_C, I_CTX, I_CCTX, I_MODW, I_MODB, I_N1G, I_N2G, I_MLAWIN, I_CQG, I_CKVG, I_WUQ, I_WUKV, I_QG, I_KG, I_FNETW, I_EWOUT,
       I_WINWIN, I_WQG, I_WKG, I_SINK, I_POOLW, I_POOLS, I_OWOUT, I_FFNUP, I_CONVW, I_CONVB, I_FFNDN };

__device__ __forceinline__ void tr_item(const float* W, int K, int Nsrc, bf16_t* WT, int nblk, int item, LAS float* scr, int lane, int mode, const float* ksc) {
    const int kb = item / nblk, nb = item % nblk, k0 = 64 * kb, n0 = 32 * nb;
    int s0 = n0;
    if (mode == 1) s0 = n0 < 672 ? n0 : -1;
    else if (mode == 2) { const int hd = n0 >> 7, d0 = n0 & 127; s0 = d0 < 96 ? hd * 96 + d0 : -1; }
    else if (mode == 3) { const int pn = n0 >> 8, bj = (n0 >> 7) & 1, c = n0 & 127; s0 = bj * DFF + pn * 128 + c; }
#pragma unroll 16
    for (int i = 0; i < 32; ++i) { const int kk = 2 * i + (lane >> 5); float v = 0.f;
        if (s0 >= 0) { v = W[(size_t)(k0 + kk) * Nsrc + s0 + (lane & 31)]; if (ksc) v *= ksc[k0 + kk]; }
        scr[kk * 33 + (lane & 31)] = v; }
    asm volatile("s_waitcnt lgkmcnt(0)" ::: "memory");
    const int c = lane & 7;
#pragma unroll
    for (int j = 0; j < 4; ++j) { const int n = (lane >> 3) + 8 * j; const LAS float* s = scr + (8 * c) * 33 + n;
        u32x4 o; o.x = cvt_pk_bf16(s[0 * 33], s[1 * 33]); o.y = cvt_pk_bf16(s[2 * 33], s[3 * 33]); o.z = cvt_pk_bf16(s[4 * 33], s[5 * 33]); o.w = cvt_pk_bf16(s[6 * 33], s[7 * 33]);
        *(u32x4*)(WT + (size_t)(n0 + n) * K + k0 + 8 * c) = o; }
    asm volatile("s_waitcnt lgkmcnt(0)" ::: "memory");
}
__device__ __forceinline__ void tr_job(const float* W, int K, int Nsrc, bf16_t* WT, int Nout, int mode, const float* ksc, LAS float* scr, int gw, int ngw, int lane) {
    const int nblk = Nout / 32, nitems = (K / 64) * nblk;
    for (int it = gw; it < nitems; it += ngw) tr_item(W, K, Nsrc, WT, nblk, it, scr, lane, mode, ksc);
}
__device__ __forceinline__ void ffn_weights(const Ctx& a, int layer, LAS float* scr, int gw, int ngw, int lane) {
    tr_job(a.inp(I_FFNUP) + (size_t)layer * DM * 2 * DFF, DM, 2 * DFF, (bf16_t*)(a.ws + WS_WUP), 2 * DFF, 3, nullptr, scr, gw, ngw, lane);
    tr_job(a.inp(I_FFNDN) + (size_t)layer * DFF * DM, DFF, DM, (bf16_t*)(a.ws + ((layer & 1) ? WS_WDN2 : WS_WDN)), DM, 0, nullptr, scr, gw, ngw, lane);
}

__device__ __forceinline__ void mods_item(const Ctx& a, int item, LAS float* sl) {
    int tid = threadIdx.x; asm volatile("" : "+v"(tid)); const int l = item / 48, nb = item % 48;
    LAS float* red = sl + 17 * 1024;
    for (int idx = tid; idx < 17 * 1024; idx += 512) { const int r = idx >> 10, k = idx & 1023; const float v = r < 16 ? a.inp(I_C)[r * 1024 + k] : a.inp(I_CCTX)[k]; sl[idx] = v / (1.0f + __expf(-v)); }
    __syncthreads();
    const int cn = tid & 127, ks = tid >> 7, n = 128 * nb + cn;
    float acc[17];
#pragma unroll
    for (int r = 0; r < 17; ++r) acc[r] = 0.f;
    const float* wp = a.inp(I_MODW) + ((size_t)l * 1024 + 256 * ks) * 6144 + n;
#pragma unroll 4
    for (int k = 0; k < 256; k += 4) {
        const float w0 = wp[(size_t)(k + 0) * 6144], w1 = wp[(size_t)(k + 1) * 6144], w2 = wp[(size_t)(k + 2) * 6144], w3 = wp[(size_t)(k + 3) * 6144];
#pragma unroll
        for (int r = 0; r < 17; ++r) { const f32x4 s4 = *(const LAS f32x4*)(sl + r * 1024 + 256 * ks + k); acc[r] += s4[0] * w0 + s4[1] * w1 + s4[2] * w2 + s4[3] * w3; }
    }
#pragma unroll
    for (int r = 0; r < 17; ++r) red[(ks * 17 + r) * 128 + cn] = acc[r];
    __syncthreads();
    float* mods = (float*)(a.ws + WS_MODS);
    for (int idx = tid; idx < 17 * 128; idx += 512) { const int r = idx >> 7, c2 = idx & 127;
        const float s = red[(0 * 17 + r) * 128 + c2] + red[(1 * 17 + r) * 128 + c2] + red[(2 * 17 + r) * 128 + c2] + red[(3 * 17 + r) * 128 + c2];
        mods[((size_t)l * 17 + r) * 6144 + 128 * nb + c2] = s + a.inp(I_MODB)[l * 6144 + 128 * nb + c2]; }
    __syncthreads();
}

__device__ __forceinline__ void norm_pass(const float* xsrc, const float* csrc, const float* g, const float* mods_l, int shift_idx, int scale_idx,
                                          bf16_t* U, bool ffn_layout, bool skip_ctx, int gw, int ngw, int lane) {
    for (int R0 = gw; R0 < T; R0 += 2 * ngw) {
        f32x4 v[2][4]; bool ok[2]; int bb[2], pp[2];
#pragma unroll
        for (int s = 0; s < 2; ++s) { const int R = R0 + s * ngw; const int b = R / TB, p = R % TB; const bool isctx = p < NCTX; bb[s] = b; pp[s] = p;
            ok[s] = (R < T) && !(isctx && skip_ctx);
            const float* src = isctx ? csrc + (size_t)(b * NCTX + p) * DM : xsrc + (size_t)(b * SEQ + p - NCTX) * DM;
            if (ok[s]) {
#pragma unroll
                for (int j = 0; j < 4; ++j) v[s][j] = *(const f32x4*)(src + (lane + 64 * j) * 4); } }
#pragma unroll
        for (int s = 0; s < 2; ++s) if (ok[s]) {
            const int R = R0 + s * ngw, b = bb[s], p = pp[s]; const bool isctx = p < NCTX;
            const float* mrow = mods_l + (size_t)(isctx ? 16 : b) * 6144;
            float ss = 0.f;
#pragma unroll
            for (int j = 0; j < 4; ++j) ss += (v[s][j][0] * v[s][j][0] + v[s][j][1] * v[s][j][1]) + (v[s][j][2] * v[s][j][2] + v[s][j][3] * v[s][j][3]);
            const float rs = rsqrtf(wave_sum(ss) * (1.0f / DM) + EPS);
            const size_t orow = ffn_layout ? (size_t)b * U2B + (isctx ? p : 264 + p - NCTX) : (size_t)R;
#pragma unroll
            for (int j = 0; j < 4; ++j) { const int c4 = (lane + 64 * j) * 4;
                const f32x4 gg = *(const f32x4*)(g + c4), sh = *(const f32x4*)(mrow + shift_idx * 1024 + c4), sc = *(const f32x4*)(mrow + scale_idx * 1024 + c4);
                const f32x4 y = v[s][j] * rs * gg * (sc + 1.0f) + sh;
                u32x2 w; w.x = cvt_pk_bf16(y[0], y[1]); w.y = cvt_pk_bf16(y[2], y[3]);
                *(u32x2*)(U + orow * DM + c4) = w;
                if (ffn_layout && !isctx && p - NCTX >= SEQ - 33) *(u32x2*)(U + ((size_t)TAILROW0 + (b / 7) * 256 + (b % 7) * TAILSEG + (p - NCTX - (SEQ - 33))) * DM + c4) = w; }
        }
    }
    if (ffn_layout && gw >= 32 && gw < 48) {
        const int tb_ = gw - 32; const size_t orow = (size_t)TAILROW0 + (tb_ / 7) * 256 + (tb_ % 7) * TAILSEG + 33;
#pragma unroll
        for (int j = 0; j < 4; ++j) *(u32x2*)(U + orow * DM + (lane + 64 * j) * 4) = (u32x2){0u, 0u};
    }
    if (ffn_layout && gw < 32) {
        const int b = gw >> 1; const size_t orow = (size_t)b * U2B + ((gw & 1) ? 264 + SEQ : 263);
#pragma unroll
        for (int j = 0; j < 4; ++j) *(u32x2*)(U + orow * DM + (lane + 64 * j) * 4) = (u32x2){0u, 0u};
    }
}

template <int NF> __device__ __forceinline__ void rope_cs(int pos, int i, float& cs, float& sn) {
    const int row = pos >> 6, col = pos & 63; const int f = i < NF ? i : i - NF;
    const float inv = exp2f(-(float)f * (13.287712379549449f / NF));
    const float ang = (float)(i < NF ? row : col) * inv;
    sincosf(ang, &sn, &cs);
}

__device__ __forceinline__ void unpack8(const u32x4 v, float (&x)[8]) {
#pragma unroll
    for (int i = 0; i < 4; ++i) { x[2 * i] = bflo(v[i]); x[2 * i + 1] = bfhi(v[i]); }
}
__device__ __forceinline__ u32x4 pack8f(const float (&x)[8]) { u32x4 o; o.x = cvt_pk_bf16(x[0], x[1]); o.y = cvt_pk_bf16(x[2], x[3]); o.z = cvt_pk_bf16(x[4], x[5]); o.w = cvt_pk_bf16(x[6], x[7]); return o; }

__device__ __forceinline__ void ew_even(const Ctx& a, int j, int gw, int ngw, int lane) {
    const bf16_t* H = (const bf16_t*)(a.ws + WS_H); bf16_t* Qb = (bf16_t*)(a.ws + WS_Q); bf16_t* KVb = (bf16_t*)(a.ws + WS_KV); bf16_t* Kout = (bf16_t*)(a.ws + WS_U);
    const float QS = 0.10206207261596577f * LOG2E;
    const f32x2v* ropeT = (const f32x2v*)(a.ws + WS_ROPE_E);
    const int g16 = lane >> 4, c16 = lane & 15; const bool act = c16 < 12; const int cc = act ? c16 : 0;
    float qg[8], kg[8];
#pragma unroll
    for (int e = 0; e < 8; ++e) { qg[e] = a.inp(I_QG)[j * 96 + 8 * cc + e]; kg[e] = a.inp(I_KG)[j * 96 + 8 * cc + e]; }
    for (int R = gw; R < T; R += ngw) {
        const int p = R % TB; const int pos = p - NCTX; const bool lat = pos >= 0;
        const bf16_t* hrow = H + (size_t)R * 768; bf16_t* qrow = Qb + (size_t)R * 1536; bf16_t* kvrow = KVb + (size_t)R * 1536;
        const u32x4 z4 = {0u, 0u, 0u, 0u};
        u32x4 hv = z4; if (lane < 48) hv = *(const u32x4*)(hrow + 8 * lane);
        u32x4 qv[3], kv[3], vv[2];
#pragma unroll
        for (int rd = 0; rd < 3; ++rd) { const int hd = 4 * rd + g16; qv[rd] = z4; kv[rd] = z4;
            if (act) { qv[rd] = *(const u32x4*)(qrow + hd * 128 + 8 * c16); kv[rd] = c16 < 8 ? *(const u32x4*)(kvrow + hd * 128 + 8 * c16) : *(const u32x4*)(hrow + 384 + 8 * (c16 - 8)); } }
        vv[0] = *(const u32x4*)(kvrow + (lane >> 3) * 128 + 64 + 8 * (lane & 7)); vv[1] = z4;
        if (lane < 32) vv[1] = *(const u32x4*)(kvrow + ((lane + 64) >> 3) * 128 + 64 + 8 * (lane & 7));
        float cs[8], sn[8];
#pragma unroll
        for (int e = 0; e < 8; ++e) { cs[e] = 1.f; sn[e] = 0.f; }
        if (lat && c16 >= 8 && act) {
#pragma unroll
            for (int e = 0; e < 8; ++e) { const f32x2v t = ropeT[pos * 16 + 8 * (c16 & 1) + e]; cs[e] = t.x; sn[e] = t.y; } }
        float x[8]; unpack8(hv, x); float ss = 0.f;
#pragma unroll
        for (int e = 0; e < 8; ++e) ss += x[e] * x[e];
        ss = half_sum(ss);
        const float r_q = rsqrtf(__shfl(ss, 0) * (1.0f / 256.0f) + EPS), r_kv = rsqrtf(__shfl(ss, 32) * (1.0f / 128.0f) + EPS);
#pragma unroll
        for (int rd = 0; rd < 3; ++rd) {
            const int hd = 4 * rd + g16;
            { float y[8], o[8]; unpack8(qv[rd], y); float s2 = 0.f;
#pragma unroll
              for (int e = 0; e < 8; ++e) { y[e] *= r_q; s2 += y[e] * y[e]; }
              s2 += __shfl_xor(s2, 8); s2 += __shfl_xor(s2, 4); s2 += __shfl_xor(s2, 2); s2 += __shfl_xor(s2, 1);
              const float sc = rsqrtf(s2 * (1.0f / 96.0f) + EPS);
#pragma unroll
              for (int e = 0; e < 8; ++e) { y[e] *= sc * qg[e]; o[e] = __shfl_xor(y[e], 2); }
              if (c16 >= 8) {
#pragma unroll
                  for (int e = 0; e < 8; ++e) y[e] = c16 < 10 ? y[e] * cs[e] - o[e] * sn[e] : o[e] * sn[e] + y[e] * cs[e]; }
#pragma unroll
              for (int e = 0; e < 8; ++e) y[e] *= QS;
              if (act) *(u32x4*)(qrow + hd * 128 + 8 * c16) = pack8f(y); }
            { float y[8], o[8]; unpack8(kv[rd], y); float s2 = 0.f; const float pre = c16 < 8 ? r_kv : 1.0f;
#pragma unroll
              for (int e = 0; e < 8; ++e) { y[e] *= pre; s2 += y[e] * y[e]; }
              s2 += __shfl_xor(s2, 8); s2 += __shfl_xor(s2, 4); s2 += __shfl_xor(s2, 2); s2 += __shfl_xor(s2, 1);
              const float sc = rsqrtf(s2 * (1.0f / 96.0f) + EPS);
#pragma unroll
              for (int e = 0; e < 8; ++e) { y[e] *= sc * kg[e]; o[e] = __shfl_xor(y[e], 2); }
              if (c16 >= 8) {
#pragma unroll
                  for (int e = 0; e < 8; ++e) y[e] = c16 < 10 ? y[e] * cs[e] - o[e] * sn[e] : o[e] * sn[e] + y[e] * cs[e]; }
              if (act) *(u32x4*)(Kout + (size_t)R * 1152 + hd * 96 + 8 * c16) = pack8f(y); }
        }
        { float y[8]; unpack8(vv[0], y);
#pragma unroll
          for (int e = 0; e < 8; ++e) y[e] *= r_kv;
          *(u32x4*)(kvrow + (lane >> 3) * 128 + 64 + 8 * (lane & 7)) = pack8f(y);
          if (lane < 32) { unpack8(vv[1], y);
#pragma unroll
              for (int e = 0; e < 8; ++e) y[e] *= r_kv;
              *(u32x4*)(kvrow + ((lane + 64) >> 3) * 128 + 64 + 8 * (lane & 7)) = pack8f(y); } }
    }
}

__device__ __forceinline__ void z_fold(const Ctx& a, LAS unsigned char* lds, int gw, int ngw, int wave, int lane) {
    const bf16_t* ZLp = (const bf16_t*)(a.ws + WS_ZL); bf16_t* ZF = (bf16_t*)(a.ws + WS_ZF);
    LAS bf16_t* zr = (LAS bf16_t*)(lds + wave * 16384);
    for (int row = gw; row < 4096; row += ngw) {
        const bf16_t* src = ZLp + (size_t)row * 8192;
#pragma unroll
        for (int i = 0; i < 16; ++i) *(LAS u32x4*)(zr + 8 * (lane + 64 * i)) = *(const u32x4*)(src + 8 * (lane + 64 * i));
        asm volatile("s_waitcnt lgkmcnt(0)" ::: "memory");
#pragma unroll
        for (int i = 0; i < 8; ++i) { const int k0 = 8 * (lane + 64 * i); float y[8];
#pragma unroll
            for (int e = 0; e < 8; ++e) { const int kap = k0 + e; float v;
                if (kap <= 2048) { v = bf2f(zr[kap]); if (kap != 0 && kap != 2048) v += bf2f(zr[4096 - kap]); }
                else { const int l = kap - 2048; v = bf2f(zr[4096 + l]) - bf2f(zr[8192 - l]); }
                y[e] = v; }
            *(u32x4*)(ZF + (size_t)row * 4096 + k0) = pack8f(y); }
        asm volatile("s_waitcnt lgkmcnt(0)" ::: "memory");
    }
}

__device__ __forceinline__ void ew_odd(const Ctx& a, int j, int gw, int ngw, int lane) {
    bf16_t* H = (bf16_t*)(a.ws + WS_H); bf16_t* PO = (bf16_t*)(a.ws + WS_POOL);
    const float QS = 0.125f * LOG2E;
    const f32x2v* ropeT = (const f32x2v*)(a.ws + WS_ROPE_O);
    const int c8 = lane & 7, hl = lane >> 3;
    float qg[8], kg[8];
#pragma unroll
    for (int e = 0; e < 8; ++e) { qg[e] = a.inp(I_WQG)[j * 64 + 8 * c8 + e]; kg[e] = a.inp(I_WKG)[j * 64 + 8 * c8 + e]; }
    for (int R = gw; R < T; R += ngw) {
        const int p = R % TB; const int pos = p - NCTX; const bool lat = pos >= 0;
        bf16_t* hrow = H + (size_t)R * 1536;
        u32x4 qk[2]; qk[1] = (u32x4){0u, 0u, 0u, 0u}; if (lane >= 32) qk[1] = *(const u32x4*)(hrow + 512 + 8 * lane);
        float cs[8], sn[8];
#pragma unroll
        for (int e = 0; e < 8; ++e) { cs[e] = 1.f; sn[e] = 0.f; }
        if (lat) {
#pragma unroll
            for (int e = 0; e < 8; ++e) { const f32x2v t = ropeT[pos * 32 + 8 * (c8 & 3) + e]; cs[e] = t.x; sn[e] = t.y; } }
        const int tpos = lat ? pos : p, Ls = lat ? SEQ : NCTX;
        { const int pc = lane & 31, g = pc >> 3, half = 1 << g;
          const int lo = tpos - half < 0 ? 0 : tpos - half, hi = tpos + half > Ls ? Ls : tpos + half;
          float sum[8];
#pragma unroll
          for (int e = 0; e < 8; ++e) sum[e] = 0.f;
          if (lane < 32) {
              for (int tt = lo; tt < hi; ++tt) { float z[8]; unpack8(*(const u32x4*)(hrow + (ptrdiff_t)(tt - tpos) * 1536 + 1280 + 8 * pc), z);
#pragma unroll
                  for (int e = 0; e < 8; ++e) sum[e] += z[e]; }
              const float rc = 1.0f / (float)(hi - lo); float z[8]; unpack8(*(const u32x4*)(hrow + 1280 + 8 * pc), z);
#pragma unroll
              for (int e = 0; e < 8; ++e) sum[e] = sum[e] * rc - z[e];
              *(u32x4*)(PO + (size_t)R * 256 + 8 * pc) = pack8f(sum); } }
        if (lane >= 32) {
            float y[8], o[8]; unpack8(qk[1], y); float s2 = 0.f;
#pragma unroll
            for (int e = 0; e < 8; ++e) s2 += y[e] * y[e];
            s2 += __shfl_xor(s2, 4); s2 += __shfl_xor(s2, 2); s2 += __shfl_xor(s2, 1);
            const float sc = rsqrtf(s2 * (1.0f / 64.0f) + EPS);
#pragma unroll
            for (int e = 0; e < 8; ++e) { y[e] *= sc * kg[e]; o[e] = __shfl_xor(y[e], 4); }
#pragma unroll
            for (int e = 0; e < 8; ++e) y[e] = c8 < 4 ? y[e] * cs[e] - o[e] * sn[e] : o[e] * sn[e] + y[e] * cs[e];
            *(u32x4*)(hrow + 512 + 8 * lane) = pack8f(y);
        }
    }
}

#define XB_TMO      128
#define XB_XCNT(j)  (256  + 64 * (j))
#define XB_XSUB(j)  (1280 + 64 * (j))
#define XB_XGEN(j)  (2304 + 64 * (j))
#define XB_TOP      3328
#define XB_TOPGEN   3392
#define XCD_BAR_WORDS 3456
#define XB_SPIN_CAP (1u << 18)
__device__ __forceinline__ unsigned xb_ld(unsigned* p)              { return __hip_atomic_load(p, __ATOMIC_RELAXED, __HIP_MEMORY_SCOPE_AGENT); }
__device__ __forceinline__ unsigned xb_add(unsigned* p, unsigned v) { return __hip_atomic_fetch_add(p, v, __ATOMIC_RELAXED, __HIP_MEMORY_SCOPE_AGENT); }
__device__ __forceinline__ unsigned xb_xcc_id() { return (unsigned)__builtin_amdgcn_s_getreg((3 << 11) | 20) & 0xFu; }
#define XB_SPIN(cond, bar) do { unsigned _sp = 0; while (cond) { __builtin_amdgcn_s_sleep(1); \
    if ((++_sp & 255u) == 0u) { if (xb_ld(&(bar)[XB_TMO])) break; if (_sp > XB_SPIN_CAP) { atomicAdd(&(bar)[XB_TMO], 1u); break; } } } } while (0)
struct XcdBarrier { unsigned* bar; unsigned x; volatile LAS unsigned* st; };
__device__ __forceinline__ XcdBarrier xcd_barrier_post(unsigned* bar, volatile LAS unsigned* st) {
    XcdBarrier b; b.bar = bar; b.x = xb_xcc_id(); b.st = st;
    int tid_ = threadIdx.x; asm volatile("" : "+v"(tid_));
    if (tid_ == 0) (void)xb_add(&bar[XB_XCNT(b.x)], 1u);
    return b;
}
__device__ __forceinline__ void xcd_barrier_complete(unsigned* bar, unsigned x, unsigned& nloc, unsigned& nx) {
    const unsigned G = gridDim.x * gridDim.y * gridDim.z;
    unsigned sum, cnt, mine, sp = 0u;
    for (;;) {
        sum = 0u; cnt = 0u; mine = 0u;
#pragma unroll
        for (unsigned j = 0; j < 16; ++j) { const unsigned c = xb_ld(&bar[XB_XCNT(j)]); sum += c; cnt += (c > 0u) ? 1u : 0u; mine = (j == x) ? c : mine; }
        if (sum == G) break;
        __builtin_amdgcn_s_sleep(1);
        if ((++sp & 255u) == 0u) { if (xb_ld(&bar[XB_TMO])) break; if (sp > XB_SPIN_CAP) { atomicAdd(&bar[XB_TMO], 1u); break; } }
    }
    nloc = mine > 0u ? mine : 1u; nx = cnt > 0u ? cnt : 1u;
}
__device__ __forceinline__ void xcd_barrier(const XcdBarrier& b) {
    asm volatile("s_waitcnt vmcnt(0)" ::: "memory");
    __syncthreads();
    int tid_ = threadIdx.x; asm volatile("" : "+v"(tid_));
    if (tid_ == 0) {
        unsigned* bar = b.bar;
        __builtin_amdgcn_s_waitcnt(0);
        unsigned nloc = b.st[0], nx = b.st[1];
        if (nloc == 0u) { xcd_barrier_complete(bar, b.x, nloc, nx); b.st[0] = nloc; b.st[1] = nx; }
        const unsigned old = xb_add(&bar[XB_XSUB(b.x)], 1u);
        const unsigned gen = old / nloc;
        if (old + 1u == (gen + 1u) * nloc) {
            __builtin_amdgcn_fence(__ATOMIC_RELEASE, "agent");
            asm volatile("s_waitcnt vmcnt(0)" ::: "memory");
            const unsigned og = xb_add(&bar[XB_TOP], 1u);
            const unsigned tg = og / nx;
            if (og + 1u == (tg + 1u) * nx) xb_add(&bar[XB_TOPGEN], 1u);
            else XB_SPIN(xb_ld(&bar[XB_TOPGEN]) == tg, bar);
            __builtin_amdgcn_fence(__ATOMIC_ACQUIRE, "agent");
            xb_add(&bar[XB_XGEN(b.x)], 1u);
            asm volatile("s_waitcnt vmcnt(0)" ::: "memory");
        } else {
            XB_SPIN(xb_ld(&bar[XB_XGEN(b.x)]) == gen, bar);
            __builtin_amdgcn_fence(__ATOMIC_ACQUIRE, "agent");
            asm volatile("s_waitcnt vmcnt(0)" ::: "memory");
        }
    }
    __syncthreads();
}

constexpr int LDS_BYTES = 147456;
constexpr int NPHASES = 1 + 2 * 9 + 2 * 8;

__global__ void __launch_bounds__(512, 2) mega_fwd(Args ka) {
    extern __shared__ __attribute__((aligned(16))) unsigned char lds_raw[];
    LAS unsigned char* lds = (LAS unsigned char*)lds_raw;
    cg::grid_group grid = cg::this_grid();
    volatile LAS unsigned* xbst = (volatile LAS unsigned*)(lds + 139264);
    { int tid_ = threadIdx.x; asm volatile("" : "+v"(tid_)); if (tid_ < 2) xbst[tid_] = 0u; }
    __syncthreads();
    XcdBarrier xbar; xbar.bar = (unsigned*)ka.ws; xbar.x = 0; xbar.st = xbst;
    if (ka.hi - ka.lo > 1) xbar = xcd_barrier_post((unsigned*)ka.ws, xbst);
#define U ((bf16_t*)(wsl + WS_U))
#define MIX ((bf16_t*)(wsl + WS_MIX))
#define Hb ((bf16_t*)(wsl + WS_H))
#define Qb ((bf16_t*)(wsl + WS_Q))
#define KVb ((bf16_t*)(wsl + WS_KV))
#define ZL ((bf16_t*)(wsl + WS_ZL))
#define ZC ((bf16_t*)(wsl + WS_ZC))
#define HID ((bf16_t*)(wsl + WS_HID))
#define POOL ((bf16_t*)(wsl + WS_POOL))
#define DFTL ((bf16_t*)(wsl + WS_DFTL))
#define DFTC ((bf16_t*)(wsl + WS_DFTC))
#define hctx ((float*)(wsl + WS_HCTX))
    int ph = 0, layer_ = 0;
#define PHASE_BEGIN if (ph >= ka.lo && ph < ka.hi) { GAS unsigned char* wsg_ = (GAS unsigned char*)ka.ws; asm volatile("" : "+s"(wsg_)); unsigned char* wsl = (unsigned char*)wsg_; \
        const __attribute__((address_space(4))) cfp_t* ain_ = (const __attribute__((address_space(4))) cfp_t*)__builtin_amdgcn_kernarg_segment_ptr(); asm volatile("" : "+s"(ain_)); \
        const Ctx a{ain_, ka.out, wsl}; \
        int lyr_ = layer_; asm volatile("" : "+s"(lyr_)); const float* mods_l = (const float*)(wsl + WS_MODS) + (size_t)lyr_ * 17 * 6144; const float* xin = lyr_ == 0 ? a.inp(I_X) : a.out; const float* cin = lyr_ == 0 ? a.inp(I_CTX) : (const float*)(wsl + WS_HCTX); (void)mods_l; (void)xin; (void)cin; int tid = threadIdx.x; asm volatile("" : "+v"(tid)); int G = gridDim.x, bx = blockIdx.x; asm volatile("" : "+s"(G), "+s"(bx)); \
        const int vcu = (G % 8 == 0) ? (bx % 8) * (G / 8) + bx / 8 : bx, ngw = G * 8, ngt = G * 512; (void)vcu; (void)ngw; (void)ngt; \
        const int lane = tid & 63, wave = __builtin_amdgcn_readfirstlane(tid >> 6), gw = bx * 8 + wave, gtid = bx * 512 + tid; LAS float* scr = (LAS float*)(lds + wave * 8448); \
        (void)lane; (void)gw; (void)gtid; (void)scr;
#define PHASE_END } if (ph >= ka.lo && ph + 1 < ka.hi) { for (int sr_ = 0; sr_ < REP_SYNC; ++sr_) { if (ph == 0) grid.sync(); else xcd_barrier(xbar); } } ++ph;

    PHASE_BEGIN
#ifndef SKIP_P0
        { REPLOOP(REP_P0) {
        for (int it = bx; it < 192; it += G) mods_item(a, it, (LAS float*)lds);
        for (int j = 0; j < 2; ++j) {
            tr_job(a.inp(I_MLAWIN) + (size_t)j * DM * 672, DM, 672, (bf16_t*)(wsl + WS_WINE) + (size_t)j * 768 * DM, 768, 1, nullptr, scr, gw, ngw, lane);
            tr_job(a.inp(I_WUQ) + (size_t)j * 256 * 1152, 256, 1152, (bf16_t*)(wsl + WS_WUQ) + (size_t)j * 1536 * 256, 1536, 2, a.inp(I_CQG) + j * 256, scr, gw, ngw, lane);
            tr_job(a.inp(I_WUKV) + (size_t)j * 128 * 1536, 128, 1536, (bf16_t*)(wsl + WS_WUKV) + (size_t)j * 1536 * 128, 1536, 0, a.inp(I_CKVG) + j * 128, scr, gw, ngw, lane);
            tr_job(a.inp(I_EWOUT) + (size_t)j * DM * DM, DM, DM, (bf16_t*)(wsl + WS_WOUTE) + (size_t)j * DM * DM, DM, 0, nullptr, scr, gw, ngw, lane);
            tr_job(a.inp(I_WINWIN) + (size_t)j * DM * 1536, DM, 1536, (bf16_t*)(wsl + WS_WINO) + (size_t)j * 1536 * DM, 1536, 0, nullptr, scr, gw, ngw, lane);
            tr_job(a.inp(I_OWOUT) + (size_t)j * DM * DM, DM, DM, (bf16_t*)(wsl + WS_WOUTO) + (size_t)j * DM * DM, DM, 0, nullptr, scr, gw, ngw, lane);
        }
        ffn_weights(a, 0, scr, gw, ngw, lane);
        __syncthreads();
        LAS float* ctab = (LAS float*)lds;
        for (int m = tid; m < 4096; m += 512) ctab[m] = cospif((float)m * (1.0f / 2048.0f)) * (1.0f / 64.0f);
        __syncthreads();
        for (int idx = gtid; idx < 4096 * 512; idx += ngt) { const int k = idx >> 9, col0 = (idx & 511) * 8; float v[8];
#pragma unroll
            for (int e = 0; e < 8; ++e) { const int kap = col0 + e; const int m = kap <= 2048 ? (k * kap) & 4095 : (k * (kap - 2048) + 1024) & 4095; v[e] = ctab[m]; }
            u32x4 o; o.x = cvt_pk_bf16(v[0], v[1]); o.y = cvt_pk_bf16(v[2], v[3]); o.z = cvt_pk_bf16(v[4], v[5]); o.w = cvt_pk_bf16(v[6], v[7]);
            *(u32x4*)(DFTL + (size_t)k * 4096 + col0) = o; }
        for (int idx = gtid; idx < 256 * 64; idx += ngt) { const int k = idx >> 6, col0 = (idx & 63) * 8, cs = col0 >> 8, l0 = col0 & 255; float v[8];
#pragma unroll
            for (int e = 0; e < 8; ++e) { const int m = (k * (l0 + e)) & 255; const float x = (float)m * (1.0f / 128.0f); v[e] = (cs ? -sinpif(x) : cospif(x)) * (1.0f / 16.0f); }
            u32x4 o; o.x = cvt_pk_bf16(v[0], v[1]); o.y = cvt_pk_bf16(v[2], v[3]); o.z = cvt_pk_bf16(v[4], v[5]); o.w = cvt_pk_bf16(v[6], v[7]);
            *(u32x4*)(DFTC + (size_t)k * 512 + col0) = o; }
        for (int idx = gtid; idx < 2 * 512 * 256; idx += ngt) { const int j = idx >> 17, n = (idx >> 8) & 511, k = idx & 255; const int cs = n >> 8, g = (n >> 6) & 3, d = n & 63, g2 = k >> 6, c = k & 63;
            float s = 0.f;
            if (g2 == g) { const float* wf = a.inp(I_FNETW) + ((size_t)(j * 4 + g) * 64) * 64 + d;
                for (int c2 = 0; c2 < 64; ++c2) { const int m = (c * c2) & 63; s += (cs ? -ctab[(m * 64 + 1024) & 4095] : ctab[m * 64]) * wf[c2 * 64]; }
                s *= 8.0f; }
            ((bf16_t*)(wsl + WS_WF))[idx] = (bf16_t)(cvt_pk_bf16(s, 0.f) & 0xffffu); }
        for (int idx = gtid; idx < 4096 * 16; idx += ngt) { float cs, sn; rope_cs<8>(idx >> 4, idx & 15, cs, sn); ((f32x2v*)(wsl + WS_ROPE_E))[idx] = (f32x2v){cs, sn}; }
        for (int idx = gtid; idx < 4096 * 32; idx += ngt) { float cs, sn; rope_cs<16>(idx >> 5, idx & 31, cs, sn); ((f32x2v*)(wsl + WS_ROPE_O))[idx] = (f32x2v){cs, sn}; }
        for (int idx = gtid; idx < 2 * 256 * 256; idx += ngt) { const int j = idx >> 16, n = (idx >> 8) & 255, k = idx & 255; const int g = n >> 6, d = n & 63, g2 = k >> 6, c = k & 63;
            float s = 0.f; if (g2 == g) s = a.inp(I_POOLW)[((size_t)(j * 4 + g) * 64 + c) * 64 + d] * a.inp(I_POOLS)[j * 256 + n];
            ((bf16_t*)(wsl + WS_WP))[idx] = (bf16_t)(cvt_pk_bf16(s, 0.f) & 0xffffu); }
        __syncthreads(); } }
#endif
    PHASE_END

    for (int layer = 0; layer < 4; ++layer) {
        const int j = layer >> 1; const bool even = !(layer & 1); const bool ctx_out = layer < 3;
        layer_ = layer;

        PHASE_BEGIN
#ifndef SKIP_NORM
            { REPLOOP(REP_NORM)
            norm_pass(xin, cin, a.inp(I_N1G) + layer * DM, mods_l, 0, 1, U, false, false, gw, ngw, lane); }
#endif
        PHASE_END

        PHASE_BEGIN
#ifndef SKIP_GIN
            { REPLOOP(REP_GIN) {
            if (even) { pg8::Gemm g{U, (const bf16_t*)(wsl + WS_WINE) + (size_t)j * 768 * DM, DM, DM, DM};
                pg8::Order<pg8::MapStd> S; S.init(T / 256, 3, G, bx, pg8::MapStd{0}); pg8::EpiBf16 E{Hb, 768, Hb, 768}; pg8::gemm_phase(lds, g, S, E); }
            else { pg8::Gemm g{U, (const bf16_t*)(wsl + WS_WINO) + (size_t)j * 1536 * DM, DM, DM, DM};
                pg8::Order<pg8::MapStd> S; S.init(T / 256, 6, G, bx, pg8::MapStd{0}); pg8::EpiBf16 E{Hb, 1536, Hb, 1536}; pg8::gemm_phase(lds, g, S, E); }
            } }
#endif
        PHASE_END

        if (even) {
            PHASE_BEGIN
#ifndef SKIP_G3
                { REPLOOP(REP_G3) {
                { pg8::Gemm g{Hb, (const bf16_t*)(wsl + WS_WUQ) + (size_t)j * 1536 * 256, 768, 256, 256};
                  pg8::Order<pg8::MapStd> S; S.init(T / 256, 6, G, bx, pg8::MapStd{0}); pg8::EpiBf16 E{Qb, 1536, Qb, 1536}; pg8::gemm_phase(lds, g, S, E); }
                { pg8::Gemm g{Hb + 256, (const bf16_t*)(wsl + WS_WUKV) + (size_t)j * 1536 * 128, 768, 128, 128};
                  pg8::Order<pg8::MapStd> S; S.init(T / 256, 6, G, bx, pg8::MapStd{0}); pg8::EpiBf16 E{KVb, 1536, KVb, 1536}; pg8::gemm_phase(lds, g, S, E); }
                { pg8::Gemm g{(const bf16_t*)(wsl + WS_WF) + (size_t)j * 512 * 256, Hb + 416, 256, 768, 256};
                  pg8::Order<pg8::MapZ> S; S.init(2, T / 256, G, bx, pg8::MapZ{}); pg8::EpiBf16 E{ZL, 8192, ZC, 512}; pg8::gemm_phase(lds, g, S, E); }
                } }
#endif
            PHASE_END
            PHASE_BEGIN
#ifndef SKIP_EWE
                ew_even(a, j, gw, ngw, lane);
                z_fold(a, lds, gw, ngw, wave, lane);
#endif
            PHASE_END
            PHASE_BEGIN
#ifndef SKIP_ATTE
                const bf16_t* Kb = (const bf16_t*)(wsl + WS_U);
                const int nu = 3072 + (ctx_out ? 192 : 0);
                { REPLOOP(REP_ATTE)
                for (int uid = vcu; uid < nu; uid += G) {
                    if (uid < 3072) { const int bh = uid >> 4, qb = uid & 15, b = bh / 12, h = bh % 12; const size_t base = (size_t)b * TB, qrow = base + NCTX + qb * 256;
                        attn_unit<96, false>(lds, Qb + qrow * 1536 + h * 128, 1536, Kb + base * 1152 + h * 96, 1152, KVb + base * 1536 + h * 128 + 64, 1536, MIX + qrow * DM + h * 64, 68, 0, 0, 0, -1e30f, false); }
                    else { const int bh = uid - 3072, b = bh / 12, h = bh % 12; const size_t base = (size_t)b * TB;
                        attn_unit<96, false>(lds, Qb + base * 1536 + h * 128, 1536, Kb + base * 1152 + h * 96, 1152, KVb + base * 1536 + h * 128 + 64, 1536, MIX + base * DM + h * 64, 4, 0, 0, 0, -1e30f, false); }
                } }
#ifndef SKIP_ATTE_G
                { REPLOOP(REP_FNET) {
                { pg8::Gemm g{DFTL, (const bf16_t*)(wsl + WS_ZF), 4096, 4096, 4096};
                  pg8::Order<pg8::MapFnetL> S; S.init(256, 1, G, bx, pg8::MapFnetL{}); pg8::EpiBf16 E{MIX, DM, MIX, DM}; pg8::gemm_phase(lds, g, S, E); }
                if (ctx_out) { pg8::Gemm g{DFTC, ZC, 512, 512, 512};
                  pg8::Order<pg8::MapFnetC> S; S.init(16, 1, G, bx, pg8::MapFnetC{}); pg8::EpiBf16 E{MIX, DM, MIX, DM}; pg8::gemm_phase(lds, g, S, E); }
                } }
#endif
#endif
            PHASE_END
        } else {
            PHASE_BEGIN
#ifndef SKIP_EWO
                ew_odd(a, j, gw, ngw, lane);
#endif
            PHASE_END
            PHASE_BEGIN
#ifndef SKIP_ATTO
                const float* sink = a.inp(I_SINK) + j * 12;
                const int nu = 3072 + (ctx_out ? 192 : 0);
                { REPLOOP(REP_ATTO)
                for (int uid = vcu; uid < nu; uid += G) {
                    if (uid < 3072) { const int bh = uid >> 4, qb = uid & 15, b = bh / 12, h = bh % 12, kvh = h / 3; const size_t base = (size_t)b * TB, qrow = base + NCTX + qb * 256;
                        int lt0 = qb * 4 - 2, lt1 = qb * 4 + 6; if (lt0 < 0) lt0 = 0; if (lt1 > 64) lt1 = 64;
                        attn_unit<64, true>(lds, Hb + qrow * 1536 + h * 64, 1536, Hb + base * 1536 + 768 + kvh * 64, 1536, Hb + base * 1536 + 1024 + kvh * 64, 1536, MIX + qrow * DM + h * 64,
                                            4, 4 + lt0, 4 + lt1, qb * 256, sink[h] * LOG2E, true, a.inp(I_WQG) + j * 64, (const f32x2v*)(wsl + WS_ROPE_O), true); }
                    else { const int bh = uid - 3072, b = bh / 12, h = bh % 12, kvh = h / 3; const size_t base = (size_t)b * TB;
                        attn_unit<64, true>(lds, Hb + base * 1536 + h * 64, 1536, Hb + base * 1536 + 768 + kvh * 64, 1536, Hb + base * 1536 + 1024 + kvh * 64, 1536, MIX + base * DM + h * 64,
                                            4, 0, 0, 0, sink[h] * LOG2E, true, a.inp(I_WQG) + j * 64, (const f32x2v*)(wsl + WS_ROPE_O), false); }
                } }
                { pg8::Gemm g{POOL, (const bf16_t*)(wsl + WS_WP) + (size_t)j * 256 * 256, 256, 256, 256};
                  pg8::Order<pg8::MapStd> S; S.init(T / 256, 1, G, bx, pg8::MapStd{768}); pg8::EpiBf16 E{MIX, DM, MIX, DM}; pg8::gemm_phase(lds, g, S, E); }
#endif
            PHASE_END
        }

        PHASE_BEGIN
#ifndef SKIP_WOUT
            pg8::Gemm g{MIX, (const bf16_t*)(wsl + (even ? WS_WOUTE : WS_WOUTO)) + (size_t)j * DM * DM, DM, DM, DM};
            pg8::Order<pg8::MapRes> S; S.init(ctx_out ? 272 : 256, 4, G, bx, pg8::MapRes{ctx_out ? 1 : 0});
            { REPLOOP(REP_WOUT) { pg8::EpiRes E{rep_ ? (const float*)a.out : xin, a.out, rep_ ? (const float*)hctx : cin, hctx, mods_l, 2, rep_ ? 0.f : 1.f}; pg8::gemm_phase(lds, g, S, E); } }
#endif
        PHASE_END

        PHASE_BEGIN
#ifndef SKIP_NORM2
            { REPLOOP(REP_NORM)
            norm_pass(a.out, hctx, a.inp(I_N2G) + layer * DM, mods_l, 3, 4, U, true, !ctx_out, gw, ngw, lane); }
#endif
        PHASE_END

        PHASE_BEGIN
#ifndef SKIP_UP
            pg8::Gemm g{U, (const bf16_t*)(wsl + WS_WUP), DM, DM, DM};
            pg8::Order<pg8::MapUp> S; S.init(ctx_out ? 275 : 259, 22, G, bx, pg8::MapUp{ctx_out ? 1 : 0});
            pg8::EpiUp E{HID, a.inp(I_CONVW) + (size_t)layer * 3 * 2 * DFF, a.inp(I_CONVB) + (size_t)layer * 2 * DFF}; { REPLOOP(REP_UP) pg8::gemm_phase(lds, g, S, E); }
#endif
        PHASE_END

        PHASE_BEGIN
#ifndef SKIP_DN
            pg8::Gemm g{HID, (const bf16_t*)(wsl + ((layer & 1) ? WS_WDN2 : WS_WDN)), DFF, DFF, DFF};
            pg8::Order<pg8::MapRes> S; S.init(ctx_out ? 272 : 256, 4, G, bx, pg8::MapRes{ctx_out ? 1 : 0});
            { REPLOOP(REP_DN) { pg8::EpiRes E{a.out, a.out, hctx, hctx, mods_l, 5, rep_ ? 0.f : 1.f}; pg8::gemm_phase(lds, g, S, E); } }
            if (layer < 3) {
                const int nfree = (ctx_out && G == 256) ? 192 : G, first = (ctx_out && G == 256) ? 64 : 0;
                if (bx >= first) ffn_weights(a, layer + 1, scr, (bx - first) * 8 + wave, nfree * 8, lane);
            }
#endif
        PHASE_END
    }
#undef PHASE_BEGIN
#undef PHASE_END
#undef U
#undef MIX
#undef Hb
#undef Qb
#undef KVb
#undef ZL
#undef ZC
#undef HID
#undef POOL
#undef DFTL
#undef DFTC
#undef hctx
}

extern "C" void kernel_launch(void* const* d_in, const int* in_sizes, int n_in, void* d_out, int out_size, void* d_ws, size_t ws_size, hipStream_t stream) {
    static int grid = 0;
    if (grid == 0) {
        if (n_in != 28 || out_size != NB * SEQ * DM || ws_size < WS_END) { fprintf(stderr, "kernel_launch: unexpected shapes (n_in %d, out %d, ws %zu); nothing launched\n", n_in, out_size, ws_size); grid = -1; return; }
        int dev = 0, cus = 0, per_cu = 0;
        if (hipGetDevice(&dev) != hipSuccess || hipDeviceGetAttribute(&cus, hipDeviceAttributeMultiprocessorCount, dev) != hipSuccess) { grid = -1; return; }
        if (hipFuncSetAttribute((const void*)mega_fwd, hipFuncAttributeMaxDynamicSharedMemorySize, LDS_BYTES) != hipSuccess) { fprintf(stderr, "kernel_launch: hipFuncSetAttribute failed\n"); grid = -1; return; }
        if (hipOccupancyMaxActiveBlocksPerMultiprocessor(&per_cu, (const void*)mega_fwd, 512, LDS_BYTES) != hipSuccess || per_cu < 1) { fprintf(stderr, "kernel_launch: occupancy query says %d\n", per_cu); per_cu = 1; }
        (void)hipGetLastError();
        grid = cus * 1;
    }
    if (grid < 0) return;
    Args a{};
    for (int i = 0; i < 28; ++i) a.in[i] = (const float*)d_in[i];
    a.out = (float*)d_out; a.ws = (unsigned char*)d_ws; a.lo = 0; a.hi = NPHASES;
    (void)hipMemsetAsync(d_ws, 0, 16384, stream);
    void* args[] = {&a};
    hipError_t e = hipLaunchCooperativeKernel((const void*)mega_fwd, dim3(grid), dim3(512), args, LDS_BYTES, stream);
    if (e != hipSuccess) {
        fprintf(stderr, "kernel_launch: cooperative launch failed: %s (grid %d); falling back to one launch per phase\n", hipGetErrorString(e), grid);
        (void)hipGetLastError();
        for (int p = 0; p < NPHASES; ++p) { a.lo = p; a.hi = p + 1; hipLaunchKernelGGL(mega_fwd, dim3(grid), dim3(512), LDS_BYTES, stream, a); }
    }
}
```

```cpp
#include <hip/hip_runtime.h>
#include <hip/hip_cooperative_groups.h>
#include <cstdio>
#include <cstdint>
namespace cg = cooperative_groups;

#define REP_NORM 1
#define REP_GIN 1
#define REP_G3 1
#define REP_ATTE 1
#define REP_FNET 1
#define REP_ATTO 1
#define REP_WOUT 1
#define REP_UP 1
#define REP_DN 1
#define REP_P0 1
#define REP_EW 1
#define REP_SYNC 1
#define PROBE_MODE 0
#define REPLOOP(N) int nrep_ = (N); asm volatile("" : "+s"(nrep_)); for (int rep_ = 0; rep_ < nrep_; ++rep_)

constexpr int NB = 16, SEQ = 4096, NCTX = 256, DM = 1024, TB = SEQ + NCTX, T = NB * TB;
constexpr int DFF = 2816, U2B = 4608, TAILROW0 = 16 * 4608, TAILSEG = 34;
constexpr float EPS = 1e-6f;
constexpr float LOG2E = 1.4426950408889634f;

constexpr size_t MiB = 1u << 20;
constexpr size_t WS_MODS = 1 * MiB;
constexpr size_t WS_RQ = 2 * MiB + 720 * 1024;
constexpr size_t WS_WINE = 3 * MiB;
constexpr size_t WS_WUQ = 6 * MiB;
constexpr size_t WS_WUKV = WS_WUQ + 3 * MiB / 2;
constexpr size_t WS_WF = WS_WUKV + 3 * MiB / 4;
constexpr size_t WS_WP = WS_WF + MiB / 2;
constexpr size_t WS_WOUTE = 9 * MiB;
constexpr size_t WS_WOUTO = 13 * MiB;
constexpr size_t WS_WINO = 17 * MiB;
constexpr size_t WS_WUP = 23 * MiB;
constexpr size_t WS_WDN = 34 * MiB;
constexpr size_t WS_DFTC = 40 * MiB;
constexpr size_t WS_DFTL = 41 * MiB;
constexpr size_t WS_ZF = 73 * MiB;
constexpr size_t WS_HCTX = 105 * MiB;
constexpr size_t WS_U = 121 * MiB;
constexpr size_t WS_MIX = 275 * MiB;
constexpr size_t WS_ARENA = 411 * MiB;
constexpr size_t WS_H = WS_ARENA;
constexpr size_t WS_Q = WS_ARENA + 102 * MiB;
constexpr size_t WS_KV = WS_Q + 204 * MiB;
constexpr size_t WS_ZL = WS_KV + 204 * MiB;
constexpr size_t WS_ZC = WS_ZL + 64 * MiB;
constexpr size_t WS_POOL = WS_ARENA + 204 * MiB;
constexpr size_t WS_HID = WS_ARENA;
constexpr size_t WS_ROPE_E = WS_ZC + 4 * MiB;
constexpr size_t WS_ROPE_O = WS_ROPE_E + 1 * MiB;
constexpr size_t WS_WDN2 = WS_ROPE_O + 1 * MiB;
constexpr size_t WS_END = WS_WDN2 + 6 * MiB;
static_assert(WS_END <= 1024 * MiB, "ws map");

#define LAS __attribute__((address_space(3)))
#define GAS __attribute__((address_space(1)))
typedef unsigned short bf16_t;
typedef short bf16x8 __attribute__((ext_vector_type(8)));
typedef float f32x4 __attribute__((ext_vector_type(4)));
typedef float f32x16 __attribute__((ext_vector_type(16)));
typedef unsigned u32x4 __attribute__((ext_vector_type(4)));
typedef unsigned u32x2 __attribute__((ext_vector_type(2)));
typedef float f32x2v __attribute__((ext_vector_type(2)));

__device__ __forceinline__ unsigned cvt_pk_bf16(float lo, float hi) { unsigned r; asm volatile("v_cvt_pk_bf16_f32 %0, %1, %2" : "=v"(r) : "v"(lo), "v"(hi)); return r; }
__device__ __forceinline__ float bflo(unsigned u) { return __uint_as_float(u << 16); }
__device__ __forceinline__ float bfhi(unsigned u) { return __uint_as_float(u & 0xffff0000u); }
__device__ __forceinline__ float bf2f(bf16_t b) { return __uint_as_float((unsigned)b << 16); }
__device__ __forceinline__ float wave_sum(float v) {
#pragma unroll
    for (int o = 1; o < 64; o <<= 1) v += __shfl_xor(v, o);
    return v;
}
__device__ __forceinline__ float half_sum(float v) {
#pragma unroll
    for (int o = 1; o < 32; o <<= 1) v += __shfl_xor(v, o);
    return v;
}

namespace pg8 {
constexpr int BM = 256, BK = 64, HALF = 128, HTB = HALF * BK * 2, STAGE_BYTES = 8 * HTB, NXCD = 8, WGM = 8;
__device__ __forceinline__ int lds_byte(int r, int c) { const int st = (r >> 4) * 2 + (c >> 5), rr = r & 15, cc = c & 31, ob = rr * 64 + cc * 2; return st * 1024 + (ob ^ (((ob >> 9) & 1) << 5)); }
__device__ __forceinline__ void stage_rc(int b, int& R, int& C) { const int st = b / 1024, sb = b % 1024, swz = sb ^ (((sb >> 9) & 1) << 5); R = (st >> 1) * 16 + swz / 64; C = (st & 1) * 32 + (swz % 64) / 2; }
__device__ __forceinline__ int perm32(int rho) { const int n = rho >> 4, i = rho & 15; return 8 * (i >> 2) + 4 * n + (i & 3); }

struct Unit { int pm, pn, arow, brow, orow, ocol, aux, bt; };
struct Gemm { const bf16_t* A; const bf16_t* Bt; int lda, ldb, K; };

template <class Map> struct Order {
    int nM, nN, nwg, G, c; Map map;
    __device__ __forceinline__ void init(int nM_, int nN_, int G_, int c_, const Map& m) { nM = nM_; nN = nN_; nwg = nM * nN; G = G_; c = c_; map = m; }
    __device__ __forceinline__ bool next(int i, Unit& u) const {
        const long L = (long)i * G + c; if (L >= nwg) return false;
        int wgid = (int)L; { const int q = nwg / NXCD, r = nwg % NXCD, xcd = wgid % NXCD, off = wgid / NXCD; wgid = (xcd < r ? xcd * (q + 1) : r * (q + 1) + (xcd - r) * q) + off; }
        const int nig = WGM * nN, gid = wgid / nig, fm = gid * WGM, gsz = (nM - fm) < WGM ? (nM - fm) : WGM;
        u.pm = fm + ((wgid % nig) % gsz); u.pn = (wgid % nig) / gsz; map(u); return true;
    }
};

struct EpiBf16 {
    static constexpr bool PERM = true;
    bf16_t* O0; int ld0; bf16_t* O1; int ld1;
    __device__ __forceinline__ void operator()(const f32x4 (&acc)[2][2][4][2], const Unit& u, int wr, int wc, int fr, int fq, LAS unsigned char*) const {
        bf16_t* base = u.aux ? O1 : O0; const int ldc = u.aux ? ld1 : ld0;
        const int row0 = u.orow + wr * 64 + fr, col0 = u.ocol + wc * 32 + 8 * fq;
#pragma unroll
        for (int ai = 0; ai < 2; ++ai)
#pragma unroll
            for (int m = 0; m < 4; ++m) { bf16_t* rowp = base + (size_t)(row0 + ai * HALF + m * 16) * ldc + col0;
#pragma unroll
                for (int bj = 0; bj < 2; ++bj) { const f32x4 v0 = acc[ai][bj][m][0], v1 = acc[ai][bj][m][1];
                    u32x4 w; w.x = cvt_pk_bf16(v0[0], v0[1]); w.y = cvt_pk_bf16(v0[2], v0[3]); w.z = cvt_pk_bf16(v1[0], v1[1]); w.w = cvt_pk_bf16(v1[2], v1[3]);
                    *(u32x4*)(rowp + bj * HALF) = w; } }
    }
};

struct EpiRes {
    static constexpr bool PERM = false;
    const float* xin; float* xout; const float* cin; float* cout; const float* mods_l; int gidx; float gs;
    __device__ __forceinline__ void operator()(const f32x4 (&acc)[2][2][4][2], const Unit& u, int wr, int wc, int fr, int fq, LAS unsigned char*) const {
        const float* src = u.aux ? cin : xin; float* dst = u.aux ? cout : xout;
        const float* gate = mods_l + (size_t)(u.aux ? 16 : u.bt) * 6144 + gidx * 1024;
        const int row0 = u.orow + wr * 64 + fr, col0 = u.ocol + wc * 32 + 4 * fq;
        const __amdgpu_buffer_rsrc_t rs = __builtin_amdgcn_make_buffer_rsrc((void*)dst, 0, 0x40000000, 0x00020000);
#pragma unroll
        for (int bj = 0; bj < 2; ++bj) {
            f32x4 g4[2], xv[2][2][4];
#pragma unroll
            for (int n = 0; n < 2; ++n) { const int col = col0 + bj * HALF + n * 16; g4[n] = *(const f32x4*)(gate + col) * gs;
#pragma unroll
                for (int ai = 0; ai < 2; ++ai)
#pragma unroll
                    for (int m = 0; m < 4; ++m) xv[n][ai][m] = *(const f32x4*)(src + (size_t)(row0 + ai * HALF + m * 16) * DM + col); }
            asm volatile("" ::: "memory");
#pragma unroll
            for (int n = 0; n < 2; ++n) { const int col = col0 + bj * HALF + n * 16;
#pragma unroll
                for (int ai = 0; ai < 2; ++ai)
#pragma unroll
                    for (int m = 0; m < 4; ++m) { const size_t off = (size_t)(row0 + ai * HALF + m * 16) * DM + col;
                        __builtin_amdgcn_raw_buffer_store_b128(__builtin_bit_cast(u32x4, xv[n][ai][m] + g4[n] * acc[ai][bj][m][n]), rs, (unsigned)(off * 4), 0, 16); } }
            asm volatile("" ::: "memory");
        }
    }
};

__device__ __forceinline__ float dpp_ror1(float v) { return __int_as_float(__builtin_amdgcn_update_dpp(__float_as_int(v), __float_as_int(v), 0x121, 0xf, 0xf, false)); }
__device__ __forceinline__ float dpp_ror15(float v) { return __int_as_float(__builtin_amdgcn_update_dpp(__float_as_int(v), __float_as_int(v), 0x12F, 0xf, 0xf, false)); }
__device__ __forceinline__ float silu_f(float x) { return x * __builtin_amdgcn_rcpf(1.0f + __expf(-x)); }

struct EpiUp {
    static constexpr bool PERM = false;
    bf16_t* Hd; const float* cw; const float* cb;
    __device__ __forceinline__ void operator()(const f32x4 (&acc)[2][2][4][2], const Unit& u, int wr, int wc, int fr, int fq, LAS unsigned char* lds) const {
        LAS float* hal = (LAS float*)(lds + STAGE_BYTES);
        LAS float* cwl = (LAS float*)(lds + 140288);
        const int tid_ = (wr * 4 + wc) * 64 + fq * 16 + fr;
        float cwv[2];
#pragma unroll
        for (int q = 0; q < 2; ++q) { const int e = tid_ + 512 * q, t = e >> 8, bj = (e >> 7) & 1, c = e & 127; cwv[q] = t < 3 ? cw[t * (2 * DFF) + bj * DFF + u.ocol + c] : cb[bj * DFF + u.ocol + c]; }
        if (fr == 0) {
#pragma unroll
            for (int ai = 0; ai < 2; ++ai)
#pragma unroll
                for (int bj = 0; bj < 2; ++bj)
#pragma unroll
                    for (int n = 0; n < 2; ++n) *(LAS f32x4*)(hal + ((2 * ai + wr) * 2 + 0) * 256 + bj * 128 + wc * 32 + n * 16 + 4 * fq) = acc[ai][bj][0][n];
        }
        if (fr == 15) {
#pragma unroll
            for (int ai = 0; ai < 2; ++ai)
#pragma unroll
                for (int bj = 0; bj < 2; ++bj)
#pragma unroll
                    for (int n = 0; n < 2; ++n) *(LAS f32x4*)(hal + ((2 * ai + wr) * 2 + 1) * 256 + bj * 128 + wc * 32 + n * 16 + 4 * fq) = acc[ai][bj][3][n];
        }
        cwl[tid_] = cwv[0]; cwl[tid_ + 512] = cwv[1];
        asm volatile("s_waitcnt lgkmcnt(0)" ::: "memory"); __builtin_amdgcn_s_barrier(); asm volatile("" ::: "memory");
        int fr_ = fr, fq_ = fq; asm volatile("" : "+v"(fr_), "+v"(fq_));
        const int rmin = u.aux == 1 ? 0 : 1, rmax = u.bt;
        const f32x4 zero4 = {0.f, 0.f, 0.f, 0.f};
#pragma unroll
        for (int ai = 0; ai < 2; ++ai) {
            const int g = 2 * ai + wr;
#pragma unroll
            for (int n = 0; n < 2; ++n) {
                const int chb = u.ocol + wc * 32 + n * 16 + 4 * fq_;
                const int colh = wc * 32 + n * 16 + 4 * fq_;
                f32x4 w0[2], w1[2], w2[2], bb[2], uh[2], dh[2];
#pragma unroll
                for (int bj = 0; bj < 2; ++bj) { const int cl = bj * 128 + colh;
                    w0[bj] = *(const LAS f32x4*)(cwl + 0 * 256 + cl); w1[bj] = *(const LAS f32x4*)(cwl + 1 * 256 + cl); w2[bj] = *(const LAS f32x4*)(cwl + 2 * 256 + cl); bb[bj] = *(const LAS f32x4*)(cwl + 3 * 256 + cl);
                    uh[bj] = zero4; dh[bj] = zero4;
                    if (g > 0) uh[bj] = *(LAS f32x4*)(hal + ((g - 1) * 2 + 1) * 256 + bj * 128 + colh);
                    if (g < 3) dh[bj] = *(LAS f32x4*)(hal + ((g + 1) * 2 + 0) * 256 + bj * 128 + colh); }
#pragma unroll
                for (int m = 0; m < 4; ++m) {
                    f32x4 res[2];
#pragma unroll
                    for (int bj = 0; bj < 2; ++bj) {
                        const f32x4 cur = acc[ai][bj][m][n];
                        const f32x4 prv = m > 0 ? acc[ai][bj][m > 0 ? m - 1 : 0][n] : uh[bj];
                        const f32x4 nxt = m < 3 ? acc[ai][bj][m < 3 ? m + 1 : 3][n] : dh[bj];
                        f32x4 su, sd;
#pragma unroll
                        for (int j = 0; j < 4; ++j) { su[j] = fr_ == 15 ? prv[j] : cur[j]; sd[j] = fr_ == 0 ? nxt[j] : cur[j]; }
                        f32x4 rr = w1[bj] * cur + bb[bj];
                        asm volatile("s_nop 1\n\t"
                                     "v_fmac_f32_dpp %0, %4, %12 row_ror:1 row_mask:0xf bank_mask:0xf\n\t"
                                     "v_fmac_f32_dpp %1, %5, %13 row_ror:1 row_mask:0xf bank_mask:0xf\n\t"
                                     "v_fmac_f32_dpp %2, %6, %14 row_ror:1 row_mask:0xf bank_mask:0xf\n\t"
                                     "v_fmac_f32_dpp %3, %7, %15 row_ror:1 row_mask:0xf bank_mask:0xf\n\t"
                                     "v_fmac_f32_dpp %0, %8, %16 row_ror:15 row_mask:0xf bank_mask:0xf\n\t"
                                     "v_fmac_f32_dpp %1, %9, %17 row_ror:15 row_mask:0xf bank_mask:0xf\n\t"
                                     "v_fmac_f32_dpp %2, %10, %18 row_ror:15 row_mask:0xf bank_mask:0xf\n\t"
                                     "v_fmac_f32_dpp %3, %11, %19 row_ror:15 row_mask:0xf bank_mask:0xf"
                                     : "+v"(rr[0]), "+v"(rr[1]), "+v"(rr[2]), "+v"(rr[3])
                                     : "v"(su[0]), "v"(su[1]), "v"(su[2]), "v"(su[3]), "v"(sd[0]), "v"(sd[1]), "v"(sd[2]), "v"(sd[3]),
                                       "v"(w0[bj][0]), "v"(w0[bj][1]), "v"(w0[bj][2]), "v"(w0[bj][3]), "v"(w2[bj][0]), "v"(w2[bj][1]), "v"(w2[bj][2]), "v"(w2[bj][3]));
                        res[bj] = rr;
                    }
                    const int r = ai * HALF + wr * 64 + m * 16 + fr_;
                    bool okr = r >= rmin && r <= rmax; int trow = u.orow + r;
                    if (u.aux == 2) { const int seg = r / TAILSEG, sq = r - seg * TAILSEG, sb = 7 * (u.orow >> 8) + seg;
                        okr = seg < 7 && sb < NB && sq >= 1 && sq <= 32; trow = sb * TB + NCTX + (SEQ - 33) + sq; }
                    if (okr) {
                        const f32x4 gq = res[0], vq = res[1];
                        u32x2 w; w.x = cvt_pk_bf16(silu_f(gq[0]) * vq[0], silu_f(gq[1]) * vq[1]); w.y = cvt_pk_bf16(silu_f(gq[2]) * vq[2], silu_f(gq[3]) * vq[3]);
                        *(u32x2*)(Hd + (size_t)trow * DFF + chb) = w;
                    }
                }
            }
        }
    }
};

template <class Epi, class Sched>
__device__ __forceinline__ void gemm_phase(LAS unsigned char* lds, const Gemm g, const Sched& S, const Epi& E) {
    int tid = threadIdx.x; asm volatile("" : "+v"(tid));
    const int wid = __builtin_amdgcn_readfirstlane(tid >> 6), lane = tid & 63, wr = wid >> 2, wc = wid & 3, fr = lane & 15, fq = lane >> 4;
    int K = g.K, lda_ = g.lda, ldb_ = g.ldb; asm volatile("" : "+s"(K), "+s"(lda_), "+s"(ldb_));
    const int nt = K / BK;
    unsigned voffA[2], voffB[2];
#pragma unroll
    for (int i = 0; i < 2; ++i) { int R, C; stage_rc(tid * 16 + i * 8192, R, C); const int Rb = Epi::PERM ? ((R & ~31) + perm32(R & 31)) : R;
        voffA[i] = (unsigned)(R * lda_ + C) * 2u; voffB[i] = (unsigned)(Rb * ldb_ + C) * 2u; }
    const size_t kstep = (size_t)(BK * 2);
    const size_t hstepA = (size_t)HALF * lda_ * 2, hstepB = (size_t)HALF * ldb_ * 2;
    const unsigned ldsw = (unsigned)wid * 1024u;
    const int aoff = lds_byte(wr * 64 + fr, fq * 8), boff = lds_byte(wc * 32 + fr, fq * 8);
#define PG8_SA(b, h) (((b) * 2 + (h)) * HTB)
#define PG8_SB(b, h) ((4 + (b) * 2 + (h)) * HTB)
#define PG8_STAGE(bufoff, gbase, voff) do { _Pragma("unroll") for (int _i = 0; _i < 2; ++_i) \
        __builtin_amdgcn_global_load_lds((const unsigned*)((const char*)(gbase) + (voff)[_i]), (LAS unsigned*)(lds + (bufoff) + ldsw + _i * 8192), 16, 0, 0); } while (0)
#define PG8_LDA(dst, b, h) do { _Pragma("unroll") for (int m = 0; m < 4; ++m) _Pragma("unroll") for (int k = 0; k < 2; ++k) dst[m][k] = *(const LAS bf16x8*)(lds + PG8_SA(b, h) + aoff + m * 2048 + k * 1024); } while (0)
#define PG8_LDB(dst, b, h) do { _Pragma("unroll") for (int n = 0; n < 2; ++n) _Pragma("unroll") for (int k = 0; k < 2; ++k) dst[n][k] = *(const LAS bf16x8*)(lds + PG8_SB(b, h) + boff + n * 2048 + k * 1024); } while (0)
#define PG8_MMA(ai, bj, At, Bt) do { __builtin_amdgcn_s_setprio(1); _Pragma("unroll") for (int m = 0; m < 4; ++m) _Pragma("unroll") for (int n = 0; n < 2; ++n) _Pragma("unroll") for (int k = 0; k < 2; ++k) \
        acc[ai][bj][m][n] = __builtin_amdgcn_mfma_f32_16x16x32_bf16(Bt[n][k], At[m][k], acc[ai][bj][m][n], 0, 0, 0); __builtin_amdgcn_s_setprio(0); } while (0)
#define PG8_WAIT_V(n) asm volatile("s_waitcnt vmcnt(" #n ")" ::: "memory")
#define PG8_WAIT_L(n) asm volatile("s_waitcnt lgkmcnt(" #n ")" ::: "memory")
#define PG8_BAR __builtin_amdgcn_s_barrier()
#define PG8_SCHED __builtin_amdgcn_sched_barrier(0)
    Unit cur, nxt; int ui = 0;
    if (!S.next(0, cur)) return;
    f32x4 acc[2][2][4][2];
#pragma unroll
    for (int a = 0; a < 2; ++a)
#pragma unroll
        for (int b = 0; b < 2; ++b)
#pragma unroll
            for (int m = 0; m < 4; ++m)
#pragma unroll
                for (int n = 0; n < 2; ++n) acc[a][b][m][n] = (f32x4){0.f, 0.f, 0.f, 0.f};
    bf16x8 At[4][2], B0[2][2], B1[2][2];
    const char* cA = (const char*)g.A + (size_t)cur.arow * lda_ * 2; const char* cB = (const char*)g.Bt + (size_t)cur.brow * ldb_ * 2;
    PG8_STAGE(PG8_SB(0, 0), cB, voffB); PG8_STAGE(PG8_SB(0, 1), cB + hstepB, voffB); PG8_STAGE(PG8_SA(0, 0), cA, voffA); PG8_STAGE(PG8_SA(0, 1), cA + hstepA, voffA);
    if (wr == 1) PG8_BAR;
    PG8_WAIT_V(2); PG8_BAR;
    PG8_STAGE(PG8_SB(1, 0), cB + kstep, voffB); PG8_STAGE(PG8_SA(1, 0), cA + kstep, voffA); PG8_STAGE(PG8_SB(1, 1), cB + hstepB + kstep, voffB);
    PG8_WAIT_V(6); PG8_BAR;
    for (;;) {
        const bool has_next = S.next(ui + 1, nxt);
        const char* nA = has_next ? (const char*)g.A + (size_t)nxt.arow * lda_ * 2 : cA; const char* nB = has_next ? (const char*)g.Bt + (size_t)nxt.brow * ldb_ * 2 : cB;
        for (int t = 0; t < nt; t += 2) {
            const bool last = (t == nt - 2);
            const char* a1 = cA + (size_t)(t + 1) * kstep;
            const char* a2 = last ? nA : cA + (size_t)(t + 2) * kstep; const char* b2 = last ? nB : cB + (size_t)(t + 2) * kstep;
            const char* a3 = a2 + kstep; const char* b3 = b2 + kstep;
            PG8_LDB(B0, 0, 0); PG8_LDB(B1, 0, 1); PG8_SCHED; PG8_LDA(At, 0, 0); PG8_STAGE(PG8_SA(1, 1), a1 + hstepA, voffA);
            PG8_WAIT_V(8); PG8_WAIT_L(0); PG8_BAR; PG8_MMA(0, 0, At, B0); PG8_MMA(0, 1, At, B1); PG8_BAR; PG8_SCHED;
            PG8_LDA(At, 0, 1); PG8_STAGE(PG8_SB(0, 0), b2, voffB); PG8_STAGE(PG8_SB(0, 1), b2 + hstepB, voffB); PG8_STAGE(PG8_SA(0, 0), a2, voffA);
            PG8_WAIT_V(8); PG8_WAIT_L(0); PG8_BAR; PG8_MMA(1, 0, At, B0); PG8_MMA(1, 1, At, B1); PG8_BAR; PG8_SCHED;
            PG8_LDB(B0, 1, 0); PG8_LDB(B1, 1, 1); PG8_SCHED; PG8_LDA(At, 1, 0); PG8_STAGE(PG8_SA(0, 1), a2 + hstepA, voffA);
            PG8_WAIT_V(8); PG8_WAIT_L(0); PG8_BAR; PG8_MMA(0, 0, At, B0); PG8_MMA(0, 1, At, B1); PG8_BAR; PG8_SCHED;
            PG8_LDA(At, 1, 1); PG8_STAGE(PG8_SB(1, 0), b3, voffB); PG8_STAGE(PG8_SB(1, 1), b3 + hstepB, voffB); PG8_STAGE(PG8_SA(1, 0), a3, voffA);
            PG8_WAIT_V(8); PG8_WAIT_L(0); PG8_BAR; PG8_MMA(1, 0, At, B0); PG8_MMA(1, 1, At, B1); PG8_BAR; PG8_SCHED;
        }
        if (wr == 0) PG8_BAR;
        E(acc, cur, wr, wc, fr, fq, lds);
        if (!has_next) break;
#pragma unroll
        for (int a = 0; a < 2; ++a)
#pragma unroll
            for (int b = 0; b < 2; ++b)
#pragma unroll
                for (int m = 0; m < 4; ++m)
#pragma unroll
                    for (int n = 0; n < 2; ++n) acc[a][b][m][n] = (f32x4){0.f, 0.f, 0.f, 0.f};
        cur = nxt; cA = nA; cB = nB; ++ui;
        if (wr == 1) PG8_BAR;
    }
    PG8_WAIT_V(0);
    PG8_BAR;
#undef PG8_SA
#undef PG8_SB
#undef PG8_STAGE
#undef PG8_LDA
#undef PG8_LDB
#undef PG8_MMA
#undef PG8_WAIT_V
#undef PG8_WAIT_L
#undef PG8_BAR
#undef PG8_SCHED
}

struct MapStd { int coff; __device__ __forceinline__ void operator()(Unit& u) const { u.arow = u.pm * 256; u.brow = u.pn * 256; u.orow = u.pm * 256; u.ocol = coff + u.pn * 256; u.aux = 0; u.bt = 0; } };
struct MapRes { int all;
    __device__ __forceinline__ void operator()(Unit& u) const {
        int b, j; if (all) { b = u.pm / 17; j = u.pm % 17; } else { b = u.pm / 16; j = u.pm % 16 + 1; }
        u.arow = (b * 17 + j) * 256; u.brow = u.pn * 256; u.ocol = u.pn * 256; u.bt = b;
        if (j == 0) { u.aux = 1; u.orow = b * 256; } else { u.aux = 0; u.orow = b * SEQ + (j - 1) * 256; } asm volatile("" : "+s"(u.aux)); } };
struct MapUp { int all;
    __device__ __forceinline__ void operator()(Unit& u) const {
        const int per = all ? 17 : 16, nmain = 16 * per;
        u.brow = u.pn * 256; u.ocol = u.pn * 128;
        if (u.pm >= nmain) { u.aux = 2; u.arow = TAILROW0 + (u.pm - nmain) * 256; u.orow = (u.pm - nmain) * 256; u.bt = 0; return; }
        const int b = u.pm / per, j = all ? u.pm % per : u.pm % per + 1;
        if (j == 0) { u.aux = 1; u.arow = b * U2B; u.orow = b * TB; u.bt = 255; }
        else { const int i = j - 1; u.aux = 0; u.arow = b * U2B + 263 + 254 * i; u.orow = b * TB + NCTX + 254 * i - 1; u.bt = 254; } } };
struct MapZ {
    __device__ __forceinline__ void operator()(Unit& u) const {
        const int b = u.pn / 17, j = u.pn % 17; u.arow = u.pm * 256; u.brow = u.pn * 256; u.orow = b * 256; u.bt = b;
        if (j == 0) { u.aux = 1; u.ocol = u.pm * NCTX; } else { u.aux = 0; u.ocol = u.pm * SEQ + (j - 1) * 256; } } };
struct MapFnetL { __device__ __forceinline__ void operator()(Unit& u) const { const int b = u.pm / 16, mt = u.pm % 16; u.arow = mt * 256; u.brow = b * 256; u.orow = b * TB + NCTX + mt * 256; u.ocol = 768; u.aux = 0; u.bt = b; } };
struct MapFnetC { __device__ __forceinline__ void operator()(Unit& u) const { const int b = u.pm; u.arow = 0; u.brow = b * 256; u.orow = b * TB; u.ocol = 768; u.aux = 0; u.bt = b; } };
}

typedef short v4i16_t __attribute__((ext_vector_type(4)));
__device__ __forceinline__ v4i16_t vtr(const LAS unsigned char* p) { return __builtin_amdgcn_ds_read_tr16_b64_v4i16((LAS v4i16_t*)p); }
#define MX3(a_, b_, c_) __builtin_fmaxf(__builtin_fmaxf((a_), (b_)), (c_))
__device__ __forceinline__ float tile_max(const f32x16& s0, const f32x16& s1) {
    float ma = MX3(s0[0], s0[1], s1[0]), mb = MX3(s0[2], s0[3], s1[1]); ma = MX3(ma, s1[2], s1[3]);
#pragma unroll
    for (int r = 4; r < 16; r += 4) { ma = MX3(ma, s0[r], s0[r + 1]); mb = MX3(mb, s0[r + 2], s0[r + 3]); ma = MX3(ma, s1[r], s1[r + 1]); mb = MX3(mb, s1[r + 2], s1[r + 3]); }
    return __builtin_fmaxf(ma, mb);
}
#undef MX3
__device__ __forceinline__ void band_mask(f32x16& s0, f32x16& s1, int k0pos, int qp, int hi) {
#pragma unroll
    for (int r = 0; r < 16; ++r) { const int kp = k0pos + (r & 3) + 8 * (r >> 2) + 4 * hi; const int d0 = kp - qp, d1 = d0 + 32;
        if (d0 > 128 || d0 < -128) s0[r] = -1e30f; if (d1 > 128 || d1 < -128) s1[r] = -1e30f; }
}
__device__ __forceinline__ void exp4(f32x16& s, int r0, float& acc0, float& acc1) {
    s[r0] = __builtin_amdgcn_exp2f(s[r0]); s[r0 + 1] = __builtin_amdgcn_exp2f(s[r0 + 1]); s[r0 + 2] = __builtin_amdgcn_exp2f(s[r0 + 2]); s[r0 + 3] = __builtin_amdgcn_exp2f(s[r0 + 3]);
    acc0 += s[r0] + s[r0 + 2]; acc1 += s[r0 + 1] + s[r0 + 3];
}
__device__ __forceinline__ bf16x8 pack8(const f32x16& s, int r0) {
    u32x4 w; w.x = cvt_pk_bf16(s[r0], s[r0 + 1]); w.y = cvt_pk_bf16(s[r0 + 2], s[r0 + 3]); w.z = cvt_pk_bf16(s[r0 + 4], s[r0 + 5]); w.w = cvt_pk_bf16(s[r0 + 6], s[r0 + 7]);
    return __builtin_bit_cast(bf16x8, w);
}
__device__ __forceinline__ void pv_slab(const LAS unsigned char* vb, int koff, const bf16x8 pj, f32x16& o0, f32x16& o1) {
    const v4i16_t a0 = vtr(vb + koff), a1 = vtr(vb + koff + 512), b0 = vtr(vb + 8192 + koff), b1 = vtr(vb + 8192 + koff + 512);
    const bf16x8 v0 = {a0[0], a0[1], a0[2], a0[3], a1[0], a1[1], a1[2], a1[3]}, v1 = {b0[0], b0[1], b0[2], b0[3], b1[0], b1[1], b1[2], b1[3]};
    o0 = __builtin_amdgcn_mfma_f32_32x32x16_bf16(v0, pj, o0, 0, 0, 0);
    o1 = __builtin_amdgcn_mfma_f32_32x32x16_bf16(v1, pj, o1, 0, 0, 0);
}

#define ATT_SCHED() __builtin_amdgcn_sched_barrier(0)
template <int DQ, bool WIN>
__device__ __forceinline__ void attn_qk(LAS unsigned char* lds, int kbufoff, int t, const bf16x8 (&qf)[DQ / 16], f32x16& o0, f32x16& o1, float& mrun, float& lsum,
                                        f32x16& sa0, f32x16& sa1, f32x16& sb0, f32x16& sb1, int l31, int hi, int qw) {
    constexpr int NDK = DQ / 16, KST = DQ * 2 + 16;
    const LAS unsigned char* kb = lds + kbufoff + l31 * KST + hi * 16;
    bf16x8 kf[2][4];
#define KLOAD(dst, dk) do { dst[0] = *(const LAS bf16x8*)(kb + (dk) * 32); dst[1] = *(const LAS bf16x8*)(kb + 32 * KST + (dk) * 32); \
                            dst[2] = *(const LAS bf16x8*)(kb + 64 * KST + (dk) * 32); dst[3] = *(const LAS bf16x8*)(kb + 96 * KST + (dk) * 32); } while (0)
    KLOAD(kf[0], 0);
#pragma unroll
    for (int dk = 0; dk < NDK; ++dk) {
        if (dk + 1 < NDK) KLOAD(kf[(dk + 1) & 1], dk + 1);
        ATT_SCHED();
        const bf16x8 (&f)[4] = kf[dk & 1];
        if (dk == 0) { f32x16 z16;
#pragma unroll
                       for (int r = 0; r < 16; ++r) z16[r] = 0.f;
                       sa0 = __builtin_amdgcn_mfma_f32_32x32x16_bf16(f[0], qf[0], z16, 0, 0, 0); sa1 = __builtin_amdgcn_mfma_f32_32x32x16_bf16(f[1], qf[0], z16, 0, 0, 0);
                       sb0 = __builtin_amdgcn_mfma_f32_32x32x16_bf16(f[2], qf[0], z16, 0, 0, 0); sb1 = __builtin_amdgcn_mfma_f32_32x32x16_bf16(f[3], qf[0], z16, 0, 0, 0); }
        else { sa0 = __builtin_amdgcn_mfma_f32_32x32x16_bf16(f[0], qf[dk], sa0, 0, 0, 0); sa1 = __builtin_amdgcn_mfma_f32_32x32x16_bf16(f[1], qf[dk], sa1, 0, 0, 0);
               sb0 = __builtin_amdgcn_mfma_f32_32x32x16_bf16(f[2], qf[dk], sb0, 0, 0, 0); sb1 = __builtin_amdgcn_mfma_f32_32x32x16_bf16(f[3], qf[dk], sb1, 0, 0, 0); }
        ATT_SCHED();
    }
#undef KLOAD
    if (__builtin_expect(__any(mrun != 0.f), 0)) {
#pragma unroll
        for (int r = 0; r < 16; ++r) { sa0[r] -= mrun; sa1[r] -= mrun; sb0[r] -= mrun; sb1[r] -= mrun; }
    }
    if (WIN && t >= 4) { const int qp = qw + l31, k0pos = (t - 4) * 64; band_mask(sa0, sa1, k0pos, qp, hi); band_mask(sb0, sb1, k0pos + 64, qp, hi); }
    float mx = __builtin_fmaxf(tile_max(sa0, sa1), tile_max(sb0, sb1));
    { auto rr = __builtin_amdgcn_permlane32_swap(__float_as_uint(mx), __float_as_uint(mx), false, false); mx = __builtin_fmaxf(__uint_as_float(rr[0]), __uint_as_float(rr[1])); }
    if (__builtin_expect(__any(mx > 8.0f), 0)) {
        const float dl = mx > 8.0f ? mx : 0.f; mrun += dl;
        const float alpha = __builtin_amdgcn_exp2f(-dl); lsum *= alpha;
#pragma unroll
        for (int r = 0; r < 16; ++r) { sa0[r] -= dl; sa1[r] -= dl; sb0[r] -= dl; sb1[r] -= dl; o0[r] *= alpha; o1[r] *= alpha; }
    }
}
#define VLOAD(dst, j) do { dst[0] = vtr(vb + (j) * 1024); dst[1] = vtr(vb + (j) * 1024 + 512); dst[2] = vtr(vb + 8192 + (j) * 1024); dst[3] = vtr(vb + 8192 + (j) * 1024 + 512); } while (0)
#define PVMMA(src, P_) do { const bf16x8 v0_ = {src[0][0], src[0][1], src[0][2], src[0][3], src[1][0], src[1][1], src[1][2], src[1][3]}, v1_ = {src[2][0], src[2][1], src[2][2], src[2][3], src[3][0], src[3][1], src[3][2], src[3][3]}; \
        const bf16x8 p_ = (P_); o0 = __builtin_amdgcn_mfma_f32_32x32x16_bf16(v0_, p_, o0, 0, 0, 0); o1 = __builtin_amdgcn_mfma_f32_32x32x16_bf16(v1_, p_, o1, 0, 0, 0); } while (0)
__device__ __forceinline__ void attn_softmax_pv(const LAS unsigned char* vb, f32x16& sa0, f32x16& sa1, f32x16& sb0, f32x16& sb1, f32x16& o0, f32x16& o1, float& lsum) {
    v4i16_t vf[2][4];
    VLOAD(vf[0], 0);
    float p0 = 0.f, p1 = 0.f, p2 = 0.f, p3 = 0.f;
    exp4(sa0, 0, p0, p1); exp4(sa0, 4, p2, p3); exp4(sa0, 8, p0, p1); exp4(sa0, 12, p2, p3);
    exp4(sa1, 0, p0, p1); exp4(sa1, 4, p2, p3); exp4(sa1, 8, p0, p1); exp4(sa1, 12, p2, p3);
    VLOAD(vf[1], 1); ATT_SCHED(); PVMMA(vf[0], pack8(sa0, 0)); exp4(sb0, 0, p0, p1); exp4(sb0, 4, p2, p3); ATT_SCHED();
    VLOAD(vf[0], 2); ATT_SCHED(); PVMMA(vf[1], pack8(sa0, 8)); exp4(sb0, 8, p0, p1); exp4(sb0, 12, p2, p3); ATT_SCHED();
    VLOAD(vf[1], 3); ATT_SCHED(); PVMMA(vf[0], pack8(sa1, 0)); exp4(sb1, 0, p0, p1); exp4(sb1, 4, p2, p3); ATT_SCHED();
    VLOAD(vf[0], 4); ATT_SCHED(); PVMMA(vf[1], pack8(sa1, 8)); exp4(sb1, 8, p0, p1); exp4(sb1, 12, p2, p3); ATT_SCHED();
    lsum += (p0 + p1) + (p2 + p3);
    VLOAD(vf[1], 5); ATT_SCHED(); PVMMA(vf[0], pack8(sb0, 0)); ATT_SCHED();
    VLOAD(vf[0], 6); ATT_SCHED(); PVMMA(vf[1], pack8(sb0, 8)); ATT_SCHED();
    VLOAD(vf[1], 7); ATT_SCHED(); PVMMA(vf[0], pack8(sb1, 0)); ATT_SCHED();
    PVMMA(vf[1], pack8(sb1, 8));
}
__device__ __forceinline__ void attn_softmax_keep(f32x16& sa0, f32x16& sa1, f32x16& sb0, f32x16& sb1, bf16x8 (&pw)[8], float& lsum) {
    float p0 = 0.f, p1 = 0.f, p2 = 0.f, p3 = 0.f;
    exp4(sa0, 0, p0, p1); exp4(sa0, 4, p2, p3); exp4(sa0, 8, p0, p1); exp4(sa0, 12, p2, p3); pw[0] = pack8(sa0, 0); pw[1] = pack8(sa0, 8);
    exp4(sa1, 0, p0, p1); exp4(sa1, 4, p2, p3); exp4(sa1, 8, p0, p1); exp4(sa1, 12, p2, p3); pw[2] = pack8(sa1, 0); pw[3] = pack8(sa1, 8);
    exp4(sb0, 0, p0, p1); exp4(sb0, 4, p2, p3); exp4(sb0, 8, p0, p1); exp4(sb0, 12, p2, p3); pw[4] = pack8(sb0, 0); pw[5] = pack8(sb0, 8);
    exp4(sb1, 0, p0, p1); exp4(sb1, 4, p2, p3); exp4(sb1, 8, p0, p1); exp4(sb1, 12, p2, p3); pw[6] = pack8(sb1, 0); pw[7] = pack8(sb1, 8);
    lsum += (p0 + p1) + (p2 + p3);
}
__device__ __forceinline__ void attn_pv_all(const LAS unsigned char* vb, const bf16x8 (&pw)[8], f32x16& o0, f32x16& o1) {
    v4i16_t vf[2][4];
    VLOAD(vf[0], 0);
    VLOAD(vf[1], 1); ATT_SCHED(); PVMMA(vf[0], pw[0]); ATT_SCHED();
    VLOAD(vf[0], 2); ATT_SCHED(); PVMMA(vf[1], pw[1]); ATT_SCHED();
    VLOAD(vf[1], 3); ATT_SCHED(); PVMMA(vf[0], pw[2]); ATT_SCHED();
    VLOAD(vf[0], 4); ATT_SCHED(); PVMMA(vf[1], pw[3]); ATT_SCHED();
    VLOAD(vf[1], 5); ATT_SCHED(); PVMMA(vf[0], pw[4]); ATT_SCHED();
    VLOAD(vf[0], 6); ATT_SCHED(); PVMMA(vf[1], pw[5]); ATT_SCHED();
    VLOAD(vf[1], 7); ATT_SCHED(); PVMMA(vf[0], pw[6]); ATT_SCHED();
    PVMMA(vf[1], pw[7]);
}
#undef VLOAD
#undef PVMMA
#undef ATT_SCHED

template <int DQ, bool WIN, int MODE = 0>
__device__ __forceinline__ void attn_unit(LAS unsigned char* lds, const bf16_t* Qp, int ldq, const bf16_t* Kp, int ldk, const bf16_t* Vp, int ldv, bf16_t* Op,
                                          int n1, int s2, int e2, int q0pos, float m_init, bool has_sink, const float* qgain = nullptr, const f32x2v* ropeT = nullptr, bool qrope = false, const float* rqrow = nullptr) {
    constexpr int NDK = DQ / 16, CH = DQ / 8, NKC = DQ / 32, KST = DQ * 2 + 16, KBUF = 128 * KST, VBUF = 16384, VOFF = 2 * KBUF;
    int tid = threadIdx.x; asm volatile("" : "+v"(tid));
    const int lane = tid & 63, wid = __builtin_amdgcn_readfirstlane(tid >> 6), l31 = lane & 31, hi = lane >> 5;
    const bool late = wid >= 4;
    bf16x8 qf[NDK];
    { const bf16_t* qrow = Qp + (size_t)(32 * wid + l31) * ldq + 8 * hi;
#pragma unroll
      for (int dk = 0; dk < NDK; ++dk) qf[dk] = *(const bf16x8*)(qrow + 16 * dk); }
    if (DQ == 96 && qgain != nullptr) {
        const float r_q = rqrow[32 * wid + l31];
        float y[6][8]; float ss = 0.f;
#pragma unroll
        for (int dk = 0; dk < 6; ++dk) { const u32x4 w = __builtin_bit_cast(u32x4, qf[dk < NDK ? dk : 0]);
#pragma unroll
            for (int i = 0; i < 4; ++i) { y[dk][2 * i] = bflo(w[i]) * r_q; y[dk][2 * i + 1] = bfhi(w[i]) * r_q; ss += y[dk][2 * i] * y[dk][2 * i] + y[dk][2 * i + 1] * y[dk][2 * i + 1]; } }
        ss += __shfl_xor(ss, 32);
        const float sc = rsqrtf(ss * (1.0f / 96.0f) + EPS);
#pragma unroll
        for (int dk = 0; dk < 6; ++dk)
#pragma unroll
            for (int e = 0; e < 8; ++e) y[dk][e] *= sc * qgain[16 * dk + 8 * hi + e];
        if (qrope) { const int pos = q0pos + 32 * wid + l31;
#pragma unroll
            for (int e = 0; e < 8; ++e) { const f32x2v t = ropeT[pos * 16 + 8 * hi + e]; const float x1 = y[4][e], x2 = y[5][e]; y[4][e] = x1 * t.x - x2 * t.y; y[5][e] = x1 * t.y + x2 * t.x; } }
        const float QS_ = 0.10206207261596577f * LOG2E;
#pragma unroll
        for (int dk = 0; dk < 6; ++dk) { u32x4 w;
#pragma unroll
            for (int i = 0; i < 4; ++i) w[i] = cvt_pk_bf16(y[dk][2 * i] * QS_, y[dk][2 * i + 1] * QS_);
            if (dk < NDK) qf[dk] = __builtin_bit_cast(bf16x8, w); }
    }
    if (DQ == 64 && qgain != nullptr) {
        float y[4][8]; float ss = 0.f;
#pragma unroll
        for (int dk = 0; dk < 4; ++dk) { const u32x4 w = __builtin_bit_cast(u32x4, qf[dk < NDK ? dk : 0]);
#pragma unroll
            for (int i = 0; i < 4; ++i) { y[dk][2 * i] = bflo(w[i]); y[dk][2 * i + 1] = bfhi(w[i]); ss += y[dk][2 * i] * y[dk][2 * i] + y[dk][2 * i + 1] * y[dk][2 * i + 1]; } }
        ss += __shfl_xor(ss, 32);
        const float rn = rsqrtf(ss * (1.0f / 64.0f) + EPS);
#pragma unroll
        for (int dk = 0; dk < 4; ++dk)
#pragma unroll
            for (int e = 0; e < 8; ++e) y[dk][e] *= rn * qgain[16 * dk + 8 * hi + e];
        if (qrope) { const int pos = q0pos + 32 * wid + l31;
#pragma unroll
            for (int dk = 0; dk < 2; ++dk)
#pragma unroll
                for (int e = 0; e < 8; ++e) { const f32x2v t = ropeT[pos * 32 + 16 * dk + 8 * hi + e]; const float x1 = y[dk][e], x2 = y[dk + 2][e]; y[dk][e] = x1 * t.x - x2 * t.y; y[dk + 2][e] = x1 * t.y + x2 * t.x; } }
        const float QS_ = 0.125f * LOG2E;
#pragma unroll
        for (int dk = 0; dk < 4; ++dk) { u32x4 w;
#pragma unroll
            for (int i = 0; i < 4; ++i) w[i] = cvt_pk_bf16(y[dk][2 * i] * QS_, y[dk][2 * i + 1] * QS_);
            if (dk < NDK) qf[dk] = __builtin_bit_cast(bf16x8, w); }
    }
    f32x16 o0, o1;
#pragma unroll
    for (int r = 0; r < 16; ++r) { o0[r] = 0.f; o1[r] = 0.f; }
    float mrun = 0.f, lsum = (has_sink && hi == 0) ? __builtin_amdgcn_exp2f(m_init) : 0.f;
    const int qw = q0pos + 32 * wid;
    const int vlane = (4 * hi + ((lane & 15) >> 2)) * 64 + ((lane >> 4) & 1) * 32 + (lane & 3) * 8;
    u32x4 kr[NKC], vr[2];
#define ATT_TILE(i_) ((i_) < n1 ? (i_) : s2 + ((i_) - n1))
#define ATT_LOAD(t) do { const bf16_t* kp_ = Kp + (size_t)(t) * 64 * ldk; const bf16_t* vp_ = Vp + (size_t)(t) * 64 * ldv; \
        _Pragma("unroll") for (int m_ = 0; m_ < NKC; ++m_) { const int c_ = tid + 512 * m_; kr[m_] = *(const GAS u32x4*)(kp_ + (size_t)(c_ / CH) * ldk + (c_ % CH) * 8); } \
        _Pragma("unroll") for (int m_ = 0; m_ < 2; ++m_) { const int c_ = tid + 512 * m_; vr[m_] = *(const GAS u32x4*)(vp_ + (size_t)(c_ >> 3) * ldv + (c_ & 7) * 8); } } while (0)
#define ATT_STORE(kb_, vb_) do { \
        _Pragma("unroll") for (int m_ = 0; m_ < NKC; ++m_) { const int c_ = tid + 512 * m_; *(LAS u32x4*)(lds + (kb_) * KBUF + (c_ / CH) * KST + (c_ % CH) * 16) = kr[m_]; } \
        _Pragma("unroll") for (int m_ = 0; m_ < 2; ++m_) { const int c_ = tid + 512 * m_; *(LAS u32x4*)(lds + VOFF + (vb_) * VBUF + ((c_ & 7) >> 2) * 8192 + (c_ >> 3) * 64 + (c_ & 3) * 16) = vr[m_]; } } while (0)
#define ATT_BAR() asm volatile("s_waitcnt lgkmcnt(0)\n\ts_barrier" ::: "memory")
    const int nst = (n1 + (e2 - s2)) >> 1;
    ATT_LOAD(0); ATT_STORE(0, 0);
    ATT_BAR();
    if (!late) {
        int vcur = 0;
        for (int I = 0; I < nst; ++I) {
            const int t = ATT_TILE(2 * I);
            if (I + 1 < nst) { const int tn = ATT_TILE(2 * I + 2); ATT_LOAD(tn); }
            bool active = true; if (WIN && t >= 4) { const int k0 = (t - 4) * 64; active = (k0 + 127 >= qw - 128) && (k0 <= qw + 31 + 128); }
            const int vnext = vcur == 2 ? 0 : vcur + 1;
            if (active) { f32x16 sa0, sa1, sb0, sb1;
                attn_qk<DQ, WIN>(lds, (I & 1) * KBUF, t, qf, o0, o1, mrun, lsum, sa0, sa1, sb0, sb1, l31, hi, qw);
                attn_softmax_pv(lds + VOFF + vcur * VBUF + vlane, sa0, sa1, sb0, sb1, o0, o1, lsum); }
            if (I + 1 < nst) ATT_STORE((I + 1) & 1, vnext);
            vcur = vnext;
            ATT_BAR();
        }
    } else {
        bf16x8 pw[8]; bool havep = false; int pvoff = 0;
        int vcur = 0;
        for (int I = 0; I < nst; ++I) {
            const int t = ATT_TILE(2 * I);
            if (I + 1 < nst) { const int tn = ATT_TILE(2 * I + 2); ATT_LOAD(tn); }
            bool active = true; if (WIN && t >= 4) { const int k0 = (t - 4) * 64; active = (k0 + 127 >= qw - 128) && (k0 <= qw + 31 + 128); }
            const int vnext = vcur == 2 ? 0 : vcur + 1;
            if (havep) attn_pv_all(lds + VOFF + pvoff + vlane, pw, o0, o1);
            havep = false;
            if (active) { f32x16 sa0, sa1, sb0, sb1;
                attn_qk<DQ, WIN>(lds, (I & 1) * KBUF, t, qf, o0, o1, mrun, lsum, sa0, sa1, sb0, sb1, l31, hi, qw);
                attn_softmax_keep(sa0, sa1, sb0, sb1, pw, lsum); havep = true; pvoff = vcur * VBUF; }
            if (I + 1 < nst) ATT_STORE((I + 1) & 1, vnext);
            vcur = vnext;
            ATT_BAR();
        }
        if (havep) attn_pv_all(lds + VOFF + pvoff + vlane, pw, o0, o1);
    }
    ATT_BAR();
#undef ATT_TILE
#undef ATT_LOAD
#undef ATT_STORE
#undef ATT_BAR
    const float lt = lsum + __shfl_xor(lsum, 32), inv = 1.0f / lt;
    bf16_t* orow = Op + (size_t)(32 * wid + l31) * DM + 4 * hi;
#pragma unroll
    for (int g = 0; g < 4; ++g) {
        u32x2 w0, w1;
        w0.x = cvt_pk_bf16(o0[4 * g] * inv, o0[4 * g + 1] * inv); w0.y = cvt_pk_bf16(o0[4 * g + 2] * inv, o0[4 * g + 3] * inv);
        w1.x = cvt_pk_bf16(o1[4 * g] * inv, o1[4 * g + 1] * inv); w1.y = cvt_pk_bf16(o1[4 * g + 2] * inv, o1[4 * g + 3] * inv);
        *(u32x2*)(orow + 8 * g) = w0; *(u32x2*)(orow + 32 + 8 * g) = w1;
    }
}

struct Args { const float* in[28]; float* out; unsigned char* ws; int lo, hi; };
typedef const GAS float* cfp_t;
struct Ctx { const __attribute__((address_space(4))) cfp_t* in; float* out; unsigned char* ws;
    __device__ __forceinline__ const float* inp(int i) const { return (const float*)in[i]; } };
enum { I_X = 0, I_C, I_CTX, I_CCTX, I_MODW, I_MODB, I_N1G, I_N2G, I_MLAWIN, I_CQG, I_CKVG, I_WUQ, I_WUKV, I_QG, I_KG, I_FNETW, I_EWOUT,
       I_WINWIN, I_WQG, I_WKG, I_SINK, I_POOLW, I_POOLS, I_OWOUT, I_FFNUP, I_CONVW, I_CONVB, I_FFNDN };

__device__ __forceinline__ void tr_item(const float* W, int K, int Nsrc, bf16_t* WT, int nblk, int item, LAS float* scr, int lane, int mode, const float* ksc) {
    const int kb = item / nblk, nb = item % nblk, k0 = 64 * kb, n0 = 32 * nb;
    int s0 = n0;
    if (mode == 1) s0 = n0 < 672 ? n0 : -1;
    else if (mode == 2) { const int hd = n0 >> 7, d0 = n0 & 127; s0 = d0 < 96 ? hd * 96 + d0 : -1; }
    else if (mode == 3) { const int pn = n0 >> 8, bj = (n0 >> 7) & 1, c = n0 & 127; s0 = bj * DFF + pn * 128 + c; }
#pragma unroll 16
    for (int i = 0; i < 32; ++i) { const int kk = 2 * i + (lane >> 5); float v = 0.f;
        if (s0 >= 0) { v = W[(size_t)(k0 + kk) * Nsrc + s0 + (lane & 31)]; if (ksc) v *= ksc[k0 + kk]; }
        scr[kk * 33 + (lane & 31)] = v; }
    asm volatile("s_waitcnt lgkmcnt(0)" ::: "memory");
    const int c = lane & 7;
#pragma unroll
    for (int j = 0; j < 4; ++j) { const int n = (lane >> 3) + 8 * j; const LAS float* s = scr + (8 * c) * 33 + n;
        u32x4 o; o.x = cvt_pk_bf16(s[0 * 33], s[1 * 33]); o.y = cvt_pk_bf16(s[2 * 33], s[3 * 33]); o.z = cvt_pk_bf16(s[4 * 33], s[5 * 33]); o.w = cvt_pk_bf16(s[6 * 33], s[7 * 33]);
        *(u32x4*)(WT + (size_t)(n0 + n) * K + k0 + 8 * c) = o; }
    asm volatile("s_waitcnt lgkmcnt(0)" ::: "memory");
}
__device__ __forceinline__ void tr_job(const float* W, int K, int Nsrc, bf16_t* WT, int Nout, int mode, const float* ksc, LAS float* scr, int gw, int ngw, int lane) {
    const int nblk = Nout / 32, nitems = (K / 64) * nblk;
    for (int it = gw; it < nitems; it += ngw) tr_item(W, K, Nsrc, WT, nblk, it, scr, lane, mode, ksc);
}
__device__ __forceinline__ void ffn_weights(const Ctx& a, int layer, LAS float* scr, int gw, int ngw, int lane) {
    tr_job(a.inp(I_FFNUP) + (size_t)layer * DM * 2 * DFF, DM, 2 * DFF, (bf16_t*)(a.ws + WS_WUP), 2 * DFF, 3, nullptr, scr, gw, ngw, lane);
    tr_job(a.inp(I_FFNDN) + (size_t)layer * DFF * DM, DFF, DM, (bf16_t*)(a.ws + ((layer & 1) ? WS_WDN2 : WS_WDN)), DM, 0, nullptr, scr, gw, ngw, lane);
}

__device__ __forceinline__ void mods_item(const Ctx& a, int item, LAS float* sl) {
    int tid = threadIdx.x; asm volatile("" : "+v"(tid)); const int l = item / 48, nb = item % 48;
    LAS float* red = sl + 17 * 1024;
    for (int idx = tid; idx < 17 * 1024; idx += 512) { const int r = idx >> 10, k = idx & 1023; const float v = r < 16 ? a.inp(I_C)[r * 1024 + k] : a.inp(I_CCTX)[k]; sl[idx] = v / (1.0f + __expf(-v)); }
    __syncthreads();
    const int cn = tid & 127, ks = tid >> 7, n = 128 * nb + cn;
    float acc[17];
#pragma unroll
    for (int r = 0; r < 17; ++r) acc[r] = 0.f;
    const float* wp = a.inp(I_MODW) + ((size_t)l * 1024 + 256 * ks) * 6144 + n;
#pragma unroll 4
    for (int k = 0; k < 256; k += 4) {
        const float w0 = wp[(size_t)(k + 0) * 6144], w1 = wp[(size_t)(k + 1) * 6144], w2 = wp[(size_t)(k + 2) * 6144], w3 = wp[(size_t)(k + 3) * 6144];
#pragma unroll
        for (int r = 0; r < 17; ++r) { const f32x4 s4 = *(const LAS f32x4*)(sl + r * 1024 + 256 * ks + k); acc[r] += s4[0] * w0 + s4[1] * w1 + s4[2] * w2 + s4[3] * w3; }
    }
#pragma unroll
    for (int r = 0; r < 17; ++r) red[(ks * 17 + r) * 128 + cn] = acc[r];
    __syncthreads();
    float* mods = (float*)(a.ws + WS_MODS);
    for (int idx = tid; idx < 17 * 128; idx += 512) { const int r = idx >> 7, c2 = idx & 127;
        const float s = red[(0 * 17 + r) * 128 + c2] + red[(1 * 17 + r) * 128 + c2] + red[(2 * 17 + r) * 128 + c2] + red[(3 * 17 + r) * 128 + c2];
        mods[((size_t)l * 17 + r) * 6144 + 128 * nb + c2] = s + a.inp(I_MODB)[l * 6144 + 128 * nb + c2]; }
    __syncthreads();
}

__device__ __forceinline__ void norm_pass(const float* xsrc, const float* csrc, const float* g, const float* mods_l, int shift_idx, int scale_idx,
                                          bf16_t* U, bool ffn_layout, bool skip_ctx, int gw, int ngw, int lane) {
    for (int R0 = gw; R0 < T; R0 += 2 * ngw) {
        f32x4 v[2][4]; bool ok[2]; int bb[2], pp[2];
#pragma unroll
        for (int s = 0; s < 2; ++s) { const int R = R0 + s * ngw; const int b = R / TB, p = R % TB; const bool isctx = p < NCTX; bb[s] = b; pp[s] = p;
            ok[s] = (R < T) && !(isctx && skip_ctx);
            const float* src = isctx ? csrc + (size_t)(b * NCTX + p) * DM : xsrc + (size_t)(b * SEQ + p - NCTX) * DM;
            if (ok[s]) {
#pragma unroll
                for (int j = 0; j < 4; ++j) v[s][j] = *(const f32x4*)(src + (lane + 64 * j) * 4); } }
#pragma unroll
        for (int s = 0; s < 2; ++s) if (ok[s]) {
            const int R = R0 + s * ngw, b = bb[s], p = pp[s]; const bool isctx = p < NCTX;
            const float* mrow = mods_l + (size_t)(isctx ? 16 : b) * 6144;
            float ss = 0.f;
#pragma unroll
            for (int j = 0; j < 4; ++j) ss += (v[s][j][0] * v[s][j][0] + v[s][j][1] * v[s][j][1]) + (v[s][j][2] * v[s][j][2] + v[s][j][3] * v[s][j][3]);
            const float rs = rsqrtf(wave_sum(ss) * (1.0f / DM) + EPS);
            const size_t orow = ffn_layout ? (size_t)b * U2B + (isctx ? p : 264 + p - NCTX) : (size_t)R;
#pragma unroll
            for (int j = 0; j < 4; ++j) { const int c4 = (lane + 64 * j) * 4;
                const f32x4 gg = *(const f32x4*)(g + c4), sh = *(const f32x4*)(mrow + shift_idx * 1024 + c4), sc = *(const f32x4*)(mrow + scale_idx * 1024 + c4);
                const f32x4 y = v[s][j] * rs * gg * (sc + 1.0f) + sh;
                u32x2 w; w.x = cvt_pk_bf16(y[0], y[1]); w.y = cvt_pk_bf16(y[2], y[3]);
                *(u32x2*)(U + orow * DM + c4) = w;
                if (ffn_layout && !isctx && p - NCTX >= SEQ - 33) *(u32x2*)(U + ((size_t)TAILROW0 + (b / 7) * 256 + (b % 7) * TAILSEG + (p - NCTX - (SEQ - 33))) * DM + c4) = w; }
        }
    }
    if (ffn_layout && gw >= 32 && gw < 48) {
        const int tb_ = gw - 32; const size_t orow = (size_t)TAILROW0 + (tb_ / 7) * 256 + (tb_ % 7) * TAILSEG + 33;
#pragma unroll
        for (int j = 0; j < 4; ++j) *(u32x2*)(U + orow * DM + (lane + 64 * j) * 4) = (u32x2){0u, 0u};
    }
    if (ffn_layout && gw < 32) {
        const int b = gw >> 1; const size_t orow = (size_t)b * U2B + ((gw & 1) ? 264 + SEQ : 263);
#pragma unroll
        for (int j = 0; j < 4; ++j) *(u32x2*)(U + orow * DM + (lane + 64 * j) * 4) = (u32x2){0u, 0u};
    }
}

template <int NF> __device__ __forceinline__ void rope_cs(int pos, int i, float& cs, float& sn) {
    const int row = pos >> 6, col = pos & 63; const int f = i < NF ? i : i - NF;
    const float inv = exp2f(-(float)f * (13.287712379549449f / NF));
    const float ang = (float)(i < NF ? row : col) * inv;
    sincosf(ang, &sn, &cs);
}

__device__ __forceinline__ void unpack8(const u32x4 v, float (&x)[8]) {
#pragma unroll
    for (int i = 0; i < 4; ++i) { x[2 * i] = bflo(v[i]); x[2 * i + 1] = bfhi(v[i]); }
}
__device__ __forceinline__ u32x4 pack8f(const float (&x)[8]) { u32x4 o; o.x = cvt_pk_bf16(x[0], x[1]); o.y = cvt_pk_bf16(x[2], x[3]); o.z = cvt_pk_bf16(x[4], x[5]); o.w = cvt_pk_bf16(x[6], x[7]); return o; }

__device__ __forceinline__ void ew_even(const Ctx& a, int j, int gw, int ngw, int lane) {
    const bf16_t* H = (const bf16_t*)(a.ws + WS_H); bf16_t* Qb = (bf16_t*)(a.ws + WS_Q); bf16_t* KVb = (bf16_t*)(a.ws + WS_KV); bf16_t* Kout = (bf16_t*)(a.ws + WS_U);
    const float QS = 0.10206207261596577f * LOG2E;
    const f32x2v* ropeT = (const f32x2v*)(a.ws + WS_ROPE_E);
    const int g16 = lane >> 4, c16 = lane & 15; const bool act = c16 < 12; const int cc = act ? c16 : 0;
    float qg[8], kg[8];
#pragma unroll
    for (int e = 0; e < 8; ++e) { qg[e] = a.inp(I_QG)[j * 96 + 8 * cc + e]; kg[e] = a.inp(I_KG)[j * 96 + 8 * cc + e]; }
    for (int R = gw; R < T; R += ngw) {
        const int p = R % TB; const int pos = p - NCTX; const bool lat = pos >= 0;
        const bf16_t* hrow = H + (size_t)R * 768; bf16_t* qrow = Qb + (size_t)R * 1536; bf16_t* kvrow = KVb + (size_t)R * 1536;
        const u32x4 z4 = {0u, 0u, 0u, 0u};
        u32x4 hv = z4; if (lane < 48) hv = *(const u32x4*)(hrow + 8 * lane);
        u32x4 qv[3], kv[3], vv[2];
#pragma unroll
        for (int rd = 0; rd < 3; ++rd) { const int hd = 4 * rd + g16; qv[rd] = z4; kv[rd] = z4;
            if (act) { kv[rd] = c16 < 8 ? *(const u32x4*)(kvrow + hd * 128 + 8 * c16) : *(const u32x4*)(hrow + 384 + 8 * (c16 - 8)); } }
        vv[0] = *(const u32x4*)(kvrow + (lane >> 3) * 128 + 64 + 8 * (lane & 7)); vv[1] = z4;
        if (lane < 32) vv[1] = *(const u32x4*)(kvrow + ((lane + 64) >> 3) * 128 + 64 + 8 * (lane & 7));
        float cs[8], sn[8];
#pragma unroll
        for (int e = 0; e < 8; ++e) { cs[e] = 1.f; sn[e] = 0.f; }
        if (lat && c16 >= 8 && act) {
#pragma unroll
            for (int e = 0; e < 8; ++e) { const f32x2v t = ropeT[pos * 16 + 8 * (c16 & 1) + e]; cs[e] = t.x; sn[e] = t.y; } }
        float x[8]; unpack8(hv, x); float ss = 0.f;
#pragma unroll
        for (int e = 0; e < 8; ++e) ss += x[e] * x[e];
        ss = half_sum(ss);
        const float r_q = rsqrtf(__shfl(ss, 0) * (1.0f / 256.0f) + EPS), r_kv = rsqrtf(__shfl(ss, 32) * (1.0f / 128.0f) + EPS);
        if (lane == 0) ((float*)(a.ws + WS_RQ))[R] = r_q;
#pragma unroll
        for (int rd = 0; rd < 3; ++rd) {
            const int hd = 4 * rd + g16;
            { float y[8], o[8]; unpack8(kv[rd], y); float s2 = 0.f; const float pre = c16 < 8 ? r_kv : 1.0f;
#pragma unroll
              for (int e = 0; e < 8; ++e) { y[e] *= pre; s2 += y[e] * y[e]; }
              s2 += __shfl_xor(s2, 8); s2 += __shfl_xor(s2, 4); s2 += __shfl_xor(s2, 2); s2 += __shfl_xor(s2, 1);
              const float sc = rsqrtf(s2 * (1.0f / 96.0f) + EPS);
#pragma unroll
              for (int e = 0; e < 8; ++e) { y[e] *= sc * kg[e]; o[e] = __shfl_xor(y[e], 2); }
              if (c16 >= 8) {
#pragma unroll
                  for (int e = 0; e < 8; ++e) y[e] = c16 < 10 ? y[e] * cs[e] - o[e] * sn[e] : o[e] * sn[e] + y[e] * cs[e]; }
              if (act) *(u32x4*)(Kout + (size_t)R * 1152 + hd * 96 + 8 * c16) = pack8f(y); }
        }
        { float y[8]; unpack8(vv[0], y);
#pragma unroll
          for (int e = 0; e < 8; ++e) y[e] *= r_kv;
          *(u32x4*)(kvrow + (lane >> 3) * 128 + 64 + 8 * (lane & 7)) = pack8f(y);
          if (lane < 32) { unpack8(vv[1], y);
#pragma unroll
              for (int e = 0; e < 8; ++e) y[e] *= r_kv;
              *(u32x4*)(kvrow + ((lane + 64) >> 3) * 128 + 64 + 8 * (lane & 7)) = pack8f(y); } }
    }
}

__device__ __forceinline__ void z_fold(const Ctx& a, LAS unsigned char* lds, int gw, int ngw, int wave, int lane) {
    const bf16_t* ZLp = (const bf16_t*)(a.ws + WS_ZL); bf16_t* ZF = (bf16_t*)(a.ws + WS_ZF);
    LAS bf16_t* zr = (LAS bf16_t*)(lds + wave * 16384);
    for (int row = gw; row < 4096; row += ngw) {
        const bf16_t* src = ZLp + (size_t)row * 8192;
#pragma unroll
        for (int i = 0; i < 16; ++i) *(LAS u32x4*)(zr + 8 * (lane + 64 * i)) = *(const u32x4*)(src + 8 * (lane + 64 * i));
        asm volatile("s_waitcnt lgkmcnt(0)" ::: "memory");
#pragma unroll
        for (int i = 0; i < 8; ++i) { const int k0 = 8 * (lane + 64 * i); float y[8];
#pragma unroll
            for (int e = 0; e < 8; ++e) { const int kap = k0 + e; float v;
                if (kap <= 2048) { v = bf2f(zr[kap]); if (kap != 0 && kap != 2048) v += bf2f(zr[4096 - kap]); }
                else { const int l = kap - 2048; v = bf2f(zr[4096 + l]) - bf2f(zr[8192 - l]); }
                y[e] = v; }
            *(u32x4*)(ZF + (size_t)row * 4096 + k0) = pack8f(y); }
        asm volatile("s_waitcnt lgkmcnt(0)" ::: "memory");
    }
}

__device__ __forceinline__ void ew_odd(const Ctx& a, int j, int gw, int ngw, int lane) {
    bf16_t* H = (bf16_t*)(a.ws + WS_H); bf16_t* PO = (bf16_t*)(a.ws + WS_POOL);
    const float QS = 0.125f * LOG2E;
    const f32x2v* ropeT = (const f32x2v*)(a.ws + WS_ROPE_O);
    const int c8 = lane & 7, hl = lane >> 3;
    float qg[8], kg[8];
#pragma unroll
    for (int e = 0; e < 8; ++e) { qg[e] = a.inp(I_WQG)[j * 64 + 8 * c8 + e]; kg[e] = a.inp(I_WKG)[j * 64 + 8 * c8 + e]; }
    for (int R = gw; R < T; R += ngw) {
        const int p = R % TB; const int pos = p - NCTX; const bool lat = pos >= 0;
        bf16_t* hrow = H + (size_t)R * 1536;
        u32x4 qk[2]; qk[1] = (u32x4){0u, 0u, 0u, 0u}; if (lane >= 32) qk[1] = *(const u32x4*)(hrow + 512 + 8 * lane);
        float cs[8], sn[8];
#pragma unroll
        for (int e = 0; e < 8; ++e) { cs[e] = 1.f; sn[e] = 0.f; }
        if (lat) {
#pragma unroll
            for (int e = 0; e < 8; ++e) { const f32x2v t = ropeT[pos * 32 + 8 * (c8 & 3) + e]; cs[e] = t.x; sn[e] = t.y; } }
        const int tpos = lat ? pos : p, Ls = lat ? SEQ : NCTX;
        { const int pc = lane & 31, g = pc >> 3, half = 1 << g;
          const int lo = tpos - half < 0 ? 0 : tpos - half, hi = tpos + half > Ls ? Ls : tpos + half;
          float sum[8];
#pragma unroll
          for (int e = 0; e < 8; ++e) sum[e] = 0.f;
          if (lane < 32) {
              for (int tt = lo; tt < hi; ++tt) { float z[8]; unpack8(*(const u32x4*)(hrow + (ptrdiff_t)(tt - tpos) * 1536 + 1280 + 8 * pc), z);
#pragma unroll
                  for (int e = 0; e < 8; ++e) sum[e] += z[e]; }
              const float rc = 1.0f / (float)(hi - lo); float z[8]; unpack8(*(const u32x4*)(hrow + 1280 + 8 * pc), z);
#pragma unroll
              for (int e = 0; e < 8; ++e) sum[e] = sum[e] * rc - z[e];
              *(u32x4*)(PO + (size_t)R * 256 + 8 * pc) = pack8f(sum); } }
        if (lane >= 32) {
            float y[8], o[8]; unpack8(qk[1], y); float s2 = 0.f;
#pragma unroll
            for (int e = 0; e < 8; ++e) s2 += y[e] * y[e];
            s2 += __shfl_xor(s2, 4); s2 += __shfl_xor(s2, 2); s2 += __shfl_xor(s2, 1);
            const float sc = rsqrtf(s2 * (1.0f / 64.0f) + EPS);
#pragma unroll
            for (int e = 0; e < 8; ++e) { y[e] *= sc * kg[e]; o[e] = __shfl_xor(y[e], 4); }
#pragma unroll
            for (int e = 0; e < 8; ++e) y[e] = c8 < 4 ? y[e] * cs[e] - o[e] * sn[e] : o[e] * sn[e] + y[e] * cs[e];
            *(u32x4*)(hrow + 512 + 8 * lane) = pack8f(y);
        }
    }
}

#define XB_TMO      128
#define XB_XCNT(j)  (256  + 64 * (j))
#define XB_XSUB(j)  (1280 + 64 * (j))
#define XB_XGEN(j)  (2304 + 64 * (j))
#define XB_TOP      3328
#define XB_TOPGEN   3392
#define XCD_BAR_WORDS 3456
#define XB_SPIN_CAP (1u << 18)
__device__ __forceinline__ unsigned xb_ld(unsigned* p)              { return __hip_atomic_load(p, __ATOMIC_RELAXED, __HIP_MEMORY_SCOPE_AGENT); }
__device__ __forceinline__ unsigned xb_add(unsigned* p, unsigned v) { return __hip_atomic_fetch_add(p, v, __ATOMIC_RELAXED, __HIP_MEMORY_SCOPE_AGENT); }
__device__ __forceinline__ unsigned xb_xcc_id() { return (unsigned)__builtin_amdgcn_s_getreg((3 << 11) | 20) & 0xFu; }
#define XB_SPIN(cond, bar) do { unsigned _sp = 0; while (cond) { __builtin_amdgcn_s_sleep(1); \
    if ((++_sp & 255u) == 0u) { if (xb_ld(&(bar)[XB_TMO])) break; if (_sp > XB_SPIN_CAP) { atomicAdd(&(bar)[XB_TMO], 1u); break; } } } } while (0)
struct XcdBarrier { unsigned* bar; unsigned x; volatile LAS unsigned* st; };
__device__ __forceinline__ XcdBarrier xcd_barrier_post(unsigned* bar, volatile LAS unsigned* st) {
    XcdBarrier b; b.bar = bar; b.x = xb_xcc_id(); b.st = st;
    int tid_ = threadIdx.x; asm volatile("" : "+v"(tid_));
    if (tid_ == 0) (void)xb_add(&bar[XB_XCNT(b.x)], 1u);
    return b;
}
__device__ __forceinline__ void xcd_barrier_complete(unsigned* bar, unsigned x, unsigned& nloc, unsigned& nx) {
    const unsigned G = gridDim.x * gridDim.y * gridDim.z;
    unsigned sum, cnt, mine, sp = 0u;
    for (;;) {
        sum = 0u; cnt = 0u; mine = 0u;
#pragma unroll
        for (unsigned j = 0; j < 16; ++j) { const unsigned c = xb_ld(&bar[XB_XCNT(j)]); sum += c; cnt += (c > 0u) ? 1u : 0u; mine = (j == x) ? c : mine; }
        if (sum == G) break;
        __builtin_amdgcn_s_sleep(1);
        if ((++sp & 255u) == 0u) { if (xb_ld(&bar[XB_TMO])) break; if (sp > XB_SPIN_CAP) { atomicAdd(&bar[XB_TMO], 1u); break; } }
    }
    nloc = mine > 0u ? mine : 1u; nx = cnt > 0u ? cnt : 1u;
}
__device__ __forceinline__ void xcd_barrier(const XcdBarrier& b) {
    asm volatile("s_waitcnt vmcnt(0)" ::: "memory");
    __syncthreads();
    int tid_ = threadIdx.x; asm volatile("" : "+v"(tid_));
    if (tid_ == 0) {
        unsigned* bar = b.bar;
        __builtin_amdgcn_s_waitcnt(0);
        unsigned nloc = b.st[0], nx = b.st[1];
        if (nloc == 0u) { xcd_barrier_complete(bar, b.x, nloc, nx); b.st[0] = nloc; b.st[1] = nx; }
        const unsigned old = xb_add(&bar[XB_XSUB(b.x)], 1u);
        const unsigned gen = old / nloc;
        if (old + 1u == (gen + 1u) * nloc) {
            __builtin_amdgcn_fence(__ATOMIC_RELEASE, "agent");
            asm volatile("s_waitcnt vmcnt(0)" ::: "memory");
            const unsigned og = xb_add(&bar[XB_TOP], 1u);
            const unsigned tg = og / nx;
            if (og + 1u == (tg + 1u) * nx) xb_add(&bar[XB_TOPGEN], 1u);
            else XB_SPIN(xb_ld(&bar[XB_TOPGEN]) == tg, bar);
            __builtin_amdgcn_fence(__ATOMIC_ACQUIRE, "agent");
            xb_add(&bar[XB_XGEN(b.x)], 1u);
            asm volatile("s_waitcnt vmcnt(0)" ::: "memory");
        } else {
            XB_SPIN(xb_ld(&bar[XB_XGEN(b.x)]) == gen, bar);
            __builtin_amdgcn_fence(__ATOMIC_ACQUIRE, "agent");
            asm volatile("s_waitcnt vmcnt(0)" ::: "memory");
        }
    }
    __syncthreads();
}

constexpr int LDS_BYTES = 147456;
constexpr int NPHASES = 1 + 2 * 9 + 2 * 8;

__global__ void __launch_bounds__(512, 2) mega_fwd(Args ka) {
    extern __shared__ __attribute__((aligned(16))) unsigned char lds_raw[];
    LAS unsigned char* lds = (LAS unsigned char*)lds_raw;
    cg::grid_group grid = cg::this_grid();
    volatile LAS unsigned* xbst = (volatile LAS unsigned*)(lds + 139264);
    { int tid_ = threadIdx.x; asm volatile("" : "+v"(tid_)); if (tid_ < 2) xbst[tid_] = 0u; }
    __syncthreads();
    XcdBarrier xbar; xbar.bar = (unsigned*)ka.ws; xbar.x = 0; xbar.st = xbst;
    if (ka.hi - ka.lo > 1) xbar = xcd_barrier_post((unsigned*)ka.ws, xbst);
#define U ((bf16_t*)(wsl + WS_U))
#define MIX ((bf16_t*)(wsl + WS_MIX))
#define Hb ((bf16_t*)(wsl + WS_H))
#define Qb ((bf16_t*)(wsl + WS_Q))
#define KVb ((bf16_t*)(wsl + WS_KV))
#define ZL ((bf16_t*)(wsl + WS_ZL))
#define ZC ((bf16_t*)(wsl + WS_ZC))
#define HID ((bf16_t*)(wsl + WS_HID))
#define POOL ((bf16_t*)(wsl + WS_POOL))
#define DFTL ((bf16_t*)(wsl + WS_DFTL))
#define DFTC ((bf16_t*)(wsl + WS_DFTC))
#define hctx ((float*)(wsl + WS_HCTX))
    int ph = 0, layer_ = 0;
#define PHASE_BEGIN if (ph >= ka.lo && ph < ka.hi) { GAS unsigned char* wsg_ = (GAS unsigned char*)ka.ws; asm volatile("" : "+s"(wsg_)); unsigned char* wsl = (unsigned char*)wsg_; \
        const __attribute__((address_space(4))) cfp_t* ain_ = (const __attribute__((address_space(4))) cfp_t*)__builtin_amdgcn_kernarg_segment_ptr(); asm volatile("" : "+s"(ain_)); \
        const Ctx a{ain_, ka.out, wsl}; \
        int lyr_ = layer_; asm volatile("" : "+s"(lyr_)); const float* mods_l = (const float*)(wsl + WS_MODS) + (size_t)lyr_ * 17 * 6144; const float* xin = lyr_ == 0 ? a.inp(I_X) : a.out; const float* cin = lyr_ == 0 ? a.inp(I_CTX) : (const float*)(wsl + WS_HCTX); (void)mods_l; (void)xin; (void)cin; int tid = threadIdx.x; asm volatile("" : "+v"(tid)); int G = gridDim.x, bx = blockIdx.x; asm volatile("" : "+s"(G), "+s"(bx)); \
        const int vcu = (G % 8 == 0) ? (bx % 8) * (G / 8) + bx / 8 : bx, ngw = G * 8, ngt = G * 512; (void)vcu; (void)ngw; (void)ngt; \
        const int lane = tid & 63, wave = __builtin_amdgcn_readfirstlane(tid >> 6), gw = bx * 8 + wave, gtid = bx * 512 + tid; LAS float* scr = (LAS float*)(lds + wave * 8448); \
        (void)lane; (void)gw; (void)gtid; (void)scr;
#define PHASE_END } if (ph >= ka.lo && ph + 1 < ka.hi) { for (int sr_ = 0; sr_ < REP_SYNC; ++sr_) { if (ph == 0) grid.sync(); else xcd_barrier(xbar); } } ++ph;

    PHASE_BEGIN
#ifndef SKIP_P0
        { REPLOOP(REP_P0) {
        for (int it = bx; it < 192; it += G) mods_item(a, it, (LAS float*)lds);
        for (int j = 0; j < 2; ++j) {
            tr_job(a.inp(I_MLAWIN) + (size_t)j * DM * 672, DM, 672, (bf16_t*)(wsl + WS_WINE) + (size_t)j * 768 * DM, 768, 1, nullptr, scr, gw, ngw, lane);
            tr_job(a.inp(I_WUQ) + (size_t)j * 256 * 1152, 256, 1152, (bf16_t*)(wsl + WS_WUQ) + (size_t)j * 1536 * 256, 1536, 2, a.inp(I_CQG) + j * 256, scr, gw, ngw, lane);
            tr_job(a.inp(I_WUKV) + (size_t)j * 128 * 1536, 128, 1536, (bf16_t*)(wsl + WS_WUKV) + (size_t)j * 1536 * 128, 1536, 0, a.inp(I_CKVG) + j * 128, scr, gw, ngw, lane);
            tr_job(a.inp(I_EWOUT) + (size_t)j * DM * DM, DM, DM, (bf16_t*)(wsl + WS_WOUTE) + (size_t)j * DM * DM, DM, 0, nullptr, scr, gw, ngw, lane);
            tr_job(a.inp(I_WINWIN) + (size_t)j * DM * 1536, DM, 1536, (bf16_t*)(wsl + WS_WINO) + (size_t)j * 1536 * DM, 1536, 0, nullptr, scr, gw, ngw, lane);
            tr_job(a.inp(I_OWOUT) + (size_t)j * DM * DM, DM, DM, (bf16_t*)(wsl + WS_WOUTO) + (size_t)j * DM * DM, DM, 0, nullptr, scr, gw, ngw, lane);
        }
        ffn_weights(a, 0, scr, gw, ngw, lane);
        __syncthreads();
        LAS float* ctab = (LAS float*)lds;
        for (int m = tid; m < 4096; m += 512) ctab[m] = cospif((float)m * (1.0f / 2048.0f)) * (1.0f / 64.0f);
        __syncthreads();
        for (int idx = gtid; idx < 4096 * 512; idx += ngt) { const int k = idx >> 9, col0 = (idx & 511) * 8; float v[8];
#pragma unroll
            for (int e = 0; e < 8; ++e) { const int kap = col0 + e; const int m = kap <= 2048 ? (k * kap) & 4095 : (k * (kap - 2048) + 1024) & 4095; v[e] = ctab[m]; }
            u32x4 o; o.x = cvt_pk_bf16(v[0], v[1]); o.y = cvt_pk_bf16(v[2], v[3]); o.z = cvt_pk_bf16(v[4], v[5]); o.w = cvt_pk_bf16(v[6], v[7]);
            *(u32x4*)(DFTL + (size_t)k * 4096 + col0) = o; }
        for (int idx = gtid; idx < 256 * 64; idx += ngt) { const int k = idx >> 6, col0 = (idx & 63) * 8, cs = col0 >> 8, l0 = col0 & 255; float v[8];
#pragma unroll
            for (int e = 0; e < 8; ++e) { const int m = (k * (l0 + e)) & 255; const float x = (float)m * (1.0f / 128.0f); v[e] = (cs ? -sinpif(x) : cospif(x)) * (1.0f / 16.0f); }
            u32x4 o; o.x = cvt_pk_bf16(v[0], v[1]); o.y = cvt_pk_bf16(v[2], v[3]); o.z = cvt_pk_bf16(v[4], v[5]); o.w = cvt_pk_bf16(v[6], v[7]);
            *(u32x4*)(DFTC + (size_t)k * 512 + col0) = o; }
        for (int idx = gtid; idx < 2 * 512 * 256; idx += ngt) { const int j = idx >> 17, n = (idx >> 8) & 511, k = idx & 255; const int cs = n >> 8, g = (n >> 6) & 3, d = n & 63, g2 = k >> 6, c = k & 63;
            float s = 0.f;
            if (g2 == g) { const float* wf = a.inp(I_FNETW) + ((size_t)(j * 4 + g) * 64) * 64 + d;
                for (int c2 = 0; c2 < 64; ++c2) { const int m = (c * c2) & 63; s += (cs ? -ctab[(m * 64 + 1024) & 4095] : ctab[m * 64]) * wf[c2 * 64]; }
                s *= 8.0f; }
            ((bf16_t*)(wsl + WS_WF))[idx] = (bf16_t)(cvt_pk_bf16(s, 0.f) & 0xffffu); }
        for (int idx = gtid; idx < 4096 * 16; idx += ngt) { float cs, sn; rope_cs<8>(idx >> 4, idx & 15, cs, sn); ((f32x2v*)(wsl + WS_ROPE_E))[idx] = (f32x2v){cs, sn}; }
        for (int idx = gtid; idx < 4096 * 32; idx += ngt) { float cs, sn; rope_cs<16>(idx >> 5, idx & 31, cs, sn); ((f32x2v*)(wsl + WS_ROPE_O))[idx] = (f32x2v){cs, sn}; }
        for (int idx = gtid; idx < 2 * 256 * 256; idx += ngt) { const int j = idx >> 16, n = (idx >> 8) & 255, k = idx & 255; const int g = n >> 6, d = n & 63, g2 = k >> 6, c = k & 63;
            float s = 0.f; if (g2 == g) s = a.inp(I_POOLW)[((size_t)(j * 4 + g) * 64 + c) * 64 + d] * a.inp(I_POOLS)[j * 256 + n];
            ((bf16_t*)(wsl + WS_WP))[idx] = (bf16_t)(cvt_pk_bf16(s, 0.f) & 0xffffu); }
        __syncthreads(); } }
#endif
    PHASE_END

    for (int layer = 0; layer < 4; ++layer) {
        const int j = layer >> 1; const bool even = !(layer & 1); const bool ctx_out = layer < 3;
        layer_ = layer;

        PHASE_BEGIN
#ifndef SKIP_NORM
            { REPLOOP(REP_NORM)
            norm_pass(xin, cin, a.inp(I_N1G) + layer * DM, mods_l, 0, 1, U, false, false, gw, ngw, lane); }
#endif
        PHASE_END

        PHASE_BEGIN
#ifndef SKIP_GIN
            { REPLOOP(REP_GIN) {
            if (even) { pg8::Gemm g{U, (const bf16_t*)(wsl + WS_WINE) + (size_t)j * 768 * DM, DM, DM, DM};
                pg8::Order<pg8::MapStd> S; S.init(T / 256, 3, G, bx, pg8::MapStd{0}); pg8::EpiBf16 E{Hb, 768, Hb, 768}; pg8::gemm_phase(lds, g, S, E); }
            else { pg8::Gemm g{U, (const bf16_t*)(wsl + WS_WINO) + (size_t)j * 1536 * DM, DM, DM, DM};
                pg8::Order<pg8::MapStd> S; S.init(T / 256, 6, G, bx, pg8::MapStd{0}); pg8::EpiBf16 E{Hb, 1536, Hb, 1536}; pg8::gemm_phase(lds, g, S, E); }
            } }
#endif
        PHASE_END

        if (even) {
            PHASE_BEGIN
#ifndef SKIP_G3
                { REPLOOP(REP_G3) {
                { pg8::Gemm g{Hb, (const bf16_t*)(wsl + WS_WUQ) + (size_t)j * 1536 * 256, 768, 256, 256};
                  pg8::Order<pg8::MapStd> S; S.init(T / 256, 6, G, bx, pg8::MapStd{0}); pg8::EpiBf16 E{Qb, 1536, Qb, 1536}; pg8::gemm_phase(lds, g, S, E); }
                { pg8::Gemm g{Hb + 256, (const bf16_t*)(wsl + WS_WUKV) + (size_t)j * 1536 * 128, 768, 128, 128};
                  pg8::Order<pg8::MapStd> S; S.init(T / 256, 6, G, bx, pg8::MapStd{0}); pg8::EpiBf16 E{KVb, 1536, KVb, 1536}; pg8::gemm_phase(lds, g, S, E); }
                { pg8::Gemm g{(const bf16_t*)(wsl + WS_WF) + (size_t)j * 512 * 256, Hb + 416, 256, 768, 256};
                  pg8::Order<pg8::MapZ> S; S.init(2, T / 256, G, bx, pg8::MapZ{}); pg8::EpiBf16 E{ZL, 8192, ZC, 512}; pg8::gemm_phase(lds, g, S, E); }
                } }
#endif
            PHASE_END
            PHASE_BEGIN
#ifndef SKIP_EWE
                ew_even(a, j, gw, ngw, lane);
                z_fold(a, lds, gw, ngw, wave, lane);
#endif
            PHASE_END
            PHASE_BEGIN
#ifndef SKIP_ATTE
                const bf16_t* Kb = (const bf16_t*)(wsl + WS_U);
                const int nu = 3072 + (ctx_out ? 192 : 0);
                { REPLOOP(REP_ATTE)
                for (int uid = vcu; uid < nu; uid += G) {
                    if (uid < 3072) { const int bh = uid >> 4, qb = uid & 15, b = bh / 12, h = bh % 12; const size_t base = (size_t)b * TB, qrow = base + NCTX + qb * 256;
                        attn_unit<96, false>(lds, Qb + qrow * 1536 + h * 128, 1536, Kb + base * 1152 + h * 96, 1152, KVb + base * 1536 + h * 128 + 64, 1536, MIX + qrow * DM + h * 64, 68, 0, 0, qb * 256, -1e30f, false, a.inp(I_QG) + j * 96, (const f32x2v*)(wsl + WS_ROPE_E), true, (const float*)(wsl + WS_RQ) + qrow); }
                    else { const int bh = uid - 3072, b = bh / 12, h = bh % 12; const size_t base = (size_t)b * TB;
                        attn_unit<96, false>(lds, Qb + base * 1536 + h * 128, 1536, Kb + base * 1152 + h * 96, 1152, KVb + base * 1536 + h * 128 + 64, 1536, MIX + base * DM + h * 64, 4, 0, 0, 0, -1e30f, false, a.inp(I_QG) + j * 96, (const f32x2v*)(wsl + WS_ROPE_E), false, (const float*)(wsl + WS_RQ) + base); }
                } }
#ifndef SKIP_ATTE_G
                { REPLOOP(REP_FNET) {
                { pg8::Gemm g{DFTL, (const bf16_t*)(wsl + WS_ZF), 4096, 4096, 4096};
                  pg8::Order<pg8::MapFnetL> S; S.init(256, 1, G, bx, pg8::MapFnetL{}); pg8::EpiBf16 E{MIX, DM, MIX, DM}; pg8::gemm_phase(lds, g, S, E); }
                if (ctx_out) { pg8::Gemm g{DFTC, ZC, 512, 512, 512};
                  pg8::Order<pg8::MapFnetC> S; S.init(16, 1, G, bx, pg8::MapFnetC{}); pg8::EpiBf16 E{MIX, DM, MIX, DM}; pg8::gemm_phase(lds, g, S, E); }
                } }
#endif
#endif
            PHASE_END
        } else {
            PHASE_BEGIN
#ifndef SKIP_EWO
                ew_odd(a, j, gw, ngw, lane);
#endif
            PHASE_END
            PHASE_BEGIN
#ifndef SKIP_ATTO
                const float* sink = a.inp(I_SINK) + j * 12;
                const int nu = 3072 + (ctx_out ? 192 : 0);
                { REPLOOP(REP_ATTO)
                for (int uid = vcu; uid < nu; uid += G) {
                    if (uid < 3072) { const int bh = uid >> 4, qb = uid & 15, b = bh / 12, h = bh % 12, kvh = h / 3; const size_t base = (size_t)b * TB, qrow = base + NCTX + qb * 256;
                        int lt0 = qb * 4 - 2, lt1 = qb * 4 + 6; if (lt0 < 0) lt0 = 0; if (lt1 > 64) lt1 = 64;
                        attn_unit<64, true>(lds, Hb + qrow * 1536 + h * 64, 1536, Hb + base * 1536 + 768 + kvh * 64, 1536, Hb + base * 1536 + 1024 + kvh * 64, 1536, MIX + qrow * DM + h * 64,
                                            4, 4 + lt0, 4 + lt1, qb * 256, sink[h] * LOG2E, true, a.inp(I_WQG) + j * 64, (const f32x2v*)(wsl + WS_ROPE_O), true); }
                    else { const int bh = uid - 3072, b = bh / 12, h = bh % 12, kvh = h / 3; const size_t base = (size_t)b * TB;
                        attn_unit<64, true>(lds, Hb + base * 1536 + h * 64, 1536, Hb + base * 1536 + 768 + kvh * 64, 1536, Hb + base * 1536 + 1024 + kvh * 64, 1536, MIX + base * DM + h * 64,
                                            4, 0, 0, 0, sink[h] * LOG2E, true, a.inp(I_WQG) + j * 64, (const f32x2v*)(wsl + WS_ROPE_O), false); }
                } }
                { pg8::Gemm g{POOL, (const bf16_t*)(wsl + WS_WP) + (size_t)j * 256 * 256, 256, 256, 256};
                  pg8::Order<pg8::MapStd> S; S.init(T / 256, 1, G, bx, pg8::MapStd{768}); pg8::EpiBf16 E{MIX, DM, MIX, DM}; pg8::gemm_phase(lds, g, S, E); }
#endif
            PHASE_END
        }

        PHASE_BEGIN
#ifndef SKIP_WOUT
            pg8::Gemm g{MIX, (const bf16_t*)(wsl + (even ? WS_WOUTE : WS_WOUTO)) + (size_t)j * DM * DM, DM, DM, DM};
            pg8::Order<pg8::MapRes> S; S.init(ctx_out ? 272 : 256, 4, G, bx, pg8::MapRes{ctx_out ? 1 : 0});
            { REPLOOP(REP_WOUT) { pg8::EpiRes E{rep_ ? (const float*)a.out : xin, a.out, rep_ ? (const float*)hctx : cin, hctx, mods_l, 2, rep_ ? 0.f : 1.f}; pg8::gemm_phase(lds, g, S, E); } }
#endif
        PHASE_END

        PHASE_BEGIN
#ifndef SKIP_NORM2
            { REPLOOP(REP_NORM)
            norm_pass(a.out, hctx, a.inp(I_N2G) + layer * DM, mods_l, 3, 4, U, true, !ctx_out, gw, ngw, lane); }
#endif
        PHASE_END

        PHASE_BEGIN
#ifndef SKIP_UP
            pg8::Gemm g{U, (const bf16_t*)(wsl + WS_WUP), DM, DM, DM};
            pg8::Order<pg8::MapUp> S; S.init(ctx_out ? 275 : 259, 22, G, bx, pg8::MapUp{ctx_out ? 1 : 0});
            pg8::EpiUp E{HID, a.inp(I_CONVW) + (size_t)layer * 3 * 2 * DFF, a.inp(I_CONVB) + (size_t)layer * 2 * DFF}; { REPLOOP(REP_UP) pg8::gemm_phase(lds, g, S, E); }
#endif
        PHASE_END

        PHASE_BEGIN
#ifndef SKIP_DN
            pg8::Gemm g{HID, (const bf16_t*)(wsl + ((layer & 1) ? WS_WDN2 : WS_WDN)), DFF, DFF, DFF};
            pg8::Order<pg8::MapRes> S; S.init(ctx_out ? 272 : 256, 4, G, bx, pg8::MapRes{ctx_out ? 1 : 0});
            { REPLOOP(REP_DN) { pg8::EpiRes E{a.out, a.out, hctx, hctx, mods_l, 5, rep_ ? 0.f : 1.f}; pg8::gemm_phase(lds, g, S, E); } }
            if (layer < 3) {
                const int nfree = (ctx_out && G == 256) ? 192 : G, first = (ctx_out && G == 256) ? 64 : 0;
                if (bx >= first) ffn_weights(a, layer + 1, scr, (bx - first) * 8 + wave, nfree * 8, lane);
            }
#endif
        PHASE_END
    }
#undef PHASE_BEGIN
#undef PHASE_END
#undef U
#undef MIX
#undef Hb
#undef Qb
#undef KVb
#undef ZL
#undef ZC
#undef HID
#undef POOL
#undef DFTL
#undef DFTC
#undef hctx
}

extern "C" void kernel_launch(void* const* d_in, const int* in_sizes, int n_in, void* d_out, int out_size, void* d_ws, size_t ws_size, hipStream_t stream) {
    static int grid = 0;
    if (grid == 0) {
        if (n_in != 28 || out_size != NB * SEQ * DM || ws_size < WS_END) { fprintf(stderr, "kernel_launch: unexpected shapes (n_in %d, out %d, ws %zu); nothing launched\n", n_in, out_size, ws_size); grid = -1; return; }
        int dev = 0, cus = 0, per_cu = 0;
        if (hipGetDevice(&dev) != hipSuccess || hipDeviceGetAttribute(&cus, hipDeviceAttributeMultiprocessorCount, dev) != hipSuccess) { grid = -1; return; }
        if (hipFuncSetAttribute((const void*)mega_fwd, hipFuncAttributeMaxDynamicSharedMemorySize, LDS_BYTES) != hipSuccess) { fprintf(stderr, "kernel_launch: hipFuncSetAttribute failed\n"); grid = -1; return; }
        if (hipOccupancyMaxActiveBlocksPerMultiprocessor(&per_cu, (const void*)mega_fwd, 512, LDS_BYTES) != hipSuccess || per_cu < 1) { fprintf(stderr, "kernel_launch: occupancy query says %d\n", per_cu); per_cu = 1; }
        (void)hipGetLastError();
        grid = cus * 1;
    }
    if (grid < 0) return;
    Args a{};
    for (int i = 0; i < 28; ++i) a.in[i] = (const float*)d_in[i];
    a.out = (float*)d_out; a.ws = (unsigned char*)d_ws; a.lo = 0; a.hi = NPHASES;
    (void)hipMemsetAsync(d_ws, 0, 16384, stream);
    void* args[] = {&a};
    hipError_t e = hipLaunchCooperativeKernel((const void*)mega_fwd, dim3(grid), dim3(512), args, LDS_BYTES, stream);
    if (e != hipSuccess) {
        fprintf(stderr, "kernel_launch: cooperative launch failed: %s (grid %d); falling back to one launch per phase\n", hipGetErrorString(e), grid);
        (void)hipGetLastError();
        for (int p = 0; p < NPHASES; ++p) { a.lo = p; a.hi = p + 1; hipLaunchKernelGGL(mega_fwd, dim3(grid), dim3(512), LDS_BYTES, stream, a); }
    }
}
```

```cpp
#include <hip/hip_runtime.h>
#include <hip/hip_cooperative_groups.h>
#include <cstdio>
#include <cstdint>
namespace cg = cooperative_groups;

#define REP_NORM 1
#define REP_GIN 1
#define REP_G3 1
#define REP_ATTE 1
#define REP_FNET 1
#define REP_ATTO 1
#define REP_WOUT 1
#define REP_UP 1
#define REP_DN 1
#define REP_P0 1
#define REP_EW 1
#define REP_SYNC 1
#define PROBE_MODE 0
#define REPLOOP(N) int nrep_ = (N); asm volatile("" : "+s"(nrep_)); for (int rep_ = 0; rep_ < nrep_; ++rep_)

constexpr int NB = 16, SEQ = 4096, NCTX = 256, DM = 1024, TB = SEQ + NCTX, T = NB * TB;
constexpr int DFF = 2816, U2B = 4608, TAILROW0 = 16 * 4608, TAILSEG = 34;
constexpr float EPS = 1e-6f;
constexpr float LOG2E = 1.4426950408889634f;

constexpr size_t MiB = 1u << 20;
constexpr size_t WS_MODS = 1 * MiB;
constexpr size_t WS_RQ = 2 * MiB + 720 * 1024;
constexpr size_t WS_WINE = 3 * MiB;
constexpr size_t WS_WUQ = 6 * MiB;
constexpr size_t WS_WUKV = WS_WUQ + 3 * MiB / 2;
constexpr size_t WS_WF = WS_WUKV + 3 * MiB / 4;
constexpr size_t WS_WP = WS_WF + MiB / 2;
constexpr size_t WS_WOUTE = 9 * MiB;
constexpr size_t WS_WOUTO = 13 * MiB;
constexpr size_t WS_WINO = 17 * MiB;
constexpr size_t WS_WUP = 23 * MiB;
constexpr size_t WS_WDN = 34 * MiB;
constexpr size_t WS_DFTC = 40 * MiB;
constexpr size_t WS_DFTL = 41 * MiB;
constexpr size_t WS_ZF = 73 * MiB;
constexpr size_t WS_HCTX = 105 * MiB;
constexpr size_t WS_U = 121 * MiB;
constexpr size_t WS_MIX = 275 * MiB;
constexpr size_t WS_ARENA = 411 * MiB;
constexpr size_t WS_H = WS_ARENA;
constexpr size_t WS_Q = WS_ARENA + 102 * MiB;
constexpr size_t WS_KV = WS_Q + 204 * MiB;
constexpr size_t WS_ZL = WS_KV + 204 * MiB;
constexpr size_t WS_ZC = WS_ZL + 64 * MiB;
constexpr size_t WS_POOL = WS_ARENA + 204 * MiB;
constexpr size_t WS_HID = WS_ARENA;
constexpr size_t WS_ROPE_E = WS_ZC + 4 * MiB;
constexpr size_t WS_ROPE_O = WS_ROPE_E + 1 * MiB;
constexpr size_t WS_WDN2 = WS_ROPE_O + 1 * MiB;
constexpr size_t WS_END = WS_WDN2 + 6 * MiB;
static_assert(WS_END <= 1024 * MiB, "ws map");

#define LAS __attribute__((address_space(3)))
#define GAS __attribute__((address_space(1)))
typedef unsigned short bf16_t;
typedef short bf16x8 __attribute__((ext_vector_type(8)));
typedef float f32x4 __attribute__((ext_vector_type(4)));
typedef float f32x16 __attribute__((ext_vector_type(16)));
typedef unsigned u32x4 __attribute__((ext_vector_type(4)));
typedef unsigned u32x2 __attribute__((ext_vector_type(2)));
typedef float f32x2v __attribute__((ext_vector_type(2)));

__device__ __forceinline__ unsigned cvt_pk_bf16(float lo, float hi) { unsigned r; asm volatile("v_cvt_pk_bf16_f32 %0, %1, %2" : "=v"(r) : "v"(lo), "v"(hi)); return r; }
__device__ __forceinline__ float bflo(unsigned u) { return __uint_as_float(u << 16); }
__device__ __forceinline__ float bfhi(unsigned u) { return __uint_as_float(u & 0xffff0000u); }
__device__ __forceinline__ float bf2f(bf16_t b) { return __uint_as_float((unsigned)b << 16); }
__device__ __forceinline__ float wave_sum(float v) {
#pragma unroll
    for (int o = 1; o < 64; o <<= 1) v += __shfl_xor(v, o);
    return v;
}
__device__ __forceinline__ float half_sum(float v) {
#pragma unroll
    for (int o = 1; o < 32; o <<= 1) v += __shfl_xor(v, o);
    return v;
}

namespace pg8 {
constexpr int BM = 256, BK = 64, HALF = 128, HTB = HALF * BK * 2, STAGE_BYTES = 8 * HTB, NXCD = 8, WGM = 8;
__device__ __forceinline__ int lds_byte(int r, int c) { const int st = (r >> 4) * 2 + (c >> 5), rr = r & 15, cc = c & 31, ob = rr * 64 + cc * 2; return st * 1024 + (ob ^ (((ob >> 9) & 1) << 5)); }
__device__ __forceinline__ void stage_rc(int b, int& R, int& C) { const int st = b / 1024, sb = b % 1024, swz = sb ^ (((sb >> 9) & 1) << 5); R = (st >> 1) * 16 + swz / 64; C = (st & 1) * 32 + (swz % 64) / 2; }
__device__ __forceinline__ int perm32(int rho) { const int n = rho >> 4, i = rho & 15; return 8 * (i >> 2) + 4 * n + (i & 3); }

struct Unit { int pm, pn, arow, brow, orow, ocol, aux, bt; };
struct Gemm { const bf16_t* A; const bf16_t* Bt; int lda, ldb, K; };

template <class Map> struct Order {
    int nM, nN, nwg, G, c; Map map;
    __device__ __forceinline__ void init(int nM_, int nN_, int G_, int c_, const Map& m) { nM = nM_; nN = nN_; nwg = nM * nN; G = G_; c = c_; map = m; }
    __device__ __forceinline__ bool next(int i, Unit& u) const {
        const long L = (long)i * G + c; if (L >= nwg) return false;
        int wgid = (int)L; { const int q = nwg / NXCD, r = nwg % NXCD, xcd = wgid % NXCD, off = wgid / NXCD; wgid = (xcd < r ? xcd * (q + 1) : r * (q + 1) + (xcd - r) * q) + off; }
        const int nig = WGM * nN, gid = wgid / nig, fm = gid * WGM, gsz = (nM - fm) < WGM ? (nM - fm) : WGM;
        u.pm = fm + ((wgid % nig) % gsz); u.pn = (wgid % nig) / gsz; map(u); return true;
    }
};

struct EpiBf16 {
    static constexpr bool PERM = true;
    bf16_t* O0; int ld0; bf16_t* O1; int ld1;
    __device__ __forceinline__ void operator()(const f32x4 (&acc)[2][2][4][2], const Unit& u, int wr, int wc, int fr, int fq, LAS unsigned char*) const {
        bf16_t* base = u.aux ? O1 : O0; const int ldc = u.aux ? ld1 : ld0;
        const int row0 = u.orow + wr * 64 + fr, col0 = u.ocol + wc * 32 + 8 * fq;
#pragma unroll
        for (int ai = 0; ai < 2; ++ai)
#pragma unroll
            for (int m = 0; m < 4; ++m) { bf16_t* rowp = base + (size_t)(row0 + ai * HALF + m * 16) * ldc + col0;
#pragma unroll
                for (int bj = 0; bj < 2; ++bj) { const f32x4 v0 = acc[ai][bj][m][0], v1 = acc[ai][bj][m][1];
                    u32x4 w; w.x = cvt_pk_bf16(v0[0], v0[1]); w.y = cvt_pk_bf16(v0[2], v0[3]); w.z = cvt_pk_bf16(v1[0], v1[1]); w.w = cvt_pk_bf16(v1[2], v1[3]);
                    *(u32x4*)(rowp + bj * HALF) = w; } }
    }
};

struct EpiRes {
    static constexpr bool PERM = false;
    const float* xin; float* xout; const float* cin; float* cout; const float* mods_l; int gidx; float gs;
    __device__ __forceinline__ void operator()(const f32x4 (&acc)[2][2][4][2], const Unit& u, int wr, int wc, int fr, int fq, LAS unsigned char*) const {
        const float* src = u.aux ? cin : xin; float* dst = u.aux ? cout : xout;
        const float* gate = mods_l + (size_t)(u.aux ? 16 : u.bt) * 6144 + gidx * 1024;
        const int row0 = u.orow + wr * 64 + fr, col0 = u.ocol + wc * 32 + 4 * fq;
        const __amdgpu_buffer_rsrc_t rs = __builtin_amdgcn_make_buffer_rsrc((void*)dst, 0, 0x40000000, 0x00020000);
#pragma unroll
        for (int bj = 0; bj < 2; ++bj) {
            f32x4 g4[2], xv[2][2][4];
#pragma unroll
            for (int n = 0; n < 2; ++n) { const int col = col0 + bj * HALF + n * 16; g4[n] = *(const f32x4*)(gate + col) * gs;
#pragma unroll
                for (int ai = 0; ai < 2; ++ai)
#pragma unroll
                    for (int m = 0; m < 4; ++m) xv[n][ai][m] = *(const f32x4*)(src + (size_t)(row0 + ai * HALF + m * 16) * DM + col); }
            asm volatile("" ::: "memory");
#pragma unroll
            for (int n = 0; n < 2; ++n) { const int col = col0 + bj * HALF + n * 16;
#pragma unroll
                for (int ai = 0; ai < 2; ++ai)
#pragma unroll
                    for (int m = 0; m < 4; ++m) { const size_t off = (size_t)(row0 + ai * HALF + m * 16) * DM + col;
                        __builtin_amdgcn_raw_buffer_store_b128(__builtin_bit_cast(u32x4, xv[n][ai][m] + g4[n] * acc[ai][bj][m][n]), rs, (unsigned)(off * 4), 0, 16); } }
            asm volatile("" ::: "memory");
        }
    }
};

__device__ __forceinline__ float dpp_ror1(float v) { return __int_as_float(__builtin_amdgcn_update_dpp(__float_as_int(v), __float_as_int(v), 0x121, 0xf, 0xf, false)); }
__device__ __forceinline__ float dpp_ror15(float v) { return __int_as_float(__builtin_amdgcn_update_dpp(__float_as_int(v), __float_as_int(v), 0x12F, 0xf, 0xf, false)); }
__device__ __forceinline__ float silu_f(float x) { return x * __builtin_amdgcn_rcpf(1.0f + __expf(-x)); }

struct EpiUp {
    static constexpr bool PERM = false;
    bf16_t* Hd; const float* cw; const float* cb;
    __device__ __forceinline__ void operator()(const f32x4 (&acc)[2][2][4][2], const Unit& u, int wr, int wc, int fr, int fq, LAS unsigned char* lds) const {
        LAS float* hal = (LAS float*)(lds + STAGE_BYTES);
        LAS float* cwl = (LAS float*)(lds + 140288);
        const int tid_ = (wr * 4 + wc) * 64 + fq * 16 + fr;
        float cwv[2];
#pragma unroll
        for (int q = 0; q < 2; ++q) { const int e = tid_ + 512 * q, t = e >> 8, bj = (e >> 7) & 1, c = e & 127; cwv[q] = t < 3 ? cw[t * (2 * DFF) + bj * DFF + u.ocol + c] : cb[bj * DFF + u.ocol + c]; }
        if (fr == 0) {
#pragma unroll
            for (int ai = 0; ai < 2; ++ai)
#pragma unroll
                for (int bj = 0; bj < 2; ++bj)
#pragma unroll
                    for (int n = 0; n < 2; ++n) *(LAS f32x4*)(hal + ((2 * ai + wr) * 2 + 0) * 256 + bj * 128 + wc * 32 + n * 16 + 4 * fq) = acc[ai][bj][0][n];
        }
        if (fr == 15) {
#pragma unroll
            for (int ai = 0; ai < 2; ++ai)
#pragma unroll
                for (int bj = 0; bj < 2; ++bj)
#pragma unroll
                    for (int n = 0; n < 2; ++n) *(LAS f32x4*)(hal + ((2 * ai + wr) * 2 + 1) * 256 + bj * 128 + wc * 32 + n * 16 + 4 * fq) = acc[ai][bj][3][n];
        }
        cwl[tid_] = cwv[0]; cwl[tid_ + 512] = cwv[1];
        asm volatile("s_waitcnt lgkmcnt(0)" ::: "memory"); __builtin_amdgcn_s_barrier(); asm volatile("" ::: "memory");
        int fr_ = fr, fq_ = fq; asm volatile("" : "+v"(fr_), "+v"(fq_));
        const int rmin = u.aux == 1 ? 0 : 1, rmax = u.bt;
        const f32x4 zero4 = {0.f, 0.f, 0.f, 0.f};
#pragma unroll
        for (int ai = 0; ai < 2; ++ai) {
            const int g = 2 * ai + wr;
#pragma unroll
            for (int n = 0; n < 2; ++n) {
                const int chb = u.ocol + wc * 32 + n * 16 + 4 * fq_;
                const int colh = wc * 32 + n * 16 + 4 * fq_;
                f32x4 w0[2], w1[2], w2[2], bb[2], uh[2], dh[2];
#pragma unroll
                for (int bj = 0; bj < 2; ++bj) { const int cl = bj * 128 + colh;
                    w0[bj] = *(const LAS f32x4*)(cwl + 0 * 256 + cl); w1[bj] = *(const LAS f32x4*)(cwl + 1 * 256 + cl); w2[bj] = *(const LAS f32x4*)(cwl + 2 * 256 + cl); bb[bj] = *(const LAS f32x4*)(cwl + 3 * 256 + cl);
                    uh[bj] = zero4; dh[bj] = zero4;
                    if (g > 0) uh[bj] = *(LAS f32x4*)(hal + ((g - 1) * 2 + 1) * 256 + bj * 128 + colh);
                    if (g < 3) dh[bj] = *(LAS f32x4*)(hal + ((g + 1) * 2 + 0) * 256 + bj * 128 + colh); }
#pragma unroll
                for (int m = 0; m < 4; ++m) {
                    f32x4 res[2];
#pragma unroll
                    for (int bj = 0; bj < 2; ++bj) {
                        const f32x4 cur = acc[ai][bj][m][n];
                        const f32x4 prv = m > 0 ? acc[ai][bj][m > 0 ? m - 1 : 0][n] : uh[bj];
                        const f32x4 nxt = m < 3 ? acc[ai][bj][m < 3 ? m + 1 : 3][n] : dh[bj];
                        f32x4 su, sd;
#pragma unroll
                        for (int j = 0; j < 4; ++j) { su[j] = fr_ == 15 ? prv[j] : cur[j]; sd[j] = fr_ == 0 ? nxt[j] : cur[j]; }
                        f32x4 rr = w1[bj] * cur + bb[bj];
                        asm volatile("s_nop 1\n\t"
                                     "v_fmac_f32_dpp %0, %4, %12 row_ror:1 row_mask:0xf bank_mask:0xf\n\t"
                                     "v_fmac_f32_dpp %1, %5, %13 row_ror:1 row_mask:0xf bank_mask:0xf\n\t"
                                     "v_fmac_f32_dpp %2, %6, %14 row_ror:1 row_mask:0xf bank_mask:0xf\n\t"
                                     "v_fmac_f32_dpp %3, %7, %15 row_ror:1 row_mask:0xf bank_mask:0xf\n\t"
                                     "v_fmac_f32_dpp %0, %8, %16 row_ror:15 row_mask:0xf bank_mask:0xf\n\t"
                                     "v_fmac_f32_dpp %1, %9, %17 row_ror:15 row_mask:0xf bank_mask:0xf\n\t"
                                     "v_fmac_f32_dpp %2, %10, %18 row_ror:15 row_mask:0xf bank_mask:0xf\n\t"
                                     "v_fmac_f32_dpp %3, %11, %19 row_ror:15 row_mask:0xf bank_mask:0xf"
                                     : "+v"(rr[0]), "+v"(rr[1]), "+v"(rr[2]), "+v"(rr[3])
                                     : "v"(su[0]), "v"(su[1]), "v"(su[2]), "v"(su[3]), "v"(sd[0]), "v"(sd[1]), "v"(sd[2]), "v"(sd[3]),
                                       "v"(w0[bj][0]), "v"(w0[bj][1]), "v"(w0[bj][2]), "v"(w0[bj][3]), "v"(w2[bj][0]), "v"(w2[bj][1]), "v"(w2[bj][2]), "v"(w2[bj][3]));
                        res[bj] = rr;
                    }
                    const int r = ai * HALF + wr * 64 + m * 16 + fr_;
                    bool okr = r >= rmin && r <= rmax; int trow = u.orow + r;
                    if (u.aux == 2) { const int seg = r / TAILSEG, sq = r - seg * TAILSEG, sb = 7 * (u.orow >> 8) + seg;
                        okr = seg < 7 && sb < NB && sq >= 1 && sq <= 32; trow = sb * TB + NCTX + (SEQ - 33) + sq; }
                    if (okr) {
                        const f32x4 gq = res[0], vq = res[1];
                        u32x2 w; w.x = cvt_pk_bf16(silu_f(gq[0]) * vq[0], silu_f(gq[1]) * vq[1]); w.y = cvt_pk_bf16(silu_f(gq[2]) * vq[2], silu_f(gq[3]) * vq[3]);
                        *(u32x2*)(Hd + (size_t)trow * DFF + chb) = w;
                    }
                }
            }
        }
    }
};

template <class Epi, class Sched>
__device__ __forceinline__ void gemm_phase(LAS unsigned char* lds, const Gemm g, const Sched& S, const Epi& E) {
    int tid = threadIdx.x; asm volatile("" : "+v"(tid));
    const int wid = __builtin_amdgcn_readfirstlane(tid >> 6), lane = tid & 63, wr = wid >> 2, wc = wid & 3, fr = lane & 15, fq = lane >> 4;
    int K = g.K, lda_ = g.lda, ldb_ = g.ldb; asm volatile("" : "+s"(K), "+s"(lda_), "+s"(ldb_));
    const int nt = K / BK;
    unsigned voffA[2], voffB[2];
#pragma unroll
    for (int i = 0; i < 2; ++i) { int R, C; stage_rc(tid * 16 + i * 8192, R, C); const int Rb = Epi::PERM ? ((R & ~31) + perm32(R & 31)) : R;
        voffA[i] = (unsigned)(R * lda_ + C) * 2u; voffB[i] = (unsigned)(Rb * ldb_ + C) * 2u; }
    const size_t kstep = (size_t)(BK * 2);
    const size_t hstepA = (size_t)HALF * lda_ * 2, hstepB = (size_t)HALF * ldb_ * 2;
    const unsigned ldsw = (unsigned)wid * 1024u;
    const int aoff = lds_byte(wr * 64 + fr, fq * 8), boff = lds_byte(wc * 32 + fr, fq * 8);
#define PG8_SA(b, h) (((b) * 2 + (h)) * HTB)
#define PG8_SB(b, h) ((4 + (b) * 2 + (h)) * HTB)
#define PG8_STAGE(bufoff, gbase, voff) do { _Pragma("unroll") for (int _i = 0; _i < 2; ++_i) \
        __builtin_amdgcn_global_load_lds((const unsigned*)((const char*)(gbase) + (voff)[_i]), (LAS unsigned*)(lds + (bufoff) + ldsw + _i * 8192), 16, 0, 0); } while (0)
#define PG8_LDA(dst, b, h) do { _Pragma("unroll") for (int m = 0; m < 4; ++m) _Pragma("unroll") for (int k = 0; k < 2; ++k) dst[m][k] = *(const LAS bf16x8*)(lds + PG8_SA(b, h) + aoff + m * 2048 + k * 1024); } while (0)
#define PG8_LDB(dst, b, h) do { _Pragma("unroll") for (int n = 0; n < 2; ++n) _Pragma("unroll") for (int k = 0; k < 2; ++k) dst[n][k] = *(const LAS bf16x8*)(lds + PG8_SB(b, h) + boff + n * 2048 + k * 1024); } while (0)
#define PG8_MMA(ai, bj, At, Bt) do { __builtin_amdgcn_s_setprio(1); _Pragma("unroll") for (int m = 0; m < 4; ++m) _Pragma("unroll") for (int n = 0; n < 2; ++n) _Pragma("unroll") for (int k = 0; k < 2; ++k) \
        acc[ai][bj][m][n] = __builtin_amdgcn_mfma_f32_16x16x32_bf16(Bt[n][k], At[m][k], acc[ai][bj][m][n], 0, 0, 0); __builtin_amdgcn_s_setprio(0); } while (0)
#define PG8_WAIT_V(n) asm volatile("s_waitcnt vmcnt(" #n ")" ::: "memory")
#define PG8_WAIT_L(n) asm volatile("s_waitcnt lgkmcnt(" #n ")" ::: "memory")
#define PG8_BAR __builtin_amdgcn_s_barrier()
#define PG8_SCHED __builtin_amdgcn_sched_barrier(0)
    Unit cur, nxt; int ui = 0;
    if (!S.next(0, cur)) return;
    f32x4 acc[2][2][4][2];
#pragma unroll
    for (int a = 0; a < 2; ++a)
#pragma unroll
        for (int b = 0; b < 2; ++b)
#pragma unroll
            for (int m = 0; m < 4; ++m)
#pragma unroll
                for (int n = 0; n < 2; ++n) acc[a][b][m][n] = (f32x4){0.f, 0.f, 0.f, 0.f};
    bf16x8 At[4][2], B0[2][2], B1[2][2];
    const char* cA = (const char*)g.A + (size_t)cur.arow * lda_ * 2; const char* cB = (const char*)g.Bt + (size_t)cur.brow * ldb_ * 2;
    PG8_STAGE(PG8_SB(0, 0), cB, voffB); PG8_STAGE(PG8_SB(0, 1), cB + hstepB, voffB); PG8_STAGE(PG8_SA(0, 0), cA, voffA); PG8_STAGE(PG8_SA(0, 1), cA + hstepA, voffA);
    if (wr == 1) PG8_BAR;
    PG8_WAIT_V(2); PG8_BAR;
    PG8_STAGE(PG8_SB(1, 0), cB + kstep, voffB); PG8_STAGE(PG8_SA(1, 0), cA + kstep, voffA); PG8_STAGE(PG8_SB(1, 1), cB + hstepB + kstep, voffB);
    PG8_WAIT_V(6); PG8_BAR;
    for (;;) {
        const bool has_next = S.next(ui + 1, nxt);
        const char* nA = has_next ? (const char*)g.A + (size_t)nxt.arow * lda_ * 2 : cA; const char* nB = has_next ? (const char*)g.Bt + (size_t)nxt.brow * ldb_ * 2 : cB;
        for (int t = 0; t < nt; t += 2) {
            const bool last = (t == nt - 2);
            const char* a1 = cA + (size_t)(t + 1) * kstep;
            const char* a2 = last ? nA : cA + (size_t)(t + 2) * kstep; const char* b2 = last ? nB : cB + (size_t)(t + 2) * kstep;
            const char* a3 = a2 + kstep; const char* b3 = b2 + kstep;
            PG8_LDB(B0, 0, 0); PG8_LDB(B1, 0, 1); PG8_SCHED; PG8_LDA(At, 0, 0); PG8_STAGE(PG8_SA(1, 1), a1 + hstepA, voffA);
            PG8_WAIT_V(8); PG8_WAIT_L(0); PG8_BAR; PG8_MMA(0, 0, At, B0); PG8_MMA(0, 1, At, B1); PG8_BAR; PG8_SCHED;
            PG8_LDA(At, 0, 1); PG8_STAGE(PG8_SB(0, 0), b2, voffB); PG8_STAGE(PG8_SB(0, 1), b2 + hstepB, voffB); PG8_STAGE(PG8_SA(0, 0), a2, voffA);
            PG8_WAIT_V(8); PG8_WAIT_L(0); PG8_BAR; PG8_MMA(1, 0, At, B0); PG8_MMA(1, 1, At, B1); PG8_BAR; PG8_SCHED;
            PG8_LDB(B0, 1, 0); PG8_LDB(B1, 1, 1); PG8_SCHED; PG8_LDA(At, 1, 0); PG8_STAGE(PG8_SA(0, 1), a2 + hstepA, voffA);
            PG8_WAIT_V(8); PG8_WAIT_L(0); PG8_BAR; PG8_MMA(0, 0, At, B0); PG8_MMA(0, 1, At, B1); PG8_BAR; PG8_SCHED;
            PG8_LDA(At, 1, 1); PG8_STAGE(PG8_SB(1, 0), b3, voffB); PG8_STAGE(PG8_SB(1, 1), b3 + hstepB, voffB); PG8_STAGE(PG8_SA(1, 0), a3, voffA);
            PG8_WAIT_V(8); PG8_WAIT_L(0); PG8_BAR; PG8_MMA(1, 0, At, B0); PG8_MMA(1, 1, At, B1); PG8_BAR; PG8_SCHED;
        }
        if (wr == 0) PG8_BAR;
        E(acc, cur, wr, wc, fr, fq, lds);
        if (!has_next) break;
#pragma unroll
        for (int a = 0; a < 2; ++a)
#pragma unroll
            for (int b = 0; b < 2; ++b)
#pragma unroll
                for (int m = 0; m < 4; ++m)
#pragma unroll
                    for (int n = 0; n < 2; ++n) acc[a][b][m][n] = (f32x4){0.f, 0.f, 0.f, 0.f};
        cur = nxt; cA = nA; cB = nB; ++ui;
        if (wr == 1) PG8_BAR;
    }
    PG8_WAIT_V(0);
    PG8_BAR;
#undef PG8_SA
#undef PG8_SB
#undef PG8_STAGE
#undef PG8_LDA
#undef PG8_LDB
#undef PG8_MMA
#undef PG8_WAIT_V
#undef PG8_WAIT_L
#undef PG8_BAR
#undef PG8_SCHED
}

struct MapStd { int coff; __device__ __forceinline__ void operator()(Unit& u) const { u.arow = u.pm * 256; u.brow = u.pn * 256; u.orow = u.pm * 256; u.ocol = coff + u.pn * 256; u.aux = 0; u.bt = 0; } };
struct MapRes { int all;
    __device__ __forceinline__ void operator()(Unit& u) const {
        int b, j; if (all) { b = u.pm / 17; j = u.pm % 17; } else { b = u.pm / 16; j = u.pm % 16 + 1; }
        u.arow = (b * 17 + j) * 256; u.brow = u.pn * 256; u.ocol = u.pn * 256; u.bt = b;
        if (j == 0) { u.aux = 1; u.orow = b * 256; } else { u.aux = 0; u.orow = b * SEQ + (j - 1) * 256; } asm volatile("" : "+s"(u.aux)); } };
struct MapUp { int all;
    __device__ __forceinline__ void operator()(Unit& u) const {
        const int per = all ? 17 : 16, nmain = 16 * per;
        u.brow = u.pn * 256; u.ocol = u.pn * 128;
        if (u.pm >= nmain) { u.aux = 2; u.arow = TAILROW0 + (u.pm - nmain) * 256; u.orow = (u.pm - nmain) * 256; u.bt = 0; return; }
        const int b = u.pm / per, j = all ? u.pm % per : u.pm % per + 1;
        if (j == 0) { u.aux = 1; u.arow = b * U2B; u.orow = b * TB; u.bt = 255; }
        else { const int i = j - 1; u.aux = 0; u.arow = b * U2B + 263 + 254 * i; u.orow = b * TB + NCTX + 254 * i - 1; u.bt = 254; } } };
struct MapZ {
    __device__ __forceinline__ void operator()(Unit& u) const {
        const int b = u.pn / 17, j = u.pn % 17; u.arow = u.pm * 256; u.brow = u.pn * 256; u.orow = b * 256; u.bt = b;
        if (j == 0) { u.aux = 1; u.ocol = u.pm * NCTX; } else { u.aux = 0; u.ocol = u.pm * SEQ + (j - 1) * 256; } } };
struct MapFnetL { __device__ __forceinline__ void operator()(Unit& u) const { const int b = u.pm / 16, mt = u.pm % 16; u.arow = mt * 256; u.brow = b * 256; u.orow = b * TB + NCTX + mt * 256; u.ocol = 768; u.aux = 0; u.bt = b; } };
struct MapFnetC { __device__ __forceinline__ void operator()(Unit& u) const { const int b = u.pm; u.arow = 0; u.brow = b * 256; u.orow = b * TB; u.ocol = 768; u.aux = 0; u.bt = b; } };
}

typedef short v4i16_t __attribute__((ext_vector_type(4)));
__device__ __forceinline__ v4i16_t vtr(const LAS unsigned char* p) { return __builtin_amdgcn_ds_read_tr16_b64_v4i16((LAS v4i16_t*)p); }
#define MX3(a_, b_, c_) __builtin_fmaxf(__builtin_fmaxf((a_), (b_)), (c_))
__device__ __forceinline__ float tile_max(const f32x16& s0, const f32x16& s1) {
    float ma = MX3(s0[0], s0[1], s1[0]), mb = MX3(s0[2], s0[3], s1[1]); ma = MX3(ma, s1[2], s1[3]);
#pragma unroll
    for (int r = 4; r < 16; r += 4) { ma = MX3(ma, s0[r], s0[r + 1]); mb = MX3(mb, s0[r + 2], s0[r + 3]); ma = MX3(ma, s1[r], s1[r + 1]); mb = MX3(mb, s1[r + 2], s1[r + 3]); }
    return __builtin_fmaxf(ma, mb);
}
#undef MX3
__device__ __forceinline__ void band_mask(f32x16& s0, f32x16& s1, int k0pos, int qp, int hi) {
#pragma unroll
    for (int r = 0; r < 16; ++r) { const int kp = k0pos + (r & 3) + 8 * (r >> 2) + 4 * hi; const int d0 = kp - qp, d1 = d0 + 32;
        if (d0 > 128 || d0 < -128) s0[r] = -1e30f; if (d1 > 128 || d1 < -128) s1[r] = -1e30f; }
}
__device__ __forceinline__ void exp4(f32x16& s, int r0, float& acc0, float& acc1) {
    s[r0] = __builtin_amdgcn_exp2f(s[r0]); s[r0 + 1] = __builtin_amdgcn_exp2f(s[r0 + 1]); s[r0 + 2] = __builtin_amdgcn_exp2f(s[r0 + 2]); s[r0 + 3] = __builtin_amdgcn_exp2f(s[r0 + 3]);
    acc0 += s[r0] + s[r0 + 2]; acc1 += s[r0 + 1] + s[r0 + 3];
}
__device__ __forceinline__ bf16x8 pack8(const f32x16& s, int r0) {
    u32x4 w; w.x = cvt_pk_bf16(s[r0], s[r0 + 1]); w.y = cvt_pk_bf16(s[r0 + 2], s[r0 + 3]); w.z = cvt_pk_bf16(s[r0 + 4], s[r0 + 5]); w.w = cvt_pk_bf16(s[r0 + 6], s[r0 + 7]);
    return __builtin_bit_cast(bf16x8, w);
}
__device__ __forceinline__ void pv_slab(const LAS unsigned char* vb, int koff, const bf16x8 pj, f32x16& o0, f32x16& o1) {
    const v4i16_t a0 = vtr(vb + koff), a1 = vtr(vb + koff + 512), b0 = vtr(vb + 8192 + koff), b1 = vtr(vb + 8192 + koff + 512);
    const bf16x8 v0 = {a0[0], a0[1], a0[2], a0[3], a1[0], a1[1], a1[2], a1[3]}, v1 = {b0[0], b0[1], b0[2], b0[3], b1[0], b1[1], b1[2], b1[3]};
    o0 = __builtin_amdgcn_mfma_f32_32x32x16_bf16(v0, pj, o0, 0, 0, 0);
    o1 = __builtin_amdgcn_mfma_f32_32x32x16_bf16(v1, pj, o1, 0, 0, 0);
}

#define ATT_SCHED() __builtin_amdgcn_sched_barrier(0)
template <int DQ, bool WIN>
__device__ __forceinline__ void attn_qk(LAS unsigned char* lds, int kbufoff, int t, const bf16x8 (&qf)[DQ / 16], f32x16& o0, f32x16& o1, float& mrun, float& lsum,
                                        f32x16& sa0, f32x16& sa1, f32x16& sb0, f32x16& sb1, int l31, int hi, int qw) {
    constexpr int NDK = DQ / 16, KST = DQ * 2 + 16;
    const LAS unsigned char* kb = lds + kbufoff + l31 * KST + hi * 16;
    bf16x8 kf[2][4];
#define KLOAD(dst, dk) do { dst[0] = *(const LAS bf16x8*)(kb + (dk) * 32); dst[1] = *(const LAS bf16x8*)(kb + 32 * KST + (dk) * 32); \
                            dst[2] = *(const LAS bf16x8*)(kb + 64 * KST + (dk) * 32); dst[3] = *(const LAS bf16x8*)(kb + 96 * KST + (dk) * 32); } while (0)
    KLOAD(kf[0], 0);
#pragma unroll
    for (int dk = 0; dk < NDK; ++dk) {
        if (dk + 1 < NDK) KLOAD(kf[(dk + 1) & 1], dk + 1);
        ATT_SCHED();
        const bf16x8 (&f)[4] = kf[dk & 1];
        if (dk == 0) { f32x16 z16;
#pragma unroll
                       for (int r = 0; r < 16; ++r) z16[r] = 0.f;
                       sa0 = __builtin_amdgcn_mfma_f32_32x32x16_bf16(f[0], qf[0], z16, 0, 0, 0); sa1 = __builtin_amdgcn_mfma_f32_32x32x16_bf16(f[1], qf[0], z16, 0, 0, 0);
                       sb0 = __builtin_amdgcn_mfma_f32_32x32x16_bf16(f[2], qf[0], z16, 0, 0, 0); sb1 = __builtin_amdgcn_mfma_f32_32x32x16_bf16(f[3], qf[0], z16, 0, 0, 0); }
        else { sa0 = __builtin_amdgcn_mfma_f32_32x32x16_bf16(f[0], qf[dk], sa0, 0, 0, 0); sa1 = __builtin_amdgcn_mfma_f32_32x32x16_bf16(f[1], qf[dk], sa1, 0, 0, 0);
               sb0 = __builtin_amdgcn_mfma_f32_32x32x16_bf16(f[2], qf[dk], sb0, 0, 0, 0); sb1 = __builtin_amdgcn_mfma_f32_32x32x16_bf16(f[3], qf[dk], sb1, 0, 0, 0); }
        ATT_SCHED();
    }
#undef KLOAD
    if (__builtin_expect(__any(mrun != 0.f), 0)) {
#pragma unroll
        for (int r = 0; r < 16; ++r) { sa0[r] -= mrun; sa1[r] -= mrun; sb0[r] -= mrun; sb1[r] -= mrun; }
    }
    if (WIN && t >= 4) { const int qp = qw + l31, k0pos = (t - 4) * 64; band_mask(sa0, sa1, k0pos, qp, hi); band_mask(sb0, sb1, k0pos + 64, qp, hi); }
    float mx = __builtin_fmaxf(tile_max(sa0, sa1), tile_max(sb0, sb1));
    { auto rr = __builtin_amdgcn_permlane32_swap(__float_as_uint(mx), __float_as_uint(mx), false, false); mx = __builtin_fmaxf(__uint_as_float(rr[0]), __uint_as_float(rr[1])); }
    if (__builtin_expect(__any(mx > 8.0f), 0)) {
        const float dl = mx > 8.0f ? mx : 0.f; mrun += dl;
        const float alpha = __builtin_amdgcn_exp2f(-dl); lsum *= alpha;
#pragma unroll
        for (int r = 0; r < 16; ++r) { sa0[r] -= dl; sa1[r] -= dl; sb0[r] -= dl; sb1[r] -= dl; o0[r] *= alpha; o1[r] *= alpha; }
    }
}
#define VLOAD(dst, j) do { dst[0] = vtr(vb + (j) * 1024); dst[1] = vtr(vb + (j) * 1024 + 512); dst[2] = vtr(vb + 8192 + (j) * 1024); dst[3] = vtr(vb + 8192 + (j) * 1024 + 512); } while (0)
#define PVMMA(src, P_) do { const bf16x8 v0_ = {src[0][0], src[0][1], src[0][2], src[0][3], src[1][0], src[1][1], src[1][2], src[1][3]}, v1_ = {src[2][0], src[2][1], src[2][2], src[2][3], src[3][0], src[3][1], src[3][2], src[3][3]}; \
        const bf16x8 p_ = (P_); o0 = __builtin_amdgcn_mfma_f32_32x32x16_bf16(v0_, p_, o0, 0, 0, 0); o1 = __builtin_amdgcn_mfma_f32_32x32x16_bf16(v1_, p_, o1, 0, 0, 0); } while (0)
__device__ __forceinline__ void attn_softmax_pv(const LAS unsigned char* vb, f32x16& sa0, f32x16& sa1, f32x16& sb0, f32x16& sb1, f32x16& o0, f32x16& o1, float& lsum) {
    v4i16_t vf[2][4];
    VLOAD(vf[0], 0);
    float p0 = 0.f, p1 = 0.f, p2 = 0.f, p3 = 0.f;
    exp4(sa0, 0, p0, p1); exp4(sa0, 4, p2, p3); exp4(sa0, 8, p0, p1); exp4(sa0, 12, p2, p3);
    exp4(sa1, 0, p0, p1); exp4(sa1, 4, p2, p3); exp4(sa1, 8, p0, p1); exp4(sa1, 12, p2, p3);
    VLOAD(vf[1], 1); ATT_SCHED(); PVMMA(vf[0], pack8(sa0, 0)); exp4(sb0, 0, p0, p1); exp4(sb0, 4, p2, p3); ATT_SCHED();
    VLOAD(vf[0], 2); ATT_SCHED(); PVMMA(vf[1], pack8(sa0, 8)); exp4(sb0, 8, p0, p1); exp4(sb0, 12, p2, p3); ATT_SCHED();
    VLOAD(vf[1], 3); ATT_SCHED(); PVMMA(vf[0], pack8(sa1, 0)); exp4(sb1, 0, p0, p1); exp4(sb1, 4, p2, p3); ATT_SCHED();
    VLOAD(vf[0], 4); ATT_SCHED(); PVMMA(vf[1], pack8(sa1, 8)); exp4(sb1, 8, p0, p1); exp4(sb1, 12, p2, p3); ATT_SCHED();
    lsum += (p0 + p1) + (p2 + p3);
    VLOAD(vf[1], 5); ATT_SCHED(); PVMMA(vf[0], pack8(sb0, 0)); ATT_SCHED();
    VLOAD(vf[0], 6); ATT_SCHED(); PVMMA(vf[1], pack8(sb0, 8)); ATT_SCHED();
    VLOAD(vf[1], 7); ATT_SCHED(); PVMMA(vf[0], pack8(sb1, 0)); ATT_SCHED();
    PVMMA(vf[1], pack8(sb1, 8));
}
__device__ __forceinline__ void attn_softmax_keep(f32x16& sa0, f32x16& sa1, f32x16& sb0, f32x16& sb1, bf16x8 (&pw)[8], float& lsum) {
    float p0 = 0.f, p1 = 0.f, p2 = 0.f, p3 = 0.f;
    exp4(sa0, 0, p0, p1); exp4(sa0, 4, p2, p3); exp4(sa0, 8, p0, p1); exp4(sa0, 12, p2, p3); pw[0] = pack8(sa0, 0); pw[1] = pack8(sa0, 8);
    exp4(sa1, 0, p0, p1); exp4(sa1, 4, p2, p3); exp4(sa1, 8, p0, p1); exp4(sa1, 12, p2, p3); pw[2] = pack8(sa1, 0); pw[3] = pack8(sa1, 8);
    exp4(sb0, 0, p0, p1); exp4(sb0, 4, p2, p3); exp4(sb0, 8, p0, p1); exp4(sb0, 12, p2, p3); pw[4] = pack8(sb0, 0); pw[5] = pack8(sb0, 8);
    exp4(sb1, 0, p0, p1); exp4(sb1, 4, p2, p3); exp4(sb1, 8, p0, p1); exp4(sb1, 12, p2, p3); pw[6] = pack8(sb1, 0); pw[7] = pack8(sb1, 8);
    lsum += (p0 + p1) + (p2 + p3);
}
__device__ __forceinline__ void attn_pv_all(const LAS unsigned char* vb, const bf16x8 (&pw)[8], f32x16& o0, f32x16& o1) {
    v4i16_t vf[2][4];
    VLOAD(vf[0], 0);
    VLOAD(vf[1], 1); ATT_SCHED(); PVMMA(vf[0], pw[0]); ATT_SCHED();
    VLOAD(vf[0], 2); ATT_SCHED(); PVMMA(vf[1], pw[1]); ATT_SCHED();
    VLOAD(vf[1], 3); ATT_SCHED(); PVMMA(vf[0], pw[2]); ATT_SCHED();
    VLOAD(vf[0], 4); ATT_SCHED(); PVMMA(vf[1], pw[3]); ATT_SCHED();
    VLOAD(vf[1], 5); ATT_SCHED(); PVMMA(vf[0], pw[4]); ATT_SCHED();
    VLOAD(vf[0], 6); ATT_SCHED(); PVMMA(vf[1], pw[5]); ATT_SCHED();
    VLOAD(vf[1], 7); ATT_SCHED(); PVMMA(vf[0], pw[6]); ATT_SCHED();
    PVMMA(vf[1], pw[7]);
}
#undef VLOAD
#undef PVMMA
#undef ATT_SCHED

template <int DQ, bool WIN, int MODE = 0>
__device__ __forceinline__ void attn_unit(LAS unsigned char* lds, const bf16_t* Qp, int ldq, const bf16_t* Kp, int ldk, const bf16_t* Vp, int ldv, bf16_t* Op,
                                          int n1, int s2, int e2, int q0pos, float m_init, bool has_sink, const float* qgain = nullptr, const f32x2v* ropeT = nullptr, bool qrope = false, const float* rqrow = nullptr) {
    constexpr int NDK = DQ / 16, CH = DQ / 8, NKC = DQ / 32, KST = DQ * 2 + 16, KBUF = 128 * KST, VBUF = 16384, VOFF = 2 * KBUF;
    int tid = threadIdx.x; asm volatile("" : "+v"(tid));
    const int lane = tid & 63, wid = __builtin_amdgcn_readfirstlane(tid >> 6), l31 = lane & 31, hi = lane >> 5;
    const bool late = wid >= 4;
    bf16x8 qf[NDK];
    { const bf16_t* qrow = Qp + (size_t)(32 * wid + l31) * ldq + 8 * hi;
#pragma unroll
      for (int dk = 0; dk < NDK; ++dk) qf[dk] = *(const bf16x8*)(qrow + 16 * dk); }
    if (DQ == 96 && qgain != nullptr) {
        const float r_q = rqrow[32 * wid + l31];
        float y[6][8]; float ss = 0.f;
#pragma unroll
        for (int dk = 0; dk < 6; ++dk) { const u32x4 w = __builtin_bit_cast(u32x4, qf[dk < NDK ? dk : 0]);
#pragma unroll
            for (int i = 0; i < 4; ++i) { y[dk][2 * i] = bflo(w[i]) * r_q; y[dk][2 * i + 1] = bfhi(w[i]) * r_q; ss += y[dk][2 * i] * y[dk][2 * i] + y[dk][2 * i + 1] * y[dk][2 * i + 1]; } }
        ss += __shfl_xor(ss, 32);
        const float sc = rsqrtf(ss * (1.0f / 96.0f) + EPS);
#pragma unroll
        for (int dk = 0; dk < 6; ++dk)
#pragma unroll
            for (int e = 0; e < 8; ++e) y[dk][e] *= sc * qgain[16 * dk + 8 * hi + e];
        if (qrope) { const int pos = q0pos + 32 * wid + l31;
#pragma unroll
            for (int e = 0; e < 8; ++e) { const f32x2v t = ropeT[pos * 16 + 8 * hi + e]; const float x1 = y[4][e], x2 = y[5][e]; y[4][e] = x1 * t.x - x2 * t.y; y[5][e] = x1 * t.y + x2 * t.x; } }
        const float QS_ = 0.10206207261596577f * LOG2E;
#pragma unroll
        for (int dk = 0; dk < 6; ++dk) { u32x4 w;
#pragma unroll
            for (int i = 0; i < 4; ++i) w[i] = cvt_pk_bf16(y[dk][2 * i] * QS_, y[dk][2 * i + 1] * QS_);
            if (dk < NDK) qf[dk] = __builtin_bit_cast(bf16x8, w); }
    }
    if (DQ == 64 && qgain != nullptr) {
        float y[4][8]; float ss = 0.f;
#pragma unroll
        for (int dk = 0; dk < 4; ++dk) { const u32x4 w = __builtin_bit_cast(u32x4, qf[dk < NDK ? dk : 0]);
#pragma unroll
            for (int i = 0; i < 4; ++i) { y[dk][2 * i] = bflo(w[i]); y[dk][2 * i + 1] = bfhi(w[i]); ss += y[dk][2 * i] * y[dk][2 * i] + y[dk][2 * i + 1] * y[dk][2 * i + 1]; } }
        ss += __shfl_xor(ss, 32);
        const float rn = rsqrtf(ss * (1.0f / 64.0f) + EPS);
#pragma unroll
        for (int dk = 0; dk < 4; ++dk)
#pragma unroll
            for (int e = 0; e < 8; ++e) y[dk][e] *= rn * qgain[16 * dk + 8 * hi + e];
        if (qrope) { const int pos = q0pos + 32 * wid + l31;
#pragma unroll
            for (int dk = 0; dk < 2; ++dk)
#pragma unroll
                for (int e = 0; e < 8; ++e) { const f32x2v t = ropeT[pos * 32 + 16 * dk + 8 * hi + e]; const float x1 = y[dk][e], x2 = y[dk + 2][e]; y[dk][e] = x1 * t.x - x2 * t.y; y[dk + 2][e] = x1 * t.y + x2 * t.x; } }
        const float QS_ = 0.125f * LOG2E;
#pragma unroll
        for (int dk = 0; dk < 4; ++dk) { u32x4 w;
#pragma unroll
            for (int i = 0; i < 4; ++i) w[i] = cvt_pk_bf16(y[dk][2 * i] * QS_, y[dk][2 * i + 1] * QS_);
            if (dk < NDK) qf[dk] = __builtin_bit_cast(bf16x8, w); }
    }
    f32x16 o0, o1;
#pragma unroll
    for (int r = 0; r < 16; ++r) { o0[r] = 0.f; o1[r] = 0.f; }
    float mrun = 0.f, lsum = (has_sink && hi == 0) ? __builtin_amdgcn_exp2f(m_init) : 0.f;
    const int qw = q0pos + 32 * wid;
    const int vlane = (4 * hi + ((lane & 15) >> 2)) * 64 + ((lane >> 4) & 1) * 32 + (lane & 3) * 8;
    u32x4 kr[NKC], vr[2];
#define ATT_TILE(i_) ((i_) < n1 ? (i_) : s2 + ((i_) - n1))
#define ATT_LOAD(t) do { const bf16_t* kp_ = Kp + (size_t)(t) * 64 * ldk; const bf16_t* vp_ = Vp + (size_t)(t) * 64 * ldv; \
        _Pragma("unroll") for (int m_ = 0; m_ < NKC; ++m_) { const int c_ = tid + 512 * m_; kr[m_] = *(const GAS u32x4*)(kp_ + (size_t)(c_ / CH) * ldk + (c_ % CH) * 8); } \
        _Pragma("unroll") for (int m_ = 0; m_ < 2; ++m_) { const int c_ = tid + 512 * m_; vr[m_] = *(const GAS u32x4*)(vp_ + (size_t)(c_ >> 3) * ldv + (c_ & 7) * 8); } } while (0)
#define ATT_STORE(kb_, vb_) do { \
        _Pragma("unroll") for (int m_ = 0; m_ < NKC; ++m_) { const int c_ = tid + 512 * m_; *(LAS u32x4*)(lds + (kb_) * KBUF + (c_ / CH) * KST + (c_ % CH) * 16) = kr[m_]; } \
        _Pragma("unroll") for (int m_ = 0; m_ < 2; ++m_) { const int c_ = tid + 512 * m_; *(LAS u32x4*)(lds + VOFF + (vb_) * VBUF + ((c_ & 7) >> 2) * 8192 + (c_ >> 3) * 64 + (c_ & 3) * 16) = vr[m_]; } } while (0)
#define ATT_BAR() asm volatile("s_waitcnt lgkmcnt(0)\n\ts_barrier" ::: "memory")
    const int nst = (n1 + (e2 - s2)) >> 1;
    ATT_LOAD(0); ATT_STORE(0, 0);
    ATT_BAR();
    if (!late) {
        int vcur = 0;
        for (int I = 0; I < nst; ++I) {
            const int t = ATT_TILE(2 * I);
            if (I + 1 < nst) { const int tn = ATT_TILE(2 * I + 2); ATT_LOAD(tn); }
            bool active = true; if (WIN && t >= 4) { const int k0 = (t - 4) * 64; active = (k0 + 127 >= qw - 128) && (k0 <= qw + 31 + 128); }
            const int vnext = vcur == 2 ? 0 : vcur + 1;
            if (active) { f32x16 sa0, sa1, sb0, sb1;
                attn_qk<DQ, WIN>(lds, (I & 1) * KBUF, t, qf, o0, o1, mrun, lsum, sa0, sa1, sb0, sb1, l31, hi, qw);
                attn_softmax_pv(lds + VOFF + vcur * VBUF + vlane, sa0, sa1, sb0, sb1, o0, o1, lsum); }
            if (I + 1 < nst) ATT_STORE((I + 1) & 1, vnext);
            vcur = vnext;
            ATT_BAR();
        }
    } else {
        bf16x8 pw[8]; bool havep = false; int pvoff = 0;
        int vcur = 0;
        for (int I = 0; I < nst; ++I) {
            const int t = ATT_TILE(2 * I);
            if (I + 1 < nst) { const int tn = ATT_TILE(2 * I + 2); ATT_LOAD(tn); }
            bool active = true; if (WIN && t >= 4) { const int k0 = (t - 4) * 64; active = (k0 + 127 >= qw - 128) && (k0 <= qw + 31 + 128); }
            const int vnext = vcur == 2 ? 0 : vcur + 1;
            if (havep) attn_pv_all(lds + VOFF + pvoff + vlane, pw, o0, o1);
            havep = false;
            if (active) { f32x16 sa0, sa1, sb0, sb1;
                attn_qk<DQ, WIN>(lds, (I & 1) * KBUF, t, qf, o0, o1, mrun, lsum, sa0, sa1, sb0, sb1, l31, hi, qw);
                attn_softmax_keep(sa0, sa1, sb0, sb1, pw, lsum); havep = true; pvoff = vcur * VBUF; }
            if (I + 1 < nst) ATT_STORE((I + 1) & 1, vnext);
            vcur = vnext;
            ATT_BAR();
        }
        if (havep) attn_pv_all(lds + VOFF + pvoff + vlane, pw, o0, o1);
    }
    ATT_BAR();
#undef ATT_TILE
#undef ATT_LOAD
#undef ATT_STORE
#undef ATT_BAR
    const float lt = lsum + __shfl_xor(lsum, 32), inv = 1.0f / lt;
    bf16_t* orow = Op + (size_t)(32 * wid + l31) * DM + 4 * hi;
#pragma unroll
    for (int g = 0; g < 4; ++g) {
        u32x2 w0, w1;
        w0.x = cvt_pk_bf16(o0[4 * g] * inv, o0[4 * g + 1] * inv); w0.y = cvt_pk_bf16(o0[4 * g + 2] * inv, o0[4 * g + 3] * inv);
        w1.x = cvt_pk_bf16(o1[4 * g] * inv, o1[4 * g + 1] * inv); w1.y = cvt_pk_bf16(o1[4 * g + 2] * inv, o1[4 * g + 3] * inv);
        *(u32x2*)(orow + 8 * g) = w0; *(u32x2*)(orow + 32 + 8 * g) = w1;
    }
}

struct Args { const float* in[28]; float* out; unsigned char* ws; int lo, hi; };
typedef const GAS float* cfp_t;
struct Ctx { const __attribute__((address_space(4))) cfp_t* in; float* out; unsigned char* ws;
    __device__ __forceinline__ const float* inp(int i) const { return (const float*)in[i]; } };
enum { I_X = 0, I_C, I_CTX, I_CCTX, I_MODW, I_MODB, I_N1G, I_N2G, I_MLAWIN, I_CQG, I_CKVG, I_WUQ, I_WUKV, I_QG, I_KG, I_FNETW, I_EWOUT,
       I_WINWIN, I_WQG, I_WKG, I_SINK, I_POOLW, I_POOLS, I_OWOUT, I_FFNUP, I_CONVW, I_CONVB, I_FFNDN };

__device__ __forceinline__ void tr_item(const float* W, int K, int Nsrc, bf16_t* WT, int nblk, int item, LAS float* scr, int lane, int mode, const float* ksc) {
    const int kb = item / nblk, nb = item % nblk, k0 = 64 * kb, n0 = 32 * nb;
    int s0 = n0;
    if (mode == 1) s0 = n0 < 672 ? n0 : -1;
    else if (mode == 2) { const int hd = n0 >> 7, d0 = n0 & 127; s0 = d0 < 96 ? hd * 96 + d0 : -1; }
    else if (mode == 3) { const int pn = n0 >> 8, bj = (n0 >> 7) & 1, c = n0 & 127; s0 = bj * DFF + pn * 128 + c; }
#pragma unroll 16
    for (int i = 0; i < 32; ++i) { const int kk = 2 * i + (lane >> 5); float v = 0.f;
        if (s0 >= 0) { v = W[(size_t)(k0 + kk) * Nsrc + s0 + (lane & 31)]; if (ksc) v *= ksc[k0 + kk]; }
        scr[kk * 33 + (lane & 31)] = v; }
    asm volatile("s_waitcnt lgkmcnt(0)" ::: "memory");
    const int c = lane & 7;
#pragma unroll
    for (int j = 0; j < 4; ++j) { const int n = (lane >> 3) + 8 * j; const LAS float* s = scr + (8 * c) * 33 + n;
        u32x4 o; o.x = cvt_pk_bf16(s[0 * 33], s[1 * 33]); o.y = cvt_pk_bf16(s[2 * 33], s[3 * 33]); o.z = cvt_pk_bf16(s[4 * 33], s[5 * 33]); o.w = cvt_pk_bf16(s[6 * 33], s[7 * 33]);
        *(u32x4*)(WT + (size_t)(n0 + n) * K + k0 + 8 * c) = o; }
    asm volatile("s_waitcnt lgkmcnt(0)" ::: "memory");
}
__device__ __forceinline__ void tr_job(const float* W, int K, int Nsrc, bf16_t* WT, int Nout, int mode, const float* ksc, LAS float* scr, int gw, int ngw, int lane) {
    const int nblk = Nout / 32, nitems = (K / 64) * nblk;
    for (int it = gw; it < nitems; it += ngw) tr_item(W, K, Nsrc, WT, nblk, it, scr, lane, mode, ksc);
}
__device__ __forceinline__ void ffn_weights(const Ctx& a, int layer, LAS float* scr, int gw, int ngw, int lane) {
    tr_job(a.inp(I_FFNUP) + (size_t)layer * DM * 2 * DFF, DM, 2 * DFF, (bf16_t*)(a.ws + WS_WUP), 2 * DFF, 3, nullptr, scr, gw, ngw, lane);
    tr_job(a.inp(I_FFNDN) + (size_t)layer * DFF * DM, DFF, DM, (bf16_t*)(a.ws + ((layer & 1) ? WS_WDN2 : WS_WDN)), DM, 0, nullptr, scr, gw, ngw, lane);
}
__device__ __forceinline__ void mixer_weights(const Ctx& a, int j, LAS float* scr, int gw, int ngw, int lane) {
    unsigned char* ws = a.ws;
    tr_job(a.inp(I_MLAWIN) + (size_t)j * DM * 672, DM, 672, (bf16_t*)(ws + WS_WINE) + (size_t)j * 768 * DM, 768, 1, nullptr, scr, gw, ngw, lane);
    tr_job(a.inp(I_WUQ) + (size_t)j * 256 * 1152, 256, 1152, (bf16_t*)(ws + WS_WUQ) + (size_t)j * 1536 * 256, 1536, 2, a.inp(I_CQG) + j * 256, scr, gw, ngw, lane);
    tr_job(a.inp(I_WUKV) + (size_t)j * 128 * 1536, 128, 1536, (bf16_t*)(ws + WS_WUKV) + (size_t)j * 1536 * 128, 1536, 0, a.inp(I_CKVG) + j * 128, scr, gw, ngw, lane);
    tr_job(a.inp(I_EWOUT) + (size_t)j * DM * DM, DM, DM, (bf16_t*)(ws + WS_WOUTE) + (size_t)j * DM * DM, DM, 0, nullptr, scr, gw, ngw, lane);
    tr_job(a.inp(I_WINWIN) + (size_t)j * DM * 1536, DM, 1536, (bf16_t*)(ws + WS_WINO) + (size_t)j * 1536 * DM, 1536, 0, nullptr, scr, gw, ngw, lane);
    tr_job(a.inp(I_OWOUT) + (size_t)j * DM * DM, DM, DM, (bf16_t*)(ws + WS_WOUTO) + (size_t)j * DM * DM, DM, 0, nullptr, scr, gw, ngw, lane);
}

__device__ __forceinline__ void mods_item(const Ctx& a, int item, LAS float* sl) {
    int tid = threadIdx.x; asm volatile("" : "+v"(tid)); const int l = item / 48, nb = item % 48;
    LAS float* red = sl + 17 * 1024;
    for (int idx = tid; idx < 17 * 1024; idx += 512) { const int r = idx >> 10, k = idx & 1023; const float v = r < 16 ? a.inp(I_C)[r * 1024 + k] : a.inp(I_CCTX)[k]; sl[idx] = v / (1.0f + __expf(-v)); }
    __syncthreads();
    const int cn = tid & 127, ks = tid >> 7, n = 128 * nb + cn;
    float acc[17];
#pragma unroll
    for (int r = 0; r < 17; ++r) acc[r] = 0.f;
    const float* wp = a.inp(I_MODW) + ((size_t)l * 1024 + 256 * ks) * 6144 + n;
#pragma unroll 4
    for (int k = 0; k < 256; k += 4) {
        const float w0 = wp[(size_t)(k + 0) * 6144], w1 = wp[(size_t)(k + 1) * 6144], w2 = wp[(size_t)(k + 2) * 6144], w3 = wp[(size_t)(k + 3) * 6144];
#pragma unroll
        for (int r = 0; r < 17; ++r) { const f32x4 s4 = *(const LAS f32x4*)(sl + r * 1024 + 256 * ks + k); acc[r] += s4[0] * w0 + s4[1] * w1 + s4[2] * w2 + s4[3] * w3; }
    }
#pragma unroll
    for (int r = 0; r < 17; ++r) red[(ks * 17 + r) * 128 + cn] = acc[r];
    __syncthreads();
    float* mods = (float*)(a.ws + WS_MODS);
    for (int idx = tid; idx < 17 * 128; idx += 512) { const int r = idx >> 7, c2 = idx & 127;
        const float s = red[(0 * 17 + r) * 128 + c2] + red[(1 * 17 + r) * 128 + c2] + red[(2 * 17 + r) * 128 + c2] + red[(3 * 17 + r) * 128 + c2];
        mods[((size_t)l * 17 + r) * 6144 + 128 * nb + c2] = s + a.inp(I_MODB)[l * 6144 + 128 * nb + c2]; }
    __syncthreads();
}

__device__ __forceinline__ void norm_pass(const float* xsrc, const float* csrc, const float* g, const float* mods_l, int shift_idx, int scale_idx,
                                          bf16_t* U, bool ffn_layout, bool skip_ctx, int gw, int ngw, int lane) {
    for (int R0 = gw; R0 < T; R0 += 2 * ngw) {
        f32x4 v[2][4]; bool ok[2]; int bb[2], pp[2];
#pragma unroll
        for (int s = 0; s < 2; ++s) { const int R = R0 + s * ngw; const int b = R / TB, p = R % TB; const bool isctx = p < NCTX; bb[s] = b; pp[s] = p;
            ok[s] = (R < T) && !(isctx && skip_ctx);
            const float* src = isctx ? csrc + (size_t)(b * NCTX + p) * DM : xsrc + (size_t)(b * SEQ + p - NCTX) * DM;
            if (ok[s]) {
#pragma unroll
                for (int j = 0; j < 4; ++j) v[s][j] = *(const f32x4*)(src + (lane + 64 * j) * 4); } }
#pragma unroll
        for (int s = 0; s < 2; ++s) if (ok[s]) {
            const int R = R0 + s * ngw, b = bb[s], p = pp[s]; const bool isctx = p < NCTX;
            const float* mrow = mods_l + (size_t)(isctx ? 16 : b) * 6144;
            float ss = 0.f;
#pragma unroll
            for (int j = 0; j < 4; ++j) ss += (v[s][j][0] * v[s][j][0] + v[s][j][1] * v[s][j][1]) + (v[s][j][2] * v[s][j][2] + v[s][j][3] * v[s][j][3]);
            const float rs = rsqrtf(wave_sum(ss) * (1.0f / DM) + EPS);
            const size_t orow = ffn_layout ? (size_t)b * U2B + (isctx ? p : 264 + p - NCTX) : (size_t)R;
#pragma unroll
            for (int j = 0; j < 4; ++j) { const int c4 = (lane + 64 * j) * 4;
                const f32x4 gg = *(const f32x4*)(g + c4), sh = *(const f32x4*)(mrow + shift_idx * 1024 + c4), sc = *(const f32x4*)(mrow + scale_idx * 1024 + c4);
                const f32x4 y = v[s][j] * rs * gg * (sc + 1.0f) + sh;
                u32x2 w; w.x = cvt_pk_bf16(y[0], y[1]); w.y = cvt_pk_bf16(y[2], y[3]);
                *(u32x2*)(U + orow * DM + c4) = w;
                if (ffn_layout && !isctx && p - NCTX >= SEQ - 33) *(u32x2*)(U + ((size_t)TAILROW0 + (b / 7) * 256 + (b % 7) * TAILSEG + (p - NCTX - (SEQ - 33))) * DM + c4) = w; }
        }
    }
    if (ffn_layout && gw >= 32 && gw < 48) {
        const int tb_ = gw - 32; const size_t orow = (size_t)TAILROW0 + (tb_ / 7) * 256 + (tb_ % 7) * TAILSEG + 33;
#pragma unroll
        for (int j = 0; j < 4; ++j) *(u32x2*)(U + orow * DM + (lane + 64 * j) * 4) = (u32x2){0u, 0u};
    }
    if (ffn_layout && gw < 32) {
        const int b = gw >> 1; const size_t orow = (size_t)b * U2B + ((gw & 1) ? 264 + SEQ : 263);
#pragma unroll
        for (int j = 0; j < 4; ++j) *(u32x2*)(U + orow * DM + (lane + 64 * j) * 4) = (u32x2){0u, 0u};
    }
}

template <int NF> __device__ __forceinline__ void rope_cs(int pos, int i, float& cs, float& sn) {
    const int row = pos >> 6, col = pos & 63; const int f = i < NF ? i : i - NF;
    const float inv = exp2f(-(float)f * (13.287712379549449f / NF));
    const float ang = (float)(i < NF ? row : col) * inv;
    sincosf(ang, &sn, &cs);
}

__device__ __forceinline__ void unpack8(const u32x4 v, float (&x)[8]) {
#pragma unroll
    for (int i = 0; i < 4; ++i) { x[2 * i] = bflo(v[i]); x[2 * i + 1] = bfhi(v[i]); }
}
__device__ __forceinline__ u32x4 pack8f(const float (&x)[8]) { u32x4 o; o.x = cvt_pk_bf16(x[0], x[1]); o.y = cvt_pk_bf16(x[2], x[3]); o.z = cvt_pk_bf16(x[4], x[5]); o.w = cvt_pk_bf16(x[6], x[7]); return o; }

__device__ __forceinline__ void ew_even(const Ctx& a, int j, int gw, int ngw, int lane) {
    const bf16_t* H = (const bf16_t*)(a.ws + WS_H); bf16_t* Qb = (bf16_t*)(a.ws + WS_Q); bf16_t* KVb = (bf16_t*)(a.ws + WS_KV); bf16_t* Kout = (bf16_t*)(a.ws + WS_U);
    const float QS = 0.10206207261596577f * LOG2E;
    const f32x2v* ropeT = (const f32x2v*)(a.ws + WS_ROPE_E);
    const int g16 = lane >> 4, c16 = lane & 15; const bool act = c16 < 12; const int cc = act ? c16 : 0;
    float qg[8], kg[8];
#pragma unroll
    for (int e = 0; e < 8; ++e) { qg[e] = a.inp(I_QG)[j * 96 + 8 * cc + e]; kg[e] = a.inp(I_KG)[j * 96 + 8 * cc + e]; }
    for (int R = gw; R < T; R += ngw) {
        const int p = R % TB; const int pos = p - NCTX; const bool lat = pos >= 0;
        const bf16_t* hrow = H + (size_t)R * 768; bf16_t* qrow = Qb + (size_t)R * 1536; bf16_t* kvrow = KVb + (size_t)R * 1536;
        const u32x4 z4 = {0u, 0u, 0u, 0u};
        u32x4 hv = z4; if (lane < 48) hv = *(const u32x4*)(hrow + 8 * lane);
        u32x4 qv[3], kv[3], vv[2];
#pragma unroll
        for (int rd = 0; rd < 3; ++rd) { const int hd = 4 * rd + g16; qv[rd] = z4; kv[rd] = z4;
            if (act) { kv[rd] = c16 < 8 ? *(const u32x4*)(kvrow + hd * 128 + 8 * c16) : *(const u32x4*)(hrow + 384 + 8 * (c16 - 8)); } }
        vv[0] = *(const u32x4*)(kvrow + (lane >> 3) * 128 + 64 + 8 * (lane & 7)); vv[1] = z4;
        if (lane < 32) vv[1] = *(const u32x4*)(kvrow + ((lane + 64) >> 3) * 128 + 64 + 8 * (lane & 7));
        float cs[8], sn[8];
#pragma unroll
        for (int e = 0; e < 8; ++e) { cs[e] = 1.f; sn[e] = 0.f; }
        if (lat && c16 >= 8 && act) {
#pragma unroll
            for (int e = 0; e < 8; ++e) { const f32x2v t = ropeT[pos * 16 + 8 * (c16 & 1) + e]; cs[e] = t.x; sn[e] = t.y; } }
        float x[8]; unpack8(hv, x); float ss = 0.f;
#pragma unroll
        for (int e = 0; e < 8; ++e) ss += x[e] * x[e];
        ss = half_sum(ss);
        const float r_q = rsqrtf(__shfl(ss, 0) * (1.0f / 256.0f) + EPS), r_kv = rsqrtf(__shfl(ss, 32) * (1.0f / 128.0f) + EPS);
        if (lane == 0) ((float*)(a.ws + WS_RQ))[R] = r_q;
#pragma unroll
        for (int rd = 0; rd < 3; ++rd) {
            const int hd = 4 * rd + g16;
            { float y[8], o[8]; unpack8(kv[rd], y); float s2 = 0.f; const float pre = c16 < 8 ? r_kv : 1.0f;
#pragma unroll
              for (int e = 0; e < 8; ++e) { y[e] *= pre; s2 += y[e] * y[e]; }
              s2 += __shfl_xor(s2, 8); s2 += __shfl_xor(s2, 4); s2 += __shfl_xor(s2, 2); s2 += __shfl_xor(s2, 1);
              const float sc = rsqrtf(s2 * (1.0f / 96.0f) + EPS);
#pragma unroll
              for (int e = 0; e < 8; ++e) { y[e] *= sc * kg[e]; o[e] = __shfl_xor(y[e], 2); }
              if (c16 >= 8) {
#pragma unroll
                  for (int e = 0; e < 8; ++e) y[e] = c16 < 10 ? y[e] * cs[e] - o[e] * sn[e] : o[e] * sn[e] + y[e] * cs[e]; }
              if (act) *(u32x4*)(Kout + (size_t)R * 1152 + hd * 96 + 8 * c16) = pack8f(y); }
        }
        { float y[8]; unpack8(vv[0], y);
#pragma unroll
          for (int e = 0; e < 8; ++e) y[e] *= r_kv;
          *(u32x4*)(kvrow + (lane >> 3) * 128 + 64 + 8 * (lane & 7)) = pack8f(y);
          if (lane < 32) { unpack8(vv[1], y);
#pragma unroll
              for (int e = 0; e < 8; ++e) y[e] *= r_kv;
              *(u32x4*)(kvrow + ((lane + 64) >> 3) * 128 + 64 + 8 * (lane & 7)) = pack8f(y); } }
    }
}

__device__ __forceinline__ void z_fold(const Ctx& a, LAS unsigned char* lds, int gw, int ngw, int wave, int lane) {
    const bf16_t* ZLp = (const bf16_t*)(a.ws + WS_ZL); bf16_t* ZF = (bf16_t*)(a.ws + WS_ZF);
    LAS bf16_t* zr = (LAS bf16_t*)(lds + wave * 16384);
    for (int row = gw; row < 4096; row += ngw) {
        const bf16_t* src = ZLp + (size_t)row * 8192;
#pragma unroll
        for (int i = 0; i < 16; ++i) *(LAS u32x4*)(zr + 8 * (lane + 64 * i)) = *(const u32x4*)(src + 8 * (lane + 64 * i));
        asm volatile("s_waitcnt lgkmcnt(0)" ::: "memory");
#pragma unroll
        for (int i = 0; i < 8; ++i) { const int k0 = 8 * (lane + 64 * i); float y[8];
#pragma unroll
            for (int e = 0; e < 8; ++e) { const int kap = k0 + e; float v;
                if (kap <= 2048) { v = bf2f(zr[kap]); if (kap != 0 && kap != 2048) v += bf2f(zr[4096 - kap]); }
                else { const int l = kap - 2048; v = bf2f(zr[4096 + l]) - bf2f(zr[8192 - l]); }
                y[e] = v; }
            *(u32x4*)(ZF + (size_t)row * 4096 + k0) = pack8f(y); }
        asm volatile("s_waitcnt lgkmcnt(0)" ::: "memory");
    }
}

__device__ __forceinline__ void ew_odd(const Ctx& a, int j, int gw, int ngw, int lane) {
    bf16_t* H = (bf16_t*)(a.ws + WS_H); bf16_t* PO = (bf16_t*)(a.ws + WS_POOL);
    const float QS = 0.125f * LOG2E;
    const f32x2v* ropeT = (const f32x2v*)(a.ws + WS_ROPE_O);
    const int c8 = lane & 7, hl = lane >> 3;
    float qg[8], kg[8];
#pragma unroll
    for (int e = 0; e < 8; ++e) { qg[e] = a.inp(I_WQG)[j * 64 + 8 * c8 + e]; kg[e] = a.inp(I_WKG)[j * 64 + 8 * c8 + e]; }
    for (int R = gw; R < T; R += ngw) {
        const int p = R % TB; const int pos = p - NCTX; const bool lat = pos >= 0;
        bf16_t* hrow = H + (size_t)R * 1536;
        u32x4 qk[2]; qk[1] = (u32x4){0u, 0u, 0u, 0u}; if (lane >= 32) qk[1] = *(const u32x4*)(hrow + 512 + 8 * lane);
        float cs[8], sn[8];
#pragma unroll
        for (int e = 0; e < 8; ++e) { cs[e] = 1.f; sn[e] = 0.f; }
        if (lat) {
#pragma unroll
            for (int e = 0; e < 8; ++e) { const f32x2v t = ropeT[pos * 32 + 8 * (c8 & 3) + e]; cs[e] = t.x; sn[e] = t.y; } }
        const int tpos = lat ? pos : p, Ls = lat ? SEQ : NCTX;
        { const int pc = lane & 31, g = pc >> 3, half = 1 << g;
          const int lo = tpos - half < 0 ? 0 : tpos - half, hi = tpos + half > Ls ? Ls : tpos + half;
          float sum[8];
#pragma unroll
          for (int e = 0; e < 8; ++e) sum[e] = 0.f;
          if (lane < 32) {
              for (int tt = lo; tt < hi; ++tt) { float z[8]; unpack8(*(const u32x4*)(hrow + (ptrdiff_t)(tt - tpos) * 1536 + 1280 + 8 * pc), z);
#pragma unroll
                  for (int e = 0; e < 8; ++e) sum[e] += z[e]; }
              const float rc = 1.0f / (float)(hi - lo); float z[8]; unpack8(*(const u32x4*)(hrow + 1280 + 8 * pc), z);
#pragma unroll
              for (int e = 0; e < 8; ++e) sum[e] = sum[e] * rc - z[e];
              *(u32x4*)(PO + (size_t)R * 256 + 8 * pc) = pack8f(sum); } }
        if (lane >= 32) {
            float y[8], o[8]; unpack8(qk[1], y); float s2 = 0.f;
#pragma unroll
            for (int e = 0; e < 8; ++e) s2 += y[e] * y[e];
            s2 += __shfl_xor(s2, 4); s2 += __shfl_xor(s2, 2); s2 += __shfl_xor(s2, 1);
            const float sc = rsqrtf(s2 * (1.0f / 64.0f) + EPS);
#pragma unroll
            for (int e = 0; e < 8; ++e) { y[e] *= sc * kg[e]; o[e] = __shfl_xor(y[e], 4); }
#pragma unroll
            for (int e = 0; e < 8; ++e) y[e] = c8 < 4 ? y[e] * cs[e] - o[e] * sn[e] : o[e] * sn[e] + y[e] * cs[e];
            *(u32x4*)(hrow + 512 + 8 * lane) = pack8f(y);
        }
    }
}

#define XB_TMO      128
#define XB_XCNT(j)  (256  + 64 * (j))
#define XB_XSUB(j)  (1280 + 64 * (j))
#define XB_XGEN(j)  (2304 + 64 * (j))
#define XB_TOP      3328
#define XB_TOPGEN   3392
#define XCD_BAR_WORDS 3456
#define XB_SPIN_CAP (1u << 18)
__device__ __forceinline__ unsigned xb_ld(unsigned* p)              { return __hip_atomic_load(p, __ATOMIC_RELAXED, __HIP_MEMORY_SCOPE_AGENT); }
__device__ __forceinline__ unsigned xb_add(unsigned* p, unsigned v) { return __hip_atomic_fetch_add(p, v, __ATOMIC_RELAXED, __HIP_MEMORY_SCOPE_AGENT); }
__device__ __forceinline__ unsigned xb_xcc_id() { return (unsigned)__builtin_amdgcn_s_getreg((3 << 11) | 20) & 0xFu; }
#define XB_SPIN(cond, bar) do { unsigned _sp = 0; while (cond) { __builtin_amdgcn_s_sleep(1); \
    if ((++_sp & 255u) == 0u) { if (xb_ld(&(bar)[XB_TMO])) break; if (_sp > XB_SPIN_CAP) { atomicAdd(&(bar)[XB_TMO], 1u); break; } } } } while (0)
struct XcdBarrier { unsigned* bar; unsigned x; volatile LAS unsigned* st; };
__device__ __forceinline__ XcdBarrier xcd_barrier_post(unsigned* bar, volatile LAS unsigned* st) {
    XcdBarrier b; b.bar = bar; b.x = xb_xcc_id(); b.st = st;
    int tid_ = threadIdx.x; asm volatile("" : "+v"(tid_));
    if (tid_ == 0) (void)xb_add(&bar[XB_XCNT(b.x)], 1u);
    return b;
}
__device__ __forceinline__ void xcd_barrier_complete(unsigned* bar, unsigned x, unsigned& nloc, unsigned& nx) {
    const unsigned G = gridDim.x * gridDim.y * gridDim.z;
    unsigned sum, cnt, mine, sp = 0u;
    for (;;) {
        sum = 0u; cnt = 0u; mine = 0u;
#pragma unroll
        for (unsigned j = 0; j < 16; ++j) { const unsigned c = xb_ld(&bar[XB_XCNT(j)]); sum += c; cnt += (c > 0u) ? 1u : 0u; mine = (j == x) ? c : mine; }
        if (sum == G) break;
        __builtin_amdgcn_s_sleep(1);
        if ((++sp & 255u) == 0u) { if (xb_ld(&bar[XB_TMO])) break; if (sp > XB_SPIN_CAP) { atomicAdd(&bar[XB_TMO], 1u); break; } }
    }
    nloc = mine > 0u ? mine : 1u; nx = cnt > 0u ? cnt : 1u;
}
__device__ __forceinline__ void xcd_barrier(const XcdBarrier& b) {
    asm volatile("s_waitcnt vmcnt(0)" ::: "memory");
    __syncthreads();
    int tid_ = threadIdx.x; asm volatile("" : "+v"(tid_));
    if (tid_ == 0) {
        unsigned* bar = b.bar;
        __builtin_amdgcn_s_waitcnt(0);
        unsigned nloc = b.st[0], nx = b.st[1];
        if (nloc == 0u) { xcd_barrier_complete(bar, b.x, nloc, nx); b.st[0] = nloc; b.st[1] = nx; }
        const unsigned old = xb_add(&bar[XB_XSUB(b.x)], 1u);
        const unsigned gen = old / nloc;
        if (old + 1u == (gen + 1u) * nloc) {
            __builtin_amdgcn_fence(__ATOMIC_RELEASE, "agent");
            asm volatile("s_waitcnt vmcnt(0)" ::: "memory");
            const unsigned og = xb_add(&bar[XB_TOP], 1u);
            const unsigned tg = og / nx;
            if (og + 1u == (tg + 1u) * nx) xb_add(&bar[XB_TOPGEN], 1u);
            else XB_SPIN(xb_ld(&bar[XB_TOPGEN]) == tg, bar);
            __builtin_amdgcn_fence(__ATOMIC_ACQUIRE, "agent");
            xb_add(&bar[XB_XGEN(b.x)], 1u);
            asm volatile("s_waitcnt vmcnt(0)" ::: "memory");
        } else {
            XB_SPIN(xb_ld(&bar[XB_XGEN(b.x)]) == gen, bar);
            __builtin_amdgcn_fence(__ATOMIC_ACQUIRE, "agent");
            asm volatile("s_waitcnt vmcnt(0)" ::: "memory");
        }
    }
    __syncthreads();
}

constexpr int LDS_BYTES = 147456;
constexpr int NPHASES = 1 + 2 * 9 + 2 * 8;

__global__ void __launch_bounds__(512, 2) mega_fwd(Args ka) {
    extern __shared__ __attribute__((aligned(16))) unsigned char lds_raw[];
    LAS unsigned char* lds = (LAS unsigned char*)lds_raw;
    cg::grid_group grid = cg::this_grid();
    volatile LAS unsigned* xbst = (volatile LAS unsigned*)(lds + 139264);
    { int tid_ = threadIdx.x; asm volatile("" : "+v"(tid_)); if (tid_ < 2) xbst[tid_] = 0u; }
    __syncthreads();
    XcdBarrier xbar; xbar.bar = (unsigned*)ka.ws; xbar.x = 0; xbar.st = xbst;
    if (ka.hi - ka.lo > 1) xbar = xcd_barrier_post((unsigned*)ka.ws, xbst);
#define U ((bf16_t*)(wsl + WS_U))
#define MIX ((bf16_t*)(wsl + WS_MIX))
#define Hb ((bf16_t*)(wsl + WS_H))
#define Qb ((bf16_t*)(wsl + WS_Q))
#define KVb ((bf16_t*)(wsl + WS_KV))
#define ZL ((bf16_t*)(wsl + WS_ZL))
#define ZC ((bf16_t*)(wsl + WS_ZC))
#define HID ((bf16_t*)(wsl + WS_HID))
#define POOL ((bf16_t*)(wsl + WS_POOL))
#define DFTL ((bf16_t*)(wsl + WS_DFTL))
#define DFTC ((bf16_t*)(wsl + WS_DFTC))
#define hctx ((float*)(wsl + WS_HCTX))
    int ph = 0, layer_ = 0;
#define PHASE_BEGIN if (ph >= ka.lo && ph < ka.hi) { GAS unsigned char* wsg_ = (GAS unsigned char*)ka.ws; asm volatile("" : "+s"(wsg_)); unsigned char* wsl = (unsigned char*)wsg_; \
        const __attribute__((address_space(4))) cfp_t* ain_ = (const __attribute__((address_space(4))) cfp_t*)__builtin_amdgcn_kernarg_segment_ptr(); asm volatile("" : "+s"(ain_)); \
        const Ctx a{ain_, ka.out, wsl}; \
        int lyr_ = layer_; asm volatile("" : "+s"(lyr_)); const float* mods_l = (const float*)(wsl + WS_MODS) + (size_t)lyr_ * 17 * 6144; const float* xin = lyr_ == 0 ? a.inp(I_X) : a.out; const float* cin = lyr_ == 0 ? a.inp(I_CTX) : (const float*)(wsl + WS_HCTX); (void)mods_l; (void)xin; (void)cin; int tid = threadIdx.x; asm volatile("" : "+v"(tid)); int G = gridDim.x, bx = blockIdx.x; asm volatile("" : "+s"(G), "+s"(bx)); \
        const int vcu = (G % 8 == 0) ? (bx % 8) * (G / 8) + bx / 8 : bx, ngw = G * 8, ngt = G * 512; (void)vcu; (void)ngw; (void)ngt; \
        const int lane = tid & 63, wave = __builtin_amdgcn_readfirstlane(tid >> 6), gw = bx * 8 + wave, gtid = bx * 512 + tid; LAS float* scr = (LAS float*)(lds + wave * 8448); \
        (void)lane; (void)gw; (void)gtid; (void)scr;
#define PHASE_END } if (ph >= ka.lo && ph + 1 < ka.hi) { for (int sr_ = 0; sr_ < REP_SYNC; ++sr_) { if (ph == 0) grid.sync(); else xcd_barrier(xbar); } } ++ph;

    PHASE_BEGIN
#ifndef SKIP_P0
        { REPLOOP(REP_P0) {
        for (int it = bx; it < 192; it += G) mods_item(a, it, (LAS float*)lds);
        mixer_weights(a, 0, scr, gw, ngw, lane);
        __syncthreads();
        LAS float* ctab = (LAS float*)lds;
        for (int m = tid; m < 4096; m += 512) ctab[m] = cospif((float)m * (1.0f / 2048.0f)) * (1.0f / 64.0f);
        __syncthreads();
        for (int idx = gtid; idx < 4096 * 512; idx += ngt) { const int k = idx >> 9, col0 = (idx & 511) * 8; float v[8];
#pragma unroll
            for (int e = 0; e < 8; ++e) { const int kap = col0 + e; const int m = kap <= 2048 ? (k * kap) & 4095 : (k * (kap - 2048) + 1024) & 4095; v[e] = ctab[m]; }
            u32x4 o; o.x = cvt_pk_bf16(v[0], v[1]); o.y = cvt_pk_bf16(v[2], v[3]); o.z = cvt_pk_bf16(v[4], v[5]); o.w = cvt_pk_bf16(v[6], v[7]);
            *(u32x4*)(DFTL + (size_t)k * 4096 + col0) = o; }
        for (int idx = gtid; idx < 256 * 64; idx += ngt) { const int k = idx >> 6, col0 = (idx & 63) * 8, cs = col0 >> 8, l0 = col0 & 255; float v[8];
#pragma unroll
            for (int e = 0; e < 8; ++e) { const int m = (k * (l0 + e)) & 255; const float x = (float)m * (1.0f / 128.0f); v[e] = (cs ? -sinpif(x) : cospif(x)) * (1.0f / 16.0f); }
            u32x4 o; o.x = cvt_pk_bf16(v[0], v[1]); o.y = cvt_pk_bf16(v[2], v[3]); o.z = cvt_pk_bf16(v[4], v[5]); o.w = cvt_pk_bf16(v[6], v[7]);
            *(u32x4*)(DFTC + (size_t)k * 512 + col0) = o; }
        for (int idx = gtid; idx < 2 * 512 * 256; idx += ngt) { const int j = idx >> 17, n = (idx >> 8) & 511, k = idx & 255; const int cs = n >> 8, g = (n >> 6) & 3, d = n & 63, g2 = k >> 6, c = k & 63;
            float s = 0.f;
            if (g2 == g) { const float* wf = a.inp(I_FNETW) + ((size_t)(j * 4 + g) * 64) * 64 + d;
                for (int c2 = 0; c2 < 64; ++c2) { const int m = (c * c2) & 63; s += (cs ? -ctab[(m * 64 + 1024) & 4095] : ctab[m * 64]) * wf[c2 * 64]; }
                s *= 8.0f; }
            ((bf16_t*)(wsl + WS_WF))[idx] = (bf16_t)(cvt_pk_bf16(s, 0.f) & 0xffffu); }
        for (int idx = gtid; idx < 4096 * 16; idx += ngt) { float cs, sn; rope_cs<8>(idx >> 4, idx & 15, cs, sn); ((f32x2v*)(wsl + WS_ROPE_E))[idx] = (f32x2v){cs, sn}; }
        for (int idx = gtid; idx < 4096 * 32; idx += ngt) { float cs, sn; rope_cs<16>(idx >> 5, idx & 31, cs, sn); ((f32x2v*)(wsl + WS_ROPE_O))[idx] = (f32x2v){cs, sn}; }
        for (int idx = gtid; idx < 2 * 256 * 256; idx += ngt) { const int j = idx >> 16, n = (idx >> 8) & 255, k = idx & 255; const int g = n >> 6, d = n & 63, g2 = k >> 6, c = k & 63;
            float s = 0.f; if (g2 == g) s = a.inp(I_POOLW)[((size_t)(j * 4 + g) * 64 + c) * 64 + d] * a.inp(I_POOLS)[j * 256 + n];
            ((bf16_t*)(wsl + WS_WP))[idx] = (bf16_t)(cvt_pk_bf16(s, 0.f) & 0xffffu); }
        __syncthreads(); } }
#endif
    PHASE_END

    for (int layer = 0; layer < 4; ++layer) {
        const int j = layer >> 1; const bool even = !(layer & 1); const bool ctx_out = layer < 3;
        layer_ = layer;

        PHASE_BEGIN
#ifndef SKIP_NORM
            { REPLOOP(REP_NORM)
            norm_pass(xin, cin, a.inp(I_N1G) + layer * DM, mods_l, 0, 1, U, false, false, gw, ngw, lane); }
#endif
        PHASE_END

        PHASE_BEGIN
#ifndef SKIP_GIN
            { REPLOOP(REP_GIN) {
            if (even) { pg8::Gemm g{U, (const bf16_t*)(wsl + WS_WINE) + (size_t)j * 768 * DM, DM, DM, DM};
                pg8::Order<pg8::MapStd> S; S.init(T / 256, 3, G, bx, pg8::MapStd{0}); pg8::EpiBf16 E{Hb, 768, Hb, 768}; pg8::gemm_phase(lds, g, S, E); }
            else { pg8::Gemm g{U, (const bf16_t*)(wsl + WS_WINO) + (size_t)j * 1536 * DM, DM, DM, DM};
                pg8::Order<pg8::MapStd> S; S.init(T / 256, 6, G, bx, pg8::MapStd{0}); pg8::EpiBf16 E{Hb, 1536, Hb, 1536}; pg8::gemm_phase(lds, g, S, E); }
            } }
#endif
        PHASE_END

        if (even) {
            PHASE_BEGIN
#ifndef SKIP_G3
                { REPLOOP(REP_G3) {
                { pg8::Gemm g{Hb, (const bf16_t*)(wsl + WS_WUQ) + (size_t)j * 1536 * 256, 768, 256, 256};
                  pg8::Order<pg8::MapStd> S; S.init(T / 256, 6, G, bx, pg8::MapStd{0}); pg8::EpiBf16 E{Qb, 1536, Qb, 1536}; pg8::gemm_phase(lds, g, S, E); }
                { pg8::Gemm g{Hb + 256, (const bf16_t*)(wsl + WS_WUKV) + (size_t)j * 1536 * 128, 768, 128, 128};
                  pg8::Order<pg8::MapStd> S; S.init(T / 256, 6, G, bx, pg8::MapStd{0}); pg8::EpiBf16 E{KVb, 1536, KVb, 1536}; pg8::gemm_phase(lds, g, S, E); }
                { pg8::Gemm g{(const bf16_t*)(wsl + WS_WF) + (size_t)j * 512 * 256, Hb + 416, 256, 768, 256};
                  pg8::Order<pg8::MapZ> S; S.init(2, T / 256, G, bx, pg8::MapZ{}); pg8::EpiBf16 E{ZL, 8192, ZC, 512}; pg8::gemm_phase(lds, g, S, E); }
                } }
#endif
            PHASE_END
            PHASE_BEGIN
#ifndef SKIP_EWE
                ew_even(a, j, gw, ngw, lane);
                z_fold(a, lds, gw, ngw, wave, lane);
#endif
            PHASE_END
            PHASE_BEGIN
#ifndef SKIP_ATTE
                const bf16_t* Kb = (const bf16_t*)(wsl + WS_U);
                const int nu = 3072 + (ctx_out ? 192 : 0);
                { REPLOOP(REP_ATTE)
                for (int uid = vcu; uid < nu; uid += G) {
                    if (uid < 3072) { const int bh = uid >> 4, qb = uid & 15, b = bh / 12, h = bh % 12; const size_t base = (size_t)b * TB, qrow = base + NCTX + qb * 256;
                        attn_unit<96, false>(lds, Qb + qrow * 1536 + h * 128, 1536, Kb + base * 1152 + h * 96, 1152, KVb + base * 1536 + h * 128 + 64, 1536, MIX + qrow * DM + h * 64, 68, 0, 0, qb * 256, -1e30f, false, a.inp(I_QG) + j * 96, (const f32x2v*)(wsl + WS_ROPE_E), true, (const float*)(wsl + WS_RQ) + qrow); }
                    else { const int bh = uid - 3072, b = bh / 12, h = bh % 12; const size_t base = (size_t)b * TB;
                        attn_unit<96, false>(lds, Qb + base * 1536 + h * 128, 1536, Kb + base * 1152 + h * 96, 1152, KVb + base * 1536 + h * 128 + 64, 1536, MIX + base * DM + h * 64, 4, 0, 0, 0, -1e30f, false, a.inp(I_QG) + j * 96, (const f32x2v*)(wsl + WS_ROPE_E), false, (const float*)(wsl + WS_RQ) + base); }
                } }
#ifndef SKIP_ATTE_G
                { REPLOOP(REP_FNET) {
                { pg8::Gemm g{DFTL, (const bf16_t*)(wsl + WS_ZF), 4096, 4096, 4096};
                  pg8::Order<pg8::MapFnetL> S; S.init(256, 1, G, bx, pg8::MapFnetL{}); pg8::EpiBf16 E{MIX, DM, MIX, DM}; pg8::gemm_phase(lds, g, S, E); }
                if (ctx_out) { pg8::Gemm g{DFTC, ZC, 512, 512, 512};
                  pg8::Order<pg8::MapFnetC> S; S.init(16, 1, G, bx, pg8::MapFnetC{}); pg8::EpiBf16 E{MIX, DM, MIX, DM}; pg8::gemm_phase(lds, g, S, E); }
                } }
#endif
#endif
            PHASE_END
        } else {
            PHASE_BEGIN
#ifndef SKIP_EWO
                ew_odd(a, j, gw, ngw, lane);
#endif
            PHASE_END
            PHASE_BEGIN
#ifndef SKIP_ATTO
                const float* sink = a.inp(I_SINK) + j * 12;
                const int nu = 3072 + (ctx_out ? 192 : 0);
                { REPLOOP(REP_ATTO)
                for (int uid = vcu; uid < nu; uid += G) {
                    if (uid < 3072) { const int bh = uid >> 4, qb = uid & 15, b = bh / 12, h = bh % 12, kvh = h / 3; const size_t base = (size_t)b * TB, qrow = base + NCTX + qb * 256;
                        int lt0 = qb * 4 - 2, lt1 = qb * 4 + 6; if (lt0 < 0) lt0 = 0; if (lt1 > 64) lt1 = 64;
                        attn_unit<64, true>(lds, Hb + qrow * 1536 + h * 64, 1536, Hb + base * 1536 + 768 + kvh * 64, 1536, Hb + base * 1536 + 1024 + kvh * 64, 1536, MIX + qrow * DM + h * 64,
                                            4, 4 + lt0, 4 + lt1, qb * 256, sink[h] * LOG2E, true, a.inp(I_WQG) + j * 64, (const f32x2v*)(wsl + WS_ROPE_O), true); }
                    else { const int bh = uid - 3072, b = bh / 12, h = bh % 12, kvh = h / 3; const size_t base = (size_t)b * TB;
                        attn_unit<64, true>(lds, Hb + base * 1536 + h * 64, 1536, Hb + base * 1536 + 768 + kvh * 64, 1536, Hb + base * 1536 + 1024 + kvh * 64, 1536, MIX + base * DM + h * 64,
                                            4, 0, 0, 0, sink[h] * LOG2E, true, a.inp(I_WQG) + j * 64, (const f32x2v*)(wsl + WS_ROPE_O), false); }
                } }
                { pg8::Gemm g{POOL, (const bf16_t*)(wsl + WS_WP) + (size_t)j * 256 * 256, 256, 256, 256};
                  pg8::Order<pg8::MapStd> S; S.init(T / 256, 1, G, bx, pg8::MapStd{768}); pg8::EpiBf16 E{MIX, DM, MIX, DM}; pg8::gemm_phase(lds, g, S, E); }
#endif
            PHASE_END
        }

        PHASE_BEGIN
#ifndef SKIP_WOUT
            pg8::Gemm g{MIX, (const bf16_t*)(wsl + (even ? WS_WOUTE : WS_WOUTO)) + (size_t)j * DM * DM, DM, DM, DM};
            pg8::Order<pg8::MapRes> S; S.init(ctx_out ? 272 : 256, 4, G, bx, pg8::MapRes{ctx_out ? 1 : 0});
            { REPLOOP(REP_WOUT) { pg8::EpiRes E{rep_ ? (const float*)a.out : xin, a.out, rep_ ? (const float*)hctx : cin, hctx, mods_l, 2, rep_ ? 0.f : 1.f}; pg8::gemm_phase(lds, g, S, E); } }
            if (layer == 0) {
                const int nfree = (G == 256) ? 192 : G, first = (G == 256) ? 64 : 0;
                if (bx >= first) ffn_weights(a, 0, scr, (bx - first) * 8 + wave, nfree * 8, lane);
            }
#endif
        PHASE_END

        PHASE_BEGIN
#ifndef SKIP_NORM2
            { REPLOOP(REP_NORM)
            norm_pass(a.out, hctx, a.inp(I_N2G) + layer * DM, mods_l, 3, 4, U, true, !ctx_out, gw, ngw, lane); }
#endif
        PHASE_END

        PHASE_BEGIN
#ifndef SKIP_UP
            pg8::Gemm g{U, (const bf16_t*)(wsl + WS_WUP), DM, DM, DM};
            pg8::Order<pg8::MapUp> S; S.init(ctx_out ? 275 : 259, 22, G, bx, pg8::MapUp{ctx_out ? 1 : 0});
            pg8::EpiUp E{HID, a.inp(I_CONVW) + (size_t)layer * 3 * 2 * DFF, a.inp(I_CONVB) + (size_t)layer * 2 * DFF}; { REPLOOP(REP_UP) pg8::gemm_phase(lds, g, S, E); }
#endif
        PHASE_END

        PHASE_BEGIN
#ifndef SKIP_DN
            pg8::Gemm g{HID, (const bf16_t*)(wsl + ((layer & 1) ? WS_WDN2 : WS_WDN)), DFF, DFF, DFF};
            pg8::Order<pg8::MapRes> S; S.init(ctx_out ? 272 : 256, 4, G, bx, pg8::MapRes{ctx_out ? 1 : 0});
            { REPLOOP(REP_DN) { pg8::EpiRes E{a.out, a.out, hctx, hctx, mods_l, 5, rep_ ? 0.f : 1.f}; pg8::gemm_phase(lds, g, S, E); } }
            if (layer < 3) {
                const int nfree = (ctx_out && G == 256) ? 192 : G, first = (ctx_out && G == 256) ? 64 : 0;
                if (bx >= first) ffn_weights(a, layer + 1, scr, (bx - first) * 8 + wave, nfree * 8, lane);
                if (layer == 0 && bx >= first) mixer_weights(a, 1, scr, (bx - first) * 8 + wave, nfree * 8, lane);
            }
#endif
        PHASE_END
    }
#undef PHASE_BEGIN
#undef PHASE_END
#undef U
#undef MIX
#undef Hb
#undef Qb
#undef KVb
#undef ZL
#undef ZC
#undef HID
#undef POOL
#undef DFTL
#undef DFTC
#undef hctx
}

extern "C" void kernel_launch(void* const* d_in, const int* in_sizes, int n_in, void* d_out, int out_size, void* d_ws, size_t ws_size, hipStream_t stream) {
    static int grid = 0;
    if (grid == 0) {
        if (n_in != 28 || out_size != NB * SEQ * DM || ws_size < WS_END) { fprintf(stderr, "kernel_launch: unexpected shapes (n_in %d, out %d, ws %zu); nothing launched\n", n_in, out_size, ws_size); grid = -1; return; }
        int dev = 0, cus = 0, per_cu = 0;
        if (hipGetDevice(&dev) != hipSuccess || hipDeviceGetAttribute(&cus, hipDeviceAttributeMultiprocessorCount, dev) != hipSuccess) { grid = -1; return; }
        if (hipFuncSetAttribute((const void*)mega_fwd, hipFuncAttributeMaxDynamicSharedMemorySize, LDS_BYTES) != hipSuccess) { fprintf(stderr, "kernel_launch: hipFuncSetAttribute failed\n"); grid = -1; return; }
        if (hipOccupancyMaxActiveBlocksPerMultiprocessor(&per_cu, (const void*)mega_fwd, 512, LDS_BYTES) != hipSuccess || per_cu < 1) { fprintf(stderr, "kernel_launch: occupancy query says %d\n", per_cu); per_cu = 1; }
        (void)hipGetLastError();
        grid = cus * 1;
    }
    if (grid < 0) return;
    Args a{};
    for (int i = 0; i < 28; ++i) a.in[i] = (const float*)d_in[i];
    a.out = (float*)d_out; a.ws = (unsigned char*)d_ws; a.lo = 0; a.hi = NPHASES;
    (void)hipMemsetAsync(d_ws, 0, 16384, stream);
    void* args[] = {&a};
    hipError_t e = hipLaunchCooperativeKernel((const void*)mega_fwd, dim3(grid), dim3(512), args, LDS_BYTES, stream);
    if (e != hipSuccess) {
        fprintf(stderr, "kernel_launch: cooperative launch failed: %s (grid %d); falling back to one launch per phase\n", hipGetErrorString(e), grid);
        (void)hipGetLastError();
        for (int p = 0; p < NPHASES; ++p) { a.lo = p; a.hi = p + 1; hipLaunchKernelGGL(mega_fwd, dim3(grid), dim3(512), LDS_BYTES, stream, a); }
    }
}
```

```cpp
#include <hip/hip_runtime.h>
#include <hip/hip_cooperative_groups.h>
#include <cstdio>
#include <cstdint>
namespace cg = cooperative_groups;

#define REP_NORM 1
#define REP_GIN 1
#define REP_G3 1
#define REP_ATTE 1
#define REP_FNET 1
#define REP_ATTO 1
#define REP_WOUT 1
#define REP_UP 1
#define REP_DN 1
#define REP_P0 1
#define REP_EW 1
#define REP_SYNC 1
#define PROBE_MODE 0
#define REPLOOP(N) int nrep_ = (N); asm volatile("" : "+s"(nrep_)); for (int rep_ = 0; rep_ < nrep_; ++rep_)

constexpr int NB = 16, SEQ = 4096, NCTX = 256, DM = 1024, TB = SEQ + NCTX, T = NB * TB;
constexpr int DFF = 2816, U2B = 4608, TAILROW0 = 16 * 4608, TAILSEG = 34;
constexpr float EPS = 1e-6f;
constexpr float LOG2E = 1.4426950408889634f;

constexpr size_t MiB = 1u << 20;
constexpr size_t WS_MODS = 1 * MiB;
constexpr size_t WS_RQ = 2 * MiB + 720 * 1024;
constexpr size_t WS_WINE = 3 * MiB;
constexpr size_t WS_WUQ = 6 * MiB;
constexpr size_t WS_WUKV = WS_WUQ + 3 * MiB / 2;
constexpr size_t WS_WF = WS_WUKV + 3 * MiB / 4;
constexpr size_t WS_WP = WS_WF + MiB / 2;
constexpr size_t WS_WOUTE = 9 * MiB;
constexpr size_t WS_WOUTO = 13 * MiB;
constexpr size_t WS_WINO = 17 * MiB;
constexpr size_t WS_WUP = 23 * MiB;
constexpr size_t WS_WDN = 34 * MiB;
constexpr size_t WS_DFTC = 40 * MiB;
constexpr size_t WS_DFTL = 41 * MiB;
constexpr size_t WS_ZF = 73 * MiB;
constexpr size_t WS_HCTX = 105 * MiB;
constexpr size_t WS_U = 121 * MiB;
constexpr size_t WS_MIX = 275 * MiB;
constexpr size_t WS_ARENA = 411 * MiB;
constexpr size_t WS_H = WS_ARENA;
constexpr size_t WS_Q = WS_ARENA + 102 * MiB;
constexpr size_t WS_KV = WS_Q + 204 * MiB;
constexpr size_t WS_ZL = WS_KV + 204 * MiB;
constexpr size_t WS_ZC = WS_ZL + 64 * MiB;
constexpr size_t WS_POOL = WS_ARENA + 204 * MiB;
constexpr size_t WS_HID = WS_ARENA;
constexpr size_t WS_ROPE_E = WS_ZC + 4 * MiB;
constexpr size_t WS_ROPE_O = WS_ROPE_E + 1 * MiB;
constexpr size_t WS_WDN2 = WS_ROPE_O + 1 * MiB;
constexpr size_t WS_END = WS_WDN2 + 6 * MiB;
static_assert(WS_END <= 1024 * MiB, "ws map");

#define LAS __attribute__((address_space(3)))
#define GAS __attribute__((address_space(1)))
typedef unsigned short bf16_t;
typedef short bf16x8 __attribute__((ext_vector_type(8)));
typedef float f32x4 __attribute__((ext_vector_type(4)));
typedef float f32x16 __attribute__((ext_vector_type(16)));
typedef unsigned u32x4 __attribute__((ext_vector_type(4)));
typedef unsigned u32x2 __attribute__((ext_vector_type(2)));
typedef float f32x2v __attribute__((ext_vector_type(2)));

__device__ __forceinline__ unsigned cvt_pk_bf16(float lo, float hi) { unsigned r; asm volatile("v_cvt_pk_bf16_f32 %0, %1, %2" : "=v"(r) : "v"(lo), "v"(hi)); return r; }
__device__ __forceinline__ float bflo(unsigned u) { return __uint_as_float(u << 16); }
__device__ __forceinline__ float bfhi(unsigned u) { return __uint_as_float(u & 0xffff0000u); }
__device__ __forceinline__ float bf2f(bf16_t b) { return __uint_as_float((unsigned)b << 16); }
__device__ __forceinline__ float wave_sum(float v) {
#pragma unroll
    for (int o = 1; o < 64; o <<= 1) v += __shfl_xor(v, o);
    return v;
}
__device__ __forceinline__ float half_sum(float v) {
#pragma unroll
    for (int o = 1; o < 32; o <<= 1) v += __shfl_xor(v, o);
    return v;
}

namespace pg8 {
constexpr int BM = 256, BK = 64, HALF = 128, HTB = HALF * BK * 2, STAGE_BYTES = 8 * HTB, NXCD = 8, WGM = 8;
__device__ __forceinline__ int lds_byte(int r, int c) { const int st = (r >> 4) * 2 + (c >> 5), rr = r & 15, cc = c & 31, ob = rr * 64 + cc * 2; return st * 1024 + (ob ^ (((ob >> 9) & 1) << 5)); }
__device__ __forceinline__ void stage_rc(int b, int& R, int& C) { const int st = b / 1024, sb = b % 1024, swz = sb ^ (((sb >> 9) & 1) << 5); R = (st >> 1) * 16 + swz / 64; C = (st & 1) * 32 + (swz % 64) / 2; }
__device__ __forceinline__ int perm32(int rho) { const int n = rho >> 4, i = rho & 15; return 8 * (i >> 2) + 4 * n + (i & 3); }

struct Unit { int pm, pn, arow, brow, orow, ocol, aux, bt; };
struct Gemm { const bf16_t* A; const bf16_t* Bt; int lda, ldb, K; };

template <class Map> struct Order {
    int nM, nN, nwg, G, c; Map map;
    __device__ __forceinline__ void init(int nM_, int nN_, int G_, int c_, const Map& m) { nM = nM_; nN = nN_; nwg = nM * nN; G = G_; c = c_; map = m; }
    __device__ __forceinline__ bool next(int i, Unit& u) const {
        const long L = (long)i * G + c; if (L >= nwg) return false;
        int wgid = (int)L; { const int q = nwg / NXCD, r = nwg % NXCD, xcd = wgid % NXCD, off = wgid / NXCD; wgid = (xcd < r ? xcd * (q + 1) : r * (q + 1) + (xcd - r) * q) + off; }
        const int nig = WGM * nN, gid = wgid / nig, fm = gid * WGM, gsz = (nM - fm) < WGM ? (nM - fm) : WGM;
        u.pm = fm + ((wgid % nig) % gsz); u.pn = (wgid % nig) / gsz; map(u); return true;
    }
};

struct EpiBf16 {
    static constexpr bool PERM = true;
    bf16_t* O0; int ld0; bf16_t* O1; int ld1;
    __device__ __forceinline__ void operator()(const f32x4 (&acc)[2][2][4][2], const Unit& u, int wr, int wc, int fr, int fq, LAS unsigned char*) const {
        bf16_t* base = u.aux ? O1 : O0; const int ldc = u.aux ? ld1 : ld0;
        const int row0 = u.orow + wr * 64 + fr, col0 = u.ocol + wc * 32 + 8 * fq;
#pragma unroll
        for (int ai = 0; ai < 2; ++ai)
#pragma unroll
            for (int m = 0; m < 4; ++m) { bf16_t* rowp = base + (size_t)(row0 + ai * HALF + m * 16) * ldc + col0;
#pragma unroll
                for (int bj = 0; bj < 2; ++bj) { const f32x4 v0 = acc[ai][bj][m][0], v1 = acc[ai][bj][m][1];
                    u32x4 w; w.x = cvt_pk_bf16(v0[0], v0[1]); w.y = cvt_pk_bf16(v0[2], v0[3]); w.z = cvt_pk_bf16(v1[0], v1[1]); w.w = cvt_pk_bf16(v1[2], v1[3]);
                    *(u32x4*)(rowp + bj * HALF) = w; } }
    }
};

struct EpiBf16Ckv {
    static constexpr bool PERM = true;
    bf16_t* O0; int ld0;
    __device__ __forceinline__ void operator()(const f32x4 (&acc)[2][2][4][2], const Unit& u, int wr, int wc, int fr, int fq, LAS unsigned char* lds) const {
        float rt[2][4];
#pragma unroll
        for (int ai = 0; ai < 2; ++ai)
#pragma unroll
            for (int m = 0; m < 4; ++m) rt[ai][m] = 1.0f;
        if (u.pn == 1) {
            LAS float* tab = (LAS float*)(lds + 140288);
#pragma unroll
            for (int ai = 0; ai < 2; ++ai)
#pragma unroll
                for (int m = 0; m < 4; ++m) { const f32x4 a0 = acc[ai][0][m][0], a1 = acc[ai][0][m][1];
                    float ss = (a0[0] * a0[0] + a0[1] * a0[1]) + (a0[2] * a0[2] + a0[3] * a0[3]) + (a1[0] * a1[0] + a1[1] * a1[1]) + (a1[2] * a1[2] + a1[3] * a1[3]);
                    ss += __shfl_xor(ss, 16); ss += __shfl_xor(ss, 32);
                    if (fq == 0) tab[(ai * HALF + wr * 64 + m * 16 + fr) * 4 + wc] = ss; }
            asm volatile("s_waitcnt lgkmcnt(0)" ::: "memory"); __builtin_amdgcn_s_barrier(); asm volatile("" ::: "memory");
#pragma unroll
            for (int ai = 0; ai < 2; ++ai)
#pragma unroll
                for (int m = 0; m < 4; ++m) { const f32x4 p = *(const LAS f32x4*)(tab + (ai * HALF + wr * 64 + m * 16 + fr) * 4);
                    rt[ai][m] = rsqrtf(((p[0] + p[1]) + (p[2] + p[3])) * (1.0f / 128.0f) + EPS); }
        }
        const int row0 = u.orow + wr * 64 + fr, col0 = u.ocol + wc * 32 + 8 * fq;
#pragma unroll
        for (int ai = 0; ai < 2; ++ai)
#pragma unroll
            for (int m = 0; m < 4; ++m) { bf16_t* rowp = O0 + (size_t)(row0 + ai * HALF + m * 16) * ld0 + col0;
#pragma unroll
                for (int bj = 0; bj < 2; ++bj) { const float sc = bj == 0 ? rt[ai][m] : 1.0f; const f32x4 v0 = acc[ai][bj][m][0] * sc, v1 = acc[ai][bj][m][1] * sc;
                    u32x4 w; w.x = cvt_pk_bf16(v0[0], v0[1]); w.y = cvt_pk_bf16(v0[2], v0[3]); w.z = cvt_pk_bf16(v1[0], v1[1]); w.w = cvt_pk_bf16(v1[2], v1[3]);
                    *(u32x4*)(rowp + bj * HALF) = w; } }
    }
};

struct EpiRes {
    static constexpr bool PERM = false;
    const float* xin; float* xout; const float* cin; float* cout; const float* mods_l; int gidx; float gs;
    __device__ __forceinline__ void operator()(const f32x4 (&acc)[2][2][4][2], const Unit& u, int wr, int wc, int fr, int fq, LAS unsigned char*) const {
        const float* src = u.aux ? cin : xin; float* dst = u.aux ? cout : xout;
        const float* gate = mods_l + (size_t)(u.aux ? 16 : u.bt) * 6144 + gidx * 1024;
        const int row0 = u.orow + wr * 64 + fr, col0 = u.ocol + wc * 32 + 4 * fq;
        const __amdgpu_buffer_rsrc_t rs = __builtin_amdgcn_make_buffer_rsrc((void*)dst, 0, 0x40000000, 0x00020000);
#pragma unroll
        for (int bj = 0; bj < 2; ++bj) {
            f32x4 g4[2], xv[2][2][4];
#pragma unroll
            for (int n = 0; n < 2; ++n) { const int col = col0 + bj * HALF + n * 16; g4[n] = *(const f32x4*)(gate + col) * gs;
#pragma unroll
                for (int ai = 0; ai < 2; ++ai)
#pragma unroll
                    for (int m = 0; m < 4; ++m) xv[n][ai][m] = *(const f32x4*)(src + (size_t)(row0 + ai * HALF + m * 16) * DM + col); }
            asm volatile("" ::: "memory");
#pragma unroll
            for (int n = 0; n < 2; ++n) { const int col = col0 + bj * HALF + n * 16;
#pragma unroll
                for (int ai = 0; ai < 2; ++ai)
#pragma unroll
                    for (int m = 0; m < 4; ++m) { const size_t off = (size_t)(row0 + ai * HALF + m * 16) * DM + col;
                        __builtin_amdgcn_raw_buffer_store_b128(__builtin_bit_cast(u32x4, xv[n][ai][m] + g4[n] * acc[ai][bj][m][n]), rs, (unsigned)(off * 4), 0, 16); } }
            asm volatile("" ::: "memory");
        }
    }
};

__device__ __forceinline__ float dpp_ror1(float v) { return __int_as_float(__builtin_amdgcn_update_dpp(__float_as_int(v), __float_as_int(v), 0x121, 0xf, 0xf, false)); }
__device__ __forceinline__ float dpp_ror15(float v) { return __int_as_float(__builtin_amdgcn_update_dpp(__float_as_int(v), __float_as_int(v), 0x12F, 0xf, 0xf, false)); }
__device__ __forceinline__ float silu_f(float x) { return x * __builtin_amdgcn_rcpf(1.0f + __expf(-x)); }

struct EpiUp {
    static constexpr bool PERM = false;
    bf16_t* Hd; const float* cw; const float* cb;
    __device__ __forceinline__ void operator()(const f32x4 (&acc)[2][2][4][2], const Unit& u, int wr, int wc, int fr, int fq, LAS unsigned char* lds) const {
        LAS float* hal = (LAS float*)(lds + STAGE_BYTES);
        LAS float* cwl = (LAS float*)(lds + 140288);
        const int tid_ = (wr * 4 + wc) * 64 + fq * 16 + fr;
        float cwv[2];
#pragma unroll
        for (int q = 0; q < 2; ++q) { const int e = tid_ + 512 * q, t = e >> 8, bj = (e >> 7) & 1, c = e & 127; cwv[q] = t < 3 ? cw[t * (2 * DFF) + bj * DFF + u.ocol + c] : cb[bj * DFF + u.ocol + c]; }
        if (fr == 0) {
#pragma unroll
            for (int ai = 0; ai < 2; ++ai)
#pragma unroll
                for (int bj = 0; bj < 2; ++bj)
#pragma unroll
                    for (int n = 0; n < 2; ++n) *(LAS f32x4*)(hal + ((2 * ai + wr) * 2 + 0) * 256 + bj * 128 + wc * 32 + n * 16 + 4 * fq) = acc[ai][bj][0][n];
        }
        if (fr == 15) {
#pragma unroll
            for (int ai = 0; ai < 2; ++ai)
#pragma unroll
                for (int bj = 0; bj < 2; ++bj)
#pragma unroll
                    for (int n = 0; n < 2; ++n) *(LAS f32x4*)(hal + ((2 * ai + wr) * 2 + 1) * 256 + bj * 128 + wc * 32 + n * 16 + 4 * fq) = acc[ai][bj][3][n];
        }
        cwl[tid_] = cwv[0]; cwl[tid_ + 512] = cwv[1];
        asm volatile("s_waitcnt lgkmcnt(0)" ::: "memory"); __builtin_amdgcn_s_barrier(); asm volatile("" ::: "memory");
        int fr_ = fr, fq_ = fq; asm volatile("" : "+v"(fr_), "+v"(fq_));
        const int rmin = u.aux == 1 ? 0 : 1, rmax = u.bt;
        const f32x4 zero4 = {0.f, 0.f, 0.f, 0.f};
#pragma unroll
        for (int ai = 0; ai < 2; ++ai) {
            const int g = 2 * ai + wr;
#pragma unroll
            for (int n = 0; n < 2; ++n) {
                const int chb = u.ocol + wc * 32 + n * 16 + 4 * fq_;
                const int colh = wc * 32 + n * 16 + 4 * fq_;
                f32x4 w0[2], w1[2], w2[2], bb[2], uh[2], dh[2];
#pragma unroll
                for (int bj = 0; bj < 2; ++bj) { const int cl = bj * 128 + colh;
                    w0[bj] = *(const LAS f32x4*)(cwl + 0 * 256 + cl); w1[bj] = *(const LAS f32x4*)(cwl + 1 * 256 + cl); w2[bj] = *(const LAS f32x4*)(cwl + 2 * 256 + cl); bb[bj] = *(const LAS f32x4*)(cwl + 3 * 256 + cl);
                    uh[bj] = zero4; dh[bj] = zero4;
                    if (g > 0) uh[bj] = *(LAS f32x4*)(hal + ((g - 1) * 2 + 1) * 256 + bj * 128 + colh);
                    if (g < 3) dh[bj] = *(LAS f32x4*)(hal + ((g + 1) * 2 + 0) * 256 + bj * 128 + colh); }
#pragma unroll
                for (int m = 0; m < 4; ++m) {
                    f32x4 res[2];
#pragma unroll
                    for (int bj = 0; bj < 2; ++bj) {
                        const f32x4 cur = acc[ai][bj][m][n];
                        const f32x4 prv = m > 0 ? acc[ai][bj][m > 0 ? m - 1 : 0][n] : uh[bj];
                        const f32x4 nxt = m < 3 ? acc[ai][bj][m < 3 ? m + 1 : 3][n] : dh[bj];
                        f32x4 su, sd;
#pragma unroll
                        for (int j = 0; j < 4; ++j) { su[j] = fr_ == 15 ? prv[j] : cur[j]; sd[j] = fr_ == 0 ? nxt[j] : cur[j]; }
                        f32x4 rr = w1[bj] * cur + bb[bj];
                        asm volatile("s_nop 1\n\t"
                                     "v_fmac_f32_dpp %0, %4, %12 row_ror:1 row_mask:0xf bank_mask:0xf\n\t"
                                     "v_fmac_f32_dpp %1, %5, %13 row_ror:1 row_mask:0xf bank_mask:0xf\n\t"
                                     "v_fmac_f32_dpp %2, %6, %14 row_ror:1 row_mask:0xf bank_mask:0xf\n\t"
                                     "v_fmac_f32_dpp %3, %7, %15 row_ror:1 row_mask:0xf bank_mask:0xf\n\t"
                                     "v_fmac_f32_dpp %0, %8, %16 row_ror:15 row_mask:0xf bank_mask:0xf\n\t"
                                     "v_fmac_f32_dpp %1, %9, %17 row_ror:15 row_mask:0xf bank_mask:0xf\n\t"
                                     "v_fmac_f32_dpp %2, %10, %18 row_ror:15 row_mask:0xf bank_mask:0xf\n\t"
                                     "v_fmac_f32_dpp %3, %11, %19 row_ror:15 row_mask:0xf bank_mask:0xf"
                                     : "+v"(rr[0]), "+v"(rr[1]), "+v"(rr[2]), "+v"(rr[3])
                                     : "v"(su[0]), "v"(su[1]), "v"(su[2]), "v"(su[3]), "v"(sd[0]), "v"(sd[1]), "v"(sd[2]), "v"(sd[3]),
                                       "v"(w0[bj][0]), "v"(w0[bj][1]), "v"(w0[bj][2]), "v"(w0[bj][3]), "v"(w2[bj][0]), "v"(w2[bj][1]), "v"(w2[bj][2]), "v"(w2[bj][3]));
                        res[bj] = rr;
                    }
                    const int r = ai * HALF + wr * 64 + m * 16 + fr_;
                    bool okr = r >= rmin && r <= rmax; int trow = u.orow + r;
                    if (u.aux == 2) { const int seg = r / TAILSEG, sq = r - seg * TAILSEG, sb = 7 * (u.orow >> 8) + seg;
                        okr = seg < 7 && sb < NB && sq >= 1 && sq <= 32; trow = sb * TB + NCTX + (SEQ - 33) + sq; }
                    if (okr) {
                        const f32x4 gq = res[0], vq = res[1];
                        u32x2 w; w.x = cvt_pk_bf16(silu_f(gq[0]) * vq[0], silu_f(gq[1]) * vq[1]); w.y = cvt_pk_bf16(silu_f(gq[2]) * vq[2], silu_f(gq[3]) * vq[3]);
                        *(u32x2*)(Hd + (size_t)trow * DFF + chb) = w;
                    }
                }
            }
        }
    }
};

template <class Epi, class Sched>
__device__ __forceinline__ void gemm_phase(LAS unsigned char* lds, const Gemm g, const Sched& S, const Epi& E) {
    int tid = threadIdx.x; asm volatile("" : "+v"(tid));
    const int wid = __builtin_amdgcn_readfirstlane(tid >> 6), lane = tid & 63, wr = wid >> 2, wc = wid & 3, fr = lane & 15, fq = lane >> 4;
    int K = g.K, lda_ = g.lda, ldb_ = g.ldb; asm volatile("" : "+s"(K), "+s"(lda_), "+s"(ldb_));
    const int nt = K / BK;
    unsigned voffA[2], voffB[2];
#pragma unroll
    for (int i = 0; i < 2; ++i) { int R, C; stage_rc(tid * 16 + i * 8192, R, C); const int Rb = Epi::PERM ? ((R & ~31) + perm32(R & 31)) : R;
        voffA[i] = (unsigned)(R * lda_ + C) * 2u; voffB[i] = (unsigned)(Rb * ldb_ + C) * 2u; }
    const size_t kstep = (size_t)(BK * 2);
    const size_t hstepA = (size_t)HALF * lda_ * 2, hstepB = (size_t)HALF * ldb_ * 2;
    const unsigned ldsw = (unsigned)wid * 1024u;
    const int aoff = lds_byte(wr * 64 + fr, fq * 8), boff = lds_byte(wc * 32 + fr, fq * 8);
#define PG8_SA(b, h) (((b) * 2 + (h)) * HTB)
#define PG8_SB(b, h) ((4 + (b) * 2 + (h)) * HTB)
#define PG8_STAGE(bufoff, gbase, voff) do { _Pragma("unroll") for (int _i = 0; _i < 2; ++_i) \
        __builtin_amdgcn_global_load_lds((const unsigned*)((const char*)(gbase) + (voff)[_i]), (LAS unsigned*)(lds + (bufoff) + ldsw + _i * 8192), 16, 0, 0); } while (0)
#define PG8_LDA(dst, b, h) do { _Pragma("unroll") for (int m = 0; m < 4; ++m) _Pragma("unroll") for (int k = 0; k < 2; ++k) dst[m][k] = *(const LAS bf16x8*)(lds + PG8_SA(b, h) + aoff + m * 2048 + k * 1024); } while (0)
#define PG8_LDB(dst, b, h) do { _Pragma("unroll") for (int n = 0; n < 2; ++n) _Pragma("unroll") for (int k = 0; k < 2; ++k) dst[n][k] = *(const LAS bf16x8*)(lds + PG8_SB(b, h) + boff + n * 2048 + k * 1024); } while (0)
#define PG8_MMA(ai, bj, At, Bt) do { __builtin_amdgcn_s_setprio(1); _Pragma("unroll") for (int m = 0; m < 4; ++m) _Pragma("unroll") for (int n = 0; n < 2; ++n) _Pragma("unroll") for (int k = 0; k < 2; ++k) \
        acc[ai][bj][m][n] = __builtin_amdgcn_mfma_f32_16x16x32_bf16(Bt[n][k], At[m][k], acc[ai][bj][m][n], 0, 0, 0); __builtin_amdgcn_s_setprio(0); } while (0)
#define PG8_WAIT_V(n) asm volatile("s_waitcnt vmcnt(" #n ")" ::: "memory")
#define PG8_WAIT_L(n) asm volatile("s_waitcnt lgkmcnt(" #n ")" ::: "memory")
#define PG8_BAR __builtin_amdgcn_s_barrier()
#define PG8_SCHED __builtin_amdgcn_sched_barrier(0)
    Unit cur, nxt; int ui = 0;
    if (!S.next(0, cur)) return;
    f32x4 acc[2][2][4][2];
#pragma unroll
    for (int a = 0; a < 2; ++a)
#pragma unroll
        for (int b = 0; b < 2; ++b)
#pragma unroll
            for (int m = 0; m < 4; ++m)
#pragma unroll
                for (int n = 0; n < 2; ++n) acc[a][b][m][n] = (f32x4){0.f, 0.f, 0.f, 0.f};
    bf16x8 At[4][2], B0[2][2], B1[2][2];
    const char* cA = (const char*)g.A + (size_t)cur.arow * lda_ * 2; const char* cB = (const char*)g.Bt + (size_t)cur.brow * ldb_ * 2;
    PG8_STAGE(PG8_SB(0, 0), cB, voffB); PG8_STAGE(PG8_SB(0, 1), cB + hstepB, voffB); PG8_STAGE(PG8_SA(0, 0), cA, voffA); PG8_STAGE(PG8_SA(0, 1), cA + hstepA, voffA);
    if (wr == 1) PG8_BAR;
    PG8_WAIT_V(2); PG8_BAR;
    PG8_STAGE(PG8_SB(1, 0), cB + kstep, voffB); PG8_STAGE(PG8_SA(1, 0), cA + kstep, voffA); PG8_STAGE(PG8_SB(1, 1), cB + hstepB + kstep, voffB);
    PG8_WAIT_V(6); PG8_BAR;
    for (;;) {
        const bool has_next = S.next(ui + 1, nxt);
        const char* nA = has_next ? (const char*)g.A + (size_t)nxt.arow * lda_ * 2 : cA; const char* nB = has_next ? (const char*)g.Bt + (size_t)nxt.brow * ldb_ * 2 : cB;
        for (int t = 0; t < nt; t += 2) {
            const bool last = (t == nt - 2);
            const char* a1 = cA + (size_t)(t + 1) * kstep;
            const char* a2 = last ? nA : cA + (size_t)(t + 2) * kstep; const char* b2 = last ? nB : cB + (size_t)(t + 2) * kstep;
            const char* a3 = a2 + kstep; const char* b3 = b2 + kstep;
            PG8_LDB(B0, 0, 0); PG8_LDB(B1, 0, 1); PG8_SCHED; PG8_LDA(At, 0, 0); PG8_STAGE(PG8_SA(1, 1), a1 + hstepA, voffA);
            PG8_WAIT_V(8); PG8_WAIT_L(0); PG8_BAR; PG8_MMA(0, 0, At, B0); PG8_MMA(0, 1, At, B1); PG8_BAR; PG8_SCHED;
            PG8_LDA(At, 0, 1); PG8_STAGE(PG8_SB(0, 0), b2, voffB); PG8_STAGE(PG8_SB(0, 1), b2 + hstepB, voffB); PG8_STAGE(PG8_SA(0, 0), a2, voffA);
            PG8_WAIT_V(8); PG8_WAIT_L(0); PG8_BAR; PG8_MMA(1, 0, At, B0); PG8_MMA(1, 1, At, B1); PG8_BAR; PG8_SCHED;
            PG8_LDB(B0, 1, 0); PG8_LDB(B1, 1, 1); PG8_SCHED; PG8_LDA(At, 1, 0); PG8_STAGE(PG8_SA(0, 1), a2 + hstepA, voffA);
            PG8_WAIT_V(8); PG8_WAIT_L(0); PG8_BAR; PG8_MMA(0, 0, At, B0); PG8_MMA(0, 1, At, B1); PG8_BAR; PG8_SCHED;
            PG8_LDA(At, 1, 1); PG8_STAGE(PG8_SB(1, 0), b3, voffB); PG8_STAGE(PG8_SB(1, 1), b3 + hstepB, voffB); PG8_STAGE(PG8_SA(1, 0), a3, voffA);
            PG8_WAIT_V(8); PG8_WAIT_L(0); PG8_BAR; PG8_MMA(1, 0, At, B0); PG8_MMA(1, 1, At, B1); PG8_BAR; PG8_SCHED;
        }
        if (wr == 0) PG8_BAR;
        E(acc, cur, wr, wc, fr, fq, lds);
        if (!has_next) break;
#pragma unroll
        for (int a = 0; a < 2; ++a)
#pragma unroll
            for (int b = 0; b < 2; ++b)
#pragma unroll
                for (int m = 0; m < 4; ++m)
#pragma unroll
                    for (int n = 0; n < 2; ++n) acc[a][b][m][n] = (f32x4){0.f, 0.f, 0.f, 0.f};
        cur = nxt; cA = nA; cB = nB; ++ui;
        if (wr == 1) PG8_BAR;
    }
    PG8_WAIT_V(0);
    PG8_BAR;
#undef PG8_SA
#undef PG8_SB
#undef PG8_STAGE
#undef PG8_LDA
#undef PG8_LDB
#undef PG8_MMA
#undef PG8_WAIT_V
#undef PG8_WAIT_L
#undef PG8_BAR
#undef PG8_SCHED
}

struct MapStd { int coff; __device__ __forceinline__ void operator()(Unit& u) const { u.arow = u.pm * 256; u.brow = u.pn * 256; u.orow = u.pm * 256; u.ocol = coff + u.pn * 256; u.aux = 0; u.bt = 0; } };
struct MapRes { int all;
    __device__ __forceinline__ void operator()(Unit& u) const {
        int b, j; if (all) { b = u.pm / 17; j = u.pm % 17; } else { b = u.pm / 16; j = u.pm % 16 + 1; }
        u.arow = (b * 17 + j) * 256; u.brow = u.pn * 256; u.ocol = u.pn * 256; u.bt = b;
        if (j == 0) { u.aux = 1; u.orow = b * 256; } else { u.aux = 0; u.orow = b * SEQ + (j - 1) * 256; } asm volatile("" : "+s"(u.aux)); } };
struct MapUp { int all;
    __device__ __forceinline__ void operator()(Unit& u) const {
        const int per = all ? 17 : 16, nmain = 16 * per;
        u.brow = u.pn * 256; u.ocol = u.pn * 128;
        if (u.pm >= nmain) { u.aux = 2; u.arow = TAILROW0 + (u.pm - nmain) * 256; u.orow = (u.pm - nmain) * 256; u.bt = 0; return; }
        const int b = u.pm / per, j = all ? u.pm % per : u.pm % per + 1;
        if (j == 0) { u.aux = 1; u.arow = b * U2B; u.orow = b * TB; u.bt = 255; }
        else { const int i = j - 1; u.aux = 0; u.arow = b * U2B + 263 + 254 * i; u.orow = b * TB + NCTX + 254 * i - 1; u.bt = 254; } } };
struct MapZ {
    __device__ __forceinline__ void operator()(Unit& u) const {
        const int b = u.pn / 17, j = u.pn % 17; u.arow = u.pm * 256; u.brow = u.pn * 256; u.orow = b * 256; u.bt = b;
        if (j == 0) { u.aux = 1; u.ocol = u.pm * NCTX; } else { u.aux = 0; u.ocol = u.pm * SEQ + (j - 1) * 256; } } };
struct MapFnetL { __device__ __forceinline__ void operator()(Unit& u) const { const int b = u.pm / 16, mt = u.pm % 16; u.arow = mt * 256; u.brow = b * 256; u.orow = b * TB + NCTX + mt * 256; u.ocol = 768; u.aux = 0; u.bt = b; } };
struct MapFnetC { __device__ __forceinline__ void operator()(Unit& u) const { const int b = u.pm; u.arow = 0; u.brow = b * 256; u.orow = b * TB; u.ocol = 768; u.aux = 0; u.bt = b; } };
}

typedef short v4i16_t __attribute__((ext_vector_type(4)));
__device__ __forceinline__ v4i16_t vtr(const LAS unsigned char* p) { return __builtin_amdgcn_ds_read_tr16_b64_v4i16((LAS v4i16_t*)p); }
#define MX3(a_, b_, c_) __builtin_fmaxf(__builtin_fmaxf((a_), (b_)), (c_))
__device__ __forceinline__ float tile_max(const f32x16& s0, const f32x16& s1) {
    float ma = MX3(s0[0], s0[1], s1[0]), mb = MX3(s0[2], s0[3], s1[1]); ma = MX3(ma, s1[2], s1[3]);
#pragma unroll
    for (int r = 4; r < 16; r += 4) { ma = MX3(ma, s0[r], s0[r + 1]); mb = MX3(mb, s0[r + 2], s0[r + 3]); ma = MX3(ma, s1[r], s1[r + 1]); mb = MX3(mb, s1[r + 2], s1[r + 3]); }
    return __builtin_fmaxf(ma, mb);
}
#undef MX3
__device__ __forceinline__ void band_mask(f32x16& s0, f32x16& s1, int k0pos, int qp, int hi) {
#pragma unroll
    for (int r = 0; r < 16; ++r) { const int kp = k0pos + (r & 3) + 8 * (r >> 2) + 4 * hi; const int d0 = kp - qp, d1 = d0 + 32;
        if (d0 > 128 || d0 < -128) s0[r] = -1e30f; if (d1 > 128 || d1 < -128) s1[r] = -1e30f; }
}
__device__ __forceinline__ void exp4(f32x16& s, int r0, float& acc0, float& acc1) {
    s[r0] = __builtin_amdgcn_exp2f(s[r0]); s[r0 + 1] = __builtin_amdgcn_exp2f(s[r0 + 1]); s[r0 + 2] = __builtin_amdgcn_exp2f(s[r0 + 2]); s[r0 + 3] = __builtin_amdgcn_exp2f(s[r0 + 3]);
    acc0 += s[r0] + s[r0 + 2]; acc1 += s[r0 + 1] + s[r0 + 3];
}
__device__ __forceinline__ bf16x8 pack8(const f32x16& s, int r0) {
    u32x4 w; w.x = cvt_pk_bf16(s[r0], s[r0 + 1]); w.y = cvt_pk_bf16(s[r0 + 2], s[r0 + 3]); w.z = cvt_pk_bf16(s[r0 + 4], s[r0 + 5]); w.w = cvt_pk_bf16(s[r0 + 6], s[r0 + 7]);
    return __builtin_bit_cast(bf16x8, w);
}
__device__ __forceinline__ void pv_slab(const LAS unsigned char* vb, int koff, const bf16x8 pj, f32x16& o0, f32x16& o1) {
    const v4i16_t a0 = vtr(vb + koff), a1 = vtr(vb + koff + 512), b0 = vtr(vb + 8192 + koff), b1 = vtr(vb + 8192 + koff + 512);
    const bf16x8 v0 = {a0[0], a0[1], a0[2], a0[3], a1[0], a1[1], a1[2], a1[3]}, v1 = {b0[0], b0[1], b0[2], b0[3], b1[0], b1[1], b1[2], b1[3]};
    o0 = __builtin_amdgcn_mfma_f32_32x32x16_bf16(v0, pj, o0, 0, 0, 0);
    o1 = __builtin_amdgcn_mfma_f32_32x32x16_bf16(v1, pj, o1, 0, 0, 0);
}

#define ATT_SCHED() __builtin_amdgcn_sched_barrier(0)
template <int DQ, bool WIN>
__device__ __forceinline__ void attn_qk(LAS unsigned char* lds, int kbufoff, int t, const bf16x8 (&qf)[DQ / 16], f32x16& o0, f32x16& o1, float& mrun, float& lsum,
                                        f32x16& sa0, f32x16& sa1, f32x16& sb0, f32x16& sb1, int l31, int hi, int qw) {
    constexpr int NDK = DQ / 16, KST = DQ * 2 + 16;
    const LAS unsigned char* kb = lds + kbufoff + l31 * KST + hi * 16;
    bf16x8 kf[2][4];
#define KLOAD(dst, dk) do { dst[0] = *(const LAS bf16x8*)(kb + (dk) * 32); dst[1] = *(const LAS bf16x8*)(kb + 32 * KST + (dk) * 32); \
                            dst[2] = *(const LAS bf16x8*)(kb + 64 * KST + (dk) * 32); dst[3] = *(const LAS bf16x8*)(kb + 96 * KST + (dk) * 32); } while (0)
    KLOAD(kf[0], 0);
#pragma unroll
    for (int dk = 0; dk < NDK; ++dk) {
        if (dk + 1 < NDK) KLOAD(kf[(dk + 1) & 1], dk + 1);
        ATT_SCHED();
        const bf16x8 (&f)[4] = kf[dk & 1];
        if (dk == 0) { f32x16 z16;
#pragma unroll
                       for (int r = 0; r < 16; ++r) z16[r] = 0.f;
                       sa0 = __builtin_amdgcn_mfma_f32_32x32x16_bf16(f[0], qf[0], z16, 0, 0, 0); sa1 = __builtin_amdgcn_mfma_f32_32x32x16_bf16(f[1], qf[0], z16, 0, 0, 0);
                       sb0 = __builtin_amdgcn_mfma_f32_32x32x16_bf16(f[2], qf[0], z16, 0, 0, 0); sb1 = __builtin_amdgcn_mfma_f32_32x32x16_bf16(f[3], qf[0], z16, 0, 0, 0); }
        else { sa0 = __builtin_amdgcn_mfma_f32_32x32x16_bf16(f[0], qf[dk], sa0, 0, 0, 0); sa1 = __builtin_amdgcn_mfma_f32_32x32x16_bf16(f[1], qf[dk], sa1, 0, 0, 0);
               sb0 = __builtin_amdgcn_mfma_f32_32x32x16_bf16(f[2], qf[dk], sb0, 0, 0, 0); sb1 = __builtin_amdgcn_mfma_f32_32x32x16_bf16(f[3], qf[dk], sb1, 0, 0, 0); }
        ATT_SCHED();
    }
#undef KLOAD
    if (__builtin_expect(__any(mrun != 0.f), 0)) {
#pragma unroll
        for (int r = 0; r < 16; ++r) { sa0[r] -= mrun; sa1[r] -= mrun; sb0[r] -= mrun; sb1[r] -= mrun; }
    }
    if (WIN && t >= 4) { const int qp = qw + l31, k0pos = (t - 4) * 64; band_mask(sa0, sa1, k0pos, qp, hi); band_mask(sb0, sb1, k0pos + 64, qp, hi); }
    float mx = __builtin_fmaxf(tile_max(sa0, sa1), tile_max(sb0, sb1));
    { auto rr = __builtin_amdgcn_permlane32_swap(__float_as_uint(mx), __float_as_uint(mx), false, false); mx = __builtin_fmaxf(__uint_as_float(rr[0]), __uint_as_float(rr[1])); }
    if (__builtin_expect(__any(mx > 8.0f), 0)) {
        const float dl = mx > 8.0f ? mx : 0.f; mrun += dl;
        const float alpha = __builtin_amdgcn_exp2f(-dl); lsum *= alpha;
#pragma unroll
        for (int r = 0; r < 16; ++r) { sa0[r] -= dl; sa1[r] -= dl; sb0[r] -= dl; sb1[r] -= dl; o0[r] *= alpha; o1[r] *= alpha; }
    }
}
#define VLOAD(dst, j) do { dst[0] = vtr(vb + (j) * 1024); dst[1] = vtr(vb + (j) * 1024 + 512); dst[2] = vtr(vb + 8192 + (j) * 1024); dst[3] = vtr(vb + 8192 + (j) * 1024 + 512); } while (0)
#define PVMMA(src, P_) do { const bf16x8 v0_ = {src[0][0], src[0][1], src[0][2], src[0][3], src[1][0], src[1][1], src[1][2], src[1][3]}, v1_ = {src[2][0], src[2][1], src[2][2], src[2][3], src[3][0], src[3][1], src[3][2], src[3][3]}; \
        const bf16x8 p_ = (P_); o0 = __builtin_amdgcn_mfma_f32_32x32x16_bf16(v0_, p_, o0, 0, 0, 0); o1 = __builtin_amdgcn_mfma_f32_32x32x16_bf16(v1_, p_, o1, 0, 0, 0); } while (0)
__device__ __forceinline__ void attn_softmax_pv(const LAS unsigned char* vb, f32x16& sa0, f32x16& sa1, f32x16& sb0, f32x16& sb1, f32x16& o0, f32x16& o1, float& lsum) {
    v4i16_t vf[2][4];
    VLOAD(vf[0], 0);
    float p0 = 0.f, p1 = 0.f, p2 = 0.f, p3 = 0.f;
    exp4(sa0, 0, p0, p1); exp4(sa0, 4, p2, p3); exp4(sa0, 8, p0, p1); exp4(sa0, 12, p2, p3);
    exp4(sa1, 0, p0, p1); exp4(sa1, 4, p2, p3); exp4(sa1, 8, p0, p1); exp4(sa1, 12, p2, p3);
    VLOAD(vf[1], 1); ATT_SCHED(); PVMMA(vf[0], pack8(sa0, 0)); exp4(sb0, 0, p0, p1); exp4(sb0, 4, p2, p3); ATT_SCHED();
    VLOAD(vf[0], 2); ATT_SCHED(); PVMMA(vf[1], pack8(sa0, 8)); exp4(sb0, 8, p0, p1); exp4(sb0, 12, p2, p3); ATT_SCHED();
    VLOAD(vf[1], 3); ATT_SCHED(); PVMMA(vf[0], pack8(sa1, 0)); exp4(sb1, 0, p0, p1); exp4(sb1, 4, p2, p3); ATT_SCHED();
    VLOAD(vf[0], 4); ATT_SCHED(); PVMMA(vf[1], pack8(sa1, 8)); exp4(sb1, 8, p0, p1); exp4(sb1, 12, p2, p3); ATT_SCHED();
    lsum += (p0 + p1) + (p2 + p3);
    VLOAD(vf[1], 5); ATT_SCHED(); PVMMA(vf[0], pack8(sb0, 0)); ATT_SCHED();
    VLOAD(vf[0], 6); ATT_SCHED(); PVMMA(vf[1], pack8(sb0, 8)); ATT_SCHED();
    VLOAD(vf[1], 7); ATT_SCHED(); PVMMA(vf[0], pack8(sb1, 0)); ATT_SCHED();
    PVMMA(vf[1], pack8(sb1, 8));
}
__device__ __forceinline__ void attn_softmax_keep(f32x16& sa0, f32x16& sa1, f32x16& sb0, f32x16& sb1, bf16x8 (&pw)[8], float& lsum) {
    float p0 = 0.f, p1 = 0.f, p2 = 0.f, p3 = 0.f;
    exp4(sa0, 0, p0, p1); exp4(sa0, 4, p2, p3); exp4(sa0, 8, p0, p1); exp4(sa0, 12, p2, p3); pw[0] = pack8(sa0, 0); pw[1] = pack8(sa0, 8);
    exp4(sa1, 0, p0, p1); exp4(sa1, 4, p2, p3); exp4(sa1, 8, p0, p1); exp4(sa1, 12, p2, p3); pw[2] = pack8(sa1, 0); pw[3] = pack8(sa1, 8);
    exp4(sb0, 0, p0, p1); exp4(sb0, 4, p2, p3); exp4(sb0, 8, p0, p1); exp4(sb0, 12, p2, p3); pw[4] = pack8(sb0, 0); pw[5] = pack8(sb0, 8);
    exp4(sb1, 0, p0, p1); exp4(sb1, 4, p2, p3); exp4(sb1, 8, p0, p1); exp4(sb1, 12, p2, p3); pw[6] = pack8(sb1, 0); pw[7] = pack8(sb1, 8);
    lsum += (p0 + p1) + (p2 + p3);
}
__device__ __forceinline__ void attn_pv_all(const LAS unsigned char* vb, const bf16x8 (&pw)[8], f32x16& o0, f32x16& o1) {
    v4i16_t vf[2][4];
    VLOAD(vf[0], 0);
    VLOAD(vf[1], 1); ATT_SCHED(); PVMMA(vf[0], pw[0]); ATT_SCHED();
    VLOAD(vf[0], 2); ATT_SCHED(); PVMMA(vf[1], pw[1]); ATT_SCHED();
    VLOAD(vf[1], 3); ATT_SCHED(); PVMMA(vf[0], pw[2]); ATT_SCHED();
    VLOAD(vf[0], 4); ATT_SCHED(); PVMMA(vf[1], pw[3]); ATT_SCHED();
    VLOAD(vf[1], 5); ATT_SCHED(); PVMMA(vf[0], pw[4]); ATT_SCHED();
    VLOAD(vf[0], 6); ATT_SCHED(); PVMMA(vf[1], pw[5]); ATT_SCHED();
    VLOAD(vf[1], 7); ATT_SCHED(); PVMMA(vf[0], pw[6]); ATT_SCHED();
    PVMMA(vf[1], pw[7]);
}
#undef VLOAD
#undef PVMMA
#undef ATT_SCHED

template <int DQ, bool WIN, int MODE = 0>
__device__ __forceinline__ void attn_unit(LAS unsigned char* lds, const bf16_t* Qp, int ldq, const bf16_t* Kp, int ldk, const bf16_t* Vp, int ldv, bf16_t* Op,
                                          int n1, int s2, int e2, int q0pos, float m_init, bool has_sink, const float* qgain = nullptr, const f32x2v* ropeT = nullptr, bool qrope = false, const float* rqrow = nullptr) {
    constexpr int NDK = DQ / 16, CH = DQ / 8, NKC = DQ / 32, KST = DQ * 2 + 16, KBUF = 128 * KST, VBUF = 16384, VOFF = 2 * KBUF;
    int tid = threadIdx.x; asm volatile("" : "+v"(tid));
    const int lane = tid & 63, wid = __builtin_amdgcn_readfirstlane(tid >> 6), l31 = lane & 31, hi = lane >> 5;
    const bool late = wid >= 4;
    bf16x8 qf[NDK];
    { const bf16_t* qrow = Qp + (size_t)(32 * wid + l31) * ldq + 8 * hi;
#pragma unroll
      for (int dk = 0; dk < NDK; ++dk) qf[dk] = *(const bf16x8*)(qrow + 16 * dk); }
    if (DQ == 96 && qgain != nullptr) {
        const float r_q = rqrow[32 * wid + l31];
        float y[6][8]; float ss = 0.f;
#pragma unroll
        for (int dk = 0; dk < 6; ++dk) { const u32x4 w = __builtin_bit_cast(u32x4, qf[dk < NDK ? dk : 0]);
#pragma unroll
            for (int i = 0; i < 4; ++i) { y[dk][2 * i] = bflo(w[i]) * r_q; y[dk][2 * i + 1] = bfhi(w[i]) * r_q; ss += y[dk][2 * i] * y[dk][2 * i] + y[dk][2 * i + 1] * y[dk][2 * i + 1]; } }
        ss += __shfl_xor(ss, 32);
        const float sc = rsqrtf(ss * (1.0f / 96.0f) + EPS);
#pragma unroll
        for (int dk = 0; dk < 6; ++dk)
#pragma unroll
            for (int e = 0; e < 8; ++e) y[dk][e] *= sc * qgain[16 * dk + 8 * hi + e];
        if (qrope) { const int pos = q0pos + 32 * wid + l31;
#pragma unroll
            for (int e = 0; e < 8; ++e) { const f32x2v t = ropeT[pos * 16 + 8 * hi + e]; const float x1 = y[4][e], x2 = y[5][e]; y[4][e] = x1 * t.x - x2 * t.y; y[5][e] = x1 * t.y + x2 * t.x; } }
        const float QS_ = 0.10206207261596577f * LOG2E;
#pragma unroll
        for (int dk = 0; dk < 6; ++dk) { u32x4 w;
#pragma unroll
            for (int i = 0; i < 4; ++i) w[i] = cvt_pk_bf16(y[dk][2 * i] * QS_, y[dk][2 * i + 1] * QS_);
            if (dk < NDK) qf[dk] = __builtin_bit_cast(bf16x8, w); }
    }
    if (DQ == 64 && qgain != nullptr) {
        float y[4][8]; float ss = 0.f;
#pragma unroll
        for (int dk = 0; dk < 4; ++dk) { const u32x4 w = __builtin_bit_cast(u32x4, qf[dk < NDK ? dk : 0]);
#pragma unroll
            for (int i = 0; i < 4; ++i) { y[dk][2 * i] = bflo(w[i]); y[dk][2 * i + 1] = bfhi(w[i]); ss += y[dk][2 * i] * y[dk][2 * i] + y[dk][2 * i + 1] * y[dk][2 * i + 1]; } }
        ss += __shfl_xor(ss, 32);
        const float rn = rsqrtf(ss * (1.0f / 64.0f) + EPS);
#pragma unroll
        for (int dk = 0; dk < 4; ++dk)
#pragma unroll
            for (int e = 0; e < 8; ++e) y[dk][e] *= rn * qgain[16 * dk + 8 * hi + e];
        if (qrope) { const int pos = q0pos + 32 * wid + l31;
#pragma unroll
            for (int dk = 0; dk < 2; ++dk)
#pragma unroll
                for (int e = 0; e < 8; ++e) { const f32x2v t = ropeT[pos * 32 + 16 * dk + 8 * hi + e]; const float x1 = y[dk][e], x2 = y[dk + 2][e]; y[dk][e] = x1 * t.x - x2 * t.y; y[dk + 2][e] = x1 * t.y + x2 * t.x; } }
        const float QS_ = 0.125f * LOG2E;
#pragma unroll
        for (int dk = 0; dk < 4; ++dk) { u32x4 w;
#pragma unroll
            for (int i = 0; i < 4; ++i) w[i] = cvt_pk_bf16(y[dk][2 * i] * QS_, y[dk][2 * i + 1] * QS_);
            if (dk < NDK) qf[dk] = __builtin_bit_cast(bf16x8, w); }
    }
    f32x16 o0, o1;
#pragma unroll
    for (int r = 0; r < 16; ++r) { o0[r] = 0.f; o1[r] = 0.f; }
    float mrun = 0.f, lsum = (has_sink && hi == 0) ? __builtin_amdgcn_exp2f(m_init) : 0.f;
    const int qw = q0pos + 32 * wid;
    const int vlane = (4 * hi + ((lane & 15) >> 2)) * 64 + ((lane >> 4) & 1) * 32 + (lane & 3) * 8;
    u32x4 kr[NKC], vr[2];
#define ATT_TILE(i_) ((i_) < n1 ? (i_) : s2 + ((i_) - n1))
#define ATT_LOAD(t) do { const bf16_t* kp_ = Kp + (size_t)(t) * 64 * ldk; const bf16_t* vp_ = Vp + (size_t)(t) * 64 * ldv; \
        _Pragma("unroll") for (int m_ = 0; m_ < NKC; ++m_) { const int c_ = tid + 512 * m_; kr[m_] = *(const GAS u32x4*)(kp_ + (size_t)(c_ / CH) * ldk + (c_ % CH) * 8); } \
        _Pragma("unroll") for (int m_ = 0; m_ < 2; ++m_) { const int c_ = tid + 512 * m_; vr[m_] = *(const GAS u32x4*)(vp_ + (size_t)(c_ >> 3) * ldv + (c_ & 7) * 8); } } while (0)
#define ATT_STORE(kb_, vb_) do { \
        _Pragma("unroll") for (int m_ = 0; m_ < NKC; ++m_) { const int c_ = tid + 512 * m_; *(LAS u32x4*)(lds + (kb_) * KBUF + (c_ / CH) * KST + (c_ % CH) * 16) = kr[m_]; } \
        _Pragma("unroll") for (int m_ = 0; m_ < 2; ++m_) { const int c_ = tid + 512 * m_; *(LAS u32x4*)(lds + VOFF + (vb_) * VBUF + ((c_ & 7) >> 2) * 8192 + (c_ >> 3) * 64 + (c_ & 3) * 16) = vr[m_]; } } while (0)
#define ATT_BAR() asm volatile("s_waitcnt lgkmcnt(0)\n\ts_barrier" ::: "memory")
    const int nst = (n1 + (e2 - s2)) >> 1;
    ATT_LOAD(0); ATT_STORE(0, 0);
    ATT_BAR();
    if (!late) {
        int vcur = 0;
        for (int I = 0; I < nst; ++I) {
            const int t = ATT_TILE(2 * I);
            if (I + 1 < nst) { const int tn = ATT_TILE(2 * I + 2); ATT_LOAD(tn); }
            bool active = true; if (WIN && t >= 4) { const int k0 = (t - 4) * 64; active = (k0 + 127 >= qw - 128) && (k0 <= qw + 31 + 128); }
            const int vnext = vcur == 2 ? 0 : vcur + 1;
            if (active) { f32x16 sa0, sa1, sb0, sb1;
                attn_qk<DQ, WIN>(lds, (I & 1) * KBUF, t, qf, o0, o1, mrun, lsum, sa0, sa1, sb0, sb1, l31, hi, qw);
                attn_softmax_pv(lds + VOFF + vcur * VBUF + vlane, sa0, sa1, sb0, sb1, o0, o1, lsum); }
            if (I + 1 < nst) ATT_STORE((I + 1) & 1, vnext);
            vcur = vnext;
            ATT_BAR();
        }
    } else {
        bf16x8 pw[8]; bool havep = false; int pvoff = 0;
        int vcur = 0;
        for (int I = 0; I < nst; ++I) {
            const int t = ATT_TILE(2 * I);
            if (I + 1 < nst) { const int tn = ATT_TILE(2 * I + 2); ATT_LOAD(tn); }
            bool active = true; if (WIN && t >= 4) { const int k0 = (t - 4) * 64; active = (k0 + 127 >= qw - 128) && (k0 <= qw + 31 + 128); }
            const int vnext = vcur == 2 ? 0 : vcur + 1;
            if (havep) attn_pv_all(lds + VOFF + pvoff + vlane, pw, o0, o1);
            havep = false;
            if (active) { f32x16 sa0, sa1, sb0, sb1;
                attn_qk<DQ, WIN>(lds, (I & 1) * KBUF, t, qf, o0, o1, mrun, lsum, sa0, sa1, sb0, sb1, l31, hi, qw);
                attn_softmax_keep(sa0, sa1, sb0, sb1, pw, lsum); havep = true; pvoff = vcur * VBUF; }
            if (I + 1 < nst) ATT_STORE((I + 1) & 1, vnext);
            vcur = vnext;
            ATT_BAR();
        }
        if (havep) attn_pv_all(lds + VOFF + pvoff + vlane, pw, o0, o1);
    }
    ATT_BAR();
#undef ATT_TILE
#undef ATT_LOAD
#undef ATT_STORE
#undef ATT_BAR
    const float lt = lsum + __shfl_xor(lsum, 32), inv = 1.0f / lt;
    bf16_t* orow = Op + (size_t)(32 * wid + l31) * DM + 4 * hi;
#pragma unroll
    for (int g = 0; g < 4; ++g) {
        u32x2 w0, w1;
        w0.x = cvt_pk_bf16(o0[4 * g] * inv, o0[4 * g + 1] * inv); w0.y = cvt_pk_bf16(o0[4 * g + 2] * inv, o0[4 * g + 3] * inv);
        w1.x = cvt_pk_bf16(o1[4 * g] * inv, o1[4 * g + 1] * inv); w1.y = cvt_pk_bf16(o1[4 * g + 2] * inv, o1[4 * g + 3] * inv);
        *(u32x2*)(orow + 8 * g) = w0; *(u32x2*)(orow + 32 + 8 * g) = w1;
    }
}

struct Args { const float* in[28]; float* out; unsigned char* ws; int lo, hi; };
typedef const GAS float* cfp_t;
struct Ctx { const __attribute__((address_space(4))) cfp_t* in; float* out; unsigned char* ws;
    __device__ __forceinline__ const float* inp(int i) const { return (const float*)in[i]; } };
enum { I_X = 0, I_C, I_CTX, I_CCTX, I_MODW, I_MODB, I_N1G, I_N2G, I_MLAWIN, I_CQG, I_CKVG, I_WUQ, I_WUKV, I_QG, I_KG, I_FNETW, I_EWOUT,
       I_WINWIN, I_WQG, I_WKG, I_SINK, I_POOLW, I_POOLS, I_OWOUT, I_FFNUP, I_CONVW, I_CONVB, I_FFNDN };

__device__ __forceinline__ void tr_item(const float* W, int K, int Nsrc, bf16_t* WT, int nblk, int item, LAS float* scr, int lane, int mode, const float* ksc) {
    const int kb = item / nblk, nb = item % nblk, k0 = 64 * kb, n0 = 32 * nb;
    int s0 = n0;
    if (mode == 1) s0 = n0 < 672 ? n0 : -1;
    else if (mode == 2) { const int hd = n0 >> 7, d0 = n0 & 127; s0 = d0 < 96 ? hd * 96 + d0 : -1; }
    else if (mode == 3) { const int pn = n0 >> 8, bj = (n0 >> 7) & 1, c = n0 & 127; s0 = bj * DFF + pn * 128 + c; }
#pragma unroll 16
    for (int i = 0; i < 32; ++i) { const int kk = 2 * i + (lane >> 5); float v = 0.f;
        if (s0 >= 0) { v = W[(size_t)(k0 + kk) * Nsrc + s0 + (lane & 31)]; if (ksc) v *= ksc[k0 + kk]; }
        scr[kk * 33 + (lane & 31)] = v; }
    asm volatile("s_waitcnt lgkmcnt(0)" ::: "memory");
    const int c = lane & 7;
#pragma unroll
    for (int j = 0; j < 4; ++j) { const int n = (lane >> 3) + 8 * j; const LAS float* s = scr + (8 * c) * 33 + n;
        u32x4 o; o.x = cvt_pk_bf16(s[0 * 33], s[1 * 33]); o.y = cvt_pk_bf16(s[2 * 33], s[3 * 33]); o.z = cvt_pk_bf16(s[4 * 33], s[5 * 33]); o.w = cvt_pk_bf16(s[6 * 33], s[7 * 33]);
        *(u32x4*)(WT + (size_t)(n0 + n) * K + k0 + 8 * c) = o; }
    asm volatile("s_waitcnt lgkmcnt(0)" ::: "memory");
}
__device__ __forceinline__ void tr_job(const float* W, int K, int Nsrc, bf16_t* WT, int Nout, int mode, const float* ksc, LAS float* scr, int gw, int ngw, int lane) {
    const int nblk = Nout / 32, nitems = (K / 64) * nblk;
    for (int it = gw; it < nitems; it += ngw) tr_item(W, K, Nsrc, WT, nblk, it, scr, lane, mode, ksc);
}
__device__ __forceinline__ void ffn_weights(const Ctx& a, int layer, LAS float* scr, int gw, int ngw, int lane) {
    tr_job(a.inp(I_FFNUP) + (size_t)layer * DM * 2 * DFF, DM, 2 * DFF, (bf16_t*)(a.ws + WS_WUP), 2 * DFF, 3, nullptr, scr, gw, ngw, lane);
    tr_job(a.inp(I_FFNDN) + (size_t)layer * DFF * DM, DFF, DM, (bf16_t*)(a.ws + ((layer & 1) ? WS_WDN2 : WS_WDN)), DM, 0, nullptr, scr, gw, ngw, lane);
}
__device__ __forceinline__ void mixer_weights(const Ctx& a, int j, LAS float* scr, int gw, int ngw, int lane) {
    unsigned char* ws = a.ws;
    tr_job(a.inp(I_MLAWIN) + (size_t)j * DM * 672, DM, 672, (bf16_t*)(ws + WS_WINE) + (size_t)j * 768 * DM, 768, 1, nullptr, scr, gw, ngw, lane);
    tr_job(a.inp(I_WUQ) + (size_t)j * 256 * 1152, 256, 1152, (bf16_t*)(ws + WS_WUQ) + (size_t)j * 1536 * 256, 1536, 2, a.inp(I_CQG) + j * 256, scr, gw, ngw, lane);
    tr_job(a.inp(I_WUKV) + (size_t)j * 128 * 1536, 128, 1536, (bf16_t*)(ws + WS_WUKV) + (size_t)j * 1536 * 128, 1536, 0, a.inp(I_CKVG) + j * 128, scr, gw, ngw, lane);
    tr_job(a.inp(I_EWOUT) + (size_t)j * DM * DM, DM, DM, (bf16_t*)(ws + WS_WOUTE) + (size_t)j * DM * DM, DM, 0, nullptr, scr, gw, ngw, lane);
    tr_job(a.inp(I_WINWIN) + (size_t)j * DM * 1536, DM, 1536, (bf16_t*)(ws + WS_WINO) + (size_t)j * 1536 * DM, 1536, 0, nullptr, scr, gw, ngw, lane);
    tr_job(a.inp(I_OWOUT) + (size_t)j * DM * DM, DM, DM, (bf16_t*)(ws + WS_WOUTO) + (size_t)j * DM * DM, DM, 0, nullptr, scr, gw, ngw, lane);
}

__device__ __forceinline__ void mods_item(const Ctx& a, int item, LAS float* sl) {
    int tid = threadIdx.x; asm volatile("" : "+v"(tid)); const int l = item / 48, nb = item % 48;
    LAS float* red = sl + 17 * 1024;
    for (int idx = tid; idx < 17 * 1024; idx += 512) { const int r = idx >> 10, k = idx & 1023; const float v = r < 16 ? a.inp(I_C)[r * 1024 + k] : a.inp(I_CCTX)[k]; sl[idx] = v / (1.0f + __expf(-v)); }
    __syncthreads();
    const int cn = tid & 127, ks = tid >> 7, n = 128 * nb + cn;
    float acc[17];
#pragma unroll
    for (int r = 0; r < 17; ++r) acc[r] = 0.f;
    const float* wp = a.inp(I_MODW) + ((size_t)l * 1024 + 256 * ks) * 6144 + n;
#pragma unroll 4
    for (int k = 0; k < 256; k += 4) {
        const float w0 = wp[(size_t)(k + 0) * 6144], w1 = wp[(size_t)(k + 1) * 6144], w2 = wp[(size_t)(k + 2) * 6144], w3 = wp[(size_t)(k + 3) * 6144];
#pragma unroll
        for (int r = 0; r < 17; ++r) { const f32x4 s4 = *(const LAS f32x4*)(sl + r * 1024 + 256 * ks + k); acc[r] += s4[0] * w0 + s4[1] * w1 + s4[2] * w2 + s4[3] * w3; }
    }
#pragma unroll
    for (int r = 0; r < 17; ++r) red[(ks * 17 + r) * 128 + cn] = acc[r];
    __syncthreads();
    float* mods = (float*)(a.ws + WS_MODS);
    for (int idx = tid; idx < 17 * 128; idx += 512) { const int r = idx >> 7, c2 = idx & 127;
        const float s = red[(0 * 17 + r) * 128 + c2] + red[(1 * 17 + r) * 128 + c2] + red[(2 * 17 + r) * 128 + c2] + red[(3 * 17 + r) * 128 + c2];
        mods[((size_t)l * 17 + r) * 6144 + 128 * nb + c2] = s + a.inp(I_MODB)[l * 6144 + 128 * nb + c2]; }
    __syncthreads();
}

__device__ __forceinline__ void norm_pass(const float* xsrc, const float* csrc, const float* g, const float* mods_l, int shift_idx, int scale_idx,
                                          bf16_t* U, bool ffn_layout, bool skip_ctx, int gw, int ngw, int lane) {
    for (int R0 = gw; R0 < T; R0 += 2 * ngw) {
        f32x4 v[2][4]; bool ok[2]; int bb[2], pp[2];
#pragma unroll
        for (int s = 0; s < 2; ++s) { const int R = R0 + s * ngw; const int b = R / TB, p = R % TB; const bool isctx = p < NCTX; bb[s] = b; pp[s] = p;
            ok[s] = (R < T) && !(isctx && skip_ctx);
            const float* src = isctx ? csrc + (size_t)(b * NCTX + p) * DM : xsrc + (size_t)(b * SEQ + p - NCTX) * DM;
            if (ok[s]) {
#pragma unroll
                for (int j = 0; j < 4; ++j) v[s][j] = *(const f32x4*)(src + (lane + 64 * j) * 4); } }
#pragma unroll
        for (int s = 0; s < 2; ++s) if (ok[s]) {
            const int R = R0 + s * ngw, b = bb[s], p = pp[s]; const bool isctx = p < NCTX;
            const float* mrow = mods_l + (size_t)(isctx ? 16 : b) * 6144;
            float ss = 0.f;
#pragma unroll
            for (int j = 0; j < 4; ++j) ss += (v[s][j][0] * v[s][j][0] + v[s][j][1] * v[s][j][1]) + (v[s][j][2] * v[s][j][2] + v[s][j][3] * v[s][j][3]);
            const float rs = rsqrtf(wave_sum(ss) * (1.0f / DM) + EPS);
            const size_t orow = ffn_layout ? (size_t)b * U2B + (isctx ? p : 264 + p - NCTX) : (size_t)R;
#pragma unroll
            for (int j = 0; j < 4; ++j) { const int c4 = (lane + 64 * j) * 4;
                const f32x4 gg = *(const f32x4*)(g + c4), sh = *(const f32x4*)(mrow + shift_idx * 1024 + c4), sc = *(const f32x4*)(mrow + scale_idx * 1024 + c4);
                const f32x4 y = v[s][j] * rs * gg * (sc + 1.0f) + sh;
                u32x2 w; w.x = cvt_pk_bf16(y[0], y[1]); w.y = cvt_pk_bf16(y[2], y[3]);
                *(u32x2*)(U + orow * DM + c4) = w;
                if (ffn_layout && !isctx && p - NCTX >= SEQ - 33) *(u32x2*)(U + ((size_t)TAILROW0 + (b / 7) * 256 + (b % 7) * TAILSEG + (p - NCTX - (SEQ - 33))) * DM + c4) = w; }
        }
    }
    if (ffn_layout && gw >= 32 && gw < 48) {
        const int tb_ = gw - 32; const size_t orow = (size_t)TAILROW0 + (tb_ / 7) * 256 + (tb_ % 7) * TAILSEG + 33;
#pragma unroll
        for (int j = 0; j < 4; ++j) *(u32x2*)(U + orow * DM + (lane + 64 * j) * 4) = (u32x2){0u, 0u};
    }
    if (ffn_layout && gw < 32) {
        const int b = gw >> 1; const size_t orow = (size_t)b * U2B + ((gw & 1) ? 264 + SEQ : 263);
#pragma unroll
        for (int j = 0; j < 4; ++j) *(u32x2*)(U + orow * DM + (lane + 64 * j) * 4) = (u32x2){0u, 0u};
    }
}

template <int NF> __device__ __forceinline__ void rope_cs(int pos, int i, float& cs, float& sn) {
    const int row = pos >> 6, col = pos & 63; const int f = i < NF ? i : i - NF;
    const float inv = exp2f(-(float)f * (13.287712379549449f / NF));
    const float ang = (float)(i < NF ? row : col) * inv;
    sincosf(ang, &sn, &cs);
}

__device__ __forceinline__ void unpack8(const u32x4 v, float (&x)[8]) {
#pragma unroll
    for (int i = 0; i < 4; ++i) { x[2 * i] = bflo(v[i]); x[2 * i + 1] = bfhi(v[i]); }
}
__device__ __forceinline__ u32x4 pack8f(const float (&x)[8]) { u32x4 o; o.x = cvt_pk_bf16(x[0], x[1]); o.y = cvt_pk_bf16(x[2], x[3]); o.z = cvt_pk_bf16(x[4], x[5]); o.w = cvt_pk_bf16(x[6], x[7]); return o; }

__device__ __forceinline__ void ew_even(const Ctx& a, int j, int gw, int ngw, int lane) {
    const bf16_t* H = (const bf16_t*)(a.ws + WS_H); bf16_t* Qb = (bf16_t*)(a.ws + WS_Q); bf16_t* KVb = (bf16_t*)(a.ws + WS_KV); bf16_t* Kout = (bf16_t*)(a.ws + WS_U);
    const float QS = 0.10206207261596577f * LOG2E;
    const f32x2v* ropeT = (const f32x2v*)(a.ws + WS_ROPE_E);
    const int g16 = lane >> 4, c16 = lane & 15; const bool act = c16 < 12; const int cc = act ? c16 : 0;
    float qg[8], kg[8];
#pragma unroll
    for (int e = 0; e < 8; ++e) { qg[e] = a.inp(I_QG)[j * 96 + 8 * cc + e]; kg[e] = a.inp(I_KG)[j * 96 + 8 * cc + e]; }
    for (int R = gw; R < T; R += ngw) {
        const int p = R % TB; const int pos = p - NCTX; const bool lat = pos >= 0;
        const bf16_t* hrow = H + (size_t)R * 768; bf16_t* qrow = Qb + (size_t)R * 1536; bf16_t* kvrow = KVb + (size_t)R * 1536;
        const u32x4 z4 = {0u, 0u, 0u, 0u};
        u32x4 hv = z4; if (lane < 48) hv = *(const u32x4*)(hrow + 8 * lane);
        u32x4 qv[3], kv[3], vv[2];
#pragma unroll
        for (int rd = 0; rd < 3; ++rd) { const int hd = 4 * rd + g16; qv[rd] = z4; kv[rd] = z4;
            if (act) { kv[rd] = c16 < 8 ? *(const u32x4*)(kvrow + hd * 128 + 8 * c16) : *(const u32x4*)(hrow + 384 + 8 * (c16 - 8)); } }
        float cs[8], sn[8];
#pragma unroll
        for (int e = 0; e < 8; ++e) { cs[e] = 1.f; sn[e] = 0.f; }
        if (lat && c16 >= 8 && act) {
#pragma unroll
            for (int e = 0; e < 8; ++e) { const f32x2v t = ropeT[pos * 16 + 8 * (c16 & 1) + e]; cs[e] = t.x; sn[e] = t.y; } }
        float x[8]; unpack8(hv, x); float ss = 0.f;
#pragma unroll
        for (int e = 0; e < 8; ++e) ss += x[e] * x[e];
        ss = half_sum(ss);
        const float r_q = rsqrtf(__shfl(ss, 0) * (1.0f / 256.0f) + EPS), r_kv = rsqrtf(__shfl(ss, 32) * (1.0f / 128.0f) + EPS);
        if (lane == 0) ((float*)(a.ws + WS_RQ))[R] = r_q;
#pragma unroll
        for (int rd = 0; rd < 3; ++rd) {
            const int hd = 4 * rd + g16;
            { float y[8], o[8]; unpack8(kv[rd], y); float s2 = 0.f; const float pre = 1.0f;
#pragma unroll
              for (int e = 0; e < 8; ++e) { y[e] *= pre; s2 += y[e] * y[e]; }
              s2 += __shfl_xor(s2, 8); s2 += __shfl_xor(s2, 4); s2 += __shfl_xor(s2, 2); s2 += __shfl_xor(s2, 1);
              const float sc = rsqrtf(s2 * (1.0f / 96.0f) + EPS);
#pragma unroll
              for (int e = 0; e < 8; ++e) { y[e] *= sc * kg[e]; o[e] = __shfl_xor(y[e], 2); }
              if (c16 >= 8) {
#pragma unroll
                  for (int e = 0; e < 8; ++e) y[e] = c16 < 10 ? y[e] * cs[e] - o[e] * sn[e] : o[e] * sn[e] + y[e] * cs[e]; }
              if (act) *(u32x4*)(Kout + (size_t)R * 1152 + hd * 96 + 8 * c16) = pack8f(y); }
        }
    }
}

__device__ __forceinline__ void z_fold(const Ctx& a, LAS unsigned char* lds, int gw, int ngw, int wave, int lane) {
    const bf16_t* ZLp = (const bf16_t*)(a.ws + WS_ZL); bf16_t* ZF = (bf16_t*)(a.ws + WS_ZF);
    LAS bf16_t* zr = (LAS bf16_t*)(lds + wave * 16384);
    for (int row = gw; row < 4096; row += ngw) {
        const bf16_t* src = ZLp + (size_t)row * 8192;
#pragma unroll
        for (int i = 0; i < 16; ++i) *(LAS u32x4*)(zr + 8 * (lane + 64 * i)) = *(const u32x4*)(src + 8 * (lane + 64 * i));
        asm volatile("s_waitcnt lgkmcnt(0)" ::: "memory");
#pragma unroll
        for (int i = 0; i < 8; ++i) { const int k0 = 8 * (lane + 64 * i); float y[8];
#pragma unroll
            for (int e = 0; e < 8; ++e) { const int kap = k0 + e; float v;
                if (kap <= 2048) { v = bf2f(zr[kap]); if (kap != 0 && kap != 2048) v += bf2f(zr[4096 - kap]); }
                else { const int l = kap - 2048; v = bf2f(zr[4096 + l]) - bf2f(zr[8192 - l]); }
                y[e] = v; }
            *(u32x4*)(ZF + (size_t)row * 4096 + k0) = pack8f(y); }
        asm volatile("s_waitcnt lgkmcnt(0)" ::: "memory");
    }
}

__device__ __forceinline__ void ew_odd(const Ctx& a, int j, int gw, int ngw, int lane) {
    bf16_t* H = (bf16_t*)(a.ws + WS_H); bf16_t* PO = (bf16_t*)(a.ws + WS_POOL);
    const float QS = 0.125f * LOG2E;
    const f32x2v* ropeT = (const f32x2v*)(a.ws + WS_ROPE_O);
    const int c8 = lane & 7, hl = lane >> 3;
    float qg[8], kg[8];
#pragma unroll
    for (int e = 0; e < 8; ++e) { qg[e] = a.inp(I_WQG)[j * 64 + 8 * c8 + e]; kg[e] = a.inp(I_WKG)[j * 64 + 8 * c8 + e]; }
    for (int R = gw; R < T; R += ngw) {
        const int p = R % TB; const int pos = p - NCTX; const bool lat = pos >= 0;
        bf16_t* hrow = H + (size_t)R * 1536;
        u32x4 qk[2]; qk[1] = (u32x4){0u, 0u, 0u, 0u}; if (lane >= 32) qk[1] = *(const u32x4*)(hrow + 512 + 8 * lane);
        float cs[8], sn[8];
#pragma unroll
        for (int e = 0; e < 8; ++e) { cs[e] = 1.f; sn[e] = 0.f; }
        if (lat) {
#pragma unroll
            for (int e = 0; e < 8; ++e) { const f32x2v t = ropeT[pos * 32 + 8 * (c8 & 3) + e]; cs[e] = t.x; sn[e] = t.y; } }
        const int tpos = lat ? pos : p, Ls = lat ? SEQ : NCTX;
        { const int pc = lane & 31, g = pc >> 3, half = 1 << g;
          const int lo = tpos - half < 0 ? 0 : tpos - half, hi = tpos + half > Ls ? Ls : tpos + half;
          float sum[8];
#pragma unroll
          for (int e = 0; e < 8; ++e) sum[e] = 0.f;
          if (lane < 32) {
              for (int tt = lo; tt < hi; ++tt) { float z[8]; unpack8(*(const u32x4*)(hrow + (ptrdiff_t)(tt - tpos) * 1536 + 1280 + 8 * pc), z);
#pragma unroll
                  for (int e = 0; e < 8; ++e) sum[e] += z[e]; }
              const float rc = 1.0f / (float)(hi - lo); float z[8]; unpack8(*(const u32x4*)(hrow + 1280 + 8 * pc), z);
#pragma unroll
              for (int e = 0; e < 8; ++e) sum[e] = sum[e] * rc - z[e];
              *(u32x4*)(PO + (size_t)R * 256 + 8 * pc) = pack8f(sum); } }
        if (lane >= 32) {
            float y[8], o[8]; unpack8(qk[1], y); float s2 = 0.f;
#pragma unroll
            for (int e = 0; e < 8; ++e) s2 += y[e] * y[e];
            s2 += __shfl_xor(s2, 4); s2 += __shfl_xor(s2, 2); s2 += __shfl_xor(s2, 1);
            const float sc = rsqrtf(s2 * (1.0f / 64.0f) + EPS);
#pragma unroll
            for (int e = 0; e < 8; ++e) { y[e] *= sc * kg[e]; o[e] = __shfl_xor(y[e], 4); }
#pragma unroll
            for (int e = 0; e < 8; ++e) y[e] = c8 < 4 ? y[e] * cs[e] - o[e] * sn[e] : o[e] * sn[e] + y[e] * cs[e];
            *(u32x4*)(hrow + 512 + 8 * lane) = pack8f(y);
        }
    }
}

#define XB_TMO      128
#define XB_XCNT(j)  (256  + 64 * (j))
#define XB_XSUB(j)  (1280 + 64 * (j))
#define XB_XGEN(j)  (2304 + 64 * (j))
#define XB_TOP      3328
#define XB_TOPGEN   3392
#define XCD_BAR_WORDS 3456
#define XB_SPIN_CAP (1u << 18)
__device__ __forceinline__ unsigned xb_ld(unsigned* p)              { return __hip_atomic_load(p, __ATOMIC_RELAXED, __HIP_MEMORY_SCOPE_AGENT); }
__device__ __forceinline__ unsigned xb_add(unsigned* p, unsigned v) { return __hip_atomic_fetch_add(p, v, __ATOMIC_RELAXED, __HIP_MEMORY_SCOPE_AGENT); }
__device__ __forceinline__ unsigned xb_xcc_id() { return (unsigned)__builtin_amdgcn_s_getreg((3 << 11) | 20) & 0xFu; }
#define XB_SPIN(cond, bar) do { unsigned _sp = 0; while (cond) { __builtin_amdgcn_s_sleep(1); \
    if ((++_sp & 255u) == 0u) { if (xb_ld(&(bar)[XB_TMO])) break; if (_sp > XB_SPIN_CAP) { atomicAdd(&(bar)[XB_TMO], 1u); break; } } } } while (0)
struct XcdBarrier { unsigned* bar; unsigned x; volatile LAS unsigned* st; };
__device__ __forceinline__ XcdBarrier xcd_barrier_post(unsigned* bar, volatile LAS unsigned* st) {
    XcdBarrier b; b.bar = bar; b.x = xb_xcc_id(); b.st = st;
    int tid_ = threadIdx.x; asm volatile("" : "+v"(tid_));
    if (tid_ == 0) (void)xb_add(&bar[XB_XCNT(b.x)], 1u);
    return b;
}
__device__ __forceinline__ void xcd_barrier_complete(unsigned* bar, unsigned x, unsigned& nloc, unsigned& nx) {
    const unsigned G = gridDim.x * gridDim.y * gridDim.z;
    unsigned sum, cnt, mine, sp = 0u;
    for (;;) {
        sum = 0u; cnt = 0u; mine = 0u;
#pragma unroll
        for (unsigned j = 0; j < 16; ++j) { const unsigned c = xb_ld(&bar[XB_XCNT(j)]); sum += c; cnt += (c > 0u) ? 1u : 0u; mine = (j == x) ? c : mine; }
        if (sum == G) break;
        __builtin_amdgcn_s_sleep(1);
        if ((++sp & 255u) == 0u) { if (xb_ld(&bar[XB_TMO])) break; if (sp > XB_SPIN_CAP) { atomicAdd(&bar[XB_TMO], 1u); break; } }
    }
    nloc = mine > 0u ? mine : 1u; nx = cnt > 0u ? cnt : 1u;
}
__device__ __forceinline__ void xcd_barrier(const XcdBarrier& b) {
    asm volatile("s_waitcnt vmcnt(0)" ::: "memory");
    __syncthreads();
    int tid_ = threadIdx.x; asm volatile("" : "+v"(tid_));
    if (tid_ == 0) {
        unsigned* bar = b.bar;
        __builtin_amdgcn_s_waitcnt(0);
        unsigned nloc = b.st[0], nx = b.st[1];
        if (nloc == 0u) { xcd_barrier_complete(bar, b.x, nloc, nx); b.st[0] = nloc; b.st[1] = nx; }
        const unsigned old = xb_add(&bar[XB_XSUB(b.x)], 1u);
        const unsigned gen = old / nloc;
        if (old + 1u == (gen + 1u) * nloc) {
            __builtin_amdgcn_fence(__ATOMIC_RELEASE, "agent");
            asm volatile("s_waitcnt vmcnt(0)" ::: "memory");
            const unsigned og = xb_add(&bar[XB_TOP], 1u);
            const unsigned tg = og / nx;
            if (og + 1u == (tg + 1u) * nx) xb_add(&bar[XB_TOPGEN], 1u);
            else XB_SPIN(xb_ld(&bar[XB_TOPGEN]) == tg, bar);
            __builtin_amdgcn_fence(__ATOMIC_ACQUIRE, "agent");
            xb_add(&bar[XB_XGEN(b.x)], 1u);
            asm volatile("s_waitcnt vmcnt(0)" ::: "memory");
        } else {
            XB_SPIN(xb_ld(&bar[XB_XGEN(b.x)]) == gen, bar);
            __builtin_amdgcn_fence(__ATOMIC_ACQUIRE, "agent");
            asm volatile("s_waitcnt vmcnt(0)" ::: "memory");
        }
    }
    __syncthreads();
}

constexpr int LDS_BYTES = 147456;
constexpr int NPHASES = 1 + 2 * 9 + 2 * 8;

__global__ void __launch_bounds__(512, 2) mega_fwd(Args ka) {
    extern __shared__ __attribute__((aligned(16))) unsigned char lds_raw[];
    LAS unsigned char* lds = (LAS unsigned char*)lds_raw;
    cg::grid_group grid = cg::this_grid();
    volatile LAS unsigned* xbst = (volatile LAS unsigned*)(lds + 139264);
    { int tid_ = threadIdx.x; asm volatile("" : "+v"(tid_)); if (tid_ < 2) xbst[tid_] = 0u; }
    __syncthreads();
    XcdBarrier xbar; xbar.bar = (unsigned*)ka.ws; xbar.x = 0; xbar.st = xbst;
    if (ka.hi - ka.lo > 1) xbar = xcd_barrier_post((unsigned*)ka.ws, xbst);
#define U ((bf16_t*)(wsl + WS_U))
#define MIX ((bf16_t*)(wsl + WS_MIX))
#define Hb ((bf16_t*)(wsl + WS_H))
#define Qb ((bf16_t*)(wsl + WS_Q))
#define KVb ((bf16_t*)(wsl + WS_KV))
#define ZL ((bf16_t*)(wsl + WS_ZL))
#define ZC ((bf16_t*)(wsl + WS_ZC))
#define HID ((bf16_t*)(wsl + WS_HID))
#define POOL ((bf16_t*)(wsl + WS_POOL))
#define DFTL ((bf16_t*)(wsl + WS_DFTL))
#define DFTC ((bf16_t*)(wsl + WS_DFTC))
#define hctx ((float*)(wsl + WS_HCTX))
    int ph = 0, layer_ = 0;
#define PHASE_BEGIN if (ph >= ka.lo && ph < ka.hi) { GAS unsigned char* wsg_ = (GAS unsigned char*)ka.ws; asm volatile("" : "+s"(wsg_)); unsigned char* wsl = (unsigned char*)wsg_; \
        const __attribute__((address_space(4))) cfp_t* ain_ = (const __attribute__((address_space(4))) cfp_t*)__builtin_amdgcn_kernarg_segment_ptr(); asm volatile("" : "+s"(ain_)); \
        const Ctx a{ain_, ka.out, wsl}; \
        int lyr_ = layer_; asm volatile("" : "+s"(lyr_)); const float* mods_l = (const float*)(wsl + WS_MODS) + (size_t)lyr_ * 17 * 6144; const float* xin = lyr_ == 0 ? a.inp(I_X) : a.out; const float* cin = lyr_ == 0 ? a.inp(I_CTX) : (const float*)(wsl + WS_HCTX); (void)mods_l; (void)xin; (void)cin; int tid = threadIdx.x; asm volatile("" : "+v"(tid)); int G = gridDim.x, bx = blockIdx.x; asm volatile("" : "+s"(G), "+s"(bx)); \
        const int vcu = (G % 8 == 0) ? (bx % 8) * (G / 8) + bx / 8 : bx, ngw = G * 8, ngt = G * 512; (void)vcu; (void)ngw; (void)ngt; \
        const int lane = tid & 63, wave = __builtin_amdgcn_readfirstlane(tid >> 6), gw = bx * 8 + wave, gtid = bx * 512 + tid; LAS float* scr = (LAS float*)(lds + wave * 8448); \
        (void)lane; (void)gw; (void)gtid; (void)scr;
#define PHASE_END } if (ph >= ka.lo && ph + 1 < ka.hi) { for (int sr_ = 0; sr_ < REP_SYNC; ++sr_) { if (ph == 0) grid.sync(); else xcd_barrier(xbar); } } ++ph;

    PHASE_BEGIN
#ifndef SKIP_P0
        { REPLOOP(REP_P0) {
        for (int it = bx; it < 192; it += G) mods_item(a, it, (LAS float*)lds);
        mixer_weights(a, 0, scr, gw, ngw, lane);
        __syncthreads();
        LAS float* ctab = (LAS float*)lds;
        for (int m = tid; m < 4096; m += 512) ctab[m] = cospif((float)m * (1.0f / 2048.0f)) * (1.0f / 64.0f);
        __syncthreads();
        for (int idx = gtid; idx < 4096 * 512; idx += ngt) { const int k = idx >> 9, col0 = (idx & 511) * 8; float v[8];
#pragma unroll
            for (int e = 0; e < 8; ++e) { const int kap = col0 + e; const int m = kap <= 2048 ? (k * kap) & 4095 : (k * (kap - 2048) + 1024) & 4095; v[e] = ctab[m]; }
            u32x4 o; o.x = cvt_pk_bf16(v[0], v[1]); o.y = cvt_pk_bf16(v[2], v[3]); o.z = cvt_pk_bf16(v[4], v[5]); o.w = cvt_pk_bf16(v[6], v[7]);
            *(u32x4*)(DFTL + (size_t)k * 4096 + col0) = o; }
        for (int idx = gtid; idx < 256 * 64; idx += ngt) { const int k = idx >> 6, col0 = (idx & 63) * 8, cs = col0 >> 8, l0 = col0 & 255; float v[8];
#pragma unroll
            for (int e = 0; e < 8; ++e) { const int m = (k * (l0 + e)) & 255; const float x = (float)m * (1.0f / 128.0f); v[e] = (cs ? -sinpif(x) : cospif(x)) * (1.0f / 16.0f); }
            u32x4 o; o.x = cvt_pk_bf16(v[0], v[1]); o.y = cvt_pk_bf16(v[2], v[3]); o.z = cvt_pk_bf16(v[4], v[5]); o.w = cvt_pk_bf16(v[6], v[7]);
            *(u32x4*)(DFTC + (size_t)k * 512 + col0) = o; }
        for (int idx = gtid; idx < 2 * 512 * 256; idx += ngt) { const int j = idx >> 17, n = (idx >> 8) & 511, k = idx & 255; const int cs = n >> 8, g = (n >> 6) & 3, d = n & 63, g2 = k >> 6, c = k & 63;
            float s = 0.f;
            if (g2 == g) { const float* wf = a.inp(I_FNETW) + ((size_t)(j * 4 + g) * 64) * 64 + d;
                for (int c2 = 0; c2 < 64; ++c2) { const int m = (c * c2) & 63; s += (cs ? -ctab[(m * 64 + 1024) & 4095] : ctab[m * 64]) * wf[c2 * 64]; }
                s *= 8.0f; }
            ((bf16_t*)(wsl + WS_WF))[idx] = (bf16_t)(cvt_pk_bf16(s, 0.f) & 0xffffu); }
        for (int idx = gtid; idx < 4096 * 16; idx += ngt) { float cs, sn; rope_cs<8>(idx >> 4, idx & 15, cs, sn); ((f32x2v*)(wsl + WS_ROPE_E))[idx] = (f32x2v){cs, sn}; }
        for (int idx = gtid; idx < 4096 * 32; idx += ngt) { float cs, sn; rope_cs<16>(idx >> 5, idx & 31, cs, sn); ((f32x2v*)(wsl + WS_ROPE_O))[idx] = (f32x2v){cs, sn}; }
        for (int idx = gtid; idx < 2 * 256 * 256; idx += ngt) { const int j = idx >> 16, n = (idx >> 8) & 255, k = idx & 255; const int g = n >> 6, d = n & 63, g2 = k >> 6, c = k & 63;
            float s = 0.f; if (g2 == g) s = a.inp(I_POOLW)[((size_t)(j * 4 + g) * 64 + c) * 64 + d] * a.inp(I_POOLS)[j * 256 + n];
            ((bf16_t*)(wsl + WS_WP))[idx] = (bf16_t)(cvt_pk_bf16(s, 0.f) & 0xffffu); }
        __syncthreads(); } }
#endif
    PHASE_END

    for (int layer = 0; layer < 4; ++layer) {
        const int j = layer >> 1; const bool even = !(layer & 1); const bool ctx_out = layer < 3;
        layer_ = layer;

        PHASE_BEGIN
#ifndef SKIP_NORM
            { REPLOOP(REP_NORM)
            norm_pass(xin, cin, a.inp(I_N1G) + layer * DM, mods_l, 0, 1, U, false, false, gw, ngw, lane); }
#endif
        PHASE_END

        PHASE_BEGIN
#ifndef SKIP_GIN
            { REPLOOP(REP_GIN) {
            if (even) { pg8::Gemm g{U, (const bf16_t*)(wsl + WS_WINE) + (size_t)j * 768 * DM, DM, DM, DM};
                pg8::Order<pg8::MapStd> S; S.init(T / 256, 3, G, bx, pg8::MapStd{0}); pg8::EpiBf16Ckv E{Hb, 768}; pg8::gemm_phase(lds, g, S, E); }
            else { pg8::Gemm g{U, (const bf16_t*)(wsl + WS_WINO) + (size_t)j * 1536 * DM, DM, DM, DM};
                pg8::Order<pg8::MapStd> S; S.init(T / 256, 6, G, bx, pg8::MapStd{0}); pg8::EpiBf16 E{Hb, 1536, Hb, 1536}; pg8::gemm_phase(lds, g, S, E); }
            } }
#endif
        PHASE_END

        if (even) {
            PHASE_BEGIN
#ifndef SKIP_G3
                { REPLOOP(REP_G3) {
                { pg8::Gemm g{Hb, (const bf16_t*)(wsl + WS_WUQ) + (size_t)j * 1536 * 256, 768, 256, 256};
                  pg8::Order<pg8::MapStd> S; S.init(T / 256, 6, G, bx, pg8::MapStd{0}); pg8::EpiBf16 E{Qb, 1536, Qb, 1536}; pg8::gemm_phase(lds, g, S, E); }
                { pg8::Gemm g{Hb + 256, (const bf16_t*)(wsl + WS_WUKV) + (size_t)j * 1536 * 128, 768, 128, 128};
                  pg8::Order<pg8::MapStd> S; S.init(T / 256, 6, G, bx, pg8::MapStd{0}); pg8::EpiBf16 E{KVb, 1536, KVb, 1536}; pg8::gemm_phase(lds, g, S, E); }
                { pg8::Gemm g{(const bf16_t*)(wsl + WS_WF) + (size_t)j * 512 * 256, Hb + 416, 256, 768, 256};
                  pg8::Order<pg8::MapZ> S; S.init(2, T / 256, G, bx, pg8::MapZ{}); pg8::EpiBf16 E{ZL, 8192, ZC, 512}; pg8::gemm_phase(lds, g, S, E); }
                } }
#endif
            PHASE_END
            PHASE_BEGIN
#ifndef SKIP_EWE
                ew_even(a, j, gw, ngw, lane);
                z_fold(a, lds, gw, ngw, wave, lane);
#endif
            PHASE_END
            PHASE_BEGIN
#ifndef SKIP_ATTE
                const bf16_t* Kb = (const bf16_t*)(wsl + WS_U);
                const int nu = 3072 + (ctx_out ? 192 : 0);
                { REPLOOP(REP_ATTE)
                for (int uid = vcu; uid < nu; uid += G) {
                    if (uid < 3072) { const int bh = uid >> 4, qb = uid & 15, b = bh / 12, h = bh % 12; const size_t base = (size_t)b * TB, qrow = base + NCTX + qb * 256;
                        attn_unit<96, false>(lds, Qb + qrow * 1536 + h * 128, 1536, Kb + base * 1152 + h * 96, 1152, KVb + base * 1536 + h * 128 + 64, 1536, MIX + qrow * DM + h * 64, 68, 0, 0, qb * 256, -1e30f, false, a.inp(I_QG) + j * 96, (const f32x2v*)(wsl + WS_ROPE_E), true, (const float*)(wsl + WS_RQ) + qrow); }
                    else { const int bh = uid - 3072, b = bh / 12, h = bh % 12; const size_t base = (size_t)b * TB;
                        attn_unit<96, false>(lds, Qb + base * 1536 + h * 128, 1536, Kb + base * 1152 + h * 96, 1152, KVb + base * 1536 + h * 128 + 64, 1536, MIX + base * DM + h * 64, 4, 0, 0, 0, -1e30f, false, a.inp(I_QG) + j * 96, (const f32x2v*)(wsl + WS_ROPE_E), false, (const float*)(wsl + WS_RQ) + base); }
                } }
#ifndef SKIP_ATTE_G
                { REPLOOP(REP_FNET) {
                { pg8::Gemm g{DFTL, (const bf16_t*)(wsl + WS_ZF), 4096, 4096, 4096};
                  pg8::Order<pg8::MapFnetL> S; S.init(256, 1, G, bx, pg8::MapFnetL{}); pg8::EpiBf16 E{MIX, DM, MIX, DM}; pg8::gemm_phase(lds, g, S, E); }
                if (ctx_out) { pg8::Gemm g{DFTC, ZC, 512, 512, 512};
                  pg8::Order<pg8::MapFnetC> S; S.init(16, 1, G, bx, pg8::MapFnetC{}); pg8::EpiBf16 E{MIX, DM, MIX, DM}; pg8::gemm_phase(lds, g, S, E); }
                } }
#endif
#endif
            PHASE_END
        } else {
            PHASE_BEGIN
#ifndef SKIP_EWO
                ew_odd(a, j, gw, ngw, lane);
#endif
            PHASE_END
            PHASE_BEGIN
#ifndef SKIP_ATTO
                const float* sink = a.inp(I_SINK) + j * 12;
                const int nu = 3072 + (ctx_out ? 192 : 0);
                { REPLOOP(REP_ATTO)
                for (int uid = vcu; uid < nu; uid += G) {
                    if (uid < 3072) { const int bh = uid >> 4, qb = uid & 15, b = bh / 12, h = bh % 12, kvh = h / 3; const size_t base = (size_t)b * TB, qrow = base + NCTX + qb * 256;
                        int lt0 = qb * 4 - 2, lt1 = qb * 4 + 6; if (lt0 < 0) lt0 = 0; if (lt1 > 64) lt1 = 64;
                        attn_unit<64, true>(lds, Hb + qrow * 1536 + h * 64, 1536, Hb + base * 1536 + 768 + kvh * 64, 1536, Hb + base * 1536 + 1024 + kvh * 64, 1536, MIX + qrow * DM + h * 64,
                                            4, 4 + lt0, 4 + lt1, qb * 256, sink[h] * LOG2E, true, a.inp(I_WQG) + j * 64, (const f32x2v*)(wsl + WS_ROPE_O), true); }
                    else { const int bh = uid - 3072, b = bh / 12, h = bh % 12, kvh = h / 3; const size_t base = (size_t)b * TB;
                        attn_unit<64, true>(lds, Hb + base * 1536 + h * 64, 1536, Hb + base * 1536 + 768 + kvh * 64, 1536, Hb + base * 1536 + 1024 + kvh * 64, 1536, MIX + base * DM + h * 64,
                                            4, 0, 0, 0, sink[h] * LOG2E, true, a.inp(I_WQG) + j * 64, (const f32x2v*)(wsl + WS_ROPE_O), false); }
                } }
                { pg8::Gemm g{POOL, (const bf16_t*)(wsl + WS_WP) + (size_t)j * 256 * 256, 256, 256, 256};
                  pg8::Order<pg8::MapStd> S; S.init(T / 256, 1, G, bx, pg8::MapStd{768}); pg8::EpiBf16 E{MIX, DM, MIX, DM}; pg8::gemm_phase(lds, g, S, E); }
#endif
            PHASE_END
        }

        PHASE_BEGIN
#ifndef SKIP_WOUT
            pg8::Gemm g{MIX, (const bf16_t*)(wsl + (even ? WS_WOUTE : WS_WOUTO)) + (size_t)j * DM * DM, DM, DM, DM};
            pg8::Order<pg8::MapRes> S; S.init(ctx_out ? 272 : 256, 4, G, bx, pg8::MapRes{ctx_out ? 1 : 0});
            { REPLOOP(REP_WOUT) { pg8::EpiRes E{rep_ ? (const float*)a.out : xin, a.out, rep_ ? (const float*)hctx : cin, hctx, mods_l, 2, rep_ ? 0.f : 1.f}; pg8::gemm_phase(lds, g, S, E); } }
            if (layer == 0) {
                const int nfree = (G == 256) ? 192 : G, first = (G == 256) ? 64 : 0;
                if (bx >= first) ffn_weights(a, 0, scr, (bx - first) * 8 + wave, nfree * 8, lane);
            }
#endif
        PHASE_END

        PHASE_BEGIN
#ifndef SKIP_NORM2
            { REPLOOP(REP_NORM)
            norm_pass(a.out, hctx, a.inp(I_N2G) + layer * DM, mods_l, 3, 4, U, true, !ctx_out, gw, ngw, lane); }
#endif
        PHASE_END

        PHASE_BEGIN
#ifndef SKIP_UP
            pg8::Gemm g{U, (const bf16_t*)(wsl + WS_WUP), DM, DM, DM};
            pg8::Order<pg8::MapUp> S; S.init(ctx_out ? 275 : 259, 22, G, bx, pg8::MapUp{ctx_out ? 1 : 0});
            pg8::EpiUp E{HID, a.inp(I_CONVW) + (size_t)layer * 3 * 2 * DFF, a.inp(I_CONVB) + (size_t)layer * 2 * DFF}; { REPLOOP(REP_UP) pg8::gemm_phase(lds, g, S, E); }
#endif
        PHASE_END

        PHASE_BEGIN
#ifndef SKIP_DN
            pg8::Gemm g{HID, (const bf16_t*)(wsl + ((layer & 1) ? WS_WDN2 : WS_WDN)), DFF, DFF, DFF};
            pg8::Order<pg8::MapRes> S; S.init(ctx_out ? 272 : 256, 4, G, bx, pg8::MapRes{ctx_out ? 1 : 0});
            { REPLOOP(REP_DN) { pg8::EpiRes E{a.out, a.out, hctx, hctx, mods_l, 5, rep_ ? 0.f : 1.f}; pg8::gemm_phase(lds, g, S, E); } }
            if (layer < 3) {
                const int nfree = (ctx_out && G == 256) ? 192 : G, first = (ctx_out && G == 256) ? 64 : 0;
                if (bx >= first) ffn_weights(a, layer + 1, scr, (bx - first) * 8 + wave, nfree * 8, lane);
                if (layer == 0 && bx >= first) mixer_weights(a, 1, scr, (bx - first) * 8 + wave, nfree * 8, lane);
            }
#endif
        PHASE_END
    }
#undef PHASE_BEGIN
#undef PHASE_END
#undef U
#undef MIX
#undef Hb
#undef Qb
#undef KVb
#undef ZL
#undef ZC
#undef HID
#undef POOL
#undef DFTL
#undef DFTC
#undef hctx
}

extern "C" void kernel_launch(void* const* d_in, const int* in_sizes, int n_in, void* d_out, int out_size, void* d_ws, size_t ws_size, hipStream_t stream) {
    static int grid = 0;
    if (grid == 0) {
        if (n_in != 28 || out_size != NB * SEQ * DM || ws_size < WS_END) { fprintf(stderr, "kernel_launch: unexpected shapes (n_in %d, out %d, ws %zu); nothing launched\n", n_in, out_size, ws_size); grid = -1; return; }
        int dev = 0, cus = 0, per_cu = 0;
        if (hipGetDevice(&dev) != hipSuccess || hipDeviceGetAttribute(&cus, hipDeviceAttributeMultiprocessorCount, dev) != hipSuccess) { grid = -1; return; }
        if (hipFuncSetAttribute((const void*)mega_fwd, hipFuncAttributeMaxDynamicSharedMemorySize, LDS_BYTES) != hipSuccess) { fprintf(stderr, "kernel_launch: hipFuncSetAttribute failed\n"); grid = -1; return; }
        if (hipOccupancyMaxActiveBlocksPerMultiprocessor(&per_cu, (const void*)mega_fwd, 512, LDS_BYTES) != hipSuccess || per_cu < 1) { fprintf(stderr, "kernel_launch: occupancy query says %d\n", per_cu); per_cu = 1; }
        (void)hipGetLastError();
        grid = cus * 1;
    }
    if (grid < 0) return;
    Args a{};
    for (int i = 0; i < 28; ++i) a.in[i] = (const float*)d_in[i];
    a.out = (float*)d_out; a.ws = (unsigned char*)d_ws; a.lo = 0; a.hi = NPHASES;
    (void)hipMemsetAsync(d_ws, 0, 16384, stream);
    void* args[] = {&a};
    hipError_t e = hipLaunchCooperativeKernel((const void*)mega_fwd, dim3(grid), dim3(512), args, LDS_BYTES, stream);
    if (e != hipSuccess) {
        fprintf(stderr, "kernel_launch: cooperative launch failed: %s (grid %d); falling back to one launch per phase\n", hipGetErrorString(e), grid);
        (void)hipGetLastError();
        for (int p = 0; p < NPHASES; ++p) { a.lo = p; a.hi = p + 1; hipLaunchKernelGGL(mega_fwd, dim3(grid), dim3(512), LDS_BYTES, stream, a); }
    }
}
```

```cpp
#include <hip/hip_runtime.h>
#include <hip/hip_cooperative_groups.h>
#include <cstdio>
#include <cstdint>
namespace cg = cooperative_groups;

#define REP_NORM 1
#define REP_GIN 1
#define REP_G3 1
#define REP_ATTE 1
#define REP_FNET 1
#define REP_ATTO 1
#define REP_WOUT 1
#define REP_UP 1
#define REP_DN 1
#define REP_P0 1
#define REP_EW 1
#define REP_SYNC 1
#define PROBE_MODE 0
#define REPLOOP(N) int nrep_ = (N); asm volatile("" : "+s"(nrep_)); for (int rep_ = 0; rep_ < nrep_; ++rep_)

constexpr int NB = 16, SEQ = 4096, NCTX = 256, DM = 1024, TB = SEQ + NCTX, T = NB * TB;
constexpr int DFF = 2816, U2B = 4608, TAILROW0 = 16 * 4608, TAILSEG = 34;
constexpr float EPS = 1e-6f;
constexpr float LOG2E = 1.4426950408889634f;

constexpr size_t MiB = 1u << 20;
constexpr size_t WS_MODS = 1 * MiB;
constexpr size_t WS_RQ = 2 * MiB + 720 * 1024;
constexpr size_t WS_WINE = 3 * MiB;
constexpr size_t WS_WUQ = 6 * MiB;
constexpr size_t WS_WUKV = WS_WUQ + 3 * MiB / 2;
constexpr size_t WS_WF = WS_WUKV + 3 * MiB / 4;
constexpr size_t WS_WP = WS_WF + MiB / 2;
constexpr size_t WS_WOUTE = 9 * MiB;
constexpr size_t WS_WOUTO = 13 * MiB;
constexpr size_t WS_WINO = 17 * MiB;
constexpr size_t WS_WUP = 23 * MiB;
constexpr size_t WS_WDN = 34 * MiB;
constexpr size_t WS_DFTC = 40 * MiB;
constexpr size_t WS_DFTL = 41 * MiB;
constexpr size_t WS_ZF = 73 * MiB;
constexpr size_t WS_HCTX = 105 * MiB;
constexpr size_t WS_U = 121 * MiB;
constexpr size_t WS_MIX = 275 * MiB;
constexpr size_t WS_ARENA = 411 * MiB;
constexpr size_t WS_H = WS_ARENA;
constexpr size_t WS_Q = WS_ARENA + 102 * MiB;
constexpr size_t WS_KV = WS_Q + 204 * MiB;
constexpr size_t WS_ZL = WS_KV + 204 * MiB;
constexpr size_t WS_ZC = WS_ZL + 64 * MiB;
constexpr size_t WS_POOL = WS_ARENA + 204 * MiB;
constexpr size_t WS_HID = WS_ARENA;
constexpr size_t WS_ROPE_E = WS_ZC + 4 * MiB;
constexpr size_t WS_ROPE_O = WS_ROPE_E + 1 * MiB;
constexpr size_t WS_WDN2 = WS_ROPE_O + 1 * MiB;
constexpr size_t WS_END = WS_WDN2 + 6 * MiB;
static_assert(WS_END <= 1024 * MiB, "ws map");

#define LAS __attribute__((address_space(3)))
#define GAS __attribute__((address_space(1)))
typedef unsigned short bf16_t;
typedef short bf16x8 __attribute__((ext_vector_type(8)));
typedef float f32x4 __attribute__((ext_vector_type(4)));
typedef float f32x16 __attribute__((ext_vector_type(16)));
typedef unsigned u32x4 __attribute__((ext_vector_type(4)));
typedef unsigned u32x2 __attribute__((ext_vector_type(2)));
typedef float f32x2v __attribute__((ext_vector_type(2)));

__device__ __forceinline__ unsigned cvt_pk_bf16(float lo, float hi) { unsigned r; asm volatile("v_cvt_pk_bf16_f32 %0, %1, %2" : "=v"(r) : "v"(lo), "v"(hi)); return r; }
__device__ __forceinline__ float bflo(unsigned u) { return __uint_as_float(u << 16); }
__device__ __forceinline__ float bfhi(unsigned u) { return __uint_as_float(u & 0xffff0000u); }
__device__ __forceinline__ float bf2f(bf16_t b) { return __uint_as_float((unsigned)b << 16); }
__device__ __forceinline__ float wave_sum(float v) {
#pragma unroll
    for (int o = 1; o < 64; o <<= 1) v += __shfl_xor(v, o);
    return v;
}
__device__ __forceinline__ float half_sum(float v) {
#pragma unroll
    for (int o = 1; o < 32; o <<= 1) v += __shfl_xor(v, o);
    return v;
}

namespace pg8 {
constexpr int BM = 256, BK = 64, HALF = 128, HTB = HALF * BK * 2, STAGE_BYTES = 8 * HTB, NXCD = 8, WGM = 8;
__device__ __forceinline__ int lds_byte(int r, int c) { const int st = (r >> 4) * 2 + (c >> 5), rr = r & 15, cc = c & 31, ob = rr * 64 + cc * 2; return st * 1024 + (ob ^ (((ob >> 9) & 1) << 5)); }
__device__ __forceinline__ void stage_rc(int b, int& R, int& C) { const int st = b / 1024, sb = b % 1024, swz = sb ^ (((sb >> 9) & 1) << 5); R = (st >> 1) * 16 + swz / 64; C = (st & 1) * 32 + (swz % 64) / 2; }
__device__ __forceinline__ int perm32(int rho) { const int n = rho >> 4, i = rho & 15; return 8 * (i >> 2) + 4 * n + (i & 3); }

struct Unit { int pm, pn, arow, brow, orow, ocol, aux, bt; };
struct Gemm { const bf16_t* A; const bf16_t* Bt; int lda, ldb, K; };

template <class Map> struct Order {
    int nM, nN, nwg, G, c; Map map;
    __device__ __forceinline__ void init(int nM_, int nN_, int G_, int c_, const Map& m) { nM = nM_; nN = nN_; nwg = nM * nN; G = G_; c = c_; map = m; }
    __device__ __forceinline__ bool next(int i, Unit& u) const {
        const long L = (long)i * G + c; if (L >= nwg) return false;
        int wgid = (int)L; { const int q = nwg / NXCD, r = nwg % NXCD, xcd = wgid % NXCD, off = wgid / NXCD; wgid = (xcd < r ? xcd * (q + 1) : r * (q + 1) + (xcd - r) * q) + off; }
        const int nig = WGM * nN, gid = wgid / nig, fm = gid * WGM, gsz = (nM - fm) < WGM ? (nM - fm) : WGM;
        u.pm = fm + ((wgid % nig) % gsz); u.pn = (wgid % nig) / gsz; map(u); return true;
    }
};

struct EpiBf16 {
    static constexpr bool PERM = true;
    bf16_t* O0; int ld0; bf16_t* O1; int ld1;
    __device__ __forceinline__ void operator()(const f32x4 (&acc)[2][2][4][2], const Unit& u, int wr, int wc, int fr, int fq, LAS unsigned char*) const {
        bf16_t* base = u.aux ? O1 : O0; const int ldc = u.aux ? ld1 : ld0;
        const int row0 = u.orow + wr * 64 + fr, col0 = u.ocol + wc * 32 + 8 * fq;
#pragma unroll
        for (int ai = 0; ai < 2; ++ai)
#pragma unroll
            for (int m = 0; m < 4; ++m) { bf16_t* rowp = base + (size_t)(row0 + ai * HALF + m * 16) * ldc + col0;
#pragma unroll
                for (int bj = 0; bj < 2; ++bj) { const f32x4 v0 = acc[ai][bj][m][0], v1 = acc[ai][bj][m][1];
                    u32x4 w; w.x = cvt_pk_bf16(v0[0], v0[1]); w.y = cvt_pk_bf16(v0[2], v0[3]); w.z = cvt_pk_bf16(v1[0], v1[1]); w.w = cvt_pk_bf16(v1[2], v1[3]);
                    *(u32x4*)(rowp + bj * HALF) = w; } }
    }
};

struct EpiBf16Ckv {
    static constexpr bool PERM = true;
    bf16_t* O0; int ld0;
    __device__ __forceinline__ void operator()(const f32x4 (&acc)[2][2][4][2], const Unit& u, int wr, int wc, int fr, int fq, LAS unsigned char* lds) const {
        float rt[2][4];
#pragma unroll
        for (int ai = 0; ai < 2; ++ai)
#pragma unroll
            for (int m = 0; m < 4; ++m) rt[ai][m] = 1.0f;
        const bool both = u.pn == 0;
        if (u.pn <= 1) {
            LAS float* tab = (LAS float*)(lds + 140288);
#pragma unroll
            for (int ai = 0; ai < 2; ++ai)
#pragma unroll
                for (int m = 0; m < 4; ++m) { const f32x4 a0 = acc[ai][0][m][0], a1 = acc[ai][0][m][1];
                    float ss = (a0[0] * a0[0] + a0[1] * a0[1]) + (a0[2] * a0[2] + a0[3] * a0[3]) + (a1[0] * a1[0] + a1[1] * a1[1]) + (a1[2] * a1[2] + a1[3] * a1[3]);
                    if (both) { const f32x4 b0 = acc[ai][1][m][0], b1 = acc[ai][1][m][1];
                        ss += (b0[0] * b0[0] + b0[1] * b0[1]) + (b0[2] * b0[2] + b0[3] * b0[3]) + (b1[0] * b1[0] + b1[1] * b1[1]) + (b1[2] * b1[2] + b1[3] * b1[3]); }
                    ss += __shfl_xor(ss, 16); ss += __shfl_xor(ss, 32);
                    if (fq == 0) tab[(ai * HALF + wr * 64 + m * 16 + fr) * 4 + wc] = ss; }
            asm volatile("s_waitcnt lgkmcnt(0)" ::: "memory"); __builtin_amdgcn_s_barrier(); asm volatile("" ::: "memory");
#pragma unroll
            for (int ai = 0; ai < 2; ++ai)
#pragma unroll
                for (int m = 0; m < 4; ++m) { const f32x4 p = *(const LAS f32x4*)(tab + (ai * HALF + wr * 64 + m * 16 + fr) * 4);
                    rt[ai][m] = rsqrtf(((p[0] + p[1]) + (p[2] + p[3])) * (both ? 1.0f / 256.0f : 1.0f / 128.0f) + EPS); }
        }
        const int row0 = u.orow + wr * 64 + fr, col0 = u.ocol + wc * 32 + 8 * fq;
#pragma unroll
        for (int ai = 0; ai < 2; ++ai)
#pragma unroll
            for (int m = 0; m < 4; ++m) { bf16_t* rowp = O0 + (size_t)(row0 + ai * HALF + m * 16) * ld0 + col0;
#pragma unroll
                for (int bj = 0; bj < 2; ++bj) { const float sc = (bj == 0 || both) ? rt[ai][m] : 1.0f; const f32x4 v0 = acc[ai][bj][m][0] * sc, v1 = acc[ai][bj][m][1] * sc;
                    u32x4 w; w.x = cvt_pk_bf16(v0[0], v0[1]); w.y = cvt_pk_bf16(v0[2], v0[3]); w.z = cvt_pk_bf16(v1[0], v1[1]); w.w = cvt_pk_bf16(v1[2], v1[3]);
                    *(u32x4*)(rowp + bj * HALF) = w; } }
    }
};

struct EpiRes {
    static constexpr bool PERM = false;
    const float* xin; float* xout; const float* cin; float* cout; const float* mods_l; int gidx; float gs;
    __device__ __forceinline__ void operator()(const f32x4 (&acc)[2][2][4][2], const Unit& u, int wr, int wc, int fr, int fq, LAS unsigned char*) const {
        const float* src = u.aux ? cin : xin; float* dst = u.aux ? cout : xout;
        const float* gate = mods_l + (size_t)(u.aux ? 16 : u.bt) * 6144 + gidx * 1024;
        const int row0 = u.orow + wr * 64 + fr, col0 = u.ocol + wc * 32 + 4 * fq;
        const __amdgpu_buffer_rsrc_t rs = __builtin_amdgcn_make_buffer_rsrc((void*)dst, 0, 0x40000000, 0x00020000);
#pragma unroll
        for (int bj = 0; bj < 2; ++bj) {
            f32x4 g4[2], xv[2][2][4];
#pragma unroll
            for (int n = 0; n < 2; ++n) { const int col = col0 + bj * HALF + n * 16; g4[n] = *(const f32x4*)(gate + col) * gs;
#pragma unroll
                for (int ai = 0; ai < 2; ++ai)
#pragma unroll
                    for (int m = 0; m < 4; ++m) xv[n][ai][m] = *(const f32x4*)(src + (size_t)(row0 + ai * HALF + m * 16) * DM + col); }
            asm volatile("" ::: "memory");
#pragma unroll
            for (int n = 0; n < 2; ++n) { const int col = col0 + bj * HALF + n * 16;
#pragma unroll
                for (int ai = 0; ai < 2; ++ai)
#pragma unroll
                    for (int m = 0; m < 4; ++m) { const size_t off = (size_t)(row0 + ai * HALF + m * 16) * DM + col;
                        __builtin_amdgcn_raw_buffer_store_b128(__builtin_bit_cast(u32x4, xv[n][ai][m] + g4[n] * acc[ai][bj][m][n]), rs, (unsigned)(off * 4), 0, 16); } }
            asm volatile("" ::: "memory");
        }
    }
};

__device__ __forceinline__ float dpp_ror1(float v) { return __int_as_float(__builtin_amdgcn_update_dpp(__float_as_int(v), __float_as_int(v), 0x121, 0xf, 0xf, false)); }
__device__ __forceinline__ float dpp_ror15(float v) { return __int_as_float(__builtin_amdgcn_update_dpp(__float_as_int(v), __float_as_int(v), 0x12F, 0xf, 0xf, false)); }
__device__ __forceinline__ float silu_f(float x) { return x * __builtin_amdgcn_rcpf(1.0f + __expf(-x)); }

struct EpiUp {
    static constexpr bool PERM = false;
    bf16_t* Hd; const float* cw; const float* cb;
    __device__ __forceinline__ void operator()(const f32x4 (&acc)[2][2][4][2], const Unit& u, int wr, int wc, int fr, int fq, LAS unsigned char* lds) const {
        LAS float* hal = (LAS float*)(lds + STAGE_BYTES);
        LAS float* cwl = (LAS float*)(lds + 140288);
        const int tid_ = (wr * 4 + wc) * 64 + fq * 16 + fr;
        float cwv[2];
#pragma unroll
        for (int q = 0; q < 2; ++q) { const int e = tid_ + 512 * q, t = e >> 8, bj = (e >> 7) & 1, c = e & 127; cwv[q] = t < 3 ? cw[t * (2 * DFF) + bj * DFF + u.ocol + c] : cb[bj * DFF + u.ocol + c]; }
        if (fr == 0) {
#pragma unroll
            for (int ai = 0; ai < 2; ++ai)
#pragma unroll
                for (int bj = 0; bj < 2; ++bj)
#pragma unroll
                    for (int n = 0; n < 2; ++n) *(LAS f32x4*)(hal + ((2 * ai + wr) * 2 + 0) * 256 + bj * 128 + wc * 32 + n * 16 + 4 * fq) = acc[ai][bj][0][n];
        }
        if (fr == 15) {
#pragma unroll
            for (int ai = 0; ai < 2; ++ai)
#pragma unroll
                for (int bj = 0; bj < 2; ++bj)
#pragma unroll
                    for (int n = 0; n < 2; ++n) *(LAS f32x4*)(hal + ((2 * ai + wr) * 2 + 1) * 256 + bj * 128 + wc * 32 + n * 16 + 4 * fq) = acc[ai][bj][3][n];
        }
        cwl[tid_] = cwv[0]; cwl[tid_ + 512] = cwv[1];
        asm volatile("s_waitcnt lgkmcnt(0)" ::: "memory"); __builtin_amdgcn_s_barrier(); asm volatile("" ::: "memory");
        int fr_ = fr, fq_ = fq; asm volatile("" : "+v"(fr_), "+v"(fq_));
        const int rmin = u.aux == 1 ? 0 : 1, rmax = u.bt;
        const f32x4 zero4 = {0.f, 0.f, 0.f, 0.f};
#pragma unroll
        for (int ai = 0; ai < 2; ++ai) {
            const int g = 2 * ai + wr;
#pragma unroll
            for (int n = 0; n < 2; ++n) {
                const int chb = u.ocol + wc * 32 + n * 16 + 4 * fq_;
                const int colh = wc * 32 + n * 16 + 4 * fq_;
                f32x4 w0[2], w1[2], w2[2], bb[2], uh[2], dh[2];
#pragma unroll
                for (int bj = 0; bj < 2; ++bj) { const int cl = bj * 128 + colh;
                    w0[bj] = *(const LAS f32x4*)(cwl + 0 * 256 + cl); w1[bj] = *(const LAS f32x4*)(cwl + 1 * 256 + cl); w2[bj] = *(const LAS f32x4*)(cwl + 2 * 256 + cl); bb[bj] = *(const LAS f32x4*)(cwl + 3 * 256 + cl);
                    uh[bj] = zero4; dh[bj] = zero4;
                    if (g > 0) uh[bj] = *(LAS f32x4*)(hal + ((g - 1) * 2 + 1) * 256 + bj * 128 + colh);
                    if (g < 3) dh[bj] = *(LAS f32x4*)(hal + ((g + 1) * 2 + 0) * 256 + bj * 128 + colh); }
#pragma unroll
                for (int m = 0; m < 4; ++m) {
                    f32x4 res[2];
#pragma unroll
                    for (int bj = 0; bj < 2; ++bj) {
                        const f32x4 cur = acc[ai][bj][m][n];
                        const f32x4 prv = m > 0 ? acc[ai][bj][m > 0 ? m - 1 : 0][n] : uh[bj];
                        const f32x4 nxt = m < 3 ? acc[ai][bj][m < 3 ? m + 1 : 3][n] : dh[bj];
                        f32x4 su, sd;
#pragma unroll
                        for (int j = 0; j < 4; ++j) { su[j] = fr_ == 15 ? prv[j] : cur[j]; sd[j] = fr_ == 0 ? nxt[j] : cur[j]; }
                        f32x4 rr = w1[bj] * cur + bb[bj];
                        asm volatile("s_nop 1\n\t"
                                     "v_fmac_f32_dpp %0, %4, %12 row_ror:1 row_mask:0xf bank_mask:0xf\n\t"
                                     "v_fmac_f32_dpp %1, %5, %13 row_ror:1 row_mask:0xf bank_mask:0xf\n\t"
                                     "v_fmac_f32_dpp %2, %6, %14 row_ror:1 row_mask:0xf bank_mask:0xf\n\t"
                                     "v_fmac_f32_dpp %3, %7, %15 row_ror:1 row_mask:0xf bank_mask:0xf\n\t"
                                     "v_fmac_f32_dpp %0, %8, %16 row_ror:15 row_mask:0xf bank_mask:0xf\n\t"
                                     "v_fmac_f32_dpp %1, %9, %17 row_ror:15 row_mask:0xf bank_mask:0xf\n\t"
                                     "v_fmac_f32_dpp %2, %10, %18 row_ror:15 row_mask:0xf bank_mask:0xf\n\t"
                                     "v_fmac_f32_dpp %3, %11, %19 row_ror:15 row_mask:0xf bank_mask:0xf"
                                     : "+v"(rr[0]), "+v"(rr[1]), "+v"(rr[2]), "+v"(rr[3])
                                     : "v"(su[0]), "v"(su[1]), "v"(su[2]), "v"(su[3]), "v"(sd[0]), "v"(sd[1]), "v"(sd[2]), "v"(sd[3]),
                                       "v"(w0[bj][0]), "v"(w0[bj][1]), "v"(w0[bj][2]), "v"(w0[bj][3]), "v"(w2[bj][0]), "v"(w2[bj][1]), "v"(w2[bj][2]), "v"(w2[bj][3]));
                        res[bj] = rr;
                    }
                    const int r = ai * HALF + wr * 64 + m * 16 + fr_;
                    bool okr = r >= rmin && r <= rmax; int trow = u.orow + r;
                    if (u.aux == 2) { const int seg = r / TAILSEG, sq = r - seg * TAILSEG, sb = 7 * (u.orow >> 8) + seg;
                        okr = seg < 7 && sb < NB && sq >= 1 && sq <= 32; trow = sb * TB + NCTX + (SEQ - 33) + sq; }
                    if (okr) {
                        const f32x4 gq = res[0], vq = res[1];
                        u32x2 w; w.x = cvt_pk_bf16(silu_f(gq[0]) * vq[0], silu_f(gq[1]) * vq[1]); w.y = cvt_pk_bf16(silu_f(gq[2]) * vq[2], silu_f(gq[3]) * vq[3]);
                        *(u32x2*)(Hd + (size_t)trow * DFF + chb) = w;
                    }
                }
            }
        }
    }
};

template <class Epi, class Sched>
__device__ __forceinline__ void gemm_phase(LAS unsigned char* lds, const Gemm g, const Sched& S, const Epi& E) {
    int tid = threadIdx.x; asm volatile("" : "+v"(tid));
    const int wid = __builtin_amdgcn_readfirstlane(tid >> 6), lane = tid & 63, wr = wid >> 2, wc = wid & 3, fr = lane & 15, fq = lane >> 4;
    int K = g.K, lda_ = g.lda, ldb_ = g.ldb; asm volatile("" : "+s"(K), "+s"(lda_), "+s"(ldb_));
    const int nt = K / BK;
    unsigned voffA[2], voffB[2];
#pragma unroll
    for (int i = 0; i < 2; ++i) { int R, C; stage_rc(tid * 16 + i * 8192, R, C); const int Rb = Epi::PERM ? ((R & ~31) + perm32(R & 31)) : R;
        voffA[i] = (unsigned)(R * lda_ + C) * 2u; voffB[i] = (unsigned)(Rb * ldb_ + C) * 2u; }
    const size_t kstep = (size_t)(BK * 2);
    const size_t hstepA = (size_t)HALF * lda_ * 2, hstepB = (size_t)HALF * ldb_ * 2;
    const unsigned ldsw = (unsigned)wid * 1024u;
    const int aoff = lds_byte(wr * 64 + fr, fq * 8), boff = lds_byte(wc * 32 + fr, fq * 8);
#define PG8_SA(b, h) (((b) * 2 + (h)) * HTB)
#define PG8_SB(b, h) ((4 + (b) * 2 + (h)) * HTB)
#define PG8_STAGE(bufoff, gbase, voff) do { _Pragma("unroll") for (int _i = 0; _i < 2; ++_i) \
        __builtin_amdgcn_global_load_lds((const unsigned*)((const char*)(gbase) + (voff)[_i]), (LAS unsigned*)(lds + (bufoff) + ldsw + _i * 8192), 16, 0, 0); } while (0)
#define PG8_LDA(dst, b, h) do { _Pragma("unroll") for (int m = 0; m < 4; ++m) _Pragma("unroll") for (int k = 0; k < 2; ++k) dst[m][k] = *(const LAS bf16x8*)(lds + PG8_SA(b, h) + aoff + m * 2048 + k * 1024); } while (0)
#define PG8_LDB(dst, b, h) do { _Pragma("unroll") for (int n = 0; n < 2; ++n) _Pragma("unroll") for (int k = 0; k < 2; ++k) dst[n][k] = *(const LAS bf16x8*)(lds + PG8_SB(b, h) + boff + n * 2048 + k * 1024); } while (0)
#define PG8_MMA(ai, bj, At, Bt) do { __builtin_amdgcn_s_setprio(1); _Pragma("unroll") for (int m = 0; m < 4; ++m) _Pragma("unroll") for (int n = 0; n < 2; ++n) _Pragma("unroll") for (int k = 0; k < 2; ++k) \
        acc[ai][bj][m][n] = __builtin_amdgcn_mfma_f32_16x16x32_bf16(Bt[n][k], At[m][k], acc[ai][bj][m][n], 0, 0, 0); __builtin_amdgcn_s_setprio(0); } while (0)
#define PG8_WAIT_V(n) asm volatile("s_waitcnt vmcnt(" #n ")" ::: "memory")
#define PG8_WAIT_L(n) asm volatile("s_waitcnt lgkmcnt(" #n ")" ::: "memory")
#define PG8_BAR __builtin_amdgcn_s_barrier()
#define PG8_SCHED __builtin_amdgcn_sched_barrier(0)
    Unit cur, nxt; int ui = 0;
    if (!S.next(0, cur)) return;
    f32x4 acc[2][2][4][2];
#pragma unroll
    for (int a = 0; a < 2; ++a)
#pragma unroll
        for (int b = 0; b < 2; ++b)
#pragma unroll
            for (int m = 0; m < 4; ++m)
#pragma unroll
                for (int n = 0; n < 2; ++n) acc[a][b][m][n] = (f32x4){0.f, 0.f, 0.f, 0.f};
    bf16x8 At[4][2], B0[2][2], B1[2][2];
    const char* cA = (const char*)g.A + (size_t)cur.arow * lda_ * 2; const char* cB = (const char*)g.Bt + (size_t)cur.brow * ldb_ * 2;
    PG8_STAGE(PG8_SB(0, 0), cB, voffB); PG8_STAGE(PG8_SB(0, 1), cB + hstepB, voffB); PG8_STAGE(PG8_SA(0, 0), cA, voffA); PG8_STAGE(PG8_SA(0, 1), cA + hstepA, voffA);
    if (wr == 1) PG8_BAR;
    PG8_WAIT_V(2); PG8_BAR;
    PG8_STAGE(PG8_SB(1, 0), cB + kstep, voffB); PG8_STAGE(PG8_SA(1, 0), cA + kstep, voffA); PG8_STAGE(PG8_SB(1, 1), cB + hstepB + kstep, voffB);
    PG8_WAIT_V(6); PG8_BAR;
    for (;;) {
        const bool has_next = S.next(ui + 1, nxt);
        const char* nA = has_next ? (const char*)g.A + (size_t)nxt.arow * lda_ * 2 : cA; const char* nB = has_next ? (const char*)g.Bt + (size_t)nxt.brow * ldb_ * 2 : cB;
        for (int t = 0; t < nt; t += 2) {
            const bool last = (t == nt - 2);
            const char* a1 = cA + (size_t)(t + 1) * kstep;
            const char* a2 = last ? nA : cA + (size_t)(t + 2) * kstep; const char* b2 = last ? nB : cB + (size_t)(t + 2) * kstep;
            const char* a3 = a2 + kstep; const char* b3 = b2 + kstep;
            PG8_LDB(B0, 0, 0); PG8_LDB(B1, 0, 1); PG8_SCHED; PG8_LDA(At, 0, 0); PG8_STAGE(PG8_SA(1, 1), a1 + hstepA, voffA);
            PG8_WAIT_V(8); PG8_WAIT_L(0); PG8_BAR; PG8_MMA(0, 0, At, B0); PG8_MMA(0, 1, At, B1); PG8_BAR; PG8_SCHED;
            PG8_LDA(At, 0, 1); PG8_STAGE(PG8_SB(0, 0), b2, voffB); PG8_STAGE(PG8_SB(0, 1), b2 + hstepB, voffB); PG8_STAGE(PG8_SA(0, 0), a2, voffA);
            PG8_WAIT_V(8); PG8_WAIT_L(0); PG8_BAR; PG8_MMA(1, 0, At, B0); PG8_MMA(1, 1, At, B1); PG8_BAR; PG8_SCHED;
            PG8_LDB(B0, 1, 0); PG8_LDB(B1, 1, 1); PG8_SCHED; PG8_LDA(At, 1, 0); PG8_STAGE(PG8_SA(0, 1), a2 + hstepA, voffA);
            PG8_WAIT_V(8); PG8_WAIT_L(0); PG8_BAR; PG8_MMA(0, 0, At, B0); PG8_MMA(0, 1, At, B1); PG8_BAR; PG8_SCHED;
            PG8_LDA(At, 1, 1); PG8_STAGE(PG8_SB(1, 0), b3, voffB); PG8_STAGE(PG8_SB(1, 1), b3 + hstepB, voffB); PG8_STAGE(PG8_SA(1, 0), a3, voffA);
            PG8_WAIT_V(8); PG8_WAIT_L(0); PG8_BAR; PG8_MMA(1, 0, At, B0); PG8_MMA(1, 1, At, B1); PG8_BAR; PG8_SCHED;
        }
        if (wr == 0) PG8_BAR;
        E(acc, cur, wr, wc, fr, fq, lds);
        if (!has_next) break;
#pragma unroll
        for (int a = 0; a < 2; ++a)
#pragma unroll
            for (int b = 0; b < 2; ++b)
#pragma unroll
                for (int m = 0; m < 4; ++m)
#pragma unroll
                    for (int n = 0; n < 2; ++n) acc[a][b][m][n] = (f32x4){0.f, 0.f, 0.f, 0.f};
        cur = nxt; cA = nA; cB = nB; ++ui;
        if (wr == 1) PG8_BAR;
    }
    PG8_WAIT_V(0);
    PG8_BAR;
#undef PG8_SA
#undef PG8_SB
#undef PG8_STAGE
#undef PG8_LDA
#undef PG8_LDB
#undef PG8_MMA
#undef PG8_WAIT_V
#undef PG8_WAIT_L
#undef PG8_BAR
#undef PG8_SCHED
}

struct MapStd { int coff; __device__ __forceinline__ void operator()(Unit& u) const { u.arow = u.pm * 256; u.brow = u.pn * 256; u.orow = u.pm * 256; u.ocol = coff + u.pn * 256; u.aux = 0; u.bt = 0; } };
struct MapRes { int all;
    __device__ __forceinline__ void operator()(Unit& u) const {
        int b, j; if (all) { b = u.pm / 17; j = u.pm % 17; } else { b = u.pm / 16; j = u.pm % 16 + 1; }
        u.arow = (b * 17 + j) * 256; u.brow = u.pn * 256; u.ocol = u.pn * 256; u.bt = b;
        if (j == 0) { u.aux = 1; u.orow = b * 256; } else { u.aux = 0; u.orow = b * SEQ + (j - 1) * 256; } asm volatile("" : "+s"(u.aux)); } };
struct MapUp { int all;
    __device__ __forceinline__ void operator()(Unit& u) const {
        const int per = all ? 17 : 16, nmain = 16 * per;
        u.brow = u.pn * 256; u.ocol = u.pn * 128;
        if (u.pm >= nmain) { u.aux = 2; u.arow = TAILROW0 + (u.pm - nmain) * 256; u.orow = (u.pm - nmain) * 256; u.bt = 0; return; }
        const int b = u.pm / per, j = all ? u.pm % per : u.pm % per + 1;
        if (j == 0) { u.aux = 1; u.arow = b * U2B; u.orow = b * TB; u.bt = 255; }
        else { const int i = j - 1; u.aux = 0; u.arow = b * U2B + 263 + 254 * i; u.orow = b * TB + NCTX + 254 * i - 1; u.bt = 254; } } };
struct MapZ {
    __device__ __forceinline__ void operator()(Unit& u) const {
        const int b = u.pn / 17, j = u.pn % 17; u.arow = u.pm * 256; u.brow = u.pn * 256; u.orow = b * 256; u.bt = b;
        if (j == 0) { u.aux = 1; u.ocol = u.pm * NCTX; } else { u.aux = 0; u.ocol = u.pm * SEQ + (j - 1) * 256; } } };
struct MapFnetL { __device__ __forceinline__ void operator()(Unit& u) const { const int b = u.pm / 16, mt = u.pm % 16; u.arow = mt * 256; u.brow = b * 256; u.orow = b * TB + NCTX + mt * 256; u.ocol = 768; u.aux = 0; u.bt = b; } };
struct MapFnetC { __device__ __forceinline__ void operator()(Unit& u) const { const int b = u.pm; u.arow = 0; u.brow = b * 256; u.orow = b * TB; u.ocol = 768; u.aux = 0; u.bt = b; } };
}

typedef short v4i16_t __attribute__((ext_vector_type(4)));
__device__ __forceinline__ v4i16_t vtr(const LAS unsigned char* p) { return __builtin_amdgcn_ds_read_tr16_b64_v4i16((LAS v4i16_t*)p); }
#define MX3(a_, b_, c_) __builtin_fmaxf(__builtin_fmaxf((a_), (b_)), (c_))
__device__ __forceinline__ float tile_max(const f32x16& s0, const f32x16& s1) {
    float ma = MX3(s0[0], s0[1], s1[0]), mb = MX3(s0[2], s0[3], s1[1]); ma = MX3(ma, s1[2], s1[3]);
#pragma unroll
    for (int r = 4; r < 16; r += 4) { ma = MX3(ma, s0[r], s0[r + 1]); mb = MX3(mb, s0[r + 2], s0[r + 3]); ma = MX3(ma, s1[r], s1[r + 1]); mb = MX3(mb, s1[r + 2], s1[r + 3]); }
    return __builtin_fmaxf(ma, mb);
}
#undef MX3
__device__ __forceinline__ void band_mask(f32x16& s0, f32x16& s1, int k0pos, int qp, int hi) {
#pragma unroll
    for (int r = 0; r < 16; ++r) { const int kp = k0pos + (r & 3) + 8 * (r >> 2) + 4 * hi; const int d0 = kp - qp, d1 = d0 + 32;
        if (d0 > 128 || d0 < -128) s0[r] = -1e30f; if (d1 > 128 || d1 < -128) s1[r] = -1e30f; }
}
__device__ __forceinline__ void exp4(f32x16& s, int r0, float& acc0, float& acc1) {
    s[r0] = __builtin_amdgcn_exp2f(s[r0]); s[r0 + 1] = __builtin_amdgcn_exp2f(s[r0 + 1]); s[r0 + 2] = __builtin_amdgcn_exp2f(s[r0 + 2]); s[r0 + 3] = __builtin_amdgcn_exp2f(s[r0 + 3]);
    acc0 += s[r0] + s[r0 + 2]; acc1 += s[r0 + 1] + s[r0 + 3];
}
__device__ __forceinline__ bf16x8 pack8(const f32x16& s, int r0) {
    u32x4 w; w.x = cvt_pk_bf16(s[r0], s[r0 + 1]); w.y = cvt_pk_bf16(s[r0 + 2], s[r0 + 3]); w.z = cvt_pk_bf16(s[r0 + 4], s[r0 + 5]); w.w = cvt_pk_bf16(s[r0 + 6], s[r0 + 7]);
    return __builtin_bit_cast(bf16x8, w);
}
__device__ __forceinline__ void pv_slab(const LAS unsigned char* vb, int koff, const bf16x8 pj, f32x16& o0, f32x16& o1) {
    const v4i16_t a0 = vtr(vb + koff), a1 = vtr(vb + koff + 512), b0 = vtr(vb + 8192 + koff), b1 = vtr(vb + 8192 + koff + 512);
    const bf16x8 v0 = {a0[0], a0[1], a0[2], a0[3], a1[0], a1[1], a1[2], a1[3]}, v1 = {b0[0], b0[1], b0[2], b0[3], b1[0], b1[1], b1[2], b1[3]};
    o0 = __builtin_amdgcn_mfma_f32_32x32x16_bf16(v0, pj, o0, 0, 0, 0);
    o1 = __builtin_amdgcn_mfma_f32_32x32x16_bf16(v1, pj, o1, 0, 0, 0);
}

#define ATT_SCHED() __builtin_amdgcn_sched_barrier(0)
template <int DQ, bool WIN>
__device__ __forceinline__ void attn_qk(LAS unsigned char* lds, int kbufoff, int t, const bf16x8 (&qf)[DQ / 16], f32x16& o0, f32x16& o1, float& mrun, float& lsum,
                                        f32x16& sa0, f32x16& sa1, f32x16& sb0, f32x16& sb1, int l31, int hi, int qw) {
    constexpr int NDK = DQ / 16, KST = DQ * 2 + 16;
    const LAS unsigned char* kb = lds + kbufoff + l31 * KST + hi * 16;
    bf16x8 kf[2][4];
#define KLOAD(dst, dk) do { dst[0] = *(const LAS bf16x8*)(kb + (dk) * 32); dst[1] = *(const LAS bf16x8*)(kb + 32 * KST + (dk) * 32); \
                            dst[2] = *(const LAS bf16x8*)(kb + 64 * KST + (dk) * 32); dst[3] = *(const LAS bf16x8*)(kb + 96 * KST + (dk) * 32); } while (0)
    KLOAD(kf[0], 0);
#pragma unroll
    for (int dk = 0; dk < NDK; ++dk) {
        if (dk + 1 < NDK) KLOAD(kf[(dk + 1) & 1], dk + 1);
        ATT_SCHED();
        const bf16x8 (&f)[4] = kf[dk & 1];
        if (dk == 0) { f32x16 z16;
#pragma unroll
                       for (int r = 0; r < 16; ++r) z16[r] = 0.f;
                       sa0 = __builtin_amdgcn_mfma_f32_32x32x16_bf16(f[0], qf[0], z16, 0, 0, 0); sa1 = __builtin_amdgcn_mfma_f32_32x32x16_bf16(f[1], qf[0], z16, 0, 0, 0);
                       sb0 = __builtin_amdgcn_mfma_f32_32x32x16_bf16(f[2], qf[0], z16, 0, 0, 0); sb1 = __builtin_amdgcn_mfma_f32_32x32x16_bf16(f[3], qf[0], z16, 0, 0, 0); }
        else { sa0 = __builtin_amdgcn_mfma_f32_32x32x16_bf16(f[0], qf[dk], sa0, 0, 0, 0); sa1 = __builtin_amdgcn_mfma_f32_32x32x16_bf16(f[1], qf[dk], sa1, 0, 0, 0);
               sb0 = __builtin_amdgcn_mfma_f32_32x32x16_bf16(f[2], qf[dk], sb0, 0, 0, 0); sb1 = __builtin_amdgcn_mfma_f32_32x32x16_bf16(f[3], qf[dk], sb1, 0, 0, 0); }
        ATT_SCHED();
    }
#undef KLOAD
    if (__builtin_expect(__any(mrun != 0.f), 0)) {
#pragma unroll
        for (int r = 0; r < 16; ++r) { sa0[r] -= mrun; sa1[r] -= mrun; sb0[r] -= mrun; sb1[r] -= mrun; }
    }
    if (WIN && t >= 4) { const int qp = qw + l31, k0pos = (t - 4) * 64; band_mask(sa0, sa1, k0pos, qp, hi); band_mask(sb0, sb1, k0pos + 64, qp, hi); }
    float mx = __builtin_fmaxf(tile_max(sa0, sa1), tile_max(sb0, sb1));
    { auto rr = __builtin_amdgcn_permlane32_swap(__float_as_uint(mx), __float_as_uint(mx), false, false); mx = __builtin_fmaxf(__uint_as_float(rr[0]), __uint_as_float(rr[1])); }
    if (__builtin_expect(__any(mx > 8.0f), 0)) {
        const float dl = mx > 8.0f ? mx : 0.f; mrun += dl;
        const float alpha = __builtin_amdgcn_exp2f(-dl); lsum *= alpha;
#pragma unroll
        for (int r = 0; r < 16; ++r) { sa0[r] -= dl; sa1[r] -= dl; sb0[r] -= dl; sb1[r] -= dl; o0[r] *= alpha; o1[r] *= alpha; }
    }
}
#define VLOAD(dst, j) do { dst[0] = vtr(vb + (j) * 1024); dst[1] = vtr(vb + (j) * 1024 + 512); dst[2] = vtr(vb + 8192 + (j) * 1024); dst[3] = vtr(vb + 8192 + (j) * 1024 + 512); } while (0)
#define PVMMA(src, P_) do { const bf16x8 v0_ = {src[0][0], src[0][1], src[0][2], src[0][3], src[1][0], src[1][1], src[1][2], src[1][3]}, v1_ = {src[2][0], src[2][1], src[2][2], src[2][3], src[3][0], src[3][1], src[3][2], src[3][3]}; \
        const bf16x8 p_ = (P_); o0 = __builtin_amdgcn_mfma_f32_32x32x16_bf16(v0_, p_, o0, 0, 0, 0); o1 = __builtin_amdgcn_mfma_f32_32x32x16_bf16(v1_, p_, o1, 0, 0, 0); } while (0)
__device__ __forceinline__ void attn_softmax_pv(const LAS unsigned char* vb, f32x16& sa0, f32x16& sa1, f32x16& sb0, f32x16& sb1, f32x16& o0, f32x16& o1, float& lsum) {
    v4i16_t vf[2][4];
    VLOAD(vf[0], 0);
    float p0 = 0.f, p1 = 0.f, p2 = 0.f, p3 = 0.f;
    exp4(sa0, 0, p0, p1); exp4(sa0, 4, p2, p3); exp4(sa0, 8, p0, p1); exp4(sa0, 12, p2, p3);
    exp4(sa1, 0, p0, p1); exp4(sa1, 4, p2, p3); exp4(sa1, 8, p0, p1); exp4(sa1, 12, p2, p3);
    VLOAD(vf[1], 1); ATT_SCHED(); PVMMA(vf[0], pack8(sa0, 0)); exp4(sb0, 0, p0, p1); exp4(sb0, 4, p2, p3); ATT_SCHED();
    VLOAD(vf[0], 2); ATT_SCHED(); PVMMA(vf[1], pack8(sa0, 8)); exp4(sb0, 8, p0, p1); exp4(sb0, 12, p2, p3); ATT_SCHED();
    VLOAD(vf[1], 3); ATT_SCHED(); PVMMA(vf[0], pack8(sa1, 0)); exp4(sb1, 0, p0, p1); exp4(sb1, 4, p2, p3); ATT_SCHED();
    VLOAD(vf[0], 4); ATT_SCHED(); PVMMA(vf[1], pack8(sa1, 8)); exp4(sb1, 8, p0, p1); exp4(sb1, 12, p2, p3); ATT_SCHED();
    lsum += (p0 + p1) + (p2 + p3);
    VLOAD(vf[1], 5); ATT_SCHED(); PVMMA(vf[0], pack8(sb0, 0)); ATT_SCHED();
    VLOAD(vf[0], 6); ATT_SCHED(); PVMMA(vf[1], pack8(sb0, 8)); ATT_SCHED();
    VLOAD(vf[1], 7); ATT_SCHED(); PVMMA(vf[0], pack8(sb1, 0)); ATT_SCHED();
    PVMMA(vf[1], pack8(sb1, 8));
}
__device__ __forceinline__ void attn_softmax_keep(f32x16& sa0, f32x16& sa1, f32x16& sb0, f32x16& sb1, bf16x8 (&pw)[8], float& lsum) {
    float p0 = 0.f, p1 = 0.f, p2 = 0.f, p3 = 0.f;
    exp4(sa0, 0, p0, p1); exp4(sa0, 4, p2, p3); exp4(sa0, 8, p0, p1); exp4(sa0, 12, p2, p3); pw[0] = pack8(sa0, 0); pw[1] = pack8(sa0, 8);
    exp4(sa1, 0, p0, p1); exp4(sa1, 4, p2, p3); exp4(sa1, 8, p0, p1); exp4(sa1, 12, p2, p3); pw[2] = pack8(sa1, 0); pw[3] = pack8(sa1, 8);
    exp4(sb0, 0, p0, p1); exp4(sb0, 4, p2, p3); exp4(sb0, 8, p0, p1); exp4(sb0, 12, p2, p3); pw[4] = pack8(sb0, 0); pw[5] = pack8(sb0, 8);
    exp4(sb1, 0, p0, p1); exp4(sb1, 4, p2, p3); exp4(sb1, 8, p0, p1); exp4(sb1, 12, p2, p3); pw[6] = pack8(sb1, 0); pw[7] = pack8(sb1, 8);
    lsum += (p0 + p1) + (p2 + p3);
}
__device__ __forceinline__ void attn_pv_all(const LAS unsigned char* vb, const bf16x8 (&pw)[8], f32x16& o0, f32x16& o1) {
    v4i16_t vf[2][4];
    VLOAD(vf[0], 0);
    VLOAD(vf[1], 1); ATT_SCHED(); PVMMA(vf[0], pw[0]); ATT_SCHED();
    VLOAD(vf[0], 2); ATT_SCHED(); PVMMA(vf[1], pw[1]); ATT_SCHED();
    VLOAD(vf[1], 3); ATT_SCHED(); PVMMA(vf[0], pw[2]); ATT_SCHED();
    VLOAD(vf[0], 4); ATT_SCHED(); PVMMA(vf[1], pw[3]); ATT_SCHED();
    VLOAD(vf[1], 5); ATT_SCHED(); PVMMA(vf[0], pw[4]); ATT_SCHED();
    VLOAD(vf[0], 6); ATT_SCHED(); PVMMA(vf[1], pw[5]); ATT_SCHED();
    VLOAD(vf[1], 7); ATT_SCHED(); PVMMA(vf[0], pw[6]); ATT_SCHED();
    PVMMA(vf[1], pw[7]);
}
#undef VLOAD
#undef PVMMA
#undef ATT_SCHED

template <int DQ, bool WIN, int MODE = 0>
__device__ __forceinline__ void attn_unit(LAS unsigned char* lds, const bf16_t* Qp, int ldq, const bf16_t* Kp, int ldk, const bf16_t* Vp, int ldv, bf16_t* Op,
                                          int n1, int s2, int e2, int q0pos, float m_init, bool has_sink, const float* qgain = nullptr, const f32x2v* ropeT = nullptr, bool qrope = false, const float* rqrow = nullptr) {
    constexpr int NDK = DQ / 16, CH = DQ / 8, NKC = DQ / 32, KST = DQ * 2 + 16, KBUF = 128 * KST, VBUF = 16384, VOFF = 2 * KBUF;
    int tid = threadIdx.x; asm volatile("" : "+v"(tid));
    const int lane = tid & 63, wid = __builtin_amdgcn_readfirstlane(tid >> 6), l31 = lane & 31, hi = lane >> 5;
    const bool late = wid >= 4;
    bf16x8 qf[NDK];
    { const bf16_t* qrow = Qp + (size_t)(32 * wid + l31) * ldq + 8 * hi;
#pragma unroll
      for (int dk = 0; dk < NDK; ++dk) qf[dk] = *(const bf16x8*)(qrow + 16 * dk); }
    if (DQ == 96 && qgain != nullptr) {
        const float r_q = 1.0f; (void)rqrow;
        float y[6][8]; float ss = 0.f;
#pragma unroll
        for (int dk = 0; dk < 6; ++dk) { const u32x4 w = __builtin_bit_cast(u32x4, qf[dk < NDK ? dk : 0]);
#pragma unroll
            for (int i = 0; i < 4; ++i) { y[dk][2 * i] = bflo(w[i]) * r_q; y[dk][2 * i + 1] = bfhi(w[i]) * r_q; ss += y[dk][2 * i] * y[dk][2 * i] + y[dk][2 * i + 1] * y[dk][2 * i + 1]; } }
        ss += __shfl_xor(ss, 32);
        const float sc = rsqrtf(ss * (1.0f / 96.0f) + EPS);
#pragma unroll
        for (int dk = 0; dk < 6; ++dk)
#pragma unroll
            for (int e = 0; e < 8; ++e) y[dk][e] *= sc * qgain[16 * dk + 8 * hi + e];
        if (qrope) { const int pos = q0pos + 32 * wid + l31;
#pragma unroll
            for (int e = 0; e < 8; ++e) { const f32x2v t = ropeT[pos * 16 + 8 * hi + e]; const float x1 = y[4][e], x2 = y[5][e]; y[4][e] = x1 * t.x - x2 * t.y; y[5][e] = x1 * t.y + x2 * t.x; } }
        const float QS_ = 0.10206207261596577f * LOG2E;
#pragma unroll
        for (int dk = 0; dk < 6; ++dk) { u32x4 w;
#pragma unroll
            for (int i = 0; i < 4; ++i) w[i] = cvt_pk_bf16(y[dk][2 * i] * QS_, y[dk][2 * i + 1] * QS_);
            if (dk < NDK) qf[dk] = __builtin_bit_cast(bf16x8, w); }
    }
    if (DQ == 64 && qgain != nullptr) {
        float y[4][8]; float ss = 0.f;
#pragma unroll
        for (int dk = 0; dk < 4; ++dk) { const u32x4 w = __builtin_bit_cast(u32x4, qf[dk < NDK ? dk : 0]);
#pragma unroll
            for (int i = 0; i < 4; ++i) { y[dk][2 * i] = bflo(w[i]); y[dk][2 * i + 1] = bfhi(w[i]); ss += y[dk][2 * i] * y[dk][2 * i] + y[dk][2 * i + 1] * y[dk][2 * i + 1]; } }
        ss += __shfl_xor(ss, 32);
        const float rn = rsqrtf(ss * (1.0f / 64.0f) + EPS);
#pragma unroll
        for (int dk = 0; dk < 4; ++dk)
#pragma unroll
            for (int e = 0; e < 8; ++e) y[dk][e] *= rn * qgain[16 * dk + 8 * hi + e];
        if (qrope) { const int pos = q0pos + 32 * wid + l31;
#pragma unroll
            for (int dk = 0; dk < 2; ++dk)
#pragma unroll
                for (int e = 0; e < 8; ++e) { const f32x2v t = ropeT[pos * 32 + 16 * dk + 8 * hi + e]; const float x1 = y[dk][e], x2 = y[dk + 2][e]; y[dk][e] = x1 * t.x - x2 * t.y; y[dk + 2][e] = x1 * t.y + x2 * t.x; } }
        const float QS_ = 0.125f * LOG2E;
#pragma unroll
        for (int dk = 0; dk < 4; ++dk) { u32x4 w;
#pragma unroll
            for (int i = 0; i < 4; ++i) w[i] = cvt_pk_bf16(y[dk][2 * i] * QS_, y[dk][2 * i + 1] * QS_);
            if (dk < NDK) qf[dk] = __builtin_bit_cast(bf16x8, w); }
    }
    f32x16 o0, o1;
#pragma unroll
    for (int r = 0; r < 16; ++r) { o0[r] = 0.f; o1[r] = 0.f; }
    float mrun = 0.f, lsum = (has_sink && hi == 0) ? __builtin_amdgcn_exp2f(m_init) : 0.f;
    const int qw = q0pos + 32 * wid;
    const int vlane = (4 * hi + ((lane & 15) >> 2)) * 64 + ((lane >> 4) & 1) * 32 + (lane & 3) * 8;
    u32x4 kr[NKC], vr[2];
#define ATT_TILE(i_) ((i_) < n1 ? (i_) : s2 + ((i_) - n1))
#define ATT_LOAD(t) do { const bf16_t* kp_ = Kp + (size_t)(t) * 64 * ldk; const bf16_t* vp_ = Vp + (size_t)(t) * 64 * ldv; \
        _Pragma("unroll") for (int m_ = 0; m_ < NKC; ++m_) { const int c_ = tid + 512 * m_; kr[m_] = *(const GAS u32x4*)(kp_ + (size_t)(c_ / CH) * ldk + (c_ % CH) * 8); } \
        _Pragma("unroll") for (int m_ = 0; m_ < 2; ++m_) { const int c_ = tid + 512 * m_; vr[m_] = *(const GAS u32x4*)(vp_ + (size_t)(c_ >> 3) * ldv + (c_ & 7) * 8); } } while (0)
#define ATT_STORE(kb_, vb_) do { \
        _Pragma("unroll") for (int m_ = 0; m_ < NKC; ++m_) { const int c_ = tid + 512 * m_; *(LAS u32x4*)(lds + (kb_) * KBUF + (c_ / CH) * KST + (c_ % CH) * 16) = kr[m_]; } \
        _Pragma("unroll") for (int m_ = 0; m_ < 2; ++m_) { const int c_ = tid + 512 * m_; *(LAS u32x4*)(lds + VOFF + (vb_) * VBUF + ((c_ & 7) >> 2) * 8192 + (c_ >> 3) * 64 + (c_ & 3) * 16) = vr[m_]; } } while (0)
#define ATT_BAR() asm volatile("s_waitcnt lgkmcnt(0)\n\ts_barrier" ::: "memory")
    const int nst = (n1 + (e2 - s2)) >> 1;
    ATT_LOAD(0); ATT_STORE(0, 0);
    ATT_BAR();
    if (!late) {
        int vcur = 0;
        for (int I = 0; I < nst; ++I) {
            const int t = ATT_TILE(2 * I);
            if (I + 1 < nst) { const int tn = ATT_TILE(2 * I + 2); ATT_LOAD(tn); }
            bool active = true; if (WIN && t >= 4) { const int k0 = (t - 4) * 64; active = (k0 + 127 >= qw - 128) && (k0 <= qw + 31 + 128); }
            const int vnext = vcur == 2 ? 0 : vcur + 1;
            if (active) { f32x16 sa0, sa1, sb0, sb1;
                attn_qk<DQ, WIN>(lds, (I & 1) * KBUF, t, qf, o0, o1, mrun, lsum, sa0, sa1, sb0, sb1, l31, hi, qw);
                attn_softmax_pv(lds + VOFF + vcur * VBUF + vlane, sa0, sa1, sb0, sb1, o0, o1, lsum); }
            if (I + 1 < nst) ATT_STORE((I + 1) & 1, vnext);
            vcur = vnext;
            ATT_BAR();
        }
    } else {
        bf16x8 pw[8]; bool havep = false; int pvoff = 0;
        int vcur = 0;
        for (int I = 0; I < nst; ++I) {
            const int t = ATT_TILE(2 * I);
            if (I + 1 < nst) { const int tn = ATT_TILE(2 * I + 2); ATT_LOAD(tn); }
            bool active = true; if (WIN && t >= 4) { const int k0 = (t - 4) * 64; active = (k0 + 127 >= qw - 128) && (k0 <= qw + 31 + 128); }
            const int vnext = vcur == 2 ? 0 : vcur + 1;
            if (havep) attn_pv_all(lds + VOFF + pvoff + vlane, pw, o0, o1);
            havep = false;
            if (active) { f32x16 sa0, sa1, sb0, sb1;
                attn_qk<DQ, WIN>(lds, (I & 1) * KBUF, t, qf, o0, o1, mrun, lsum, sa0, sa1, sb0, sb1, l31, hi, qw);
                attn_softmax_keep(sa0, sa1, sb0, sb1, pw, lsum); havep = true; pvoff = vcur * VBUF; }
            if (I + 1 < nst) ATT_STORE((I + 1) & 1, vnext);
            vcur = vnext;
            ATT_BAR();
        }
        if (havep) attn_pv_all(lds + VOFF + pvoff + vlane, pw, o0, o1);
    }
    ATT_BAR();
#undef ATT_TILE
#undef ATT_LOAD
#undef ATT_STORE
#undef ATT_BAR
    const float lt = lsum + __shfl_xor(lsum, 32), inv = 1.0f / lt;
    bf16_t* orow = Op + (size_t)(32 * wid + l31) * DM + 4 * hi;
#pragma unroll
    for (int g = 0; g < 4; ++g) {
        u32x2 w0, w1;
        w0.x = cvt_pk_bf16(o0[4 * g] * inv, o0[4 * g + 1] * inv); w0.y = cvt_pk_bf16(o0[4 * g + 2] * inv, o0[4 * g + 3] * inv);
        w1.x = cvt_pk_bf16(o1[4 * g] * inv, o1[4 * g + 1] * inv); w1.y = cvt_pk_bf16(o1[4 * g + 2] * inv, o1[4 * g + 3] * inv);
        *(u32x2*)(orow + 8 * g) = w0; *(u32x2*)(orow + 32 + 8 * g) = w1;
    }
}

struct Args { const float* in[28]; float* out; unsigned char* ws; int lo, hi; };
typedef const GAS float* cfp_t;
struct Ctx { const __attribute__((address_space(4))) cfp_t* in; float* out; unsigned char* ws;
    __device__ __forceinline__ const float* inp(int i) const { return (const float*)in[i]; } };
enum { I_X = 0, I_C, I_CTX, I_CCTX, I_MODW, I_MODB, I_N1G, I_N2G, I_MLAWIN, I_CQG, I_CKVG, I_WUQ, I_WUKV, I_QG, I_KG, I_FNETW, I_EWOUT,
       I_WINWIN, I_WQG, I_WKG, I_SINK, I_POOLW, I_POOLS, I_OWOUT, I_FFNUP, I_CONVW, I_CONVB, I_FFNDN };

__device__ __forceinline__ void tr_item(const float* W, int K, int Nsrc, bf16_t* WT, int nblk, int item, LAS float* scr, int lane, int mode, const float* ksc) {
    const int kb = item / nblk, nb = item % nblk, k0 = 64 * kb, n0 = 32 * nb;
    int s0 = n0;
    if (mode == 1) s0 = n0 < 672 ? n0 : -1;
    else if (mode == 2) { const int hd = n0 >> 7, d0 = n0 & 127; s0 = d0 < 96 ? hd * 96 + d0 : -1; }
    else if (mode == 3) { const int pn = n0 >> 8, bj = (n0 >> 7) & 1, c = n0 & 127; s0 = bj * DFF + pn * 128 + c; }
#pragma unroll 16
    for (int i = 0; i < 32; ++i) { const int kk = 2 * i + (lane >> 5); float v = 0.f;
        if (s0 >= 0) { v = W[(size_t)(k0 + kk) * Nsrc + s0 + (lane & 31)]; if (ksc) v *= ksc[k0 + kk]; }
        scr[kk * 33 + (lane & 31)] = v; }
    asm volatile("s_waitcnt lgkmcnt(0)" ::: "memory");
    const int c = lane & 7;
#pragma unroll
    for (int j = 0; j < 4; ++j) { const int n = (lane >> 3) + 8 * j; const LAS float* s = scr + (8 * c) * 33 + n;
        u32x4 o; o.x = cvt_pk_bf16(s[0 * 33], s[1 * 33]); o.y = cvt_pk_bf16(s[2 * 33], s[3 * 33]); o.z = cvt_pk_bf16(s[4 * 33], s[5 * 33]); o.w = cvt_pk_bf16(s[6 * 33], s[7 * 33]);
        *(u32x4*)(WT + (size_t)(n0 + n) * K + k0 + 8 * c) = o; }
    asm volatile("s_waitcnt lgkmcnt(0)" ::: "memory");
}
__device__ __forceinline__ void tr_job(const float* W, int K, int Nsrc, bf16_t* WT, int Nout, int mode, const float* ksc, LAS float* scr, int gw, int ngw, int lane) {
    const int nblk = Nout / 32, nitems = (K / 64) * nblk;
    for (int it = gw; it < nitems; it += ngw) tr_item(W, K, Nsrc, WT, nblk, it, scr, lane, mode, ksc);
}
__device__ __forceinline__ void ffn_weights(const Ctx& a, int layer, LAS float* scr, int gw, int ngw, int lane) {
    tr_job(a.inp(I_FFNUP) + (size_t)layer * DM * 2 * DFF, DM, 2 * DFF, (bf16_t*)(a.ws + WS_WUP), 2 * DFF, 3, nullptr, scr, gw, ngw, lane);
    tr_job(a.inp(I_FFNDN) + (size_t)layer * DFF * DM, DFF, DM, (bf16_t*)(a.ws + ((layer & 1) ? WS_WDN2 : WS_WDN)), DM, 0, nullptr, scr, gw, ngw, lane);
}
__device__ __forceinline__ void mixer_weights(const Ctx& a, int j, LAS float* scr, int gw, int ngw, int lane) {
    unsigned char* ws = a.ws;
    tr_job(a.inp(I_MLAWIN) + (size_t)j * DM * 672, DM, 672, (bf16_t*)(ws + WS_WINE) + (size_t)j * 768 * DM, 768, 1, nullptr, scr, gw, ngw, lane);
    tr_job(a.inp(I_WUQ) + (size_t)j * 256 * 1152, 256, 1152, (bf16_t*)(ws + WS_WUQ) + (size_t)j * 1536 * 256, 1536, 2, a.inp(I_CQG) + j * 256, scr, gw, ngw, lane);
    tr_job(a.inp(I_WUKV) + (size_t)j * 128 * 1536, 128, 1536, (bf16_t*)(ws + WS_WUKV) + (size_t)j * 1536 * 128, 1536, 0, a.inp(I_CKVG) + j * 128, scr, gw, ngw, lane);
    tr_job(a.inp(I_EWOUT) + (size_t)j * DM * DM, DM, DM, (bf16_t*)(ws + WS_WOUTE) + (size_t)j * DM * DM, DM, 0, nullptr, scr, gw, ngw, lane);
    tr_job(a.inp(I_WINWIN) + (size_t)j * DM * 1536, DM, 1536, (bf16_t*)(ws + WS_WINO) + (size_t)j * 1536 * DM, 1536, 0, nullptr, scr, gw, ngw, lane);
    tr_job(a.inp(I_OWOUT) + (size_t)j * DM * DM, DM, DM, (bf16_t*)(ws + WS_WOUTO) + (size_t)j * DM * DM, DM, 0, nullptr, scr, gw, ngw, lane);
}

__device__ __forceinline__ void mods_item(const Ctx& a, int item, LAS float* sl) {
    int tid = threadIdx.x; asm volatile("" : "+v"(tid)); const int l = item / 48, nb = item % 48;
    LAS float* red = sl + 17 * 1024;
    for (int idx = tid; idx < 17 * 1024; idx += 512) { const int r = idx >> 10, k = idx & 1023; const float v = r < 16 ? a.inp(I_C)[r * 1024 + k] : a.inp(I_CCTX)[k]; sl[idx] = v / (1.0f + __expf(-v)); }
    __syncthreads();
    const int cn = tid & 127, ks = tid >> 7, n = 128 * nb + cn;
    float acc[17];
#pragma unroll
    for (int r = 0; r < 17; ++r) acc[r] = 0.f;
    const float* wp = a.inp(I_MODW) + ((size_t)l * 1024 + 256 * ks) * 6144 + n;
#pragma unroll 4
    for (int k = 0; k < 256; k += 4) {
        const float w0 = wp[(size_t)(k + 0) * 6144], w1 = wp[(size_t)(k + 1) * 6144], w2 = wp[(size_t)(k + 2) * 6144], w3 = wp[(size_t)(k + 3) * 6144];
#pragma unroll
        for (int r = 0; r < 17; ++r) { const f32x4 s4 = *(const LAS f32x4*)(sl + r * 1024 + 256 * ks + k); acc[r] += s4[0] * w0 + s4[1] * w1 + s4[2] * w2 + s4[3] * w3; }
    }
#pragma unroll
    for (int r = 0; r < 17; ++r) red[(ks * 17 + r) * 128 + cn] = acc[r];
    __syncthreads();
    float* mods = (float*)(a.ws + WS_MODS);
    for (int idx = tid; idx < 17 * 128; idx += 512) { const int r = idx >> 7, c2 = idx & 127;
        const float s = red[(0 * 17 + r) * 128 + c2] + red[(1 * 17 + r) * 128 + c2] + red[(2 * 17 + r) * 128 + c2] + red[(3 * 17 + r) * 128 + c2];
        mods[((size_t)l * 17 + r) * 6144 + 128 * nb + c2] = s + a.inp(I_MODB)[l * 6144 + 128 * nb + c2]; }
    __syncthreads();
}

__device__ __forceinline__ void norm_pass(const float* xsrc, const float* csrc, const float* g, const float* mods_l, int shift_idx, int scale_idx,
                                          bf16_t* U, bool ffn_layout, bool skip_ctx, int gw, int ngw, int lane) {
    for (int R0 = gw; R0 < T; R0 += 2 * ngw) {
        f32x4 v[2][4]; bool ok[2]; int bb[2], pp[2];
#pragma unroll
        for (int s = 0; s < 2; ++s) { const int R = R0 + s * ngw; const int b = R / TB, p = R % TB; const bool isctx = p < NCTX; bb[s] = b; pp[s] = p;
            ok[s] = (R < T) && !(isctx && skip_ctx);
            const float* src = isctx ? csrc + (size_t)(b * NCTX + p) * DM : xsrc + (size_t)(b * SEQ + p - NCTX) * DM;
            if (ok[s]) {
#pragma unroll
                for (int j = 0; j < 4; ++j) v[s][j] = *(const f32x4*)(src + (lane + 64 * j) * 4); } }
#pragma unroll
        for (int s = 0; s < 2; ++s) if (ok[s]) {
            const int R = R0 + s * ngw, b = bb[s], p = pp[s]; const bool isctx = p < NCTX;
            const float* mrow = mods_l + (size_t)(isctx ? 16 : b) * 6144;
            float ss = 0.f;
#pragma unroll
            for (int j = 0; j < 4; ++j) ss += (v[s][j][0] * v[s][j][0] + v[s][j][1] * v[s][j][1]) + (v[s][j][2] * v[s][j][2] + v[s][j][3] * v[s][j][3]);
            const float rs = rsqrtf(wave_sum(ss) * (1.0f / DM) + EPS);
            const size_t orow = ffn_layout ? (size_t)b * U2B + (isctx ? p : 264 + p - NCTX) : (size_t)R;
#pragma unroll
            for (int j = 0; j < 4; ++j) { const int c4 = (lane + 64 * j) * 4;
                const f32x4 gg = *(const f32x4*)(g + c4), sh = *(const f32x4*)(mrow + shift_idx * 1024 + c4), sc = *(const f32x4*)(mrow + scale_idx * 1024 + c4);
                const f32x4 y = v[s][j] * rs * gg * (sc + 1.0f) + sh;
                u32x2 w; w.x = cvt_pk_bf16(y[0], y[1]); w.y = cvt_pk_bf16(y[2], y[3]);
                *(u32x2*)(U + orow * DM + c4) = w;
                if (ffn_layout && !isctx && p - NCTX >= SEQ - 33) *(u32x2*)(U + ((size_t)TAILROW0 + (b / 7) * 256 + (b % 7) * TAILSEG + (p - NCTX - (SEQ - 33))) * DM + c4) = w; }
        }
    }
    if (ffn_layout && gw >= 32 && gw < 48) {
        const int tb_ = gw - 32; const size_t orow = (size_t)TAILROW0 + (tb_ / 7) * 256 + (tb_ % 7) * TAILSEG + 33;
#pragma unroll
        for (int j = 0; j < 4; ++j) *(u32x2*)(U + orow * DM + (lane + 64 * j) * 4) = (u32x2){0u, 0u};
    }
    if (ffn_layout && gw < 32) {
        const int b = gw >> 1; const size_t orow = (size_t)b * U2B + ((gw & 1) ? 264 + SEQ : 263);
#pragma unroll
        for (int j = 0; j < 4; ++j) *(u32x2*)(U + orow * DM + (lane + 64 * j) * 4) = (u32x2){0u, 0u};
    }
}

template <int NF> __device__ __forceinline__ void rope_cs(int pos, int i, float& cs, float& sn) {
    const int row = pos >> 6, col = pos & 63; const int f = i < NF ? i : i - NF;
    const float inv = exp2f(-(float)f * (13.287712379549449f / NF));
    const float ang = (float)(i < NF ? row : col) * inv;
    sincosf(ang, &sn, &cs);
}

__device__ __forceinline__ void unpack8(const u32x4 v, float (&x)[8]) {
#pragma unroll
    for (int i = 0; i < 4; ++i) { x[2 * i] = bflo(v[i]); x[2 * i + 1] = bfhi(v[i]); }
}
__device__ __forceinline__ u32x4 pack8f(const float (&x)[8]) { u32x4 o; o.x = cvt_pk_bf16(x[0], x[1]); o.y = cvt_pk_bf16(x[2], x[3]); o.z = cvt_pk_bf16(x[4], x[5]); o.w = cvt_pk_bf16(x[6], x[7]); return o; }

__device__ __forceinline__ void ew_even(const Ctx& a, int j, int gw, int ngw, int lane) {
    const bf16_t* H = (const bf16_t*)(a.ws + WS_H); bf16_t* Qb = (bf16_t*)(a.ws + WS_Q); bf16_t* KVb = (bf16_t*)(a.ws + WS_KV); bf16_t* Kout = (bf16_t*)(a.ws + WS_U);
    const float QS = 0.10206207261596577f * LOG2E;
    const f32x2v* ropeT = (const f32x2v*)(a.ws + WS_ROPE_E);
    const int g16 = lane >> 4, c16 = lane & 15; const bool act = c16 < 12; const int cc = act ? c16 : 0;
    float qg[8], kg[8];
#pragma unroll
    for (int e = 0; e < 8; ++e) { qg[e] = a.inp(I_QG)[j * 96 + 8 * cc + e]; kg[e] = a.inp(I_KG)[j * 96 + 8 * cc + e]; }
    for (int R = gw; R < T; R += ngw) {
        const int p = R % TB; const int pos = p - NCTX; const bool lat = pos >= 0;
        const bf16_t* hrow = H + (size_t)R * 768; bf16_t* qrow = Qb + (size_t)R * 1536; bf16_t* kvrow = KVb + (size_t)R * 1536;
        const u32x4 z4 = {0u, 0u, 0u, 0u};
        u32x4 qv[3], kv[3], vv[2];
#pragma unroll
        for (int rd = 0; rd < 3; ++rd) { const int hd = 4 * rd + g16; qv[rd] = z4; kv[rd] = z4;
            if (act) { kv[rd] = c16 < 8 ? *(const u32x4*)(kvrow + hd * 128 + 8 * c16) : *(const u32x4*)(hrow + 384 + 8 * (c16 - 8)); } }
        float cs[8], sn[8];
#pragma unroll
        for (int e = 0; e < 8; ++e) { cs[e] = 1.f; sn[e] = 0.f; }
        if (lat && c16 >= 8 && act) {
#pragma unroll
            for (int e = 0; e < 8; ++e) { const f32x2v t = ropeT[pos * 16 + 8 * (c16 & 1) + e]; cs[e] = t.x; sn[e] = t.y; } }
#pragma unroll
        for (int rd = 0; rd < 3; ++rd) {
            const int hd = 4 * rd + g16;
            { float y[8], o[8]; unpack8(kv[rd], y); float s2 = 0.f; const float pre = 1.0f;
#pragma unroll
              for (int e = 0; e < 8; ++e) { y[e] *= pre; s2 += y[e] * y[e]; }
              s2 += __shfl_xor(s2, 8); s2 += __shfl_xor(s2, 4); s2 += __shfl_xor(s2, 2); s2 += __shfl_xor(s2, 1);
              const float sc = rsqrtf(s2 * (1.0f / 96.0f) + EPS);
#pragma unroll
              for (int e = 0; e < 8; ++e) { y[e] *= sc * kg[e]; o[e] = __shfl_xor(y[e], 2); }
              if (c16 >= 8) {
#pragma unroll
                  for (int e = 0; e < 8; ++e) y[e] = c16 < 10 ? y[e] * cs[e] - o[e] * sn[e] : o[e] * sn[e] + y[e] * cs[e]; }
              if (act) *(u32x4*)(Kout + (size_t)R * 1152 + hd * 96 + 8 * c16) = pack8f(y); }
        }
    }
}

__device__ __forceinline__ void z_fold(const Ctx& a, LAS unsigned char* lds, int gw, int ngw, int wave, int lane) {
    const bf16_t* ZLp = (const bf16_t*)(a.ws + WS_ZL); bf16_t* ZF = (bf16_t*)(a.ws + WS_ZF);
    LAS bf16_t* zr = (LAS bf16_t*)(lds + wave * 16384);
    for (int row = gw; row < 4096; row += ngw) {
        const bf16_t* src = ZLp + (size_t)row * 8192;
#pragma unroll
        for (int i = 0; i < 16; ++i) *(LAS u32x4*)(zr + 8 * (lane + 64 * i)) = *(const u32x4*)(src + 8 * (lane + 64 * i));
        asm volatile("s_waitcnt lgkmcnt(0)" ::: "memory");
#pragma unroll
        for (int i = 0; i < 8; ++i) { const int k0 = 8 * (lane + 64 * i); float y[8];
#pragma unroll
            for (int e = 0; e < 8; ++e) { const int kap = k0 + e; float v;
                if (kap <= 2048) { v = bf2f(zr[kap]); if (kap != 0 && kap != 2048) v += bf2f(zr[4096 - kap]); }
                else { const int l = kap - 2048; v = bf2f(zr[4096 + l]) - bf2f(zr[8192 - l]); }
                y[e] = v; }
            *(u32x4*)(ZF + (size_t)row * 4096 + k0) = pack8f(y); }
        asm volatile("s_waitcnt lgkmcnt(0)" ::: "memory");
    }
}

__device__ __forceinline__ void ew_odd(const Ctx& a, int j, int gw, int ngw, int lane) {
    bf16_t* H = (bf16_t*)(a.ws + WS_H); bf16_t* PO = (bf16_t*)(a.ws + WS_POOL);
    const float QS = 0.125f * LOG2E;
    const f32x2v* ropeT = (const f32x2v*)(a.ws + WS_ROPE_O);
    const int c8 = lane & 7, hl = lane >> 3;
    float qg[8], kg[8];
#pragma unroll
    for (int e = 0; e < 8; ++e) { qg[e] = a.inp(I_WQG)[j * 64 + 8 * c8 + e]; kg[e] = a.inp(I_WKG)[j * 64 + 8 * c8 + e]; }
    for (int R = gw; R < T; R += ngw) {
        const int p = R % TB; const int pos = p - NCTX; const bool lat = pos >= 0;
        bf16_t* hrow = H + (size_t)R * 1536;
        u32x4 qk[2]; qk[1] = (u32x4){0u, 0u, 0u, 0u}; if (lane >= 32) qk[1] = *(const u32x4*)(hrow + 512 + 8 * lane);
        float cs[8], sn[8];
#pragma unroll
        for (int e = 0; e < 8; ++e) { cs[e] = 1.f; sn[e] = 0.f; }
        if (lat) {
#pragma unroll
            for (int e = 0; e < 8; ++e) { const f32x2v t = ropeT[pos * 32 + 8 * (c8 & 3) + e]; cs[e] = t.x; sn[e] = t.y; } }
        const int tpos = lat ? pos : p, Ls = lat ? SEQ : NCTX;
        { const int pc = lane & 31, g = pc >> 3, half = 1 << g;
          const int lo = tpos - half < 0 ? 0 : tpos - half, hi = tpos + half > Ls ? Ls : tpos + half;
          float sum[8];
#pragma unroll
          for (int e = 0; e < 8; ++e) sum[e] = 0.f;
          if (lane < 32) {
              for (int tt = lo; tt < hi; ++tt) { float z[8]; unpack8(*(const u32x4*)(hrow + (ptrdiff_t)(tt - tpos) * 1536 + 1280 + 8 * pc), z);
#pragma unroll
                  for (int e = 0; e < 8; ++e) sum[e] += z[e]; }
              const float rc = 1.0f / (float)(hi - lo); float z[8]; unpack8(*(const u32x4*)(hrow + 1280 + 8 * pc), z);
#pragma unroll
              for (int e = 0; e < 8; ++e) sum[e] = sum[e] * rc - z[e];
              *(u32x4*)(PO + (size_t)R * 256 + 8 * pc) = pack8f(sum); } }
        if (lane >= 32) {
            float y[8], o[8]; unpack8(qk[1], y); float s2 = 0.f;
#pragma unroll
            for (int e = 0; e < 8; ++e) s2 += y[e] * y[e];
            s2 += __shfl_xor(s2, 4); s2 += __shfl_xor(s2, 2); s2 += __shfl_xor(s2, 1);
            const float sc = rsqrtf(s2 * (1.0f / 64.0f) + EPS);
#pragma unroll
            for (int e = 0; e < 8; ++e) { y[e] *= sc * kg[e]; o[e] = __shfl_xor(y[e], 4); }
#pragma unroll
            for (int e = 0; e < 8; ++e) y[e] = c8 < 4 ? y[e] * cs[e] - o[e] * sn[e] : o[e] * sn[e] + y[e] * cs[e];
            *(u32x4*)(hrow + 512 + 8 * lane) = pack8f(y);
        }
    }
}

#define XB_TMO      128
#define XB_XCNT(j)  (256  + 64 * (j))
#define XB_XSUB(j)  (1280 + 64 * (j))
#define XB_XGEN(j)  (2304 + 64 * (j))
#define XB_TOP      3328
#define XB_TOPGEN   3392
#define XCD_BAR_WORDS 3456
#define XB_SPIN_CAP (1u << 18)
__device__ __forceinline__ unsigned xb_ld(unsigned* p)              { return __hip_atomic_load(p, __ATOMIC_RELAXED, __HIP_MEMORY_SCOPE_AGENT); }
__device__ __forceinline__ unsigned xb_add(unsigned* p, unsigned v) { return __hip_atomic_fetch_add(p, v, __ATOMIC_RELAXED, __HIP_MEMORY_SCOPE_AGENT); }
__device__ __forceinline__ unsigned xb_xcc_id() { return (unsigned)__builtin_amdgcn_s_getreg((3 << 11) | 20) & 0xFu; }
#define XB_SPIN(cond, bar) do { unsigned _sp = 0; while (cond) { __builtin_amdgcn_s_sleep(1); \
    if ((++_sp & 255u) == 0u) { if (xb_ld(&(bar)[XB_TMO])) break; if (_sp > XB_SPIN_CAP) { atomicAdd(&(bar)[XB_TMO], 1u); break; } } } } while (0)
struct XcdBarrier { unsigned* bar; unsigned x; volatile LAS unsigned* st; };
__device__ __forceinline__ XcdBarrier xcd_barrier_post(unsigned* bar, volatile LAS unsigned* st) {
    XcdBarrier b; b.bar = bar; b.x = xb_xcc_id(); b.st = st;
    int tid_ = threadIdx.x; asm volatile("" : "+v"(tid_));
    if (tid_ == 0) (void)xb_add(&bar[XB_XCNT(b.x)], 1u);
    return b;
}
__device__ __forceinline__ void xcd_barrier_complete(unsigned* bar, unsigned x, unsigned& nloc, unsigned& nx) {
    const unsigned G = gridDim.x * gridDim.y * gridDim.z;
    unsigned sum, cnt, mine, sp = 0u;
    for (;;) {
        sum = 0u; cnt = 0u; mine = 0u;
#pragma unroll
        for (unsigned j = 0; j < 16; ++j) { const unsigned c = xb_ld(&bar[XB_XCNT(j)]); sum += c; cnt += (c > 0u) ? 1u : 0u; mine = (j == x) ? c : mine; }
        if (sum == G) break;
        __builtin_amdgcn_s_sleep(1);
        if ((++sp & 255u) == 0u) { if (xb_ld(&bar[XB_TMO])) break; if (sp > XB_SPIN_CAP) { atomicAdd(&bar[XB_TMO], 1u); break; } }
    }
    nloc = mine > 0u ? mine : 1u; nx = cnt > 0u ? cnt : 1u;
}
__device__ __forceinline__ void xcd_barrier(const XcdBarrier& b) {
    asm volatile("s_waitcnt vmcnt(0)" ::: "memory");
    __syncthreads();
    int tid_ = threadIdx.x; asm volatile("" : "+v"(tid_));
    if (tid_ == 0) {
        unsigned* bar = b.bar;
        __builtin_amdgcn_s_waitcnt(0);
        unsigned nloc = b.st[0], nx = b.st[1];
        if (nloc == 0u) { xcd_barrier_complete(bar, b.x, nloc, nx); b.st[0] = nloc; b.st[1] = nx; }
        const unsigned old = xb_add(&bar[XB_XSUB(b.x)], 1u);
        const unsigned gen = old / nloc;
        if (old + 1u == (gen + 1u) * nloc) {
            __builtin_amdgcn_fence(__ATOMIC_RELEASE, "agent");
            asm volatile("s_waitcnt vmcnt(0)" ::: "memory");
            const unsigned og = xb_add(&bar[XB_TOP], 1u);
            const unsigned tg = og / nx;
            if (og + 1u == (tg + 1u) * nx) xb_add(&bar[XB_TOPGEN], 1u);
            else XB_SPIN(xb_ld(&bar[XB_TOPGEN]) == tg, bar);
            __builtin_amdgcn_fence(__ATOMIC_ACQUIRE, "agent");
            xb_add(&bar[XB_XGEN(b.x)], 1u);
            asm volatile("s_waitcnt vmcnt(0)" ::: "memory");
        } else {
            XB_SPIN(xb_ld(&bar[XB_XGEN(b.x)]) == gen, bar);
            __builtin_amdgcn_fence(__ATOMIC_ACQUIRE, "agent");
            asm volatile("s_waitcnt vmcnt(0)" ::: "memory");
        }
    }
    __syncthreads();
}

constexpr int LDS_BYTES = 147456;
constexpr int NPHASES = 1 + 2 * 9 + 2 * 8;

__global__ void __launch_bounds__(512, 2) mega_fwd(Args ka) {
    extern __shared__ __attribute__((aligned(16))) unsigned char lds_raw[];
    LAS unsigned char* lds = (LAS unsigned char*)lds_raw;
    cg::grid_group grid = cg::this_grid();
    volatile LAS unsigned* xbst = (volatile LAS unsigned*)(lds + 139264);
    { int tid_ = threadIdx.x; asm volatile("" : "+v"(tid_)); if (tid_ < 2) xbst[tid_] = 0u; }
    __syncthreads();
    XcdBarrier xbar; xbar.bar = (unsigned*)ka.ws; xbar.x = 0; xbar.st = xbst;
    if (ka.hi - ka.lo > 1) xbar = xcd_barrier_post((unsigned*)ka.ws, xbst);
#define U ((bf16_t*)(wsl + WS_U))
#define MIX ((bf16_t*)(wsl + WS_MIX))
#define Hb ((bf16_t*)(wsl + WS_H))
#define Qb ((bf16_t*)(wsl + WS_Q))
#define KVb ((bf16_t*)(wsl + WS_KV))
#define ZL ((bf16_t*)(wsl + WS_ZL))
#define ZC ((bf16_t*)(wsl + WS_ZC))
#define HID ((bf16_t*)(wsl + WS_HID))
#define POOL ((bf16_t*)(wsl + WS_POOL))
#define DFTL ((bf16_t*)(wsl + WS_DFTL))
#define DFTC ((bf16_t*)(wsl + WS_DFTC))
#define hctx ((float*)(wsl + WS_HCTX))
    int ph = 0, layer_ = 0;
#define PHASE_BEGIN if (ph >= ka.lo && ph < ka.hi) { GAS unsigned char* wsg_ = (GAS unsigned char*)ka.ws; asm volatile("" : "+s"(wsg_)); unsigned char* wsl = (unsigned char*)wsg_; \
        const __attribute__((address_space(4))) cfp_t* ain_ = (const __attribute__((address_space(4))) cfp_t*)__builtin_amdgcn_kernarg_segment_ptr(); asm volatile("" : "+s"(ain_)); \
        const Ctx a{ain_, ka.out, wsl}; \
        int lyr_ = layer_; asm volatile("" : "+s"(lyr_)); const float* mods_l = (const float*)(wsl + WS_MODS) + (size_t)lyr_ * 17 * 6144; const float* xin = lyr_ == 0 ? a.inp(I_X) : a.out; const float* cin = lyr_ == 0 ? a.inp(I_CTX) : (const float*)(wsl + WS_HCTX); (void)mods_l; (void)xin; (void)cin; int tid = threadIdx.x; asm volatile("" : "+v"(tid)); int G = gridDim.x, bx = blockIdx.x; asm volatile("" : "+s"(G), "+s"(bx)); \
        const int vcu = (G % 8 == 0) ? (bx % 8) * (G / 8) + bx / 8 : bx, ngw = G * 8, ngt = G * 512; (void)vcu; (void)ngw; (void)ngt; \
        const int lane = tid & 63, wave = __builtin_amdgcn_readfirstlane(tid >> 6), gw = bx * 8 + wave, gtid = bx * 512 + tid; LAS float* scr = (LAS float*)(lds + wave * 8448); \
        (void)lane; (void)gw; (void)gtid; (void)scr;
#define PHASE_END } if (ph >= ka.lo && ph + 1 < ka.hi) { for (int sr_ = 0; sr_ < REP_SYNC; ++sr_) { if (ph == 0) grid.sync(); else xcd_barrier(xbar); } } ++ph;

    PHASE_BEGIN
#ifndef SKIP_P0
        { REPLOOP(REP_P0) {
        for (int it = bx; it < 192; it += G) mods_item(a, it, (LAS float*)lds);
        mixer_weights(a, 0, scr, gw, ngw, lane);
        __syncthreads();
        LAS float* ctab = (LAS float*)lds;
        for (int m = tid; m < 4096; m += 512) ctab[m] = cospif((float)m * (1.0f / 2048.0f)) * (1.0f / 64.0f);
        __syncthreads();
        for (int idx = gtid; idx < 4096 * 512; idx += ngt) { const int k = idx >> 9, col0 = (idx & 511) * 8; float v[8];
#pragma unroll
            for (int e = 0; e < 8; ++e) { const int kap = col0 + e; const int m = kap <= 2048 ? (k * kap) & 4095 : (k * (kap - 2048) + 1024) & 4095; v[e] = ctab[m]; }
            u32x4 o; o.x = cvt_pk_bf16(v[0], v[1]); o.y = cvt_pk_bf16(v[2], v[3]); o.z = cvt_pk_bf16(v[4], v[5]); o.w = cvt_pk_bf16(v[6], v[7]);
            *(u32x4*)(DFTL + (size_t)k * 4096 + col0) = o; }
        for (int idx = gtid; idx < 256 * 64; idx += ngt) { const int k = idx >> 6, col0 = (idx & 63) * 8, cs = col0 >> 8, l0 = col0 & 255; float v[8];
#pragma unroll
            for (int e = 0; e < 8; ++e) { const int m = (k * (l0 + e)) & 255; const float x = (float)m * (1.0f / 128.0f); v[e] = (cs ? -sinpif(x) : cospif(x)) * (1.0f / 16.0f); }
            u32x4 o; o.x = cvt_pk_bf16(v[0], v[1]); o.y = cvt_pk_bf16(v[2], v[3]); o.z = cvt_pk_bf16(v[4], v[5]); o.w = cvt_pk_bf16(v[6], v[7]);
            *(u32x4*)(DFTC + (size_t)k * 512 + col0) = o; }
        for (int idx = gtid; idx < 2 * 512 * 256; idx += ngt) { const int j = idx >> 17, n = (idx >> 8) & 511, k = idx & 255; const int cs = n >> 8, g = (n >> 6) & 3, d = n & 63, g2 = k >> 6, c = k & 63;
            float s = 0.f;
            if (g2 == g) { const float* wf = a.inp(I_FNETW) + ((size_t)(j * 4 + g) * 64) * 64 + d;
                for (int c2 = 0; c2 < 64; ++c2) { const int m = (c * c2) & 63; s += (cs ? -ctab[(m * 64 + 1024) & 4095] : ctab[m * 64]) * wf[c2 * 64]; }
                s *= 8.0f; }
            ((bf16_t*)(wsl + WS_WF))[idx] = (bf16_t)(cvt_pk_bf16(s, 0.f) & 0xffffu); }
        for (int idx = gtid; idx < 4096 * 16; idx += ngt) { float cs, sn; rope_cs<8>(idx >> 4, idx & 15, cs, sn); ((f32x2v*)(wsl + WS_ROPE_E))[idx] = (f32x2v){cs, sn}; }
        for (int idx = gtid; idx < 4096 * 32; idx += ngt) { float cs, sn; rope_cs<16>(idx >> 5, idx & 31, cs, sn); ((f32x2v*)(wsl + WS_ROPE_O))[idx] = (f32x2v){cs, sn}; }
        for (int idx = gtid; idx < 2 * 256 * 256; idx += ngt) { const int j = idx >> 16, n = (idx >> 8) & 255, k = idx & 255; const int g = n >> 6, d = n & 63, g2 = k >> 6, c = k & 63;
            float s = 0.f; if (g2 == g) s = a.inp(I_POOLW)[((size_t)(j * 4 + g) * 64 + c) * 64 + d] * a.inp(I_POOLS)[j * 256 + n];
            ((bf16_t*)(wsl + WS_WP))[idx] = (bf16_t)(cvt_pk_bf16(s, 0.f) & 0xffffu); }
        __syncthreads(); } }
#endif
    PHASE_END

    for (int layer = 0; layer < 4; ++layer) {
        const int j = layer >> 1; const bool even = !(layer & 1); const bool ctx_out = layer < 3;
        layer_ = layer;

        PHASE_BEGIN
#ifndef SKIP_NORM
            { REPLOOP(REP_NORM)
            norm_pass(xin, cin, a.inp(I_N1G) + layer * DM, mods_l, 0, 1, U, false, false, gw, ngw, lane); }
#endif
        PHASE_END

        PHASE_BEGIN
#ifndef SKIP_GIN
            { REPLOOP(REP_GIN) {
            if (even) { pg8::Gemm g{U, (const bf16_t*)(wsl + WS_WINE) + (size_t)j * 768 * DM, DM, DM, DM};
                pg8::Order<pg8::MapStd> S; S.init(T / 256, 3, G, bx, pg8::MapStd{0}); pg8::EpiBf16Ckv E{Hb, 768}; pg8::gemm_phase(lds, g, S, E); }
            else { pg8::Gemm g{U, (const bf16_t*)(wsl + WS_WINO) + (size_t)j * 1536 * DM, DM, DM, DM};
                pg8::Order<pg8::MapStd> S; S.init(T / 256, 6, G, bx, pg8::MapStd{0}); pg8::EpiBf16 E{Hb, 1536, Hb, 1536}; pg8::gemm_phase(lds, g, S, E); }
            } }
#endif
        PHASE_END

        if (even) {
            PHASE_BEGIN
#ifndef SKIP_G3
                { REPLOOP(REP_G3) {
                { pg8::Gemm g{Hb, (const bf16_t*)(wsl + WS_WUQ) + (size_t)j * 1536 * 256, 768, 256, 256};
                  pg8::Order<pg8::MapStd> S; S.init(T / 256, 6, G, bx, pg8::MapStd{0}); pg8::EpiBf16 E{Qb, 1536, Qb, 1536}; pg8::gemm_phase(lds, g, S, E); }
                { pg8::Gemm g{Hb + 256, (const bf16_t*)(wsl + WS_WUKV) + (size_t)j * 1536 * 128, 768, 128, 128};
                  pg8::Order<pg8::MapStd> S; S.init(T / 256, 6, G, bx, pg8::MapStd{0}); pg8::EpiBf16 E{KVb, 1536, KVb, 1536}; pg8::gemm_phase(lds, g, S, E); }
                { pg8::Gemm g{(const bf16_t*)(wsl + WS_WF) + (size_t)j * 512 * 256, Hb + 416, 256, 768, 256};
                  pg8::Order<pg8::MapZ> S; S.init(2, T / 256, G, bx, pg8::MapZ{}); pg8::EpiBf16 E{ZL, 8192, ZC, 512}; pg8::gemm_phase(lds, g, S, E); }
                } }
#endif
            PHASE_END
            PHASE_BEGIN
#ifndef SKIP_EWE
                ew_even(a, j, gw, ngw, lane);
                z_fold(a, lds, gw, ngw, wave, lane);
#endif
            PHASE_END
            PHASE_BEGIN
#ifndef SKIP_ATTE
                const bf16_t* Kb = (const bf16_t*)(wsl + WS_U);
                const int nu = 3072 + (ctx_out ? 192 : 0);
                { REPLOOP(REP_ATTE)
                for (int uid = vcu; uid < nu; uid += G) {
                    if (uid < 3072) { const int bh = uid >> 4, qb = uid & 15, b = bh / 12, h = bh % 12; const size_t base = (size_t)b * TB, qrow = base + NCTX + qb * 256;
                        attn_unit<96, false>(lds, Qb + qrow * 1536 + h * 128, 1536, Kb + base * 1152 + h * 96, 1152, KVb + base * 1536 + h * 128 + 64, 1536, MIX + qrow * DM + h * 64, 68, 0, 0, qb * 256, -1e30f, false, a.inp(I_QG) + j * 96, (const f32x2v*)(wsl + WS_ROPE_E), true, (const float*)(wsl + WS_RQ) + qrow); }
                    else { const int bh = uid - 3072, b = bh / 12, h = bh % 12; const size_t base = (size_t)b * TB;
                        attn_unit<96, false>(lds, Qb + base * 1536 + h * 128, 1536, Kb + base * 1152 + h * 96, 1152, KVb + base * 1536 + h * 128 + 64, 1536, MIX + base * DM + h * 64, 4, 0, 0, 0, -1e30f, false, a.inp(I_QG) + j * 96, (const f32x2v*)(wsl + WS_ROPE_E), false, (const float*)(wsl + WS_RQ) + base); }
                } }
#ifndef SKIP_ATTE_G
                { REPLOOP(REP_FNET) {
                { pg8::Gemm g{DFTL, (const bf16_t*)(wsl + WS_ZF), 4096, 4096, 4096};
                  pg8::Order<pg8::MapFnetL> S; S.init(256, 1, G, bx, pg8::MapFnetL{}); pg8::EpiBf16 E{MIX, DM, MIX, DM}; pg8::gemm_phase(lds, g, S, E); }
                if (ctx_out) { pg8::Gemm g{DFTC, ZC, 512, 512, 512};
                  pg8::Order<pg8::MapFnetC> S; S.init(16, 1, G, bx, pg8::MapFnetC{}); pg8::EpiBf16 E{MIX, DM, MIX, DM}; pg8::gemm_phase(lds, g, S, E); }
                } }
#endif
#endif
            PHASE_END
        } else {
            PHASE_BEGIN
#ifndef SKIP_EWO
                ew_odd(a, j, gw, ngw, lane);
#endif
            PHASE_END
            PHASE_BEGIN
#ifndef SKIP_ATTO
                const float* sink = a.inp(I_SINK) + j * 12;
                const int nu = 3072 + (ctx_out ? 192 : 0);
                { REPLOOP(REP_ATTO)
                for (int uid = vcu; uid < nu; uid += G) {
                    if (uid < 3072) { const int bh = uid >> 4, qb = uid & 15, b = bh / 12, h = bh % 12, kvh = h / 3; const size_t base = (size_t)b * TB, qrow = base + NCTX + qb * 256;
                        int lt0 = qb * 4 - 2, lt1 = qb * 4 + 6; if (lt0 < 0) lt0 = 0; if (lt1 > 64) lt1 = 64;
                        attn_unit<64, true>(lds, Hb + qrow * 1536 + h * 64, 1536, Hb + base * 1536 + 768 + kvh * 64, 1536, Hb + base * 1536 + 1024 + kvh * 64, 1536, MIX + qrow * DM + h * 64,
                                            4, 4 + lt0, 4 + lt1, qb * 256, sink[h] * LOG2E, true, a.inp(I_WQG) + j * 64, (const f32x2v*)(wsl + WS_ROPE_O), true); }
                    else { const int bh = uid - 3072, b = bh / 12, h = bh % 12, kvh = h / 3; const size_t base = (size_t)b * TB;
                        attn_unit<64, true>(lds, Hb + base * 1536 + h * 64, 1536, Hb + base * 1536 + 768 + kvh * 64, 1536, Hb + base * 1536 + 1024 + kvh * 64, 1536, MIX + base * DM + h * 64,
                                            4, 0, 0, 0, sink[h] * LOG2E, true, a.inp(I_WQG) + j * 64, (const f32x2v*)(wsl + WS_ROPE_O), false); }
                } }
                { pg8::Gemm g{POOL, (const bf16_t*)(wsl + WS_WP) + (size_t)j * 256 * 256, 256, 256, 256};
                  pg8::Order<pg8::MapStd> S; S.init(T / 256, 1, G, bx, pg8::MapStd{768}); pg8::EpiBf16 E{MIX, DM, MIX, DM}; pg8::gemm_phase(lds, g, S, E); }
#endif
            PHASE_END
        }

        PHASE_BEGIN
#ifndef SKIP_WOUT
            pg8::Gemm g{MIX, (const bf16_t*)(wsl + (even ? WS_WOUTE : WS_WOUTO)) + (size_t)j * DM * DM, DM, DM, DM};
            pg8::Order<pg8::MapRes> S; S.init(ctx_out ? 272 : 256, 4, G, bx, pg8::MapRes{ctx_out ? 1 : 0});
            { REPLOOP(REP_WOUT) { pg8::EpiRes E{rep_ ? (const float*)a.out : xin, a.out, rep_ ? (const float*)hctx : cin, hctx, mods_l, 2, rep_ ? 0.f : 1.f}; pg8::gemm_phase(lds, g, S, E); } }
            if (layer == 0) {
                const int nfree = (G == 256) ? 192 : G, first = (G == 256) ? 64 : 0;
                if (bx >= first) ffn_weights(a, 0, scr, (bx - first) * 8 + wave, nfree * 8, lane);
            }
#endif
        PHASE_END

        PHASE_BEGIN
#ifndef SKIP_NORM2
            { REPLOOP(REP_NORM)
            norm_pass(a.out, hctx, a.inp(I_N2G) + layer * DM, mods_l, 3, 4, U, true, !ctx_out, gw, ngw, lane); }
#endif
        PHASE_END

        PHASE_BEGIN
#ifndef SKIP_UP
            pg8::Gemm g{U, (const bf16_t*)(wsl + WS_WUP), DM, DM, DM};
            pg8::Order<pg8::MapUp> S; S.init(ctx_out ? 275 : 259, 22, G, bx, pg8::MapUp{ctx_out ? 1 : 0});
            pg8::EpiUp E{HID, a.inp(I_CONVW) + (size_t)layer * 3 * 2 * DFF, a.inp(I_CONVB) + (size_t)layer * 2 * DFF}; { REPLOOP(REP_UP) pg8::gemm_phase(lds, g, S, E); }
#endif
        PHASE_END

        PHASE_BEGIN
#ifndef SKIP_DN
            pg8::Gemm g{HID, (const bf16_t*)(wsl + ((layer & 1) ? WS_WDN2 : WS_WDN)), DFF, DFF, DFF};
            pg8::Order<pg8::MapRes> S; S.init(ctx_out ? 272 : 256, 4, G, bx, pg8::MapRes{ctx_out ? 1 : 0});
            { REPLOOP(REP_DN) { pg8::EpiRes E{a.out, a.out, hctx, hctx, mods_l, 5, rep_ ? 0.f : 1.f}; pg8::gemm_phase(lds, g, S, E); } }
            if (layer < 3) {
                const int nfree = (ctx_out && G == 256) ? 192 : G, first = (ctx_out && G == 256) ? 64 : 0;
                if (bx >= first) ffn_weights(a, layer + 1, scr, (bx - first) * 8 + wave, nfree * 8, lane);
                if (layer == 0 && bx >= first) mixer_weights(a, 1, scr, (bx - first) * 8 + wave, nfree * 8, lane);
            }
#endif
        PHASE_END
    }
#undef PHASE_BEGIN
#undef PHASE_END
#undef U
#undef MIX
#undef Hb
#undef Qb
#undef KVb
#undef ZL
#undef ZC
#undef HID
#undef POOL
#undef DFTL
#undef DFTC
#undef hctx
}

extern "C" void kernel_launch(void* const* d_in, const int* in_sizes, int n_in, void* d_out, int out_size, void* d_ws, size_t ws_size, hipStream_t stream) {
    static int grid = 0;
    if (grid == 0) {
        if (n_in != 28 || out_size != NB * SEQ * DM || ws_size < WS_END) { fprintf(stderr, "kernel_launch: unexpected shapes (n_in %d, out %d, ws %zu); nothing launched\n", n_in, out_size, ws_size); grid = -1; return; }
        int dev = 0, cus = 0, per_cu = 0;
        if (hipGetDevice(&dev) != hipSuccess || hipDeviceGetAttribute(&cus, hipDeviceAttributeMultiprocessorCount, dev) != hipSuccess) { grid = -1; return; }
        if (hipFuncSetAttribute((const void*)mega_fwd, hipFuncAttributeMaxDynamicSharedMemorySize, LDS_BYTES) != hipSuccess) { fprintf(stderr, "kernel_launch: hipFuncSetAttribute failed\n"); grid = -1; return; }
        if (hipOccupancyMaxActiveBlocksPerMultiprocessor(&per_cu, (const void*)mega_fwd, 512, LDS_BYTES) != hipSuccess || per_cu < 1) { fprintf(stderr, "kernel_launch: occupancy query says %d\n", per_cu); per_cu = 1; }
        (void)hipGetLastError();
        grid = cus * 1;
    }
    if (grid < 0) return;
    Args a{};
    for (int i = 0; i < 28; ++i) a.in[i] = (const float*)d_in[i];
    a.out = (float*)d_out; a.ws = (unsigned char*)d_ws; a.lo = 0; a.hi = NPHASES;
    (void)hipMemsetAsync(d_ws, 0, 16384, stream);
    void* args[] = {&a};
    hipError_t e = hipLaunchCooperativeKernel((const void*)mega_fwd, dim3(grid), dim3(512), args, LDS_BYTES, stream);
    if (e != hipSuccess) {
        fprintf(stderr, "kernel_launch: cooperative launch failed: %s (grid %d); falling back to one launch per phase\n", hipGetErrorString(e), grid);
        (void)hipGetLastError();
        for (int p = 0; p < NPHASES; ++p) { a.lo = p; a.hi = p + 1; hipLaunchKernelGGL(mega_fwd, dim3(grid), dim3(512), LDS_BYTES, stream, a); }
    }
}
```
